# Optimizing an MI355X kernel written in HIP

```python
import math
import jax, jax.numpy as jnp
from jax import lax
import numpy as np

D_MODEL = 1024
BATCH = 4
SEQ = 4096
DEPTH = 4

HEAD_DIM = 64
NORM_EPS = 1e-6
GMLP_GROUPS = 8
GMLP_WIDTH = GMLP_GROUPS * HEAD_DIM
GMLP_CHUNK = 128
FOX_HEADS = 8
FOX_WIDTH = FOX_HEADS * HEAD_DIM
FOX_Q_BLOCK = 128
MOBA_HEADS = 8
MOBA_WIDTH = MOBA_HEADS * HEAD_DIM
MOBA_BLOCK = 256
MOBA_TOPK = 3
MOBA_Q_CHUNK = 16
ROPE_THETA = 500000.0
ROPE_DIM = HEAD_DIM // 4
SSM_HEADS = 12
SSM_HEAD_DIM = 64
SSM_WIDTH = SSM_HEADS * SSM_HEAD_DIM
SSM_GROUPS = 2
SSM_STATE = 128
SSM_CONV = 4
SSM_CHUNK = 128
SSM_CONV_DIM = SSM_WIDTH + 2 * SSM_GROUPS * SSM_STATE
N_BRANCH = 4
D_FF = 4 * D_MODEL
IN_SPLITS = (2 * GMLP_WIDTH, 3 * FOX_WIDTH, FOX_HEADS, 3 * MOBA_WIDTH,
             SSM_WIDTH, SSM_CONV_DIM, SSM_HEADS, N_BRANCH * D_MODEL)
IN_COLS = sum(IN_SPLITS)

kernel_name = 'conditioned_hybrid_gmlp_fox_moba_ssd_trunk'


def split_cols(t, sizes):
    outs, start = [], 0
    for s in sizes:
        outs.append(t[..., start:start + s])
        start += s
    return outs


def rms_norm(x, w):
    xf = x.astype(jnp.float32)
    xn = xf * lax.rsqrt(jnp.mean(xf * xf, axis=-1, keepdims=True) + NORM_EPS)
    return xn.astype(x.dtype) * w


def layer_norm(x, w, b):
    xf = x.astype(jnp.float32)
    xc = xf - jnp.mean(xf, axis=-1, keepdims=True)
    xn = xc * lax.rsqrt(jnp.mean(xc * xc, axis=-1, keepdims=True) + NORM_EPS)
    return xn.astype(x.dtype) * w + b


def partial_rotary(x):
    S = x.shape[1]
    half = ROPE_DIM // 2
    inv_freq = ROPE_THETA ** (-jnp.arange(half, dtype=jnp.float32) / half)
    ang = jnp.arange(S, dtype=jnp.float32)[:, None] * inv_freq[None, :]
    cos = jnp.cos(ang)[None, :, None, :]
    sin = jnp.sin(ang)[None, :, None, :]
    xr = x[..., :ROPE_DIM].astype(jnp.float32)
    x1, x2 = xr[..., :half], xr[..., half:]
    rot = jnp.concatenate([x1 * cos - x2 * sin, x2 * cos + x1 * sin], axis=-1).astype(x.dtype)
    return jnp.concatenate([rot, x[..., ROPE_DIM:]], axis=-1)


def chunked_gmlp(u, v, ln_w, ln_b, w_s, b_s):
    Bn, S, _ = v.shape
    vn = layer_norm(v, ln_w, ln_b).reshape(Bn, S // GMLP_CHUNK, GMLP_CHUNK, GMLP_GROUPS, HEAD_DIM)
    causal = jnp.tril(jnp.ones((GMLP_CHUNK, GMLP_CHUNK), dtype=bool))
    ws = jnp.where(causal[None], w_s, 0.0)
    mixed = jnp.einsum('gts,bnsgc->bntgc', ws, vn) + b_s.T[None, None, :, :, None]
    return u * mixed.reshape(Bn, S, GMLP_WIDTH)


def forgetting_attention(q, k, v, f_logit, f_bias):
    Bn, S, H, Dh = q.shape
    log_f = jax.nn.log_sigmoid((f_logit + f_bias).astype(jnp.float32))
    cum = jnp.cumsum(log_f, axis=1).transpose(0, 2, 1)
    qh, kh, vh = (t.transpose(0, 2, 1, 3) for t in (q, k, v))
    scale = Dh ** -0.5
    key_pos = jnp.arange(S)

    def block(i):
        start = i * FOX_Q_BLOCK
        qb = lax.dynamic_slice_in_dim(qh, start, FOX_Q_BLOCK, axis=2)
        cq = lax.dynamic_slice_in_dim(cum, start, FOX_Q_BLOCK, axis=2)
        s = jnp.einsum('bhqd,bhkd->bhqk', qb, kh, preferred_element_type=jnp.float32) * scale
        s = s + (cq[..., :, None] - cum[..., None, :])
        q_pos = start + jnp.arange(FOX_Q_BLOCK)
        s = jnp.where(q_pos[:, None] >= key_pos[None, :], s, -jnp.inf)
        p = jax.nn.softmax(s, axis=-1).astype(v.dtype)
        return jnp.einsum('bhqk,bhkd->bhqd', p, vh)

    out = lax.map(block, jnp.arange(S // FOX_Q_BLOCK))
    return out.transpose(1, 0, 3, 2, 4).reshape(Bn, S, H * Dh)


def moba_attention(q, k, v):
    Bn, S, H, Dh = q.shape
    nb = -(-S // MOBA_BLOCK)
    pad = nb * MOBA_BLOCK - S
    topk = min(MOBA_TOPK, nb)
    qh = q.transpose(0, 2, 1, 3)
    padw = ((0, 0), (0, pad), (0, 0), (0, 0))
    kp = jnp.pad(k, padw).transpose(0, 2, 1, 3).reshape(Bn, H, nb, MOBA_BLOCK, Dh)
    vp = jnp.pad(v, padw).transpose(0, 2, 1, 3).reshape(Bn, H, nb, MOBA_BLOCK, Dh)
    k_mean = jnp.mean(kp.astype(jnp.float32), axis=3)
    scale = Dh ** -0.5
    blk = jnp.arange(nb)
    in_blk = jnp.arange(MOBA_BLOCK)
    b_idx = jnp.arange(Bn)[:, None, None, None]
    h_idx = jnp.arange(H)[None, :, None, None]

    def chunk(i):
        start = i * MOBA_Q_CHUNK
        own = start // MOBA_BLOCK
        qc = lax.dynamic_slice_in_dim(qh, start, MOBA_Q_CHUNK, axis=2)
        q_pos = start + jnp.arange(MOBA_Q_CHUNK)
        gate = jnp.einsum('bhqd,bhnd->bhqn', qc.astype(jnp.float32), k_mean)
        gate = jnp.where(blk < own, gate, -jnp.inf)
        _, sel = lax.top_k(gate, topk)
        valid = sel < own
        k_sel = kp[b_idx, h_idx, sel]
        v_sel = vp[b_idx, h_idx, sel]
        s_sel = jnp.einsum('bhqd,bhqntd->bhqnt', qc, k_sel, preferred_element_type=jnp.float32) * scale
        s_sel = jnp.where(valid[..., None], s_sel, -jnp.inf).reshape(Bn, H, MOBA_Q_CHUNK, topk * MOBA_BLOCK)
        k_own = lax.dynamic_index_in_dim(kp, own, axis=2, keepdims=False)
        v_own = lax.dynamic_index_in_dim(vp, own, axis=2, keepdims=False)
        s_own = jnp.einsum('bhqd,bhtd->bhqt', qc, k_own, preferred_element_type=jnp.float32) * scale
        key_pos = own * MOBA_BLOCK + in_blk
        s_own = jnp.where(key_pos[None, :] <= q_pos[:, None], s_own, -jnp.inf)
        p = jax.nn.softmax(jnp.concatenate([s_sel, s_own], axis=-1), axis=-1).astype(v.dtype)
        p_sel = p[..., :topk * MOBA_BLOCK].reshape(Bn, H, MOBA_Q_CHUNK, topk, MOBA_BLOCK)
        p_own = p[..., topk * MOBA_BLOCK:]
        return (jnp.einsum('bhqnt,bhqntd->bhqd', p_sel, v_sel)
                + jnp.einsum('bhqt,bhtd->bhqd', p_own, v_own))

    out = lax.map(chunk, jnp.arange(S // MOBA_Q_CHUNK))
    return out.transpose(1, 0, 3, 2, 4).reshape(Bn, S, H * Dh)


def causal_depthwise_conv(x, w, b):
    K, C = w.shape
    y = lax.conv_general_dilated(x, w[:, None, :].astype(x.dtype), window_strides=(1,),
                                 padding=[(K - 1, 0)], dimension_numbers=('NWC', 'WIO', 'NWC'),
                                 feature_group_count=C)
    return y + b


def segsum(a):
    T = a.shape[-1]
    cs = jnp.cumsum(a, axis=-1)
    d = cs[..., :, None] - cs[..., None, :]
    return jnp.where(jnp.tril(jnp.ones((T, T), dtype=bool)), d, -jnp.inf)


def ssd_chunked_scan(x, dt, a, bm, cm):
    Bn, S, H, P = x.shape
    G, N = bm.shape[-2:]
    R = H // G
    nc, L = S // SSM_CHUNK, SSM_CHUNK
    xdt = (x.astype(jnp.float32) * dt[..., None]).reshape(Bn, nc, L, G, R, P)
    adt = (dt * a).reshape(Bn, nc, L, G, R).transpose(0, 3, 4, 1, 2)
    bc = bm.astype(jnp.float32).reshape(Bn, nc, L, G, N)
    cc = cm.astype(jnp.float32).reshape(Bn, nc, L, G, N)
    a_cum = jnp.cumsum(adt, axis=-1)
    decay_in = jnp.exp(segsum(adt))
    y_diag = jnp.einsum('bclgn,bcsgn,bgrcls,bcsgrp->bclgrp', cc, bc, decay_in, xdt)
    decay_to_end = jnp.exp(a_cum[..., -1:] - a_cum)
    states = jnp.einsum('bcsgn,bgrcs,bcsgrp->bcgrpn', bc, decay_to_end, xdt)
    chunk_decay = jnp.exp(a_cum[..., -1])

    def step(h, inp):
        st, dec = inp
        return h * dec[..., None, None] + st, h

    h0 = jnp.zeros((Bn, G, R, P, N), jnp.float32)
    _, prev = lax.scan(step, h0, (states.transpose(1, 0, 2, 3, 4, 5), chunk_decay.transpose(3, 0, 1, 2)))
    y_off = jnp.einsum('bclgn,cbgrpn,bgrcl->bclgrp', cc, prev, jnp.exp(a_cum))
    return (y_diag + y_off).reshape(Bn, S, H, P)


def mamba2_mixer(z, xbc, dt_raw, conv_w, conv_b, dt_bias, a_log, d_skip, norm_w):
    Bn, S, _ = z.shape
    xbc = jax.nn.silu(causal_depthwise_conv(xbc, conv_w, conv_b))
    xs, bm, cm = split_cols(xbc, (SSM_WIDTH, SSM_GROUPS * SSM_STATE, SSM_GROUPS * SSM_STATE))
    xs = xs.reshape(Bn, S, SSM_HEADS, SSM_HEAD_DIM)
    bm = bm.reshape(Bn, S, SSM_GROUPS, SSM_STATE)
    cm = cm.reshape(Bn, S, SSM_GROUPS, SSM_STATE)
    dt = jax.nn.softplus((dt_raw + dt_bias).astype(jnp.float32))
    a = -jnp.exp(a_log.astype(jnp.float32))
    y = ssd_chunked_scan(xs, dt, a, bm, cm) + d_skip.astype(jnp.float32)[:, None] * xs.astype(jnp.float32)
    y = y.reshape(Bn, S, SSM_WIDTH).astype(z.dtype) * jax.nn.silu(z)
    yg = rms_norm(y.reshape(Bn, S, SSM_GROUPS, SSM_WIDTH // SSM_GROUPS),
                  norm_w.reshape(SSM_GROUPS, SSM_WIDTH // SSM_GROUPS))
    return yg.reshape(Bn, S, SSM_WIDTH)


def hybrid_mixer(h, w_in, gmlp_ln_w, gmlp_ln_b, gmlp_ws, gmlp_bs, fox_f_bias,
                 ssm_conv_w, ssm_conv_b, ssm_dt_bias, ssm_a_log, ssm_d, ssm_norm_w,
                 w_branch_a, w_branch_b, w_branch_c, w_branch_d, w_out):
    Bn, S, _ = h.shape
    proj = h @ w_in
    uv, fox_qkv, fox_f, moba_qkv, ssm_z, ssm_xbc, ssm_dt, gate_logits = split_cols(proj, IN_SPLITS)
    u, v = jnp.split(jax.nn.gelu(uv), 2, axis=-1)
    y_a = chunked_gmlp(u, v, gmlp_ln_w, gmlp_ln_b, gmlp_ws, gmlp_bs)
    qf, kf, vf = [t.reshape(Bn, S, FOX_HEADS, HEAD_DIM) for t in jnp.split(fox_qkv, 3, axis=-1)]
    y_b = forgetting_attention(qf, kf, vf, fox_f, fox_f_bias)
    qm, km, vm = [t.reshape(Bn, S, MOBA_HEADS, HEAD_DIM) for t in jnp.split(moba_qkv, 3, axis=-1)]
    y_c = moba_attention(partial_rotary(qm), partial_rotary(km), vm)
    y_d = mamba2_mixer(ssm_z, ssm_xbc, ssm_dt, ssm_conv_w, ssm_conv_b, ssm_dt_bias,
                       ssm_a_log, ssm_d, ssm_norm_w)
    g = jax.nn.sigmoid(gate_logits).reshape(Bn, S, N_BRANCH, D_MODEL)
    merged = (g[:, :, 0] * (y_a @ w_branch_a) + g[:, :, 1] * (y_b @ w_branch_b)
              + g[:, :, 2] * (y_c @ w_branch_c) + g[:, :, 3] * (y_d @ w_branch_d))
    return merged @ w_out


def setup_inputs(seed: int = 0) -> dict:
    key = jax.random.key(seed)
    ks = jax.random.split(key, 28)
    L, D = DEPTH, D_MODEL
    f32 = jnp.float32

    def nrm(k, shape, scale):
        return jax.random.normal(k, shape, f32) * scale

    dt_init = jnp.exp(jax.random.uniform(ks[12], (L, SSM_HEADS), f32, math.log(1e-3), math.log(1e-1)))
    return {
        'x': nrm(ks[0], (BATCH, SEQ, D), 1.0),
        'c': nrm(ks[1], (BATCH, D), 1.0),
        'ada_w': nrm(ks[2], (L, D, 6 * D), 0.5 * D ** -0.5),
        'ada_b': nrm(ks[3], (L, 6 * D), 0.02),
        'norm_mix_w': 1.0 + nrm(ks[4], (L, D), 0.02),
        'w_in': nrm(ks[5], (L, D, IN_COLS), D ** -0.5),
        'gmlp_ln_w': 1.0 + nrm(ks[6], (L, GMLP_WIDTH), 0.02),
        'gmlp_ln_b': nrm(ks[7], (L, GMLP_WIDTH), 0.02),
        'gmlp_ws': nrm(ks[8], (L, GMLP_GROUPS, GMLP_CHUNK, GMLP_CHUNK), GMLP_CHUNK ** -0.5),
        'gmlp_bs': 1.0 + nrm(ks[9], (L, GMLP_GROUPS, GMLP_CHUNK), 0.1),
        'fox_f_bias': jax.random.uniform(ks[10], (L, FOX_HEADS), f32, 1.0, 6.0),
        'ssm_conv_w': nrm(ks[11], (L, SSM_CONV, SSM_CONV_DIM), SSM_CONV ** -0.5),
        'ssm_conv_b': nrm(ks[13], (L, SSM_CONV_DIM), 0.02),
        'ssm_dt_bias': dt_init + jnp.log(-jnp.expm1(-dt_init)),
        'ssm_a_log': jnp.log(jax.random.uniform(ks[14], (L, SSM_HEADS), f32, 1.0, 16.0)),
        'ssm_d': 1.0 + nrm(ks[15], (L, SSM_HEADS), 0.1),
        'ssm_norm_w': 1.0 + nrm(ks[16], (L, SSM_WIDTH), 0.02),
        'w_branch_a': nrm(ks[17], (L, GMLP_WIDTH, D), GMLP_WIDTH ** -0.5),
        'w_branch_b': nrm(ks[18], (L, FOX_WIDTH, D), FOX_WIDTH ** -0.5),
        'w_branch_c': nrm(ks[19], (L, MOBA_WIDTH, D), MOBA_WIDTH ** -0.5),
        'w_branch_d': nrm(ks[20], (L, SSM_WIDTH, D), SSM_WIDTH ** -0.5),
        'w_out': nrm(ks[21], (L, D, D), D ** -0.5),
        'norm_mlp_w': 1.0 + nrm(ks[22], (L, D), 0.02),
        'mlp_w1': nrm(ks[23], (L, D, D_FF), D ** -0.5),
        'mlp_w2': nrm(ks[24], (L, D_FF, D), D_FF ** -0.5),
        'final_norm_w': 1.0 + nrm(ks[25], (D,), 0.02),
    }


def reference(x, c, ada_w, ada_b, norm_mix_w, w_in, gmlp_ln_w, gmlp_ln_b, gmlp_ws, gmlp_bs,
              fox_f_bias, ssm_conv_w, ssm_conv_b, ssm_dt_bias, ssm_a_log, ssm_d, ssm_norm_w,
              w_branch_a, w_branch_b, w_branch_c, w_branch_d, w_out, norm_mlp_w, mlp_w1, mlp_w2,
              final_norm_w):
    c_act = jax.nn.silu(c)
    for l in range(DEPTH):
        mod = c_act @ ada_w[l] + ada_b[l]
        sh1, sc1, g1, sh2, sc2, g2 = [m[:, None, :] for m in jnp.split(mod, 6, axis=-1)]
        h = rms_norm(x, norm_mix_w[l]) * (1.0 + sc1) + sh1
        x = x + g1 * hybrid_mixer(h, w_in[l], gmlp_ln_w[l], gmlp_ln_b[l], gmlp_ws[l], gmlp_bs[l],
                                  fox_f_bias[l], ssm_conv_w[l], ssm_conv_b[l], ssm_dt_bias[l],
                                  ssm_a_log[l], ssm_d[l], ssm_norm_w[l], w_branch_a[l],
                                  w_branch_b[l], w_branch_c[l], w_branch_d[l], w_out[l])
        h = rms_norm(x, norm_mlp_w[l]) * (1.0 + sc2) + sh2
        x = x + g2 * (jnp.square(jax.nn.relu(h @ mlp_w1[l])) @ mlp_w2[l])
    return rms_norm(x, final_norm_w)
```

```cpp
#include <hip/hip_runtime.h>
#include <hip/hip_cooperative_groups.h>
#include <cstdio>
#include <cstdint>
#include <cmath>
namespace cg = cooperative_groups;
namespace pg8 {
#define PG8_LAS __attribute__((address_space(3)))
typedef unsigned short bf16_t;
typedef short bf16x8 __attribute__((ext_vector_type(8)));
typedef float f32x4 __attribute__((ext_vector_type(4)));
typedef unsigned u32x4 __attribute__((ext_vector_type(4)));
constexpr int BM = 256, BK = 64, HALF = 128, HTB = HALF * BK * 2  , STAGE_BYTES = 8 * HTB, NXCD = 8, WGM = 8;

__host__ __device__ __forceinline__ int lds_byte(int r, int c) { const int st = (r >> 4) * 2 + (c >> 5), rr = r & 15, cc = c & 31, ob = rr * 64 + cc * 2; return st * 1024 + (ob ^ (((ob >> 9) & 1) << 5)); }
__host__ __device__ __forceinline__ void stage_rc(int b, int& R, int& C) { const int st = b / 1024, sb = b % 1024, swz = sb ^ (((sb >> 9) & 1) << 5); R = (st >> 1) * 16 + swz / 64; C = (st & 1) * 32 + (swz % 64) / 2; }
__host__ __device__ __forceinline__ int perm32(int rho) { const int n = rho >> 4, i = rho & 15; return 8 * (i >> 2) + 4 * n + (i & 3); }

struct Unit { int pm, pn; };
struct Gemm { const bf16_t* A; const bf16_t* Bt; int M, N, K, lda; };

struct StaticOrder {
    int nM, nN, nwg, G, c;
    __host__ __device__ void init(int M, int N, int G_, int c_) { nM = M / BM; nN = N / BM; nwg = nM * nN; G = G_; c = c_; }
    __host__ __device__ bool next(int i, Unit& u) const {
        const long L = (long)i * G + c; if (L >= nwg) return false;
        int wgid = (int)L; { const int q = nwg / NXCD, r = nwg % NXCD, xcd = wgid % NXCD, off = wgid / NXCD; wgid = (xcd < r ? xcd * (q + 1) : r * (q + 1) + (xcd - r) * q) + off; }
        const int nig = WGM * nN, gid = wgid / nig, fm = gid * WGM, gsz = (nM - fm) < WGM ? (nM - fm) : WGM;
        u.pm = fm + ((wgid % nig) % gsz); u.pn = (wgid % nig) / gsz; return true;
    }
    __device__ __forceinline__ void a_ready(const Unit&) const {}
    __device__ __forceinline__ void done(const Unit&) const {}
};


template <class Epi, class Sched, bool ALIGN_EPI = false, bool SP2 = false>
__device__ __forceinline__ void gemm_phase(PG8_LAS unsigned char* lds, const Gemm g, const Sched& S, const Epi& E) {
    const int tid = threadIdx.x, wid = __builtin_amdgcn_readfirstlane(tid >> 6), lane = tid & 63, wr = wid >> 2, wc = wid & 3, fr = lane & 15, fq = lane >> 4;
    const int K = g.K, nt = K / BK;
    unsigned voffA[2], voffB[2];
#pragma unroll
    for (int i = 0; i < 2; ++i) { int R, C; stage_rc(tid * 16 + i * 8192, R, C); const int Rb = Epi::PERM ? ((R & ~31) + perm32(R & 31)) : R;
        voffA[i] = (unsigned)(R * g.lda + C) * 2u; voffB[i] = (unsigned)(Rb * K + C) * 2u; }
    const size_t kstep = (size_t)(BK * 2);
    const size_t hstepB = (size_t)HALF * K * 2, hstepA = (size_t)HALF * g.lda * 2;
    const size_t tstepB = 2 * hstepB, tstepA = 2 * hstepA;
    const unsigned ldsw = (unsigned)wid * 1024u;
    const int aoff = lds_byte(wr * 64 + fr, fq * 8), boff = lds_byte(wc * 32 + fr, fq * 8);
#define PG8_SA(b, h) (((b) * 2 + (h)) * HTB)
#define PG8_SB(b, h) ((4 + (b) * 2 + (h)) * HTB)
#define PG8_STAGE(bufoff, gbase, voff) do { _Pragma("unroll") for (int _i = 0; _i < 2; ++_i) \
        __builtin_amdgcn_global_load_lds((const unsigned*)((const char*)(gbase) + (voff)[_i]), (PG8_LAS unsigned*)(lds + (bufoff) + ldsw + _i * 8192), 16, 0, 0); } while (0)
#define PG8_LDA(dst, b, h) do { _Pragma("unroll") for (int m = 0; m < 4; ++m) _Pragma("unroll") for (int k = 0; k < 2; ++k) dst[m][k] = *(const PG8_LAS bf16x8*)(lds + PG8_SA(b, h) + aoff + m * 2048 + k * 1024); } while (0)
#define PG8_LDB(dst, b, h) do { _Pragma("unroll") for (int n = 0; n < 2; ++n) _Pragma("unroll") for (int k = 0; k < 2; ++k) dst[n][k] = *(const PG8_LAS bf16x8*)(lds + PG8_SB(b, h) + boff + n * 2048 + k * 1024); } while (0)
#define PG8_MMA(ai, bj, At, Bt) do { __builtin_amdgcn_s_setprio(1); _Pragma("unroll") for (int m = 0; m < 4; ++m) _Pragma("unroll") for (int n = 0; n < 2; ++n) _Pragma("unroll") for (int k = 0; k < 2; ++k) \
        acc[ai][bj][m][n] = __builtin_amdgcn_mfma_f32_16x16x32_bf16(Bt[n][k], At[m][k], acc[ai][bj][m][n], 0, 0, 0); __builtin_amdgcn_s_setprio(0); } while (0)
#define PG8_WAIT_V(n) asm volatile("s_waitcnt vmcnt(" #n ")" ::: "memory")
#define PG8_WAIT_L(n) asm volatile("s_waitcnt lgkmcnt(" #n ")" ::: "memory")
#define PG8_BAR __builtin_amdgcn_s_barrier()
#define PG8_SCHED __builtin_amdgcn_sched_barrier(0)
    Unit cur, nxt; int ui = 0;
    if (!S.next(0, cur)) return;
    f32x4 acc[2][2][4][2];
#pragma unroll
    for (int a = 0; a < 2; ++a)
#pragma unroll
        for (int b = 0; b < 2; ++b)
#pragma unroll
            for (int m = 0; m < 4; ++m)
#pragma unroll
                for (int n = 0; n < 2; ++n) acc[a][b][m][n] = (f32x4){0.f, 0.f, 0.f, 0.f};
    bf16x8 At[4][2], B0[2][2], B1[2][2];
    const char* cA = (const char*)g.A + (size_t)cur.pm * tstepA; const char* cB = (const char*)g.Bt + (size_t)cur.pn * tstepB;
    S.a_ready(cur);
    if constexpr (SP2) {
        PG8_STAGE(PG8_SB(0, 0), cB, voffB); PG8_STAGE(PG8_SB(0, 1), cB + hstepB, voffB); PG8_STAGE(PG8_SA(0, 0), cA, voffA); PG8_STAGE(PG8_SA(0, 1), cA + hstepA, voffA);
        if (wr == 1) PG8_BAR;
        PG8_WAIT_V(2); PG8_BAR;
        PG8_STAGE(PG8_SB(1, 0), cB + kstep, voffB); PG8_STAGE(PG8_SA(1, 0), cA + kstep, voffA); PG8_STAGE(PG8_SB(1, 1), cB + hstepB + kstep, voffB);
        PG8_WAIT_V(6); PG8_BAR;
    } else {
        PG8_STAGE(PG8_SB(0, 0), cB, voffB); PG8_STAGE(PG8_SA(0, 0), cA, voffA); PG8_STAGE(PG8_SB(0, 1), cB + hstepB, voffB); PG8_STAGE(PG8_SA(0, 1), cA + hstepA, voffA);
        if (wr == 1) PG8_BAR;
        PG8_WAIT_V(4); PG8_BAR;
        PG8_STAGE(PG8_SB(1, 0), cB + kstep, voffB); PG8_STAGE(PG8_SA(1, 0), cA + kstep, voffA); PG8_STAGE(PG8_SB(1, 1), cB + hstepB + kstep, voffB);
        PG8_WAIT_V(6); PG8_BAR;
    }
    for (;;) {
        const bool has_next = S.next(ui + 1, nxt);
        const char* nA = has_next ? (const char*)g.A + (size_t)nxt.pm * tstepA : cA; const char* nB = has_next ? (const char*)g.Bt + (size_t)nxt.pn * tstepB : cB;
        for (int t = 0; t < nt; t += 2) {
            const bool last = (t == nt - 2);
            const char* a1 = cA + (size_t)(t + 1) * kstep;
            const char* a2 = last ? nA : cA + (size_t)(t + 2) * kstep; const char* b2 = last ? nB : cB + (size_t)(t + 2) * kstep;
            const char* a3 = a2 + kstep; const char* b3 = b2 + kstep;
            if (last && has_next) S.a_ready(nxt);
            if constexpr (SP2) {
            PG8_LDB(B0, 0, 0); PG8_LDB(B1, 0, 1); PG8_SCHED; PG8_LDA(At, 0, 0); PG8_STAGE(PG8_SA(1, 1), a1 + hstepA, voffA);
            PG8_WAIT_V(8); PG8_WAIT_L(0); PG8_BAR; PG8_MMA(0, 0, At, B0); PG8_MMA(0, 1, At, B1); PG8_BAR; PG8_SCHED;
            PG8_LDA(At, 0, 1); PG8_STAGE(PG8_SB(0, 0), b2, voffB); PG8_STAGE(PG8_SB(0, 1), b2 + hstepB, voffB); PG8_STAGE(PG8_SA(0, 0), a2, voffA);
            PG8_WAIT_V(8); PG8_WAIT_L(0); PG8_BAR; PG8_MMA(1, 0, At, B0); PG8_MMA(1, 1, At, B1); PG8_BAR; PG8_SCHED;
            PG8_LDB(B0, 1, 0); PG8_LDB(B1, 1, 1); PG8_SCHED; PG8_LDA(At, 1, 0); PG8_STAGE(PG8_SA(0, 1), a2 + hstepA, voffA);
            PG8_WAIT_V(8); PG8_WAIT_L(0); PG8_BAR; PG8_MMA(0, 0, At, B0); PG8_MMA(0, 1, At, B1); PG8_BAR; PG8_SCHED;
            PG8_LDA(At, 1, 1); PG8_STAGE(PG8_SB(1, 0), b3, voffB); PG8_STAGE(PG8_SB(1, 1), b3 + hstepB, voffB); PG8_STAGE(PG8_SA(1, 0), a3, voffA);
            PG8_WAIT_V(8); PG8_WAIT_L(0); PG8_BAR; PG8_MMA(1, 0, At, B0); PG8_MMA(1, 1, At, B1); PG8_BAR; PG8_SCHED;
            } else {
            PG8_LDB(B0, 0, 0); PG8_SCHED; PG8_LDA(At, 0, 0); PG8_STAGE(PG8_SA(1, 1), a1 + hstepA, voffA);
            PG8_WAIT_L(8); PG8_BAR; PG8_WAIT_L(0); PG8_MMA(0, 0, At, B0); PG8_BAR; PG8_SCHED;
            PG8_LDB(B1, 0, 1); PG8_STAGE(PG8_SB(0, 0), b2, voffB);
            PG8_BAR; PG8_WAIT_L(0); PG8_MMA(0, 1, At, B1); PG8_BAR;
            PG8_LDA(At, 0, 1); PG8_STAGE(PG8_SA(0, 0), a2, voffA);
            PG8_BAR; PG8_WAIT_L(0); PG8_MMA(1, 0, At, B0); PG8_BAR; PG8_SCHED;
            PG8_STAGE(PG8_SB(0, 1), b2 + hstepB, voffB);
            PG8_WAIT_V(6); PG8_BAR; PG8_MMA(1, 1, At, B1); PG8_BAR;
            PG8_LDB(B0, 1, 0); PG8_SCHED; PG8_LDA(At, 1, 0); PG8_STAGE(PG8_SA(0, 1), a2 + hstepA, voffA);
            PG8_WAIT_L(8); PG8_BAR; PG8_WAIT_L(0); PG8_MMA(0, 0, At, B0); PG8_BAR; PG8_SCHED;
            PG8_LDB(B1, 1, 1); PG8_STAGE(PG8_SB(1, 0), b3, voffB);
            PG8_BAR; PG8_WAIT_L(0); PG8_MMA(0, 1, At, B1); PG8_BAR;
            PG8_LDA(At, 1, 1); PG8_STAGE(PG8_SA(1, 0), a3, voffA);
            PG8_BAR; PG8_WAIT_L(0); PG8_MMA(1, 0, At, B0); PG8_BAR; PG8_SCHED;
            PG8_STAGE(PG8_SB(1, 1), b3 + hstepB, voffB);
            PG8_WAIT_V(6); PG8_BAR; PG8_MMA(1, 1, At, B1); PG8_BAR;
            }
        }
        if constexpr (ALIGN_EPI) { if (wr == 0) PG8_BAR; }
        if constexpr (!Epi::AFTER_DRAIN) { E(acc, cur, wr, wc, fr, fq); S.done(cur); }
        if (!has_next) break;
#pragma unroll
        for (int a = 0; a < 2; ++a)
#pragma unroll
            for (int b = 0; b < 2; ++b)
#pragma unroll
                for (int m = 0; m < 4; ++m)
#pragma unroll
                    for (int n = 0; n < 2; ++n) acc[a][b][m][n] = (f32x4){0.f, 0.f, 0.f, 0.f};
        cur = nxt; cA = nA; cB = nB; ++ui;
        if constexpr (ALIGN_EPI) { if (wr == 1) PG8_BAR; }
    }
    PG8_WAIT_V(0);
    if constexpr (!ALIGN_EPI) { if (wr == 0) PG8_BAR; }
    PG8_BAR;
    if constexpr (Epi::AFTER_DRAIN) { E.fused(acc, cur, wr, wc, fr, fq, lds, wid, lane); S.done(cur); }
#undef PG8_SA
#undef PG8_SB
#undef PG8_STAGE
#undef PG8_LDA
#undef PG8_LDB
#undef PG8_MMA
#undef PG8_WAIT_V
#undef PG8_WAIT_L
#undef PG8_BAR
#undef PG8_SCHED
}
}

constexpr int NB = 4, SEQ = 4096, T = NB * SEQ, DM = 1024, DEPTH = 4;
constexpr int NPROJ = 10496;
constexpr int IN_COLS = 10260;
constexpr float NORM_EPS = 1e-6f;
constexpr float LOG2E = 1.4426950408889634f;

typedef unsigned short bf16_t;
typedef short bf16x8 __attribute__((ext_vector_type(8)));
typedef float f32x4 __attribute__((ext_vector_type(4)));
typedef float f32x2 __attribute__((ext_vector_type(2)));
typedef unsigned u32x4 __attribute__((ext_vector_type(4)));
typedef unsigned u32x2 __attribute__((ext_vector_type(2)));
typedef __bf16 bf16x2_t __attribute__((ext_vector_type(2)));

constexpr size_t MiB = 1u << 20;
constexpr size_t O_MOD = 0, O_X = 1 * MiB, O_H = 65 * MiB, O_UV = 97 * MiB, O_FQKV = 129 * MiB, O_MQKV = 177 * MiB, O_Z = 225 * MiB,
                 O_XBC = 249 * MiB, O_GATE = 289 * MiB, O_SMALL = 417 * MiB, O_VTF = 419 * MiB, O_VTM = 435 * MiB, O_XT = 451 * MiB,
                 O_BC = 475 * MiB, O_BT = 491 * MiB, O_ST = 499 * MiB, O_CUMF = 547 * MiB, O_ACUM = 548 * MiB, O_KMEAN = 549 * MiB,
                 O_WIN = 550 * MiB, O_WA = 571 * MiB, O_WB = 572 * MiB, O_WC = 573 * MiB, O_WD = 574 * MiB, O_WO = 576 * MiB,
                 O_W1 = 578 * MiB, O_W2 = 586 * MiB, O_GWS = 594 * MiB, WS_END = 595 * MiB;
constexpr size_t O_DT = O_KMEAN + 256 * 1024;
constexpr size_t O_PREV = O_XBC;
constexpr size_t O_HID = O_GATE;
constexpr size_t O_MF32 = O_VTF;
constexpr int LDS_BYTES = 147456;

struct Params { const float* in[26]; float* out; unsigned char* ws; int ph_lo, ph_hi; };

__device__ __forceinline__ int opq(int i) { asm volatile("" : "+s"(i)); return i; }
#define PIN(i) (p.in[opq(i)])
__device__ __forceinline__ unsigned cvtpk(float lo, float hi) { f32x2 v = {lo, hi}; bf16x2_t b = __builtin_convertvector(v, bf16x2_t); return __builtin_bit_cast(unsigned, b); }
__device__ __forceinline__ float bf2f(short h) { return __uint_as_float(((unsigned)(unsigned short)h) << 16); }
__device__ __forceinline__ float bflo(unsigned w) { return __uint_as_float(w << 16); }
__device__ __forceinline__ float bfhi(unsigned w) { return __uint_as_float(w & 0xffff0000u); }
__device__ __forceinline__ bf16x8 pack8(float a0, float a1, float a2, float a3, float a4, float a5, float a6, float a7) {
    u32x4 w = {cvtpk(a0, a1), cvtpk(a2, a3), cvtpk(a4, a5), cvtpk(a6, a7)}; return __builtin_bit_cast(bf16x8, w); }
__device__ __forceinline__ bf16x8 ld2x8(const bf16_t* p0, const bf16_t* p1) { const u32x2 a = *(const u32x2*)p0, b = *(const u32x2*)p1; u32x4 w = {a.x, a.y, b.x, b.y}; return __builtin_bit_cast(bf16x8, w); }
__device__ __forceinline__ f32x4 mfma16(bf16x8 a, bf16x8 b, f32x4 c) { return __builtin_amdgcn_mfma_f32_16x16x32_bf16(a, b, c, 0, 0, 0); }
__device__ __forceinline__ float wave_sum(float v) {
#pragma unroll
    for (int o = 1; o < 64; o <<= 1) v += __shfl_xor(v, o);
    return v; }
__device__ __forceinline__ float ex2(float x) { return __builtin_amdgcn_exp2f(x); }
__device__ __forceinline__ float sigmoidf_(float x) { return 1.f / (1.f + __expf(-x)); }
__device__ __forceinline__ float softplusf_(float x) { return fmaxf(x, 0.f) + log1pf(expf(-fabsf(x))); }
#define LDS_WAIT() asm volatile("s_waitcnt lgkmcnt(0)" ::: "memory")
#define VM_WAIT() asm volatile("s_waitcnt vmcnt(0)" ::: "memory")

#define EPI_LANE_SETUP() int t_ = threadIdx.x; asm volatile("" : "+v"(t_)); const int fr = t_ & 15, fq = (t_ >> 4) & 3; const int wv_ = __builtin_amdgcn_readfirstlane(t_ >> 6); const int wr = wv_ >> 2, wc = wv_ & 3
struct EpiInproj {
    static constexpr bool PERM = false, AFTER_DRAIN = false;
    unsigned char* ws;
    __device__ __forceinline__ void operator()(const f32x4 (&acc)[2][2][4][2], const pg8::Unit& u, int, int, int, int) const {
        EPI_LANE_SETUP();
        const int pn = u.pn; const int row0 = u.pm * 256 + wr * 64 + fr;
        if (pn == 40) {
            if (wc == 0) {
                float* sm = (float*)(ws + O_SMALL);
#pragma unroll
                for (int ai = 0; ai < 2; ++ai)
#pragma unroll
                    for (int m = 0; m < 4; ++m) { float* rp = sm + (size_t)(row0 + ai * 128 + m * 16) * 32 + 4 * fq;
                        *(f32x4*)rp = acc[ai][0][m][0]; *(f32x4*)(rp + 16) = acc[ai][0][m][1]; }
            }
            return;
        }
        bf16_t* base; int pitch, ct, act;
        if (pn < 4) { base = (bf16_t*)(ws + O_UV); pitch = 1024; ct = pn; act = 1; }
        else if (pn < 10) { base = (bf16_t*)(ws + O_FQKV); pitch = 1536; ct = pn - 4; act = 0; }
        else if (pn < 16) { base = (bf16_t*)(ws + O_MQKV); pitch = 1536; ct = pn - 10; act = 0; }
        else if (pn < 19) { base = (bf16_t*)(ws + O_Z); pitch = 768; ct = pn - 16; act = 2; }
        else if (pn < 24) { base = (bf16_t*)(ws + O_XBC); pitch = 1280; ct = pn - 19; act = 0; }
        else { base = (bf16_t*)(ws + O_GATE); pitch = 4096; ct = pn - 24; act = 3; }
        const int col0 = ct * 256 + wc * 32 + 4 * fq;
#pragma unroll
        for (int ai = 0; ai < 2; ++ai)
#pragma unroll
            for (int m = 0; m < 4; ++m) { bf16_t* rowp = base + (size_t)(row0 + ai * 128 + m * 16) * pitch + col0;
#pragma unroll
                for (int bj = 0; bj < 2; ++bj)
#pragma unroll
                    for (int n = 0; n < 2; ++n) { f32x4 v = acc[ai][bj][m][n];
#pragma unroll
                        for (int j = 0; j < 4; ++j) { const float x = v[j];
                            const float uu = 1.5957691216057308f * (x + 0.044715f * x * x * x);
                            const float arg = (act == 1) ? uu : (act == 0) ? INFINITY : x;
                            const float num = (act == 3) ? 1.f : x;
                            v[j] = num / (1.f + __expf(-arg)); }
                        u32x2 w; w.x = cvtpk(v[0], v[1]); w.y = cvtpk(v[2], v[3]);
                        *(u32x2*)(rowp + bj * 128 + n * 16) = w; }
                asm volatile("" ::: "memory"); }
    }
};
struct EpiMerge {
    static constexpr bool PERM = false, AFTER_DRAIN = false;
    const bf16_t* gate; float* mf; bf16_t* outb; int mode;
    __device__ __forceinline__ void operator()(const f32x4 (&acc)[2][2][4][2], const pg8::Unit& u, int, int, int, int) const {
        EPI_LANE_SETUP();
        const int row0 = u.pm * 256 + wr * 64 + fr, col0 = u.pn * 256 + wc * 32 + 4 * fq;
#pragma unroll
        for (int ai = 0; ai < 2; ++ai)
#pragma unroll
            for (int m = 0; m < 4; ++m) { const size_t row = (size_t)(row0 + ai * 128 + m * 16);
#pragma unroll
                for (int bj = 0; bj < 2; ++bj)
#pragma unroll
                    for (int n = 0; n < 2; ++n) { const int col = col0 + bj * 128 + n * 16;
                        const u32x2 gw = *(const u32x2*)(gate + row * 4096 + col);
                        f32x4 v = acc[ai][bj][m][n]; v[0] *= bflo(gw.x); v[1] *= bfhi(gw.x); v[2] *= bflo(gw.y); v[3] *= bfhi(gw.y);
                        float* mp = mf + row * 1024 + col;
                        if (mode == 0) *(f32x4*)mp = v;
                        else if (mode == 1) *(f32x4*)mp = *(const f32x4*)mp + v;
                        else { v = *(const f32x4*)mp + v; u32x2 w; w.x = cvtpk(v[0], v[1]); w.y = cvtpk(v[2], v[3]); *(u32x2*)(outb + row * 1024 + col) = w; } }
                asm volatile("" ::: "memory"); }
    }
};
struct EpiResid {
    static constexpr bool PERM = false, AFTER_DRAIN = false;
    const float* xin; float* xout; const float* gmod;
    __device__ __forceinline__ void operator()(const f32x4 (&acc)[2][2][4][2], const pg8::Unit& u, int, int, int, int) const {
        EPI_LANE_SETUP();
        const int row0 = u.pm * 256 + wr * 64 + fr, col0 = u.pn * 256 + wc * 32 + 4 * fq; const int b = u.pm >> 4;
        const float* gp = gmod + (size_t)b * 6144 + col0;
#pragma unroll
        for (int ai = 0; ai < 2; ++ai)
#pragma unroll
            for (int m = 0; m < 4; ++m) { const size_t off = (size_t)(row0 + ai * 128 + m * 16) * 1024 + col0;
#pragma unroll
                for (int bj = 0; bj < 2; ++bj)
#pragma unroll
                    for (int n = 0; n < 2; ++n) { const int co = bj * 128 + n * 16; const f32x4 g = *(const f32x4*)(gp + co);
                        *(f32x4*)(xout + off + co) = *(const f32x4*)(xin + off + co) + g * acc[ai][bj][m][n]; }
                asm volatile("" ::: "memory"); }
    }
};
struct EpiRelu2 {
    static constexpr bool PERM = false, AFTER_DRAIN = false;
    bf16_t* out;
    __device__ __forceinline__ void operator()(const f32x4 (&acc)[2][2][4][2], const pg8::Unit& u, int, int, int, int) const {
        EPI_LANE_SETUP();
        const int row0 = u.pm * 256 + wr * 64 + fr, col0 = u.pn * 256 + wc * 32 + 4 * fq;
#pragma unroll
        for (int ai = 0; ai < 2; ++ai)
#pragma unroll
            for (int m = 0; m < 4; ++m) { bf16_t* rowp = out + (size_t)(row0 + ai * 128 + m * 16) * 4096 + col0;
#pragma unroll
                for (int bj = 0; bj < 2; ++bj)
#pragma unroll
                    for (int n = 0; n < 2; ++n) { f32x4 v = acc[ai][bj][m][n];
#pragma unroll
                        for (int j = 0; j < 4; ++j) { const float r = fmaxf(v[j], 0.f); v[j] = r * r; }
                        u32x2 w; w.x = cvtpk(v[0], v[1]); w.y = cvtpk(v[2], v[3]); *(u32x2*)(rowp + bj * 128 + n * 16) = w; }
                asm volatile("" ::: "memory"); }
    }
};
struct EpiU {
    static constexpr bool PERM = false, AFTER_DRAIN = false;
    int kind, mode; const void* p0; void* p1; void* p2;
    __device__ __forceinline__ void operator()(const f32x4 (&acc)[2][2][4][2], const pg8::Unit& u, int a, int b, int c, int d) const {
        if (kind == 0) { EpiInproj e{(unsigned char*)p1}; e(acc, u, a, b, c, d); }
        else if (kind == 1) { EpiMerge e{(const bf16_t*)p0, (float*)p1, (bf16_t*)p2, mode}; e(acc, u, a, b, c, d); }
        else if (kind == 2) { EpiResid e{(const float*)p0, (float*)p1, (const float*)p2}; e(acc, u, a, b, c, d); }
        else { EpiRelu2 e{(bf16_t*)p1}; e(acc, u, a, b, c, d); }
    }
};
template <class Epi>
__device__ __forceinline__ void run_gemm(unsigned char* lds, const bf16_t* A, int lda, const bf16_t* Bt, int N, int K, const Epi& E) {
    pg8::Gemm g{A, Bt, T, N, K, lda}; pg8::StaticOrder S; S.init(T, N, (int)gridDim.x, (int)blockIdx.x);
    pg8::gemm_phase<Epi, pg8::StaticOrder, true, true>((PG8_LAS unsigned char*)lds, g, S, E);
}

__device__ __forceinline__ void phase_pre(const Params& p, unsigned char* lds, const int tid) {
    float* cs = (float*)lds; float* red = cs + 4096;
    const float* c = PIN(1); const float* ada_w = PIN(2); const float* ada_b = PIN(3);
    float* mod = (float*)(p.ws + O_MOD);
    for (int i = tid; i < 4096; i += 512) { const float v = c[i]; cs[i] = v / (1.f + expf(-v)); }
    __syncthreads();
    const int jj = tid & 63, ks = tid >> 6;
    for (int it = blockIdx.x; it < DEPTH * 96; it += gridDim.x) {
        const int l = it / 96, jb = it % 96;
        const float* w = ada_w + (size_t)l * 1024 * 6144 + jb * 64 + jj;
        float a0 = 0.f, a1 = 0.f, a2 = 0.f, a3 = 0.f;
#pragma unroll 8
        for (int k = ks * 128; k < ks * 128 + 128; ++k) { const float wv = w[(size_t)k * 6144]; a0 += cs[k] * wv; a1 += cs[1024 + k] * wv; a2 += cs[2048 + k] * wv; a3 += cs[3072 + k] * wv; }
        red[(ks * 64 + jj) * 4 + 0] = a0; red[(ks * 64 + jj) * 4 + 1] = a1; red[(ks * 64 + jj) * 4 + 2] = a2; red[(ks * 64 + jj) * 4 + 3] = a3;
        __syncthreads();
        if (tid < 256) { const int b = tid >> 6, j2 = tid & 63; float s = 0.f;
#pragma unroll
            for (int q = 0; q < 8; ++q) s += red[(q * 64 + j2) * 4 + b];
            const int cc = jb * 64 + j2; mod[((size_t)l * 4 + b) * 6144 + cc] = s + ada_b[l * 6144 + cc]; }
        __syncthreads();
    }
}

__device__ __forceinline__ int inproj_src_col(int n) {
    if (n < 2560) return n;
    if (n < 6144) return n + 8;
    if (n < 10240) return n + 20;
    if (n < 10248) return 2560 + (n - 10240);
    if (n < 10260) return 6152 + (n - 10248);
    return -1;
}
__device__ __forceinline__ void transpose_item(const float* W, int K, int Nsrc, bf16_t* WT, float* scr, int k0, int n0, int lane, bool remap) {
    const int nd = n0 + (lane & 31); const int sc = remap ? inproj_src_col(nd) : nd;
#pragma unroll 8
    for (int i = 0; i < 32; ++i) { const int kk = 2 * i + (lane >> 5); scr[kk * 33 + (lane & 31)] = (sc >= 0) ? W[(size_t)(k0 + kk) * Nsrc + sc] : 0.f; }
    LDS_WAIT();
    const int c = lane & 7;
#pragma unroll
    for (int j = 0; j < 4; ++j) { const int n = (lane >> 3) + 8 * j; const float* s = scr + (8 * c) * 33 + n;
        u32x4 o; o.x = cvtpk(s[0 * 33], s[1 * 33]); o.y = cvtpk(s[2 * 33], s[3 * 33]); o.z = cvtpk(s[4 * 33], s[5 * 33]); o.w = cvtpk(s[6 * 33], s[7 * 33]);
        *(u32x4*)(WT + (size_t)(n0 + n) * K + k0 + 8 * c) = o; }
    LDS_WAIT();
}
__device__ __forceinline__ void convert_weights(const Params& p, int l, unsigned char* lds, int gw, int NGW, int wid, int lane) {
    float* scr = (float*)(lds + wid * 16384);
    unsigned char* ws = p.ws;
    constexpr int I_IN = 16 * (NPROJ / 32), I_BR = 8 * 32, I_D = 12 * 32, I_O = 16 * 32, I_1 = 16 * 128, I_2 = 64 * 32;
    constexpr int TOT = I_IN + 3 * I_BR + I_D + I_O + I_1 + I_2;
    for (int it = gw; it < TOT; it += NGW) {
        int r = it; const float* W; bf16_t* WT; int K, Nsrc, Nd; bool remap = false;
        if (r < I_IN) { W = PIN(5) + (size_t)l * 1024 * IN_COLS; WT = (bf16_t*)(ws + O_WIN); K = 1024; Nsrc = IN_COLS; Nd = NPROJ; remap = true; }
        else if ((r -= I_IN) < I_BR) { W = PIN(17) + (size_t)l * 512 * 1024; WT = (bf16_t*)(ws + O_WA); K = 512; Nsrc = 1024; Nd = 1024; }
        else if ((r -= I_BR) < I_BR) { W = PIN(18) + (size_t)l * 512 * 1024; WT = (bf16_t*)(ws + O_WB); K = 512; Nsrc = 1024; Nd = 1024; }
        else if ((r -= I_BR) < I_BR) { W = PIN(19) + (size_t)l * 512 * 1024; WT = (bf16_t*)(ws + O_WC); K = 512; Nsrc = 1024; Nd = 1024; }
        else if ((r -= I_BR) < I_D) { W = PIN(20) + (size_t)l * 768 * 1024; WT = (bf16_t*)(ws + O_WD); K = 768; Nsrc = 1024; Nd = 1024; }
        else if ((r -= I_D) < I_O) { W = PIN(21) + (size_t)l * 1024 * 1024; WT = (bf16_t*)(ws + O_WO); K = 1024; Nsrc = 1024; Nd = 1024; }
        else if ((r -= I_O) < I_1) { W = PIN(23) + (size_t)l * 1024 * 4096; WT = (bf16_t*)(ws + O_W1); K = 1024; Nsrc = 4096; Nd = 4096; }
        else { r -= I_1; W = PIN(24) + (size_t)l * 4096 * 1024; WT = (bf16_t*)(ws + O_W2); K = 4096; Nsrc = 1024; Nd = 1024; }
        const int nblk = Nd / 32, kb = r / nblk, nb = r % nblk;
        transpose_item(W, K, Nsrc, WT, scr, 64 * kb, 32 * nb, lane, remap);
    }
    const float* gws = PIN(8) + (size_t)l * 8 * 128 * 128; bf16_t* gd = (bf16_t*)(ws + O_GWS);
    for (int e = gw * 64 + lane; e < 8 * 128 * 128; e += NGW * 64) { const int s = e & 127, t = (e >> 7) & 127; const float v = (s <= t) ? gws[e] : 0.f; gd[e] = (bf16_t)(cvtpk(v, 0.f) & 0xffffu); }
}
__device__ __forceinline__ void norm_mod_rows(const float* x, const float* w, const float* sh, const float* sc, bf16_t* out, int gw, int NGW, int lane) {
    for (int row = gw; row < T; row += NGW) {
        const int b = row >> 12; const f32x4* xr = (const f32x4*)(x + (size_t)row * 1024) + lane;
        f32x4 v[4]; float ss = 0.f;
#pragma unroll
        for (int j = 0; j < 4; ++j) { v[j] = xr[64 * j]; ss += (v[j][0] * v[j][0] + v[j][1] * v[j][1]) + (v[j][2] * v[j][2] + v[j][3] * v[j][3]); }
        const float rstd = rsqrtf(wave_sum(ss) * (1.f / 1024.f) + NORM_EPS);
#pragma unroll
        for (int j = 0; j < 4; ++j) { const int col = 4 * (64 * j + lane);
            const f32x4 wv = *(const f32x4*)(w + col), sv = *(const f32x4*)(sc + (size_t)b * 6144 + col), hv = *(const f32x4*)(sh + (size_t)b * 6144 + col);
            const f32x4 o = (v[j] * rstd * wv) * (sv + 1.f) + hv;
            u32x2 pk; pk.x = cvtpk(o[0], o[1]); pk.y = cvtpk(o[2], o[3]); *(u32x2*)(out + (size_t)row * 1024 + col) = pk; }
    }
}
__device__ __forceinline__ void final_norm_rows(const float* x, const float* w, float* out, int gw, int NGW, int lane) {
    for (int row = gw; row < T; row += NGW) {
        const f32x4* xr = (const f32x4*)(x + (size_t)row * 1024) + lane;
        f32x4 v[4]; float ss = 0.f;
#pragma unroll
        for (int j = 0; j < 4; ++j) { v[j] = xr[64 * j]; ss += (v[j][0] * v[j][0] + v[j][1] * v[j][1]) + (v[j][2] * v[j][2] + v[j][3] * v[j][3]); }
        const float rstd = rsqrtf(wave_sum(ss) * (1.f / 1024.f) + NORM_EPS);
#pragma unroll
        for (int j = 0; j < 4; ++j) { const int col = 4 * (64 * j + lane); const f32x4 wv = *(const f32x4*)(w + col);
            *(f32x4*)(out + (size_t)row * 1024 + col) = v[j] * rstd * wv; }
    }
}

__device__ __forceinline__ void gmlp_item(const Params& p, int l, unsigned char* lds, int item, int wid, int lane) {
    const int grp = item & 7, ch = (item >> 3) & 31, b = item >> 8;
    const int fr = lane & 15, fq = lane >> 4;
    bf16_t* UV = (bf16_t*)(p.ws + O_UV); const bf16_t* GWS = (const bf16_t*)(p.ws + O_GWS);
    const float* lnw = PIN(6) + l * 512; const float* lnb = PIN(7) + l * 512; const float* bs = PIN(9) + (size_t)l * 8 * 128 + grp * 128;
    bf16_t* vnT = (bf16_t*)lds;
    const size_t row0 = (size_t)b * SEQ + ch * 128;
    for (int r = 0; r < 16; ++r) {
        const int s = wid * 16 + r;
        const bf16x8 raw = *(const bf16x8*)(UV + (row0 + s) * 1024 + 512 + 8 * lane);
        float x[8]; float sum = 0.f;
#pragma unroll
        for (int j = 0; j < 8; ++j) { x[j] = bf2f(raw[j]); sum += x[j]; }
        const float mean = wave_sum(sum) * (1.f / 512.f); float sq = 0.f;
#pragma unroll
        for (int j = 0; j < 8; ++j) { x[j] -= mean; sq += x[j] * x[j]; }
        const float rstd = rsqrtf(wave_sum(sq) * (1.f / 512.f) + NORM_EPS);
        if ((lane >> 3) == grp) { const int c0 = (lane & 7) * 8;
#pragma unroll
            for (int j = 0; j < 8; ++j) { const int cc = grp * 64 + c0 + j; const float o = x[j] * rstd * lnw[cc] + lnb[cc]; vnT[(c0 + j) * 136 + s] = (bf16_t)(cvtpk(o, 0.f) & 0xffffu); } }
    }
    __syncthreads();
    const int t0 = wid * 16;
    f32x4 acc[4];
#pragma unroll
    for (int ct = 0; ct < 4; ++ct) acc[ct] = (f32x4){0.f, 0.f, 0.f, 0.f};
    const int nks = (t0 + 15) / 32 + 1;
    for (int ks = 0; ks < nks; ++ks) {
        const bf16x8 bw = *(const bf16x8*)(GWS + ((size_t)grp * 128 + t0 + fr) * 128 + ks * 32 + 8 * fq);
#pragma unroll
        for (int ct = 0; ct < 4; ++ct) { const bf16x8 av = *(const bf16x8*)(vnT + (ct * 16 + fr) * 136 + ks * 32 + 8 * fq); acc[ct] = mfma16(av, bw, acc[ct]); }
    }
    const float bsv = bs[t0 + fr];
#pragma unroll
    for (int ct = 0; ct < 4; ++ct) { bf16_t* up = UV + (row0 + t0 + fr) * 1024 + grp * 64 + ct * 16 + 4 * fq;
        const u32x2 uw = *(const u32x2*)up; u32x2 o;
        o.x = cvtpk(bflo(uw.x) * (acc[ct][0] + bsv), bfhi(uw.x) * (acc[ct][1] + bsv)); o.y = cvtpk(bflo(uw.y) * (acc[ct][2] + bsv), bfhi(uw.y) * (acc[ct][3] + bsv));
        *(u32x2*)up = o; }
    __syncthreads();
}
__device__ __forceinline__ void rotary_item(const Params& p, unsigned char* lds, int item, int tid) {
    const int h = item & 7, nb = (item >> 3) & 15, b = item >> 7;
    float* sums = (float*)lds;
    if (tid < 64) sums[tid] = 0.f;
    __syncthreads();
    bf16_t* MQ = (bf16_t*)(p.ws + O_MQKV);
    const int tt = tid >> 1, half = tid & 1; const int pos = nb * 256 + tt; const size_t row = (size_t)b * SEQ + pos;
    bf16_t* kp = MQ + row * 1536 + 512 + h * 64 + half * 32;
    float kv[32];
#pragma unroll
    for (int q = 0; q < 4; ++q) { const bf16x8 raw = *(const bf16x8*)(kp + 8 * q);
#pragma unroll
        for (int j = 0; j < 8; ++j) kv[8 * q + j] = bf2f(raw[j]); }
    if (half == 0) {
        bf16_t* qp = MQ + row * 1536 + h * 64;
        float qv[16];
        { const bf16x8 r0 = *(const bf16x8*)qp, r1 = *(const bf16x8*)(qp + 8);
#pragma unroll
          for (int j = 0; j < 8; ++j) { qv[j] = bf2f(r0[j]); qv[8 + j] = bf2f(r1[j]); } }
#pragma unroll
        for (int j = 0; j < 8; ++j) {
            const float inv_freq = powf(500000.0f, -(float)j * 0.125f); const float ang = (float)pos * inv_freq;
            const float cs = cosf(ang), sn = sinf(ang);
            const float k1 = kv[j], k2 = kv[8 + j]; kv[j] = k1 * cs - k2 * sn; kv[8 + j] = k2 * cs + k1 * sn;
            const float q1 = qv[j], q2 = qv[8 + j]; qv[j] = q1 * cs - q2 * sn; qv[8 + j] = q2 * cs + q1 * sn;
        }
        *(bf16x8*)kp = pack8(kv[0], kv[1], kv[2], kv[3], kv[4], kv[5], kv[6], kv[7]);
        *(bf16x8*)(kp + 8) = pack8(kv[8], kv[9], kv[10], kv[11], kv[12], kv[13], kv[14], kv[15]);
        *(bf16x8*)qp = pack8(qv[0], qv[1], qv[2], qv[3], qv[4], qv[5], qv[6], qv[7]);
        *(bf16x8*)(qp + 8) = pack8(qv[8], qv[9], qv[10], qv[11], qv[12], qv[13], qv[14], qv[15]);
    }
#pragma unroll
    for (int d = 0; d < 32; ++d) {
        float v = kv[d];
#pragma unroll
        for (int o = 2; o < 64; o <<= 1) v += __shfl_xor(v, o);
        if ((tid & 63) < 2) atomicAdd(&sums[half * 32 + d], v);
    }
    __syncthreads();
    if (tid < 64) ((float*)(p.ws + O_KMEAN))[(((size_t)b * 8 + h) * 16 + nb) * 64 + tid] = sums[tid] * (1.f / 256.f);
    __syncthreads();
}
__device__ __forceinline__ void vt_item(const Params& p, unsigned char* lds, int item, int tid) {
    const int tb = item & 31, h = (item >> 5) & 7, b = (item >> 8) & 3, which = item >> 10;
    const bf16_t* src = (const bf16_t*)(p.ws + (which ? O_MQKV : O_FQKV)) + ((size_t)b * SEQ + tb * 128) * 1536 + 1024 + h * 64;
    bf16_t* dst = (bf16_t*)(p.ws + (which ? O_VTM : O_VTF)) + ((size_t)(b * 8 + h) * 64) * 4096 + tb * 128;
    bf16_t* tl = (bf16_t*)lds;
    { const int tok = tid >> 2, dq = tid & 3;
      const bf16x8 r0 = *(const bf16x8*)(src + (size_t)tok * 1536 + dq * 16), r1 = *(const bf16x8*)(src + (size_t)tok * 1536 + dq * 16 + 8);
#pragma unroll
      for (int j = 0; j < 8; ++j) { tl[(dq * 16 + j) * 136 + tok] = (bf16_t)r0[j]; tl[(dq * 16 + 8 + j) * 136 + tok] = (bf16_t)r1[j]; } }
    __syncthreads();
    { const int d = tid >> 3, c = tid & 7;
      const bf16x8 a = *(const bf16x8*)(tl + d * 136 + c * 16), bq = *(const bf16x8*)(tl + d * 136 + c * 16 + 8);
      *(bf16x8*)(dst + (size_t)d * 4096 + c * 16) = a; *(bf16x8*)(dst + (size_t)d * 4096 + c * 16 + 8) = bq; }
    __syncthreads();
}
__device__ __forceinline__ void conv_item(const Params& p, int l, unsigned char* lds, int item, int tid) {
    const int cb = item % 20, ch = (item / 20) & 31, b = item / 640;
    const bf16_t* XBC = (const bf16_t*)(p.ws + O_XBC);
    float* tile = (float*)lds;
    const int t00 = ch * 128 - 3;
    for (int e = tid; e < 131 * 64; e += 512) { const int r = e >> 6, c = e & 63; const int t = t00 + r;
        tile[r * 65 + c] = (t >= 0) ? bf2f((short)XBC[((size_t)b * SEQ + t) * 1280 + cb * 64 + c]) : 0.f; }
    __syncthreads();
    const int c = tid & 63, tg = tid >> 6; const int gc = cb * 64 + c;
    const float* cw = PIN(11) + (size_t)l * 4 * 1280 + gc; const float w0 = cw[0], w1 = cw[1280], w2 = cw[2560], w3 = cw[3840], cbv = PIN(12)[l * 1280 + gc];
    float o[16];
#pragma unroll
    for (int tt = 0; tt < 16; ++tt) { const int t = tg * 16 + tt;
        const float v = cbv + w0 * tile[t * 65 + c] + w1 * tile[(t + 1) * 65 + c] + w2 * tile[(t + 2) * 65 + c] + w3 * tile[(t + 3) * 65 + c];
        o[tt] = v / (1.f + __expf(-v)); }
    const size_t tok0 = (size_t)b * SEQ + ch * 128 + tg * 16;
    const bf16x8 p0 = pack8(o[0], o[1], o[2], o[3], o[4], o[5], o[6], o[7]), p1 = pack8(o[8], o[9], o[10], o[11], o[12], o[13], o[14], o[15]);
    if (cb < 12) { bf16_t* d = (bf16_t*)(p.ws + O_XT) + ((size_t)(b * 12 + cb) * 64 + c) * 4096 + ch * 128 + tg * 16; *(bf16x8*)d = p0; *(bf16x8*)(d + 8) = p1; }
    else {
        bf16_t* BC = (bf16_t*)(p.ws + O_BC); const int bc = gc - 768;
#pragma unroll
        for (int tt = 0; tt < 8; ++tt) { BC[(tok0 + tt) * 512 + bc] = (bf16_t)p0[tt]; BC[(tok0 + 8 + tt) * 512 + bc] = (bf16_t)p1[tt]; }
        if (cb < 16) { bf16_t* d = (bf16_t*)(p.ws + O_BT) + ((size_t)b * 256 + bc) * 4096 + ch * 128 + tg * 16; *(bf16x8*)d = p0; *(bf16x8*)(d + 8) = p1; }
    }
    __syncthreads();
}
__device__ __forceinline__ void acum_item(const Params& p, int l, int item, int lane) {
    const int ch = item & 31, h = (item >> 5) % 12, b = item / 384;
    const float* sm = (const float*)(p.ws + O_SMALL); const float a = -expf(PIN(14)[l * 12 + h]);
    const size_t tok = (size_t)b * SEQ + ch * 128 + 2 * lane;
    const float dtb = PIN(13)[l * 12 + h];
    const float d0 = softplusf_(sm[tok * 32 + 8 + h] + dtb), d1 = softplusf_(sm[(tok + 1) * 32 + 8 + h] + dtb);
    { f32x2 dd = {d0, d1}; *(f32x2*)((float*)(p.ws + O_DT) + ((size_t)(b * 12 + h)) * 4096 + ch * 128 + 2 * lane) = dd; }
    const float v0 = d0 * a, v1 = d1 * a;
    float sc = v0 + v1;
#pragma unroll
    for (int o = 1; o < 64; o <<= 1) { const float t = __shfl_up(sc, o); if (lane >= o) sc += t; }
    const float ex = sc - (v0 + v1);
    f32x2 r = {ex + v0, ex + v0 + v1};
    *(f32x2*)((float*)(p.ws + O_ACUM) + ((size_t)(b * 12 + h)) * 4096 + ch * 128 + 2 * lane) = r;
}
__device__ __forceinline__ void foxcum_item(const Params& p, int l, int item, int lane) {
    const int h = item & 7, b = item >> 3; const float fb = PIN(10)[l * 8 + h];
    const float* sm = (const float*)(p.ws + O_SMALL) + ((size_t)b * SEQ) * 32 + h;
    float* cum = (float*)(p.ws + O_CUMF) + (size_t)(b * 8 + h) * 4096;
    float carry = 0.f;
    for (int r = 0; r < 64; ++r) {
        const float v = -softplusf_(-(sm[(size_t)(r * 64 + lane) * 32] + fb)); float sc = v;
#pragma unroll
        for (int o = 1; o < 64; o <<= 1) { const float t = __shfl_up(sc, o); if (lane >= o) sc += t; }
        cum[r * 64 + lane] = carry + sc;
        carry += __shfl(sc, 63);
    }
}

template <bool MOBA>
__device__ __forceinline__ void attn_tile(const bf16_t* __restrict__ kbase, const bf16_t* __restrict__ vtbase, const float* __restrict__ cum, int k0, bool diag, int kb,
                                          const bf16x8 (&qf)[2][2], const float (&cq)[2], const unsigned (&sel)[2], int qpos0, int fr, int fq,
                                          float (&m)[2], float (&lsum)[2], f32x4 (&o)[4][2]) {
    bf16x8 kf[2][2];
#pragma unroll
    for (int jk = 0; jk < 2; ++jk)
#pragma unroll
        for (int ks = 0; ks < 2; ++ks) kf[jk][ks] = *(const bf16x8*)(kbase + (size_t)(k0 + 16 * jk + fr) * 1536 + ks * 32 + 8 * fq);
    bf16x8 vf[4];
#pragma unroll
    for (int dt = 0; dt < 4; ++dt) { const bf16_t* vp = vtbase + (size_t)(dt * 16 + fr) * 4096 + k0 + 4 * fq; vf[dt] = ld2x8(vp, vp + 16); }
    f32x4 s[2][2];
#pragma unroll
    for (int jk = 0; jk < 2; ++jk)
#pragma unroll
        for (int jq = 0; jq < 2; ++jq) { f32x4 z = {0.f, 0.f, 0.f, 0.f}; z = mfma16(kf[jk][0], qf[jq][0], z); s[jk][jq] = mfma16(kf[jk][1], qf[jq][1], z); }
    constexpr float C2 = 0.125f * LOG2E;
#pragma unroll
    for (int jk = 0; jk < 2; ++jk) {
        f32x4 ck = {0.f, 0.f, 0.f, 0.f};
        if (!MOBA) ck = *(const f32x4*)(cum + k0 + 16 * jk + 4 * fq) * LOG2E;
#pragma unroll
        for (int jq = 0; jq < 2; ++jq) {
            const bool blocked = MOBA && kb >= 0 && !((sel[jq] >> kb) & 1u);
#pragma unroll
            for (int i = 0; i < 4; ++i) { const int key = k0 + 16 * jk + 4 * fq + i; const int qp = qpos0 + 16 * jq + fr;
                float v = s[jk][jq][i] * C2; if (!MOBA) v += cq[jq] - ck[i];
                if ((diag && key > qp) || blocked) v = -INFINITY;
                s[jk][jq][i] = v; } }
    }
    bf16x8 pb[2];
#pragma unroll
    for (int jq = 0; jq < 2; ++jq) {
        float mx = fmaxf(fmaxf(fmaxf(s[0][jq][0], s[0][jq][1]), fmaxf(s[0][jq][2], s[0][jq][3])), fmaxf(fmaxf(s[1][jq][0], s[1][jq][1]), fmaxf(s[1][jq][2], s[1][jq][3])));
        mx = fmaxf(mx, __shfl_xor(mx, 16)); mx = fmaxf(mx, __shfl_xor(mx, 32));
        const float mnew = fmaxf(m[jq], mx); const float alpha = ex2(m[jq] - mnew); m[jq] = mnew;
        float pv[8]; float ps = 0.f;
#pragma unroll
        for (int i = 0; i < 4; ++i) { pv[i] = ex2(s[0][jq][i] - mnew); pv[4 + i] = ex2(s[1][jq][i] - mnew); ps += pv[i] + pv[4 + i]; }
        lsum[jq] = lsum[jq] * alpha + ps;
#pragma unroll
        for (int dt = 0; dt < 4; ++dt) o[dt][jq] = o[dt][jq] * alpha;
        pb[jq] = pack8(pv[0], pv[1], pv[2], pv[3], pv[4], pv[5], pv[6], pv[7]);
    }
#pragma unroll
    for (int dt = 0; dt < 4; ++dt)
#pragma unroll
        for (int jq = 0; jq < 2; ++jq) o[dt][jq] = mfma16(vf[dt], pb[jq], o[dt][jq]);
}
template <bool MOBA>
__device__ __forceinline__ void attn_item(const Params& p, int b, int h, int qt, int lane) {
    const int fr = lane & 15, fq = lane >> 4; const int q0 = qt * 32;
    bf16_t* qkv = (bf16_t*)(p.ws + (MOBA ? O_MQKV : O_FQKV)) + ((size_t)b * SEQ) * 1536 + h * 64;
    const bf16_t* kbase = qkv + 512; const bf16_t* vtbase = (const bf16_t*)(p.ws + (MOBA ? O_VTM : O_VTF)) + ((size_t)(b * 8 + h) * 64) * 4096;
    const float* cum = (const float*)(p.ws + O_CUMF) + (size_t)(b * 8 + h) * 4096;
    bf16x8 qf[2][2];
#pragma unroll
    for (int jq = 0; jq < 2; ++jq)
#pragma unroll
        for (int ks = 0; ks < 2; ++ks) qf[jq][ks] = *(const bf16x8*)(qkv + (size_t)(q0 + 16 * jq + fr) * 1536 + ks * 32 + 8 * fq);
    float cq[2] = {0.f, 0.f}; unsigned sel[2] = {0u, 0u}; unsigned umask = 0u;
    const int own = qt >> 3;
    if (!MOBA) { cq[0] = cum[q0 + fr] * LOG2E; cq[1] = cum[q0 + 16 + fr] * LOG2E; }
    else if (own > 0) {
        const float* km = (const float*)(p.ws + O_KMEAN) + ((size_t)(b * 8 + h) * 16) * 64 + 16 * fq;
#pragma unroll
        for (int jq = 0; jq < 2; ++jq) {
            const bf16_t* qp = qkv + (size_t)(q0 + 16 * jq + fr) * 1536 + 16 * fq;
            const bf16x8 r0 = *(const bf16x8*)qp, r1 = *(const bf16x8*)(qp + 8);
            float qd[16];
#pragma unroll
            for (int j = 0; j < 8; ++j) { qd[j] = bf2f(r0[j]); qd[8 + j] = bf2f(r1[j]); }
            float gate[15];
#pragma unroll
            for (int n = 0; n < 15; ++n) {
                float a = -INFINITY;
                if (n < own) { a = 0.f;
#pragma unroll
                    for (int d = 0; d < 16; d += 4) { const f32x4 kk = *(const f32x4*)(km + n * 64 + d); a += qd[d] * kk[0] + qd[d + 1] * kk[1] + qd[d + 2] * kk[2] + qd[d + 3] * kk[3]; }
                    a += __shfl_xor(a, 16); a += __shfl_xor(a, 32); }
                gate[n] = a;
            }
            unsigned msk = 0u;
#pragma unroll
            for (int pass = 0; pass < 3; ++pass) { float best = -INFINITY; int bi = -1;
#pragma unroll
                for (int n = 0; n < 15; ++n) { const float v = ((msk >> n) & 1u) ? -INFINITY : gate[n]; if (v > best) { best = v; bi = n; } }
                if (bi >= 0) msk |= 1u << bi; }
            sel[jq] = msk;
        }
        umask = sel[0] | sel[1];
#pragma unroll
        for (int o2 = 1; o2 < 16; o2 <<= 1) umask |= __shfl_xor(umask, o2);
        umask = __builtin_amdgcn_readfirstlane(umask);
    }
    float m[2] = {-INFINITY, -INFINITY}, lsum[2] = {0.f, 0.f}; f32x4 o[4][2];
#pragma unroll
    for (int dt = 0; dt < 4; ++dt) { o[dt][0] = (f32x4){0.f, 0.f, 0.f, 0.f}; o[dt][1] = (f32x4){0.f, 0.f, 0.f, 0.f}; }
    if (!MOBA) {
        for (int kt = 0; kt <= qt; ++kt) attn_tile<false>(kbase, vtbase, cum, kt * 32, kt == qt, -1, qf, cq, sel, q0, fr, fq, m, lsum, o);
    } else {
        for (int kt = own * 8; kt <= qt; ++kt) attn_tile<true>(kbase, vtbase, cum, kt * 32, kt == qt, -1, qf, cq, sel, q0, fr, fq, m, lsum, o);
        for (int kb = 0; kb < own; ++kb) if ((umask >> kb) & 1u)
            for (int kt = kb * 8; kt < kb * 8 + 8; ++kt) attn_tile<true>(kbase, vtbase, cum, kt * 32, false, kb, qf, cq, sel, q0, fr, fq, m, lsum, o);
    }
#pragma unroll
    for (int jq = 0; jq < 2; ++jq) {
        float ls = lsum[jq]; ls += __shfl_xor(ls, 16); ls += __shfl_xor(ls, 32); const float inv = 1.f / ls;
        bf16_t* op = qkv + (size_t)(q0 + 16 * jq + fr) * 1536 + 4 * fq;
#pragma unroll
        for (int dt = 0; dt < 4; ++dt) { const f32x4 v = o[dt][jq] * inv; u32x2 w; w.x = cvtpk(v[0], v[1]); w.y = cvtpk(v[2], v[3]); *(u32x2*)(op + dt * 16) = w; }
    }
}
__device__ __forceinline__ void ssd_states_item(const Params& p, int item, int lane) {
    const int h = item % 12, c = (item / 12) & 31, b = item / 384; const int grp = h / 6;
    const int fr = lane & 15, fq = lane >> 4;
    const float* ac = (const float*)(p.ws + O_ACUM) + (size_t)(b * 12 + h) * 4096 + c * 128;
    const float* dtp = (const float*)(p.ws + O_DT) + (size_t)(b * 12 + h) * 4096 + c * 128;
    const bf16_t* XT = (const bf16_t*)(p.ws + O_XT) + ((size_t)(b * 12 + h) * 64) * 4096 + c * 128;
    const bf16_t* BT = (const bf16_t*)(p.ws + O_BT) + ((size_t)(b * 2 + grp) * 128) * 4096 + c * 128;
    float* ST = (float*)(p.ws + O_ST) + ((size_t)((b * 32 + c) * 12 + h)) * 8192;
    const float total = ac[127];
#pragma unroll 1
    for (int q2 = 0; q2 < 4; ++q2) {
        f32x4 acc[4][2];
#pragma unroll
        for (int pt = 0; pt < 4; ++pt) { acc[pt][0] = (f32x4){0.f, 0.f, 0.f, 0.f}; acc[pt][1] = (f32x4){0.f, 0.f, 0.f, 0.f}; }
#pragma unroll 1
        for (int ks = 0; ks < 4; ++ks) {
            const int s0 = ks * 32 + 8 * fq;
            const f32x4 a0 = *(const f32x4*)(ac + s0), a1 = *(const f32x4*)(ac + s0 + 4);
            const f32x4 d0 = *(const f32x4*)(dtp + s0), d1 = *(const f32x4*)(dtp + s0 + 4);
            float w8[8];
#pragma unroll
            for (int j = 0; j < 4; ++j) { w8[j] = expf(total - a0[j]) * d0[j]; w8[4 + j] = expf(total - a1[j]) * d1[j]; }
            const bf16x8 b0 = *(const bf16x8*)(BT + (size_t)((q2 * 2 + 0) * 16 + fr) * 4096 + s0), b1 = *(const bf16x8*)(BT + (size_t)((q2 * 2 + 1) * 16 + fr) * 4096 + s0);
#pragma unroll
            for (int pt = 0; pt < 4; ++pt) { const bf16x8 xa = *(const bf16x8*)(XT + (size_t)(pt * 16 + fr) * 4096 + s0);
                const bf16x8 af = pack8(bf2f(xa[0]) * w8[0], bf2f(xa[1]) * w8[1], bf2f(xa[2]) * w8[2], bf2f(xa[3]) * w8[3], bf2f(xa[4]) * w8[4], bf2f(xa[5]) * w8[5], bf2f(xa[6]) * w8[6], bf2f(xa[7]) * w8[7]);
                acc[pt][0] = mfma16(af, b0, acc[pt][0]); acc[pt][1] = mfma16(af, b1, acc[pt][1]); }
        }
#pragma unroll
        for (int pt = 0; pt < 4; ++pt)
#pragma unroll
            for (int nt = 0; nt < 2; ++nt)
#pragma unroll
                for (int i = 0; i < 4; ++i) ST[(size_t)(pt * 16 + 4 * fq + i) * 128 + (q2 * 2 + nt) * 16 + fr] = acc[pt][nt][i];
    }
}
__device__ __forceinline__ void ssd_scan(const Params& p, int gtid, int gthreads) {
    const float* ST = (const float*)(p.ws + O_ST); bf16_t* PV = (bf16_t*)(p.ws + O_PREV); const float* ACUM = (const float*)(p.ws + O_ACUM);
    for (int e = gtid; e < NB * 12 * 8192; e += gthreads) {
        const int pn = e & 8191, h = (e >> 13) % 12, b = e / (12 * 8192);
        const float* ac = ACUM + (size_t)(b * 12 + h) * 4096;
        float hs = 0.f;
        for (int c = 0; c < 32; ++c) { const size_t idx = ((size_t)((b * 32 + c) * 12 + h)) * 8192 + pn;
            const float st = ST[idx]; PV[idx] = (bf16_t)(cvtpk(hs, 0.f) & 0xffffu); hs = hs * expf(ac[c * 128 + 127]) + st; }
    }
}
__device__ __forceinline__ void ssd_out_item(const Params& p, int l, int item, int wid, int lane) {
    const int grp = item & 1, c = (item >> 1) & 31, b = item >> 6;
    const int fr = lane & 15, fq = lane >> 4; const int w = wid; const int tl = 16 * w + fr;
    const size_t row0 = (size_t)b * SEQ + c * 128; const size_t row = row0 + tl;
    const bf16_t* BC = (const bf16_t*)(p.ws + O_BC);
    bf16_t* Z = (bf16_t*)(p.ws + O_Z);
    bf16x8 cf[4];
#pragma unroll
    for (int ks = 0; ks < 4; ++ks) cf[ks] = *(const bf16x8*)(BC + row * 512 + 256 + grp * 128 + ks * 32 + 8 * fq);
    f32x4 cbt[8];
#pragma unroll
    for (int js = 0; js < 8; ++js) { cbt[js] = (f32x4){0.f, 0.f, 0.f, 0.f};
        if (js <= w) {
#pragma unroll
            for (int ks = 0; ks < 4; ++ks) { const bf16x8 a = *(const bf16x8*)(BC + (row0 + js * 16 + fr) * 512 + grp * 128 + ks * 32 + 8 * fq); cbt[js] = mfma16(a, cf[ks], cbt[js]); } } }
    float ssq = 0.f;
#pragma unroll 1
    for (int r = 0; r < 6; ++r) {
        const int h = grp * 6 + r;
        const float* ac = (const float*)(p.ws + O_ACUM) + (size_t)(b * 12 + h) * 4096 + c * 128;
        const float* dtp = (const float*)(p.ws + O_DT) + (size_t)(b * 12 + h) * 4096 + c * 128;
        const float acl = ac[tl]; const float eacl = expf(acl); const float Dh = PIN(15)[l * 12 + h];
        const bf16_t* PV = (const bf16_t*)(p.ws + O_PREV) + ((size_t)((b * 32 + c) * 12 + h)) * 8192;
        const bf16_t* XT = (const bf16_t*)(p.ws + O_XT) + ((size_t)(b * 12 + h) * 64) * 4096 + c * 128;
        f32x4 yt[4];
#pragma unroll
        for (int pt = 0; pt < 4; ++pt) yt[pt] = (f32x4){0.f, 0.f, 0.f, 0.f};
#pragma unroll
        for (int ks = 0; ks < 4; ++ks)
#pragma unroll
            for (int pt = 0; pt < 4; ++pt) { const bf16x8 a = *(const bf16x8*)(PV + (size_t)(pt * 16 + fr) * 128 + ks * 32 + 8 * fq); yt[pt] = mfma16(a, cf[ks], yt[pt]); }
#pragma unroll
        for (int pt = 0; pt < 4; ++pt) yt[pt] = yt[pt] * eacl;
#pragma unroll
        for (int jp = 0; jp < 4; ++jp) {
            if (2 * jp <= w) {
                const int sA = 32 * jp + 4 * fq, sB = sA + 16;
                const f32x4 a0 = *(const f32x4*)(ac + sA), a1 = *(const f32x4*)(ac + sB), dv0 = *(const f32x4*)(dtp + sA), dv1 = *(const f32x4*)(dtp + sB);
                float mv[8];
#pragma unroll
                for (int j = 0; j < 4; ++j) {
                    const int s = sA + j; const float d0 = dv0[j];
                    float v = (s <= tl) ? cbt[2 * jp][j] * expf(acl - a0[j]) * d0 : 0.f; if (s == tl) v += Dh; mv[j] = v;
                    const int s2 = sB + j; const float d1 = dv1[j];
                    float v2 = (s2 <= tl) ? cbt[2 * jp + 1][j] * expf(acl - a1[j]) * d1 : 0.f; if (s2 == tl) v2 += Dh; mv[4 + j] = v2;
                }
                const bf16x8 mb = pack8(mv[0], mv[1], mv[2], mv[3], mv[4], mv[5], mv[6], mv[7]);
#pragma unroll
                for (int pt = 0; pt < 4; ++pt) { const bf16_t* xp = XT + (size_t)(pt * 16 + fr) * 4096 + sA; yt[pt] = mfma16(ld2x8(xp, xp + 16), mb, yt[pt]); }
            }
        }
#pragma unroll
        for (int pt = 0; pt < 4; ++pt) { bf16_t* zp = Z + row * 768 + h * 64 + pt * 16 + 4 * fq; const u32x2 zw = *(const u32x2*)zp;
            const float y0 = yt[pt][0] * bflo(zw.x), y1 = yt[pt][1] * bfhi(zw.x), y2 = yt[pt][2] * bflo(zw.y), y3 = yt[pt][3] * bfhi(zw.y);
            ssq += (y0 * y0 + y1 * y1) + (y2 * y2 + y3 * y3);
            u32x2 o; o.x = cvtpk(y0, y1); o.y = cvtpk(y2, y3); *(u32x2*)zp = o; }
    }
    ssq += __shfl_xor(ssq, 16); ssq += __shfl_xor(ssq, 32);
    const float rstd = rsqrtf(ssq * (1.f / 384.f) + NORM_EPS);
    VM_WAIT();
    const float* nw = PIN(16) + l * 768 + grp * 384;
    bf16_t* zp0 = Z + row * 768 + grp * 384 + 4 * fq;
#pragma unroll 4
    for (int q = 0; q < 24; ++q) { bf16_t* zp = zp0 + q * 16; const u32x2 zw = *(const u32x2*)zp; const f32x4 nv = *(const f32x4*)(nw + q * 16 + 4 * fq);
        u32x2 o; o.x = cvtpk(bflo(zw.x) * rstd * nv[0], bfhi(zw.x) * rstd * nv[1]); o.y = cvtpk(bflo(zw.y) * rstd * nv[2], bfhi(zw.y) * rstd * nv[3]); *(u32x2*)zp = o; }
}

constexpr int PH_PER_LAYER = 11, N_PHASES = 1 + DEPTH * PH_PER_LAYER + 1;
template <int EN_MASK, bool EN_GEMM>
__device__ __forceinline__ void fwd_body(const Params& p) {
    extern __shared__ __attribute__((aligned(16))) unsigned char lds[];
    cg::grid_group grid = cg::this_grid();
    const int G = gridDim.x, NGW = G * 8;
    unsigned char* ws = p.ws;
    float* mod = (float*)(ws + O_MOD); float* X = (float*)(ws + O_X); bf16_t* H = (bf16_t*)(ws + O_H);
    for (int ph = p.ph_lo; ph < p.ph_hi; ++ph) {
        int tid = threadIdx.x; asm volatile("" : "+v"(tid));
        const int lane = tid & 63, wid = __builtin_amdgcn_readfirstlane(tid >> 6); const int gw = blockIdx.x * 8 + wid;
        if (ph == 0) { if constexpr (EN_MASK != 0) phase_pre(p, lds, tid); }
        else if (ph == N_PHASES - 1) { if constexpr (EN_MASK != 0) final_norm_rows(X, PIN(25), p.out, gw, NGW, lane); }
        else {
            const int l = (ph - 1) / PH_PER_LAYER, k = (ph - 1) % PH_PER_LAYER;
            const float* modl = mod + (size_t)l * 4 * 6144;
            const float* xin = (l == 0) ? PIN(0) : X;
            if (k == 1 || k == 6 || k == 7 || k == 9 || k == 10) { if constexpr (EN_GEMM) {
                const int nsub = (k == 6) ? 4 : 1;
#pragma unroll 1
                for (int br = 0; br < nsub; ++br) {
                    EpiU E{}; const bf16_t* A; const bf16_t* Bt; int lda, N, K;
                    if (k == 1) { E.kind = 0; E.p1 = ws; A = H; lda = 1024; Bt = (const bf16_t*)(ws + O_WIN); N = NPROJ; K = 1024; }
                    else if (k == 6) {
                        const size_t aoffs = (br == 0) ? O_UV : (br == 1) ? O_FQKV : (br == 2) ? O_MQKV : O_Z;
                        const size_t woffs = (br == 0) ? O_WA : (br == 1) ? O_WB : (br == 2) ? O_WC : O_WD;
                        E.kind = 1; E.p0 = (const bf16_t*)(ws + O_GATE) + br * 1024; E.p1 = (float*)(ws + O_MF32); E.p2 = H; E.mode = (br == 0) ? 0 : (br == 3) ? 2 : 1;
                        A = (const bf16_t*)(ws + aoffs); lda = (br == 0) ? 1024 : (br == 3) ? 768 : 1536; Bt = (const bf16_t*)(ws + woffs); N = 1024; K = (br == 3) ? 768 : 512; }
                    else if (k == 7) { E.kind = 2; E.p0 = xin; E.p1 = X; E.p2 = (void*)(modl + 2048); A = H; lda = 1024; Bt = (const bf16_t*)(ws + O_WO); N = 1024; K = 1024; }
                    else if (k == 9) { E.kind = 3; E.p1 = (bf16_t*)(ws + O_HID); A = H; lda = 1024; Bt = (const bf16_t*)(ws + O_W1); N = 4096; K = 1024; }
                    else { E.kind = 2; E.p0 = X; E.p1 = X; E.p2 = (void*)(modl + 5120); A = (const bf16_t*)(ws + O_HID); lda = 4096; Bt = (const bf16_t*)(ws + O_W2); N = 1024; K = 4096; }
                    run_gemm(lds, A, lda, Bt, N, K, E);
                }
            } } else switch (k) {
            case 0: if constexpr ((EN_MASK >> 0) & 1) {
                convert_weights(p, l, lds, gw, NGW, wid, lane);
                norm_mod_rows(xin, PIN(4) + l * 1024, modl + 0, modl + 1024, H, gw, NGW, lane);
            } break;
            case 2: if constexpr ((EN_MASK >> 2) & 1) {
                for (int it = blockIdx.x; it < 1024; it += G) gmlp_item(p, l, lds, it, wid, lane);
                for (int it = blockIdx.x; it < 512; it += G) rotary_item(p, lds, it, tid);
                for (int it = blockIdx.x; it < 2048; it += G) vt_item(p, lds, it, tid);
                for (int it = blockIdx.x; it < 2560; it += G) conv_item(p, l, lds, it, tid);
                for (int it = gw; it < 1536; it += NGW) acum_item(p, l, it, lane);
                for (int it = NGW - 1 - gw; it < 32; it += NGW) foxcum_item(p, l, it, lane);
            } break;
            case 3: if constexpr ((EN_MASK >> 3) & 1) {
#ifndef EN3
#define EN3 7
#endif
                if constexpr (EN3 & 1) for (int i = gw; i < 4096; i += NGW) { const int bh = i & 31; const int r = (i >> 5); const int qt = (r < 64) ? 127 - r : r - 64; attn_item<false>(p, bh >> 3, bh & 7, qt, lane); }
                if constexpr (EN3 & 2) for (int i = gw; i < 4096; i += NGW) { const int bh = i & 31; const int r = (i >> 5); const int qt = (r < 64) ? 127 - r : r - 64; attn_item<true>(p, bh >> 3, bh & 7, qt, lane); }
                if constexpr (EN3 & 4) for (int i = NGW - 1 - gw; i < 1536; i += NGW) ssd_states_item(p, i, lane);
            } break;
            case 4: if constexpr ((EN_MASK >> 4) & 1) { ssd_scan(p, blockIdx.x * 512 + tid, G * 512); } break;
            case 5: if constexpr ((EN_MASK >> 5) & 1) { for (int it = blockIdx.x; it < 256; it += G) ssd_out_item(p, l, it, wid, lane); } break;
            case 8: if constexpr ((EN_MASK >> 8) & 1) { norm_mod_rows(X, PIN(22) + l * 1024, modl + 3072, modl + 4096, H, gw, NGW, lane); } break;
            }
        }
        if (ph + 1 < p.ph_hi) grid.sync();
    }
}

#ifndef N_LAUNCH_MODE
#define N_LAUNCH_MODE 1
#endif
#if N_LAUNCH_MODE == 1
__global__ void __launch_bounds__(512, 2) fwd_all(Params p) { fwd_body<0x7ff, true>(p); }
#define KERNEL_FOR_ATTR fwd_all
#else
__global__ void __launch_bounds__(512, 2) fwd_gemm(Params p) { fwd_body<0, true>(p); }
__global__ void __launch_bounds__(512, 2) fwd_misc(Params p) { fwd_body<0x7ff, false>(p); }
#endif
extern "C" void kernel_launch(void* const* d_in, const int* in_sizes, int n_in, void* d_out, int out_size, void* d_ws, size_t ws_size, hipStream_t stream) {
    static int grid = 0;
    if (grid == 0) {
        if (n_in != 26 || out_size != T * DM || ws_size < WS_END) { fprintf(stderr, "kernel_launch: unexpected shapes (n_in %d out %d ws %zu need %zu)\n", n_in, out_size, ws_size, (size_t)WS_END); grid = -1; return; }
        int dev = 0, cus = 0;
        (void)hipGetDevice(&dev); (void)hipDeviceGetAttribute(&cus, hipDeviceAttributeMultiprocessorCount, dev);
#if N_LAUNCH_MODE == 1
        if (hipFuncSetAttribute((const void*)fwd_all, hipFuncAttributeMaxDynamicSharedMemorySize, LDS_BYTES) != hipSuccess) { fprintf(stderr, "kernel_launch: hipFuncSetAttribute failed\n"); grid = -1; return; }
#else
        if (hipFuncSetAttribute((const void*)fwd_gemm, hipFuncAttributeMaxDynamicSharedMemorySize, LDS_BYTES) != hipSuccess || hipFuncSetAttribute((const void*)fwd_misc, hipFuncAttributeMaxDynamicSharedMemorySize, LDS_BYTES) != hipSuccess) { fprintf(stderr, "kernel_launch: hipFuncSetAttribute failed\n"); grid = -1; return; }
#endif
        (void)hipGetLastError();
        grid = cus > 0 ? cus : 256;
    }
    if (grid < 0) return;
    Params p{};
    for (int i = 0; i < 26; ++i) p.in[i] = (const float*)d_in[i];
    p.out = (float*)d_out; p.ws = (unsigned char*)d_ws;
#if N_LAUNCH_MODE == 1
    p.ph_lo = 0; p.ph_hi = N_PHASES;
    void* args[] = {&p};
    hipError_t e = hipLaunchCooperativeKernel((const void*)fwd_all, dim3(grid), dim3(512), args, LDS_BYTES, stream);
    if (e != hipSuccess) fprintf(stderr, "kernel_launch: cooperative launch failed: %s (grid %d)\n", hipGetErrorString(e), grid);
#else
    for (int ph = 0; ph < N_PHASES; ++ph) { p.ph_lo = ph; p.ph_hi = ph + 1;
        const int k = (ph >= 1 && ph < N_PHASES - 1) ? (ph - 1) % PH_PER_LAYER : -1;
        if (k == 1 || k == 6 || k == 7 || k == 9 || k == 10) hipLaunchKernelGGL(fwd_gemm, dim3(grid), dim3(512), LDS_BYTES, stream, p);
        else hipLaunchKernelGGL(fwd_misc, dim3(grid), dim3(512), LDS_BYTES, stream, p); }
#endif
}
```

```cpp
#include <hip/hip_runtime.h>
#include <hip/hip_cooperative_groups.h>
#include <cstdio>
#include <cstdint>
#include <cmath>
namespace cg = cooperative_groups;
namespace pg8 {
#define PG8_LAS __attribute__((address_space(3)))
typedef unsigned short bf16_t;
typedef short bf16x8 __attribute__((ext_vector_type(8)));
typedef float f32x4 __attribute__((ext_vector_type(4)));
typedef unsigned u32x4 __attribute__((ext_vector_type(4)));
constexpr int BM = 256, BK = 64, HALF = 128, HTB = HALF * BK * 2  , STAGE_BYTES = 8 * HTB, NXCD = 8, WGM = 8;

__host__ __device__ __forceinline__ int lds_byte(int r, int c) { const int st = (r >> 4) * 2 + (c >> 5), rr = r & 15, cc = c & 31, ob = rr * 64 + cc * 2; return st * 1024 + (ob ^ (((ob >> 9) & 1) << 5)); }
__host__ __device__ __forceinline__ void stage_rc(int b, int& R, int& C) { const int st = b / 1024, sb = b % 1024, swz = sb ^ (((sb >> 9) & 1) << 5); R = (st >> 1) * 16 + swz / 64; C = (st & 1) * 32 + (swz % 64) / 2; }
__host__ __device__ __forceinline__ int perm32(int rho) { const int n = rho >> 4, i = rho & 15; return 8 * (i >> 2) + 4 * n + (i & 3); }

struct Unit { int pm, pn; };
struct Gemm { const bf16_t* A; const bf16_t* Bt; int M, N, K, lda; };

struct StaticOrder {
    int nM, nN, nwg, G, c;
    __host__ __device__ void init(int M, int N, int G_, int c_) { nM = M / BM; nN = N / BM; nwg = nM * nN; G = G_; c = c_; }
    __host__ __device__ bool next(int i, Unit& u) const {
        const long L = (long)i * G + c; if (L >= nwg) return false;
        int wgid = (int)L; { const int q = nwg / NXCD, r = nwg % NXCD, xcd = wgid % NXCD, off = wgid / NXCD; wgid = (xcd < r ? xcd * (q + 1) : r * (q + 1) + (xcd - r) * q) + off; }
        const int nig = WGM * nN, gid = wgid / nig, fm = gid * WGM, gsz = (nM - fm) < WGM ? (nM - fm) : WGM;
        u.pm = fm + ((wgid % nig) % gsz); u.pn = (wgid % nig) / gsz; return true;
    }
    __device__ __forceinline__ void a_ready(const Unit&) const {}
    __device__ __forceinline__ void done(const Unit&) const {}
};


template <class Epi, class Sched, bool ALIGN_EPI = false, bool SP2 = false>
__device__ __forceinline__ void gemm_phase(PG8_LAS unsigned char* lds, const Gemm g, const Sched& S, const Epi& E) {
    const int tid = threadIdx.x, wid = __builtin_amdgcn_readfirstlane(tid >> 6), lane = tid & 63, wr = wid >> 2, wc = wid & 3, fr = lane & 15, fq = lane >> 4;
    const int K = g.K, nt = K / BK;
    unsigned voffA[2], voffB[2];
#pragma unroll
    for (int i = 0; i < 2; ++i) { int R, C; stage_rc(tid * 16 + i * 8192, R, C); const int Rb = Epi::PERM ? ((R & ~31) + perm32(R & 31)) : R;
        voffA[i] = (unsigned)(R * g.lda + C) * 2u; voffB[i] = (unsigned)(Rb * K + C) * 2u; }
    const size_t kstep = (size_t)(BK * 2);
    const size_t hstepB = (size_t)HALF * K * 2, hstepA = (size_t)HALF * g.lda * 2;
    const size_t tstepB = 2 * hstepB, tstepA = 2 * hstepA;
    const unsigned ldsw = (unsigned)wid * 1024u;
    const int aoff = lds_byte(wr * 64 + fr, fq * 8), boff = lds_byte(wc * 32 + fr, fq * 8);
#define PG8_SA(b, h) (((b) * 2 + (h)) * HTB)
#define PG8_SB(b, h) ((4 + (b) * 2 + (h)) * HTB)
#define PG8_STAGE(bufoff, gbase, voff) do { _Pragma("unroll") for (int _i = 0; _i < 2; ++_i) \
        __builtin_amdgcn_global_load_lds((const unsigned*)((const char*)(gbase) + (voff)[_i]), (PG8_LAS unsigned*)(lds + (bufoff) + ldsw + _i * 8192), 16, 0, 0); } while (0)
#define PG8_LDA(dst, b, h) do { _Pragma("unroll") for (int m = 0; m < 4; ++m) _Pragma("unroll") for (int k = 0; k < 2; ++k) dst[m][k] = *(const PG8_LAS bf16x8*)(lds + PG8_SA(b, h) + aoff + m * 2048 + k * 1024); } while (0)
#define PG8_LDB(dst, b, h) do { _Pragma("unroll") for (int n = 0; n < 2; ++n) _Pragma("unroll") for (int k = 0; k < 2; ++k) dst[n][k] = *(const PG8_LAS bf16x8*)(lds + PG8_SB(b, h) + boff + n * 2048 + k * 1024); } while (0)
#define PG8_MMA(ai, bj, At, Bt) do { __builtin_amdgcn_s_setprio(1); _Pragma("unroll") for (int m = 0; m < 4; ++m) _Pragma("unroll") for (int n = 0; n < 2; ++n) _Pragma("unroll") for (int k = 0; k < 2; ++k) \
        acc[ai][bj][m][n] = __builtin_amdgcn_mfma_f32_16x16x32_bf16(Bt[n][k], At[m][k], acc[ai][bj][m][n], 0, 0, 0); __builtin_amdgcn_s_setprio(0); } while (0)
#define PG8_WAIT_V(n) asm volatile("s_waitcnt vmcnt(" #n ")" ::: "memory")
#define PG8_WAIT_L(n) asm volatile("s_waitcnt lgkmcnt(" #n ")" ::: "memory")
#define PG8_BAR __builtin_amdgcn_s_barrier()
#define PG8_SCHED __builtin_amdgcn_sched_barrier(0)
    Unit cur, nxt; int ui = 0;
    if (!S.next(0, cur)) return;
    f32x4 acc[2][2][4][2];
#pragma unroll
    for (int a = 0; a < 2; ++a)
#pragma unroll
        for (int b = 0; b < 2; ++b)
#pragma unroll
            for (int m = 0; m < 4; ++m)
#pragma unroll
                for (int n = 0; n < 2; ++n) acc[a][b][m][n] = (f32x4){0.f, 0.f, 0.f, 0.f};
    bf16x8 At[4][2], B0[2][2], B1[2][2];
    const char* cA = (const char*)g.A + (size_t)cur.pm * tstepA; const char* cB = (const char*)g.Bt + (size_t)cur.pn * tstepB;
    S.a_ready(cur);
    if constexpr (SP2) {
        PG8_STAGE(PG8_SB(0, 0), cB, voffB); PG8_STAGE(PG8_SB(0, 1), cB + hstepB, voffB); PG8_STAGE(PG8_SA(0, 0), cA, voffA); PG8_STAGE(PG8_SA(0, 1), cA + hstepA, voffA);
        if (wr == 1) PG8_BAR;
        PG8_WAIT_V(2); PG8_BAR;
        PG8_STAGE(PG8_SB(1, 0), cB + kstep, voffB); PG8_STAGE(PG8_SA(1, 0), cA + kstep, voffA); PG8_STAGE(PG8_SB(1, 1), cB + hstepB + kstep, voffB);
        PG8_WAIT_V(6); PG8_BAR;
    } else {
        PG8_STAGE(PG8_SB(0, 0), cB, voffB); PG8_STAGE(PG8_SA(0, 0), cA, voffA); PG8_STAGE(PG8_SB(0, 1), cB + hstepB, voffB); PG8_STAGE(PG8_SA(0, 1), cA + hstepA, voffA);
        if (wr == 1) PG8_BAR;
        PG8_WAIT_V(4); PG8_BAR;
        PG8_STAGE(PG8_SB(1, 0), cB + kstep, voffB); PG8_STAGE(PG8_SA(1, 0), cA + kstep, voffA); PG8_STAGE(PG8_SB(1, 1), cB + hstepB + kstep, voffB);
        PG8_WAIT_V(6); PG8_BAR;
    }
    for (;;) {
        const bool has_next = S.next(ui + 1, nxt);
        const char* nA = has_next ? (const char*)g.A + (size_t)nxt.pm * tstepA : cA; const char* nB = has_next ? (const char*)g.Bt + (size_t)nxt.pn * tstepB : cB;
        for (int t = 0; t < nt; t += 2) {
            const bool last = (t == nt - 2);
            const char* a1 = cA + (size_t)(t + 1) * kstep;
            const char* a2 = last ? nA : cA + (size_t)(t + 2) * kstep; const char* b2 = last ? nB : cB + (size_t)(t + 2) * kstep;
            const char* a3 = a2 + kstep; const char* b3 = b2 + kstep;
            if (last && has_next) S.a_ready(nxt);
            if constexpr (SP2) {
            PG8_LDB(B0, 0, 0); PG8_LDB(B1, 0, 1); PG8_SCHED; PG8_LDA(At, 0, 0); PG8_STAGE(PG8_SA(1, 1), a1 + hstepA, voffA);
            PG8_WAIT_V(8); PG8_WAIT_L(0); PG8_BAR; PG8_MMA(0, 0, At, B0); PG8_MMA(0, 1, At, B1); PG8_BAR; PG8_SCHED;
            PG8_LDA(At, 0, 1); PG8_STAGE(PG8_SB(0, 0), b2, voffB); PG8_STAGE(PG8_SB(0, 1), b2 + hstepB, voffB); PG8_STAGE(PG8_SA(0, 0), a2, voffA);
            PG8_WAIT_V(8); PG8_WAIT_L(0); PG8_BAR; PG8_MMA(1, 0, At, B0); PG8_MMA(1, 1, At, B1); PG8_BAR; PG8_SCHED;
            PG8_LDB(B0, 1, 0); PG8_LDB(B1, 1, 1); PG8_SCHED; PG8_LDA(At, 1, 0); PG8_STAGE(PG8_SA(0, 1), a2 + hstepA, voffA);
            PG8_WAIT_V(8); PG8_WAIT_L(0); PG8_BAR; PG8_MMA(0, 0, At, B0); PG8_MMA(0, 1, At, B1); PG8_BAR; PG8_SCHED;
            PG8_LDA(At, 1, 1); PG8_STAGE(PG8_SB(1, 0), b3, voffB); PG8_STAGE(PG8_SB(1, 1), b3 + hstepB, voffB); PG8_STAGE(PG8_SA(1, 0), a3, voffA);
            PG8_WAIT_V(8); PG8_WAIT_L(0); PG8_BAR; PG8_MMA(1, 0, At, B0); PG8_MMA(1, 1, At, B1); PG8_BAR; PG8_SCHED;
            } else {
            PG8_LDB(B0, 0, 0); PG8_SCHED; PG8_LDA(At, 0, 0); PG8_STAGE(PG8_SA(1, 1), a1 + hstepA, voffA);
            PG8_WAIT_L(8); PG8_BAR; PG8_WAIT_L(0); PG8_MMA(0, 0, At, B0); PG8_BAR; PG8_SCHED;
            PG8_LDB(B1, 0, 1); PG8_STAGE(PG8_SB(0, 0), b2, voffB);
            PG8_BAR; PG8_WAIT_L(0); PG8_MMA(0, 1, At, B1); PG8_BAR;
            PG8_LDA(At, 0, 1); PG8_STAGE(PG8_SA(0, 0), a2, voffA);
            PG8_BAR; PG8_WAIT_L(0); PG8_MMA(1, 0, At, B0); PG8_BAR; PG8_SCHED;
            PG8_STAGE(PG8_SB(0, 1), b2 + hstepB, voffB);
            PG8_WAIT_V(6); PG8_BAR; PG8_MMA(1, 1, At, B1); PG8_BAR;
            PG8_LDB(B0, 1, 0); PG8_SCHED; PG8_LDA(At, 1, 0); PG8_STAGE(PG8_SA(0, 1), a2 + hstepA, voffA);
            PG8_WAIT_L(8); PG8_BAR; PG8_WAIT_L(0); PG8_MMA(0, 0, At, B0); PG8_BAR; PG8_SCHED;
            PG8_LDB(B1, 1, 1); PG8_STAGE(PG8_SB(1, 0), b3, voffB);
            PG8_BAR; PG8_WAIT_L(0); PG8_MMA(0, 1, At, B1); PG8_BAR;
            PG8_LDA(At, 1, 1); PG8_STAGE(PG8_SA(1, 0), a3, voffA);
            PG8_BAR; PG8_WAIT_L(0); PG8_MMA(1, 0, At, B0); PG8_BAR; PG8_SCHED;
            PG8_STAGE(PG8_SB(1, 1), b3 + hstepB, voffB);
            PG8_WAIT_V(6); PG8_BAR; PG8_MMA(1, 1, At, B1); PG8_BAR;
            }
        }
        if constexpr (ALIGN_EPI) { if (wr == 0) PG8_BAR; }
        if constexpr (!Epi::AFTER_DRAIN) { E(acc, cur, wr, wc, fr, fq); S.done(cur); }
        if (!has_next) break;
#pragma unroll
        for (int a = 0; a < 2; ++a)
#pragma unroll
            for (int b = 0; b < 2; ++b)
#pragma unroll
                for (int m = 0; m < 4; ++m)
#pragma unroll
                    for (int n = 0; n < 2; ++n) acc[a][b][m][n] = (f32x4){0.f, 0.f, 0.f, 0.f};
        cur = nxt; cA = nA; cB = nB; ++ui;
        if constexpr (ALIGN_EPI) { if (wr == 1) PG8_BAR; }
    }
    PG8_WAIT_V(0);
    if constexpr (!ALIGN_EPI) { if (wr == 0) PG8_BAR; }
    PG8_BAR;
    if constexpr (Epi::AFTER_DRAIN) { E.fused(acc, cur, wr, wc, fr, fq, lds, wid, lane); S.done(cur); }
#undef PG8_SA
#undef PG8_SB
#undef PG8_STAGE
#undef PG8_LDA
#undef PG8_LDB
#undef PG8_MMA
#undef PG8_WAIT_V
#undef PG8_WAIT_L
#undef PG8_BAR
#undef PG8_SCHED
}
}

constexpr int NB = 4, SEQ = 4096, T = NB * SEQ, DM = 1024, DEPTH = 4;
constexpr int NPROJ = 10496;
constexpr int IN_COLS = 10260;
constexpr float NORM_EPS = 1e-6f;
constexpr float LOG2E = 1.4426950408889634f;

typedef unsigned short bf16_t;
typedef short bf16x8 __attribute__((ext_vector_type(8)));
typedef float f32x4 __attribute__((ext_vector_type(4)));
typedef float f32x2 __attribute__((ext_vector_type(2)));
typedef unsigned u32x4 __attribute__((ext_vector_type(4)));
typedef unsigned u32x2 __attribute__((ext_vector_type(2)));
typedef __bf16 bf16x2_t __attribute__((ext_vector_type(2)));

constexpr size_t MiB = 1u << 20;
constexpr size_t O_MOD = 0, O_X = 1 * MiB, O_H = 65 * MiB, O_UV = 97 * MiB, O_FQKV = 129 * MiB, O_MQKV = 177 * MiB, O_Z = 225 * MiB,
                 O_XBC = 249 * MiB, O_GATE = 289 * MiB, O_SMALL = 417 * MiB, O_VTF = 419 * MiB, O_VTM = 435 * MiB, O_XT = 451 * MiB,
                 O_BC = 475 * MiB, O_BT = 491 * MiB, O_ST = 499 * MiB, O_CUMF = 547 * MiB, O_ACUM = 548 * MiB, O_KMEAN = 549 * MiB,
                 O_WIN = 550 * MiB, O_WA = 571 * MiB, O_WB = 572 * MiB, O_WC = 573 * MiB, O_WD = 574 * MiB, O_WO = 576 * MiB,
                 O_W1 = 578 * MiB, O_W2 = 586 * MiB, O_GWS = 594 * MiB, WS_END = 595 * MiB;
constexpr size_t O_DT = O_KMEAN + 256 * 1024;
constexpr size_t O_PREV = O_XBC;
constexpr size_t O_HID = O_GATE;
constexpr size_t O_MF32 = O_VTF;
constexpr int LDS_BYTES = 147456;

struct Params { const float* in[26]; float* out; unsigned char* ws; int ph_lo, ph_hi; };

__device__ __forceinline__ int opq(int i) { asm volatile("" : "+s"(i)); return i; }
#define PIN(i) (p.in[opq(i)])
__device__ __forceinline__ unsigned cvtpk(float lo, float hi) { f32x2 v = {lo, hi}; bf16x2_t b = __builtin_convertvector(v, bf16x2_t); return __builtin_bit_cast(unsigned, b); }
__device__ __forceinline__ float bf2f(short h) { return __uint_as_float(((unsigned)(unsigned short)h) << 16); }
__device__ __forceinline__ float bflo(unsigned w) { return __uint_as_float(w << 16); }
__device__ __forceinline__ float bfhi(unsigned w) { return __uint_as_float(w & 0xffff0000u); }
__device__ __forceinline__ bf16x8 pack8(float a0, float a1, float a2, float a3, float a4, float a5, float a6, float a7) {
    u32x4 w = {cvtpk(a0, a1), cvtpk(a2, a3), cvtpk(a4, a5), cvtpk(a6, a7)}; return __builtin_bit_cast(bf16x8, w); }
__device__ __forceinline__ bf16x8 ld2x8(const bf16_t* p0, const bf16_t* p1) { const u32x2 a = *(const u32x2*)p0, b = *(const u32x2*)p1; u32x4 w = {a.x, a.y, b.x, b.y}; return __builtin_bit_cast(bf16x8, w); }
__device__ __forceinline__ f32x4 mfma16(bf16x8 a, bf16x8 b, f32x4 c) { return __builtin_amdgcn_mfma_f32_16x16x32_bf16(a, b, c, 0, 0, 0); }
__device__ __forceinline__ float wave_sum(float v) {
#pragma unroll
    for (int o = 1; o < 64; o <<= 1) v += __shfl_xor(v, o);
    return v; }
__device__ __forceinline__ float ex2(float x) { return __builtin_amdgcn_exp2f(x); }
__device__ __forceinline__ float sigmoidf_(float x) { return 1.f / (1.f + __expf(-x)); }
__device__ __forceinline__ float softplusf_(float x) { return fmaxf(x, 0.f) + log1pf(expf(-fabsf(x))); }
#define LDS_WAIT() asm volatile("s_waitcnt lgkmcnt(0)" ::: "memory")
#define VM_WAIT() asm volatile("s_waitcnt vmcnt(0)" ::: "memory")

#define EPI_LANE_SETUP() int t_ = threadIdx.x; asm volatile("" : "+v"(t_)); const int fr = t_ & 15, fq = (t_ >> 4) & 3; const int wv_ = __builtin_amdgcn_readfirstlane(t_ >> 6); const int wr = wv_ >> 2, wc = wv_ & 3
struct EpiInproj {
    static constexpr bool PERM = false, AFTER_DRAIN = false;
    unsigned char* ws;
    __device__ __forceinline__ void operator()(const f32x4 (&acc)[2][2][4][2], const pg8::Unit& u, int, int, int, int) const {
        EPI_LANE_SETUP();
        const int pn = u.pn; const int row0 = u.pm * 256 + wr * 64 + fr;
        if (pn == 40) {
            if (wc == 0) {
                float* sm = (float*)(ws + O_SMALL);
#pragma unroll
                for (int ai = 0; ai < 2; ++ai)
#pragma unroll
                    for (int m = 0; m < 4; ++m) { float* rp = sm + (size_t)(row0 + ai * 128 + m * 16) * 32 + 4 * fq;
                        *(f32x4*)rp = acc[ai][0][m][0]; *(f32x4*)(rp + 16) = acc[ai][0][m][1]; }
            }
            return;
        }
        bf16_t* base; int pitch, ct, act;
        if (pn < 4) { base = (bf16_t*)(ws + O_UV); pitch = 1024; ct = pn; act = 1; }
        else if (pn < 10) { base = (bf16_t*)(ws + O_FQKV); pitch = 1536; ct = pn - 4; act = 0; }
        else if (pn < 16) { base = (bf16_t*)(ws + O_MQKV); pitch = 1536; ct = pn - 10; act = 0; }
        else if (pn < 19) { base = (bf16_t*)(ws + O_Z); pitch = 768; ct = pn - 16; act = 2; }
        else if (pn < 24) { base = (bf16_t*)(ws + O_XBC); pitch = 1280; ct = pn - 19; act = 0; }
        else { base = (bf16_t*)(ws + O_GATE); pitch = 4096; ct = pn - 24; act = 3; }
        const int col0 = ct * 256 + wc * 32 + 4 * fq;
#pragma unroll
        for (int ai = 0; ai < 2; ++ai)
#pragma unroll
            for (int m = 0; m < 4; ++m) { bf16_t* rowp = base + (size_t)(row0 + ai * 128 + m * 16) * pitch + col0;
#pragma unroll
                for (int bj = 0; bj < 2; ++bj)
#pragma unroll
                    for (int n = 0; n < 2; ++n) { f32x4 v = acc[ai][bj][m][n];
#pragma unroll
                        for (int j = 0; j < 4; ++j) { const float x = v[j];
                            const float uu = 1.5957691216057308f * (x + 0.044715f * x * x * x);
                            const float arg = (act == 1) ? uu : (act == 0) ? INFINITY : x;
                            const float num = (act == 3) ? 1.f : x;
                            v[j] = num / (1.f + __expf(-arg)); }
                        u32x2 w; w.x = cvtpk(v[0], v[1]); w.y = cvtpk(v[2], v[3]);
                        *(u32x2*)(rowp + bj * 128 + n * 16) = w; }
                asm volatile("" ::: "memory"); }
    }
};
struct EpiMerge {
    static constexpr bool PERM = false, AFTER_DRAIN = false;
    const bf16_t* gate; float* mf; bf16_t* outb; int mode;
    __device__ __forceinline__ void operator()(const f32x4 (&acc)[2][2][4][2], const pg8::Unit& u, int, int, int, int) const {
        EPI_LANE_SETUP();
        const int row0 = u.pm * 256 + wr * 64 + fr, col0 = u.pn * 256 + wc * 32 + 4 * fq;
#pragma unroll
        for (int ai = 0; ai < 2; ++ai)
#pragma unroll
            for (int m = 0; m < 4; ++m) { const size_t row = (size_t)(row0 + ai * 128 + m * 16);
#pragma unroll
                for (int bj = 0; bj < 2; ++bj)
#pragma unroll
                    for (int n = 0; n < 2; ++n) { const int col = col0 + bj * 128 + n * 16;
                        const u32x2 gw = *(const u32x2*)(gate + row * 4096 + col);
                        f32x4 v = acc[ai][bj][m][n]; v[0] *= bflo(gw.x); v[1] *= bfhi(gw.x); v[2] *= bflo(gw.y); v[3] *= bfhi(gw.y);
                        float* mp = mf + row * 1024 + col;
                        if (mode == 0) *(f32x4*)mp = v;
                        else if (mode == 1) *(f32x4*)mp = *(const f32x4*)mp + v;
                        else { v = *(const f32x4*)mp + v; u32x2 w; w.x = cvtpk(v[0], v[1]); w.y = cvtpk(v[2], v[3]); *(u32x2*)(outb + row * 1024 + col) = w; } }
                asm volatile("" ::: "memory"); }
    }
};
struct EpiResid {
    static constexpr bool PERM = false, AFTER_DRAIN = false;
    const float* xin; float* xout; const float* gmod;
    __device__ __forceinline__ void operator()(const f32x4 (&acc)[2][2][4][2], const pg8::Unit& u, int, int, int, int) const {
        EPI_LANE_SETUP();
        const int row0 = u.pm * 256 + wr * 64 + fr, col0 = u.pn * 256 + wc * 32 + 4 * fq; const int b = u.pm >> 4;
        const float* gp = gmod + (size_t)b * 6144 + col0;
#pragma unroll
        for (int ai = 0; ai < 2; ++ai)
#pragma unroll
            for (int m = 0; m < 4; ++m) { const size_t off = (size_t)(row0 + ai * 128 + m * 16) * 1024 + col0;
#pragma unroll
                for (int bj = 0; bj < 2; ++bj)
#pragma unroll
                    for (int n = 0; n < 2; ++n) { const int co = bj * 128 + n * 16; const f32x4 g = *(const f32x4*)(gp + co);
                        *(f32x4*)(xout + off + co) = *(const f32x4*)(xin + off + co) + g * acc[ai][bj][m][n]; }
                asm volatile("" ::: "memory"); }
    }
};
struct EpiRelu2 {
    static constexpr bool PERM = false, AFTER_DRAIN = false;
    bf16_t* out;
    __device__ __forceinline__ void operator()(const f32x4 (&acc)[2][2][4][2], const pg8::Unit& u, int, int, int, int) const {
        EPI_LANE_SETUP();
        const int row0 = u.pm * 256 + wr * 64 + fr, col0 = u.pn * 256 + wc * 32 + 4 * fq;
#pragma unroll
        for (int ai = 0; ai < 2; ++ai)
#pragma unroll
            for (int m = 0; m < 4; ++m) { bf16_t* rowp = out + (size_t)(row0 + ai * 128 + m * 16) * 4096 + col0;
#pragma unroll
                for (int bj = 0; bj < 2; ++bj)
#pragma unroll
                    for (int n = 0; n < 2; ++n) { f32x4 v = acc[ai][bj][m][n];
#pragma unroll
                        for (int j = 0; j < 4; ++j) { const float r = fmaxf(v[j], 0.f); v[j] = r * r; }
                        u32x2 w; w.x = cvtpk(v[0], v[1]); w.y = cvtpk(v[2], v[3]); *(u32x2*)(rowp + bj * 128 + n * 16) = w; }
                asm volatile("" ::: "memory"); }
    }
};
struct EpiU {
    static constexpr bool PERM = false, AFTER_DRAIN = false;
    int kind, mode; const void* p0; void* p1; void* p2; int dry;
    __device__ __forceinline__ void operator()(const f32x4 (&acc)[2][2][4][2], const pg8::Unit& u, int a, int b, int c, int d) const {
        if (dry) return;
        if (kind == 0) { EpiInproj e{(unsigned char*)p1}; e(acc, u, a, b, c, d); }
        else if (kind == 1) { EpiMerge e{(const bf16_t*)p0, (float*)p1, (bf16_t*)p2, mode}; e(acc, u, a, b, c, d); }
        else if (kind == 2) { EpiResid e{(const float*)p0, (float*)p1, (const float*)p2}; e(acc, u, a, b, c, d); }
        else { EpiRelu2 e{(bf16_t*)p1}; e(acc, u, a, b, c, d); }
    }
};
template <class Epi>
__device__ __forceinline__ void run_gemm(unsigned char* lds, const bf16_t* A, int lda, const bf16_t* Bt, int N, int K, const Epi& E) {
    pg8::Gemm g{A, Bt, T, N, K, lda}; pg8::StaticOrder S; S.init(T, N, (int)gridDim.x, (int)blockIdx.x);
    pg8::gemm_phase<Epi, pg8::StaticOrder, true, true>((PG8_LAS unsigned char*)lds, g, S, E);
}

__device__ __forceinline__ void phase_pre(const Params& p, unsigned char* lds, const int tid) {
    float* cs = (float*)lds; float* red = cs + 4096;
    const float* c = PIN(1); const float* ada_w = PIN(2); const float* ada_b = PIN(3);
    float* mod = (float*)(p.ws + O_MOD);
    for (int i = tid; i < 4096; i += 512) { const float v = c[i]; cs[i] = v / (1.f + expf(-v)); }
    __syncthreads();
    const int jj = tid & 63, ks = tid >> 6;
    for (int it = blockIdx.x; it < DEPTH * 96; it += gridDim.x) {
        const int l = it / 96, jb = it % 96;
        const float* w = ada_w + (size_t)l * 1024 * 6144 + jb * 64 + jj;
        float a0 = 0.f, a1 = 0.f, a2 = 0.f, a3 = 0.f;
#pragma unroll 8
        for (int k = ks * 128; k < ks * 128 + 128; ++k) { const float wv = w[(size_t)k * 6144]; a0 += cs[k] * wv; a1 += cs[1024 + k] * wv; a2 += cs[2048 + k] * wv; a3 += cs[3072 + k] * wv; }
        red[(ks * 64 + jj) * 4 + 0] = a0; red[(ks * 64 + jj) * 4 + 1] = a1; red[(ks * 64 + jj) * 4 + 2] = a2; red[(ks * 64 + jj) * 4 + 3] = a3;
        __syncthreads();
        if (tid < 256) { const int b = tid >> 6, j2 = tid & 63; float s = 0.f;
#pragma unroll
            for (int q = 0; q < 8; ++q) s += red[(q * 64 + j2) * 4 + b];
            const int cc = jb * 64 + j2; mod[((size_t)l * 4 + b) * 6144 + cc] = s + ada_b[l * 6144 + cc]; }
        __syncthreads();
    }
}

__device__ __forceinline__ int inproj_src_col(int n) {
    if (n < 2560) return n;
    if (n < 6144) return n + 8;
    if (n < 10240) return n + 20;
    if (n < 10248) return 2560 + (n - 10240);
    if (n < 10260) return 6152 + (n - 10248);
    return -1;
}
__device__ __forceinline__ void transpose_item(const float* W, int K, int Nsrc, bf16_t* WT, float* scr, int k0, int n0, int lane, bool remap) {
    const int nd = n0 + (lane & 31); const int sc = remap ? inproj_src_col(nd) : nd;
#pragma unroll 8
    for (int i = 0; i < 32; ++i) { const int kk = 2 * i + (lane >> 5); scr[kk * 33 + (lane & 31)] = (sc >= 0) ? W[(size_t)(k0 + kk) * Nsrc + sc] : 0.f; }
    LDS_WAIT();
    const int c = lane & 7;
#pragma unroll
    for (int j = 0; j < 4; ++j) { const int n = (lane >> 3) + 8 * j; const float* s = scr + (8 * c) * 33 + n;
        u32x4 o; o.x = cvtpk(s[0 * 33], s[1 * 33]); o.y = cvtpk(s[2 * 33], s[3 * 33]); o.z = cvtpk(s[4 * 33], s[5 * 33]); o.w = cvtpk(s[6 * 33], s[7 * 33]);
        *(u32x4*)(WT + (size_t)(n0 + n) * K + k0 + 8 * c) = o; }
    LDS_WAIT();
}
__device__ __forceinline__ void convert_weights(const Params& p, int l, unsigned char* lds, int gw, int NGW, int wid, int lane) {
    float* scr = (float*)(lds + wid * 16384);
    unsigned char* ws = p.ws;
    constexpr int I_IN = 16 * (NPROJ / 32), I_BR = 8 * 32, I_D = 12 * 32, I_O = 16 * 32, I_1 = 16 * 128, I_2 = 64 * 32;
    constexpr int TOT = I_IN + 3 * I_BR + I_D + I_O + I_1 + I_2;
    for (int it = gw; it < TOT; it += NGW) {
        int r = it; const float* W; bf16_t* WT; int K, Nsrc, Nd; bool remap = false;
        if (r < I_IN) { W = PIN(5) + (size_t)l * 1024 * IN_COLS; WT = (bf16_t*)(ws + O_WIN); K = 1024; Nsrc = IN_COLS; Nd = NPROJ; remap = true; }
        else if ((r -= I_IN) < I_BR) { W = PIN(17) + (size_t)l * 512 * 1024; WT = (bf16_t*)(ws + O_WA); K = 512; Nsrc = 1024; Nd = 1024; }
        else if ((r -= I_BR) < I_BR) { W = PIN(18) + (size_t)l * 512 * 1024; WT = (bf16_t*)(ws + O_WB); K = 512; Nsrc = 1024; Nd = 1024; }
        else if ((r -= I_BR) < I_BR) { W = PIN(19) + (size_t)l * 512 * 1024; WT = (bf16_t*)(ws + O_WC); K = 512; Nsrc = 1024; Nd = 1024; }
        else if ((r -= I_BR) < I_D) { W = PIN(20) + (size_t)l * 768 * 1024; WT = (bf16_t*)(ws + O_WD); K = 768; Nsrc = 1024; Nd = 1024; }
        else if ((r -= I_D) < I_O) { W = PIN(21) + (size_t)l * 1024 * 1024; WT = (bf16_t*)(ws + O_WO); K = 1024; Nsrc = 1024; Nd = 1024; }
        else if ((r -= I_O) < I_1) { W = PIN(23) + (size_t)l * 1024 * 4096; WT = (bf16_t*)(ws + O_W1); K = 1024; Nsrc = 4096; Nd = 4096; }
        else { r -= I_1; W = PIN(24) + (size_t)l * 4096 * 1024; WT = (bf16_t*)(ws + O_W2); K = 4096; Nsrc = 1024; Nd = 1024; }
        const int nblk = Nd / 32, kb = r / nblk, nb = r % nblk;
        transpose_item(W, K, Nsrc, WT, scr, 64 * kb, 32 * nb, lane, remap);
    }
    const float* gws = PIN(8) + (size_t)l * 8 * 128 * 128; bf16_t* gd = (bf16_t*)(ws + O_GWS);
    for (int e = gw * 64 + lane; e < 8 * 128 * 128; e += NGW * 64) { const int s = e & 127, t = (e >> 7) & 127; const float v = (s <= t) ? gws[e] : 0.f; gd[e] = (bf16_t)(cvtpk(v, 0.f) & 0xffffu); }
}
__device__ __forceinline__ void norm_mod_rows(const float* x, const float* w, const float* sh, const float* sc, bf16_t* out, int gw, int NGW, int lane) {
    for (int row = gw; row < T; row += NGW) {
        const int b = row >> 12; const f32x4* xr = (const f32x4*)(x + (size_t)row * 1024) + lane;
        f32x4 v[4]; float ss = 0.f;
#pragma unroll
        for (int j = 0; j < 4; ++j) { v[j] = xr[64 * j]; ss += (v[j][0] * v[j][0] + v[j][1] * v[j][1]) + (v[j][2] * v[j][2] + v[j][3] * v[j][3]); }
        const float rstd = rsqrtf(wave_sum(ss) * (1.f / 1024.f) + NORM_EPS);
#pragma unroll
        for (int j = 0; j < 4; ++j) { const int col = 4 * (64 * j + lane);
            const f32x4 wv = *(const f32x4*)(w + col), sv = *(const f32x4*)(sc + (size_t)b * 6144 + col), hv = *(const f32x4*)(sh + (size_t)b * 6144 + col);
            const f32x4 o = (v[j] * rstd * wv) * (sv + 1.f) + hv;
            u32x2 pk; pk.x = cvtpk(o[0], o[1]); pk.y = cvtpk(o[2], o[3]); *(u32x2*)(out + (size_t)row * 1024 + col) = pk; }
    }
}
__device__ __forceinline__ void final_norm_rows(const float* x, const float* w, float* out, int gw, int NGW, int lane) {
    for (int row = gw; row < T; row += NGW) {
        const f32x4* xr = (const f32x4*)(x + (size_t)row * 1024) + lane;
        f32x4 v[4]; float ss = 0.f;
#pragma unroll
        for (int j = 0; j < 4; ++j) { v[j] = xr[64 * j]; ss += (v[j][0] * v[j][0] + v[j][1] * v[j][1]) + (v[j][2] * v[j][2] + v[j][3] * v[j][3]); }
        const float rstd = rsqrtf(wave_sum(ss) * (1.f / 1024.f) + NORM_EPS);
#pragma unroll
        for (int j = 0; j < 4; ++j) { const int col = 4 * (64 * j + lane); const f32x4 wv = *(const f32x4*)(w + col);
            *(f32x4*)(out + (size_t)row * 1024 + col) = v[j] * rstd * wv; }
    }
}

__device__ __forceinline__ void gmlp_item(const Params& p, int l, unsigned char* lds, int item, int wid, int lane) {
    const int grp = item & 7, ch = (item >> 3) & 31, b = item >> 8;
    const int fr = lane & 15, fq = lane >> 4;
    bf16_t* UV = (bf16_t*)(p.ws + O_UV); const bf16_t* GWS = (const bf16_t*)(p.ws + O_GWS);
    const float* lnw = PIN(6) + l * 512; const float* lnb = PIN(7) + l * 512; const float* bs = PIN(9) + (size_t)l * 8 * 128 + grp * 128;
    bf16_t* vnT = (bf16_t*)lds;
    const size_t row0 = (size_t)b * SEQ + ch * 128;
    for (int r = 0; r < 16; ++r) {
        const int s = wid * 16 + r;
        const bf16x8 raw = *(const bf16x8*)(UV + (row0 + s) * 1024 + 512 + 8 * lane);
        float x[8]; float sum = 0.f;
#pragma unroll
        for (int j = 0; j < 8; ++j) { x[j] = bf2f(raw[j]); sum += x[j]; }
        const float mean = wave_sum(sum) * (1.f / 512.f); float sq = 0.f;
#pragma unroll
        for (int j = 0; j < 8; ++j) { x[j] -= mean; sq += x[j] * x[j]; }
        const float rstd = rsqrtf(wave_sum(sq) * (1.f / 512.f) + NORM_EPS);
        if ((lane >> 3) == grp) { const int c0 = (lane & 7) * 8;
#pragma unroll
            for (int j = 0; j < 8; ++j) { const int cc = grp * 64 + c0 + j; const float o = x[j] * rstd * lnw[cc] + lnb[cc]; vnT[(c0 + j) * 136 + s] = (bf16_t)(cvtpk(o, 0.f) & 0xffffu); } }
    }
    __syncthreads();
    const int t0 = wid * 16;
    f32x4 acc[4];
#pragma unroll
    for (int ct = 0; ct < 4; ++ct) acc[ct] = (f32x4){0.f, 0.f, 0.f, 0.f};
    const int nks = (t0 + 15) / 32 + 1;
    for (int ks = 0; ks < nks; ++ks) {
        const bf16x8 bw = *(const bf16x8*)(GWS + ((size_t)grp * 128 + t0 + fr) * 128 + ks * 32 + 8 * fq);
#pragma unroll
        for (int ct = 0; ct < 4; ++ct) { const bf16x8 av = *(const bf16x8*)(vnT + (ct * 16 + fr) * 136 + ks * 32 + 8 * fq); acc[ct] = mfma16(av, bw, acc[ct]); }
    }
    const float bsv = bs[t0 + fr];
#pragma unroll
    for (int ct = 0; ct < 4; ++ct) { bf16_t* up = UV + (row0 + t0 + fr) * 1024 + grp * 64 + ct * 16 + 4 * fq;
        const u32x2 uw = *(const u32x2*)up; u32x2 o;
        o.x = cvtpk(bflo(uw.x) * (acc[ct][0] + bsv), bfhi(uw.x) * (acc[ct][1] + bsv)); o.y = cvtpk(bflo(uw.y) * (acc[ct][2] + bsv), bfhi(uw.y) * (acc[ct][3] + bsv));
        *(u32x2*)up = o; }
    __syncthreads();
}
__device__ __forceinline__ void rotary_item(const Params& p, unsigned char* lds, int item, int tid) {
    const int h = item & 7, nb = (item >> 3) & 15, b = item >> 7;
    float* sums = (float*)lds;
    if (tid < 64) sums[tid] = 0.f;
    __syncthreads();
    bf16_t* MQ = (bf16_t*)(p.ws + O_MQKV);
    const int tt = tid >> 1, half = tid & 1; const int pos = nb * 256 + tt; const size_t row = (size_t)b * SEQ + pos;
    bf16_t* kp = MQ + row * 1536 + 512 + h * 64 + half * 32;
    float kv[32];
#pragma unroll
    for (int q = 0; q < 4; ++q) { const bf16x8 raw = *(const bf16x8*)(kp + 8 * q);
#pragma unroll
        for (int j = 0; j < 8; ++j) kv[8 * q + j] = bf2f(raw[j]); }
    if (half == 0) {
        bf16_t* qp = MQ + row * 1536 + h * 64;
        float qv[16];
        { const bf16x8 r0 = *(const bf16x8*)qp, r1 = *(const bf16x8*)(qp + 8);
#pragma unroll
          for (int j = 0; j < 8; ++j) { qv[j] = bf2f(r0[j]); qv[8 + j] = bf2f(r1[j]); } }
#pragma unroll
        for (int j = 0; j < 8; ++j) {
            const float inv_freq = powf(500000.0f, -(float)j * 0.125f); const float ang = (float)pos * inv_freq;
            const float cs = cosf(ang), sn = sinf(ang);
            const float k1 = kv[j], k2 = kv[8 + j]; kv[j] = k1 * cs - k2 * sn; kv[8 + j] = k2 * cs + k1 * sn;
            const float q1 = qv[j], q2 = qv[8 + j]; qv[j] = q1 * cs - q2 * sn; qv[8 + j] = q2 * cs + q1 * sn;
        }
        *(bf16x8*)kp = pack8(kv[0], kv[1], kv[2], kv[3], kv[4], kv[5], kv[6], kv[7]);
        *(bf16x8*)(kp + 8) = pack8(kv[8], kv[9], kv[10], kv[11], kv[12], kv[13], kv[14], kv[15]);
        *(bf16x8*)qp = pack8(qv[0], qv[1], qv[2], qv[3], qv[4], qv[5], qv[6], qv[7]);
        *(bf16x8*)(qp + 8) = pack8(qv[8], qv[9], qv[10], qv[11], qv[12], qv[13], qv[14], qv[15]);
    }
#pragma unroll
    for (int d = 0; d < 32; ++d) {
        float v = kv[d];
#pragma unroll
        for (int o = 2; o < 64; o <<= 1) v += __shfl_xor(v, o);
        if ((tid & 63) < 2) atomicAdd(&sums[half * 32 + d], v);
    }
    __syncthreads();
    if (tid < 64) ((float*)(p.ws + O_KMEAN))[(((size_t)b * 8 + h) * 16 + nb) * 64 + tid] = sums[tid] * (1.f / 256.f);
    __syncthreads();
}
__device__ __forceinline__ void vt_item(const Params& p, unsigned char* lds, int item, int tid) {
    const int tb = item & 31, h = (item >> 5) & 7, b = (item >> 8) & 3, which = item >> 10;
    const bf16_t* src = (const bf16_t*)(p.ws + (which ? O_MQKV : O_FQKV)) + ((size_t)b * SEQ + tb * 128) * 1536 + 1024 + h * 64;
    bf16_t* dst = (bf16_t*)(p.ws + (which ? O_VTM : O_VTF)) + ((size_t)(b * 8 + h) * 64) * 4096 + tb * 128;
    bf16_t* tl = (bf16_t*)lds;
    { const int tok = tid >> 2, dq = tid & 3;
      const bf16x8 r0 = *(const bf16x8*)(src + (size_t)tok * 1536 + dq * 16), r1 = *(const bf16x8*)(src + (size_t)tok * 1536 + dq * 16 + 8);
#pragma unroll
      for (int j = 0; j < 8; ++j) { tl[(dq * 16 + j) * 136 + tok] = (bf16_t)r0[j]; tl[(dq * 16 + 8 + j) * 136 + tok] = (bf16_t)r1[j]; } }
    __syncthreads();
    { const int d = tid >> 3, c = tid & 7;
      const bf16x8 a = *(const bf16x8*)(tl + d * 136 + c * 16), bq = *(const bf16x8*)(tl + d * 136 + c * 16 + 8);
      *(bf16x8*)(dst + (size_t)d * 4096 + c * 16) = a; *(bf16x8*)(dst + (size_t)d * 4096 + c * 16 + 8) = bq; }
    __syncthreads();
}
__device__ __forceinline__ void conv_item(const Params& p, int l, unsigned char* lds, int item, int tid) {
    const int cb = item % 20, ch = (item / 20) & 31, b = item / 640;
    const bf16_t* XBC = (const bf16_t*)(p.ws + O_XBC);
    float* tile = (float*)lds;
    const int t00 = ch * 128 - 3;
    for (int e = tid; e < 131 * 64; e += 512) { const int r = e >> 6, c = e & 63; const int t = t00 + r;
        tile[r * 65 + c] = (t >= 0) ? bf2f((short)XBC[((size_t)b * SEQ + t) * 1280 + cb * 64 + c]) : 0.f; }
    __syncthreads();
    const int c = tid & 63, tg = tid >> 6; const int gc = cb * 64 + c;
    const float* cw = PIN(11) + (size_t)l * 4 * 1280 + gc; const float w0 = cw[0], w1 = cw[1280], w2 = cw[2560], w3 = cw[3840], cbv = PIN(12)[l * 1280 + gc];
    float o[16];
#pragma unroll
    for (int tt = 0; tt < 16; ++tt) { const int t = tg * 16 + tt;
        const float v = cbv + w0 * tile[t * 65 + c] + w1 * tile[(t + 1) * 65 + c] + w2 * tile[(t + 2) * 65 + c] + w3 * tile[(t + 3) * 65 + c];
        o[tt] = v / (1.f + __expf(-v)); }
    const size_t tok0 = (size_t)b * SEQ + ch * 128 + tg * 16;
    const bf16x8 p0 = pack8(o[0], o[1], o[2], o[3], o[4], o[5], o[6], o[7]), p1 = pack8(o[8], o[9], o[10], o[11], o[12], o[13], o[14], o[15]);
    if (cb < 12) { bf16_t* d = (bf16_t*)(p.ws + O_XT) + ((size_t)(b * 12 + cb) * 64 + c) * 4096 + ch * 128 + tg * 16; *(bf16x8*)d = p0; *(bf16x8*)(d + 8) = p1; }
    else {
        bf16_t* BC = (bf16_t*)(p.ws + O_BC); const int bc = gc - 768;
#pragma unroll
        for (int tt = 0; tt < 8; ++tt) { BC[(tok0 + tt) * 512 + bc] = (bf16_t)p0[tt]; BC[(tok0 + 8 + tt) * 512 + bc] = (bf16_t)p1[tt]; }
        if (cb < 16) { bf16_t* d = (bf16_t*)(p.ws + O_BT) + ((size_t)b * 256 + bc) * 4096 + ch * 128 + tg * 16; *(bf16x8*)d = p0; *(bf16x8*)(d + 8) = p1; }
    }
    __syncthreads();
}
__device__ __forceinline__ void acum_item(const Params& p, int l, int item, int lane) {
    const int ch = item & 31, h = (item >> 5) % 12, b = item / 384;
    const float* sm = (const float*)(p.ws + O_SMALL); const float a = -expf(PIN(14)[l * 12 + h]);
    const size_t tok = (size_t)b * SEQ + ch * 128 + 2 * lane;
    const float dtb = PIN(13)[l * 12 + h];
    const float d0 = softplusf_(sm[tok * 32 + 8 + h] + dtb), d1 = softplusf_(sm[(tok + 1) * 32 + 8 + h] + dtb);
    { f32x2 dd = {d0, d1}; *(f32x2*)((float*)(p.ws + O_DT) + ((size_t)(b * 12 + h)) * 4096 + ch * 128 + 2 * lane) = dd; }
    const float v0 = d0 * a, v1 = d1 * a;
    float sc = v0 + v1;
#pragma unroll
    for (int o = 1; o < 64; o <<= 1) { const float t = __shfl_up(sc, o); if (lane >= o) sc += t; }
    const float ex = sc - (v0 + v1);
    f32x2 r = {ex + v0, ex + v0 + v1};
    *(f32x2*)((float*)(p.ws + O_ACUM) + ((size_t)(b * 12 + h)) * 4096 + ch * 128 + 2 * lane) = r;
}
__device__ __forceinline__ void foxcum_item(const Params& p, int l, int item, int lane) {
    const int h = item & 7, b = item >> 3; const float fb = PIN(10)[l * 8 + h];
    const float* sm = (const float*)(p.ws + O_SMALL) + ((size_t)b * SEQ) * 32 + h;
    float* cum = (float*)(p.ws + O_CUMF) + (size_t)(b * 8 + h) * 4096;
    float carry = 0.f;
    for (int r = 0; r < 64; ++r) {
        const float v = -softplusf_(-(sm[(size_t)(r * 64 + lane) * 32] + fb)); float sc = v;
#pragma unroll
        for (int o = 1; o < 64; o <<= 1) { const float t = __shfl_up(sc, o); if (lane >= o) sc += t; }
        cum[r * 64 + lane] = carry + sc;
        carry += __shfl(sc, 63);
    }
}

template <bool MOBA>
__device__ __forceinline__ void attn_tile(const bf16_t* KL, const bf16_t* VL, const float* __restrict__ cum, int k0, bool diag, int kb,
                                          const bf16x8 (&qf)[2][2], const float (&cq)[2], const unsigned (&sel)[2], int qpos0, int fr, int fq,
                                          float (&m)[2], float (&lsum)[2], f32x4 (&o)[4][2]) {
    bf16x8 kf[2][2];
#pragma unroll
    for (int jk = 0; jk < 2; ++jk)
#pragma unroll
        for (int ks = 0; ks < 2; ++ks) kf[jk][ks] = *(const bf16x8*)(KL + (16 * jk + fr) * 72 + ks * 32 + 8 * fq);
    bf16x8 vf[4];
#pragma unroll
    for (int dt = 0; dt < 4; ++dt) { const bf16_t* vp = VL + (dt * 16 + fr) * 72 + 4 * fq; vf[dt] = ld2x8(vp, vp + 16); }
    f32x4 s[2][2];
#pragma unroll
    for (int jk = 0; jk < 2; ++jk)
#pragma unroll
        for (int jq = 0; jq < 2; ++jq) { f32x4 z = {0.f, 0.f, 0.f, 0.f}; z = mfma16(kf[jk][0], qf[jq][0], z); s[jk][jq] = mfma16(kf[jk][1], qf[jq][1], z); }
    constexpr float C2 = 0.125f * LOG2E;
#pragma unroll
    for (int jk = 0; jk < 2; ++jk) {
        f32x4 ck = {0.f, 0.f, 0.f, 0.f};
        if (!MOBA) ck = *(const f32x4*)(cum + k0 + 16 * jk + 4 * fq) * LOG2E;
#pragma unroll
        for (int jq = 0; jq < 2; ++jq) {
            const bool blocked = MOBA && kb >= 0 && !((sel[jq] >> kb) & 1u);
#pragma unroll
            for (int i = 0; i < 4; ++i) { const int key = k0 + 16 * jk + 4 * fq + i; const int qp = qpos0 + 16 * jq + fr;
                float v = s[jk][jq][i] * C2; if (!MOBA) v += cq[jq] - ck[i];
                if ((diag && key > qp) || blocked) v = -INFINITY;
                s[jk][jq][i] = v; } }
    }
    bf16x8 pb[2];
#pragma unroll
    for (int jq = 0; jq < 2; ++jq) {
        float mx = fmaxf(fmaxf(fmaxf(s[0][jq][0], s[0][jq][1]), fmaxf(s[0][jq][2], s[0][jq][3])), fmaxf(fmaxf(s[1][jq][0], s[1][jq][1]), fmaxf(s[1][jq][2], s[1][jq][3])));
        mx = fmaxf(mx, __shfl_xor(mx, 16)); mx = fmaxf(mx, __shfl_xor(mx, 32));
        const float mnew = fmaxf(m[jq], mx); const float alpha = ex2(m[jq] - mnew); m[jq] = mnew;
        float pv[8]; float ps = 0.f;
#pragma unroll
        for (int i = 0; i < 4; ++i) { pv[i] = ex2(s[0][jq][i] - mnew); pv[4 + i] = ex2(s[1][jq][i] - mnew); ps += pv[i] + pv[4 + i]; }
        lsum[jq] = lsum[jq] * alpha + ps;
#pragma unroll
        for (int dt = 0; dt < 4; ++dt) o[dt][jq] = o[dt][jq] * alpha;
        pb[jq] = pack8(pv[0], pv[1], pv[2], pv[3], pv[4], pv[5], pv[6], pv[7]);
    }
#pragma unroll
    for (int dt = 0; dt < 4; ++dt)
#pragma unroll
        for (int jq = 0; jq < 2; ++jq) o[dt][jq] = mfma16(vf[dt], pb[jq], o[dt][jq]);
}
template <bool MOBA>
__device__ __forceinline__ void attn_block_item(const Params& p, unsigned char* lds, int b, int h, int qb, int tid, int wid, int lane) {
    const int fr = lane & 15, fq = lane >> 4; const int q0 = qb * 256 + wid * 32;
    bf16_t* KLb = (bf16_t*)lds; bf16_t* VLb = KLb + 2 * 64 * 72;
    bf16_t* qkv = (bf16_t*)(p.ws + (MOBA ? O_MQKV : O_FQKV)) + ((size_t)b * SEQ) * 1536 + h * 64;
    const bf16_t* kbase = qkv + 512; const bf16_t* vtbase = (const bf16_t*)(p.ws + (MOBA ? O_VTM : O_VTF)) + ((size_t)(b * 8 + h) * 64) * 4096;
    const float* cum = (const float*)(p.ws + O_CUMF) + (size_t)(b * 8 + h) * 4096;
    bf16x8 qf[2][2];
#pragma unroll
    for (int jq = 0; jq < 2; ++jq)
#pragma unroll
        for (int ks = 0; ks < 2; ++ks) qf[jq][ks] = *(const bf16x8*)(qkv + (size_t)(q0 + 16 * jq + fr) * 1536 + ks * 32 + 8 * fq);
    float cq[2] = {0.f, 0.f}; unsigned sel[2] = {0u, 0u}; unsigned umask = 0u;
    const int own = qb;
    if (!MOBA) { cq[0] = cum[q0 + fr] * LOG2E; cq[1] = cum[q0 + 16 + fr] * LOG2E; }
    else if (own > 0) {
        const float* km = (const float*)(p.ws + O_KMEAN) + ((size_t)(b * 8 + h) * 16) * 64 + 16 * fq;
#pragma unroll
        for (int jq = 0; jq < 2; ++jq) {
            const bf16_t* qp = qkv + (size_t)(q0 + 16 * jq + fr) * 1536 + 16 * fq;
            const bf16x8 r0 = *(const bf16x8*)qp, r1 = *(const bf16x8*)(qp + 8);
            float qd[16];
#pragma unroll
            for (int j = 0; j < 8; ++j) { qd[j] = bf2f(r0[j]); qd[8 + j] = bf2f(r1[j]); }
            float gate[15];
#pragma unroll
            for (int n = 0; n < 15; ++n) {
                float a = -INFINITY;
                if (n < own) { a = 0.f;
#pragma unroll
                    for (int d = 0; d < 16; d += 4) { const f32x4 kk = *(const f32x4*)(km + n * 64 + d); a += qd[d] * kk[0] + qd[d + 1] * kk[1] + qd[d + 2] * kk[2] + qd[d + 3] * kk[3]; }
                    a += __shfl_xor(a, 16); a += __shfl_xor(a, 32); }
                gate[n] = a;
            }
            unsigned msk = 0u;
#pragma unroll
            for (int pass = 0; pass < 3; ++pass) { float best = -INFINITY; int bi = -1;
#pragma unroll
                for (int n = 0; n < 15; ++n) { const float v = ((msk >> n) & 1u) ? -INFINITY : gate[n]; if (v > best) { best = v; bi = n; } }
                if (bi >= 0) msk |= 1u << bi; }
            sel[jq] = msk;
        }
        umask = sel[0] | sel[1];
#pragma unroll
        for (int o2 = 1; o2 < 16; o2 <<= 1) umask |= __shfl_xor(umask, o2);
        umask = __builtin_amdgcn_readfirstlane(umask);
    }
    float m[2] = {-1e30f, -1e30f}, lsum[2] = {0.f, 0.f}; f32x4 o[4][2];
#pragma unroll
    for (int dt = 0; dt < 4; ++dt) { o[dt][0] = (f32x4){0.f, 0.f, 0.f, 0.f}; o[dt][1] = (f32x4){0.f, 0.f, 0.f, 0.f}; }
    const int NT = 4 * (qb + 1);
    const int lr = tid >> 3, lc = (tid & 7) * 8;
    #define TILE_KT(i) (MOBA ? (((i) < 4) ? 4 * qb + (i) : (i) - 4) : (i))
    bf16x8 kreg, vreg;
    { const int k0 = TILE_KT(0) * 64; kreg = *(const bf16x8*)(kbase + (size_t)(k0 + lr) * 1536 + lc); vreg = *(const bf16x8*)(vtbase + (size_t)lr * 4096 + k0 + lc); }
    *(bf16x8*)(KLb + lr * 72 + lc) = kreg; *(bf16x8*)(VLb + lr * 72 + lc) = vreg;
    __syncthreads();
#pragma unroll 1
    for (int i = 0; i < NT; ++i) {
        const int k0 = TILE_KT(i) * 64; const int buf = i & 1;
        if (i + 1 < NT) { const int k1 = TILE_KT(i + 1) * 64; kreg = *(const bf16x8*)(kbase + (size_t)(k1 + lr) * 1536 + lc); vreg = *(const bf16x8*)(vtbase + (size_t)lr * 4096 + k1 + lc); }
        const bf16_t* KL = KLb + buf * 64 * 72; const bf16_t* VL = VLb + buf * 64 * 72;
        const int kb = k0 >> 8;
        const bool live = !MOBA || kb == own || ((umask >> kb) & 1u);
        if (live) {
#pragma unroll
            for (int kk = 0; kk < 2; ++kk) { const int k0h = k0 + 32 * kk;
                if (k0h <= q0 + 31) attn_tile<MOBA>(KL + kk * 32 * 72, VL + kk * 32, cum, k0h, k0h + 31 > q0, (MOBA && kb < own) ? kb : -1, qf, cq, sel, q0, fr, fq, m, lsum, o); }
        }
        if (i + 1 < NT) { *(bf16x8*)((bf16_t*)KLb + (buf ^ 1) * 64 * 72 + lr * 72 + lc) = kreg; *(bf16x8*)((bf16_t*)VLb + (buf ^ 1) * 64 * 72 + lr * 72 + lc) = vreg; }
        __syncthreads();
    }
    #undef TILE_KT
#pragma unroll
    for (int jq = 0; jq < 2; ++jq) {
        float ls = lsum[jq]; ls += __shfl_xor(ls, 16); ls += __shfl_xor(ls, 32); const float inv = 1.f / ls;
        bf16_t* op = qkv + (size_t)(q0 + 16 * jq + fr) * 1536 + 4 * fq;
#pragma unroll
        for (int dt = 0; dt < 4; ++dt) { const f32x4 v = o[dt][jq] * inv; u32x2 w; w.x = cvtpk(v[0], v[1]); w.y = cvtpk(v[2], v[3]); *(u32x2*)(op + dt * 16) = w; }
    }
}
__device__ __forceinline__ void ssd_states_item(const Params& p, int item, int lane) {
    const int h = item % 12, c = (item / 12) & 31, b = item / 384; const int grp = h / 6;
    const int fr = lane & 15, fq = lane >> 4;
    const float* ac = (const float*)(p.ws + O_ACUM) + (size_t)(b * 12 + h) * 4096 + c * 128;
    const float* dtp = (const float*)(p.ws + O_DT) + (size_t)(b * 12 + h) * 4096 + c * 128;
    const bf16_t* XT = (const bf16_t*)(p.ws + O_XT) + ((size_t)(b * 12 + h) * 64) * 4096 + c * 128;
    const bf16_t* BT = (const bf16_t*)(p.ws + O_BT) + ((size_t)(b * 2 + grp) * 128) * 4096 + c * 128;
    float* ST = (float*)(p.ws + O_ST) + ((size_t)((b * 32 + c) * 12 + h)) * 8192;
    const float total = ac[127];
#pragma unroll 1
    for (int q2 = 0; q2 < 4; ++q2) {
        f32x4 acc[4][2];
#pragma unroll
        for (int pt = 0; pt < 4; ++pt) { acc[pt][0] = (f32x4){0.f, 0.f, 0.f, 0.f}; acc[pt][1] = (f32x4){0.f, 0.f, 0.f, 0.f}; }
#pragma unroll 1
        for (int ks = 0; ks < 4; ++ks) {
            const int s0 = ks * 32 + 8 * fq;
            const f32x4 a0 = *(const f32x4*)(ac + s0), a1 = *(const f32x4*)(ac + s0 + 4);
            const f32x4 d0 = *(const f32x4*)(dtp + s0), d1 = *(const f32x4*)(dtp + s0 + 4);
            float w8[8];
#pragma unroll
            for (int j = 0; j < 4; ++j) { w8[j] = expf(total - a0[j]) * d0[j]; w8[4 + j] = expf(total - a1[j]) * d1[j]; }
            const bf16x8 b0 = *(const bf16x8*)(BT + (size_t)((q2 * 2 + 0) * 16 + fr) * 4096 + s0), b1 = *(const bf16x8*)(BT + (size_t)((q2 * 2 + 1) * 16 + fr) * 4096 + s0);
#pragma unroll
            for (int pt = 0; pt < 4; ++pt) { const bf16x8 xa = *(const bf16x8*)(XT + (size_t)(pt * 16 + fr) * 4096 + s0);
                const bf16x8 af = pack8(bf2f(xa[0]) * w8[0], bf2f(xa[1]) * w8[1], bf2f(xa[2]) * w8[2], bf2f(xa[3]) * w8[3], bf2f(xa[4]) * w8[4], bf2f(xa[5]) * w8[5], bf2f(xa[6]) * w8[6], bf2f(xa[7]) * w8[7]);
                acc[pt][0] = mfma16(af, b0, acc[pt][0]); acc[pt][1] = mfma16(af, b1, acc[pt][1]); }
        }
#pragma unroll
        for (int pt = 0; pt < 4; ++pt)
#pragma unroll
            for (int nt = 0; nt < 2; ++nt)
#pragma unroll
                for (int i = 0; i < 4; ++i) ST[(size_t)(pt * 16 + 4 * fq + i) * 128 + (q2 * 2 + nt) * 16 + fr] = acc[pt][nt][i];
    }
}
__device__ __forceinline__ void ssd_scan(const Params& p, int gtid, int gthreads) {
    const float* ST = (const float*)(p.ws + O_ST); bf16_t* PV = (bf16_t*)(p.ws + O_PREV); const float* ACUM = (const float*)(p.ws + O_ACUM);
    for (int e = gtid; e < NB * 12 * 8192; e += gthreads) {
        const int pn = e & 8191, h = (e >> 13) % 12, b = e / (12 * 8192);
        const float* ac = ACUM + (size_t)(b * 12 + h) * 4096;
        float hs = 0.f;
        for (int c = 0; c < 32; ++c) { const size_t idx = ((size_t)((b * 32 + c) * 12 + h)) * 8192 + pn;
            const float st = ST[idx]; PV[idx] = (bf16_t)(cvtpk(hs, 0.f) & 0xffffu); hs = hs * expf(ac[c * 128 + 127]) + st; }
    }
}
__device__ __forceinline__ void ssd_out_item(const Params& p, int l, int item, int wid, int lane) {
    const int grp = item & 1, c = (item >> 1) & 31, b = item >> 6;
    const int fr = lane & 15, fq = lane >> 4; const int w = wid; const int tl = 16 * w + fr;
    const size_t row0 = (size_t)b * SEQ + c * 128; const size_t row = row0 + tl;
    const bf16_t* BC = (const bf16_t*)(p.ws + O_BC);
    bf16_t* Z = (bf16_t*)(p.ws + O_Z);
    bf16x8 cf[4];
#pragma unroll
    for (int ks = 0; ks < 4; ++ks) cf[ks] = *(const bf16x8*)(BC + row * 512 + 256 + grp * 128 + ks * 32 + 8 * fq);
    f32x4 cbt[8];
#pragma unroll
    for (int js = 0; js < 8; ++js) { cbt[js] = (f32x4){0.f, 0.f, 0.f, 0.f};
        if (js <= w) {
#pragma unroll
            for (int ks = 0; ks < 4; ++ks) { const bf16x8 a = *(const bf16x8*)(BC + (row0 + js * 16 + fr) * 512 + grp * 128 + ks * 32 + 8 * fq); cbt[js] = mfma16(a, cf[ks], cbt[js]); } } }
    float ssq = 0.f;
#pragma unroll 1
    for (int r = 0; r < 6; ++r) {
        const int h = grp * 6 + r;
        const float* ac = (const float*)(p.ws + O_ACUM) + (size_t)(b * 12 + h) * 4096 + c * 128;
        const float* dtp = (const float*)(p.ws + O_DT) + (size_t)(b * 12 + h) * 4096 + c * 128;
        const float acl = ac[tl]; const float eacl = expf(acl); const float Dh = PIN(15)[l * 12 + h];
        const bf16_t* PV = (const bf16_t*)(p.ws + O_PREV) + ((size_t)((b * 32 + c) * 12 + h)) * 8192;
        const bf16_t* XT = (const bf16_t*)(p.ws + O_XT) + ((size_t)(b * 12 + h) * 64) * 4096 + c * 128;
        f32x4 yt[4];
#pragma unroll
        for (int pt = 0; pt < 4; ++pt) yt[pt] = (f32x4){0.f, 0.f, 0.f, 0.f};
#pragma unroll
        for (int ks = 0; ks < 4; ++ks)
#pragma unroll
            for (int pt = 0; pt < 4; ++pt) { const bf16x8 a = *(const bf16x8*)(PV + (size_t)(pt * 16 + fr) * 128 + ks * 32 + 8 * fq); yt[pt] = mfma16(a, cf[ks], yt[pt]); }
#pragma unroll
        for (int pt = 0; pt < 4; ++pt) yt[pt] = yt[pt] * eacl;
#pragma unroll
        for (int jp = 0; jp < 4; ++jp) {
            if (2 * jp <= w) {
                const int sA = 32 * jp + 4 * fq, sB = sA + 16;
                const f32x4 a0 = *(const f32x4*)(ac + sA), a1 = *(const f32x4*)(ac + sB), dv0 = *(const f32x4*)(dtp + sA), dv1 = *(const f32x4*)(dtp + sB);
                float mv[8];
#pragma unroll
                for (int j = 0; j < 4; ++j) {
                    const int s = sA + j; const float d0 = dv0[j];
                    float v = (s <= tl) ? cbt[2 * jp][j] * expf(acl - a0[j]) * d0 : 0.f; if (s == tl) v += Dh; mv[j] = v;
                    const int s2 = sB + j; const float d1 = dv1[j];
                    float v2 = (s2 <= tl) ? cbt[2 * jp + 1][j] * expf(acl - a1[j]) * d1 : 0.f; if (s2 == tl) v2 += Dh; mv[4 + j] = v2;
                }
                const bf16x8 mb = pack8(mv[0], mv[1], mv[2], mv[3], mv[4], mv[5], mv[6], mv[7]);
#pragma unroll
                for (int pt = 0; pt < 4; ++pt) { const bf16_t* xp = XT + (size_t)(pt * 16 + fr) * 4096 + sA; yt[pt] = mfma16(ld2x8(xp, xp + 16), mb, yt[pt]); }
            }
        }
#pragma unroll
        for (int pt = 0; pt < 4; ++pt) { bf16_t* zp = Z + row * 768 + h * 64 + pt * 16 + 4 * fq; const u32x2 zw = *(const u32x2*)zp;
            const float y0 = yt[pt][0] * bflo(zw.x), y1 = yt[pt][1] * bfhi(zw.x), y2 = yt[pt][2] * bflo(zw.y), y3 = yt[pt][3] * bfhi(zw.y);
            ssq += (y0 * y0 + y1 * y1) + (y2 * y2 + y3 * y3);
            u32x2 o; o.x = cvtpk(y0, y1); o.y = cvtpk(y2, y3); *(u32x2*)zp = o; }
    }
    ssq += __shfl_xor(ssq, 16); ssq += __shfl_xor(ssq, 32);
    const float rstd = rsqrtf(ssq * (1.f / 384.f) + NORM_EPS);
    VM_WAIT();
    const float* nw = PIN(16) + l * 768 + grp * 384;
    bf16_t* zp0 = Z + row * 768 + grp * 384 + 4 * fq;
#pragma unroll 4
    for (int q = 0; q < 24; ++q) { bf16_t* zp = zp0 + q * 16; const u32x2 zw = *(const u32x2*)zp; const f32x4 nv = *(const f32x4*)(nw + q * 16 + 4 * fq);
        u32x2 o; o.x = cvtpk(bflo(zw.x) * rstd * nv[0], bfhi(zw.x) * rstd * nv[1]); o.y = cvtpk(bflo(zw.y) * rstd * nv[2], bfhi(zw.y) * rstd * nv[3]); *(u32x2*)zp = o; }
}

constexpr int PH_PER_LAYER = 11, N_PHASES = 1 + DEPTH * PH_PER_LAYER + 1;
template <int EN_MASK, bool EN_GEMM>
__device__ __forceinline__ void fwd_body(const Params& p) {
    extern __shared__ __attribute__((aligned(16))) unsigned char lds[];
    cg::grid_group grid = cg::this_grid();
    const int G = gridDim.x, NGW = G * 8;
    unsigned char* ws = p.ws;
    float* mod = (float*)(ws + O_MOD); float* X = (float*)(ws + O_X); bf16_t* H = (bf16_t*)(ws + O_H);
    for (int ph = p.ph_lo; ph < p.ph_hi; ++ph) {
        int tid = threadIdx.x; asm volatile("" : "+v"(tid));
        const int lane = tid & 63, wid = __builtin_amdgcn_readfirstlane(tid >> 6); const int gw = blockIdx.x * 8 + wid;
        if (ph == 0) { if constexpr (EN_MASK != 0) phase_pre(p, lds, tid); }
        else if (ph == N_PHASES - 1) { if constexpr (EN_MASK != 0) final_norm_rows(X, PIN(25), p.out, gw, NGW, lane); }
        else {
            const int l = (ph - 1) / PH_PER_LAYER, k = (ph - 1) % PH_PER_LAYER;
            const float* modl = mod + (size_t)l * 4 * 6144;
            const float* xin = (l == 0) ? PIN(0) : X;
            if (k == 1 || k == 6 || k == 7 || k == 9 || k == 10) { if constexpr (EN_GEMM) {
                const int nsub = (k == 6) ? 4 : 1;
#pragma unroll 1
                for (int br = 0; br < nsub; ++br) {
                    EpiU E{}; const bf16_t* A; const bf16_t* Bt; int lda, N, K;
                    if (k == 1) { E.kind = 0; E.p1 = ws; A = H; lda = 1024; Bt = (const bf16_t*)(ws + O_WIN); N = NPROJ; K = 1024; }
                    else if (k == 6) {
                        const size_t aoffs = (br == 0) ? O_UV : (br == 1) ? O_FQKV : (br == 2) ? O_MQKV : O_Z;
                        const size_t woffs = (br == 0) ? O_WA : (br == 1) ? O_WB : (br == 2) ? O_WC : O_WD;
                        E.kind = 1; E.p0 = (const bf16_t*)(ws + O_GATE) + br * 1024; E.p1 = (float*)(ws + O_MF32); E.p2 = H; E.mode = (br == 0) ? 0 : (br == 3) ? 2 : 1;
                        A = (const bf16_t*)(ws + aoffs); lda = (br == 0) ? 1024 : (br == 3) ? 768 : 1536; Bt = (const bf16_t*)(ws + woffs); N = 1024; K = (br == 3) ? 768 : 512; }
                    else if (k == 7) { E.kind = 2; E.p0 = xin; E.p1 = X; E.p2 = (void*)(modl + 2048); A = H; lda = 1024; Bt = (const bf16_t*)(ws + O_WO); N = 1024; K = 1024; }
                    else if (k == 9) { E.kind = 3; E.p1 = (bf16_t*)(ws + O_HID); A = H; lda = 1024; Bt = (const bf16_t*)(ws + O_W1); N = 4096; K = 1024; }
                    else { E.kind = 2; E.p0 = X; E.p1 = X; E.p2 = (void*)(modl + 5120); A = (const bf16_t*)(ws + O_HID); lda = 4096; Bt = (const bf16_t*)(ws + O_W2); N = 1024; K = 4096; }
#ifdef PROBE_DUP_GEMM
                    E.dry = (p.ph_lo == 0); run_gemm(lds, A, lda, Bt, N, K, E); E.dry = 0;
#endif
                    run_gemm(lds, A, lda, Bt, N, K, E);
                }
            } } else switch (k) {
            case 0: if constexpr ((EN_MASK >> 0) & 1) {
                convert_weights(p, l, lds, gw, NGW, wid, lane);
                norm_mod_rows(xin, PIN(4) + l * 1024, modl + 0, modl + 1024, H, gw, NGW, lane);
            } break;
            case 2: if constexpr ((EN_MASK >> 2) & 1) {
                for (int it = blockIdx.x; it < 1024; it += G) gmlp_item(p, l, lds, it, wid, lane);
                for (int it = blockIdx.x; it < 512; it += G) rotary_item(p, lds, it, tid);
                for (int it = blockIdx.x; it < 2048; it += G) vt_item(p, lds, it, tid);
                for (int it = blockIdx.x; it < 2560; it += G) conv_item(p, l, lds, it, tid);
                for (int it = gw; it < 1536; it += NGW) acum_item(p, l, it, lane);
                for (int it = NGW - 1 - gw; it < 32; it += NGW) foxcum_item(p, l, it, lane);
            } break;
            case 3: if constexpr ((EN_MASK >> 3) & 1) {
#ifndef EN3
#define EN3 7
#endif
                for (int i = blockIdx.x; i < 512; i += G) { const int bh = i & 31, r = i >> 5; const int qb = (r < 8) ? 15 - r : r - 8;
                    if constexpr (EN3 & 1) attn_block_item<false>(p, lds, bh >> 3, bh & 7, qb, tid, wid, lane);
                    if constexpr (EN3 & 2) attn_block_item<true>(p, lds, bh >> 3, bh & 7, qb, tid, wid, lane); }
                if constexpr (EN3 & 4) for (int i = NGW - 1 - gw; i < 1536; i += NGW) ssd_states_item(p, i, lane);
            } break;
            case 4: if constexpr ((EN_MASK >> 4) & 1) { ssd_scan(p, blockIdx.x * 512 + tid, G * 512); } break;
            case 5: if constexpr ((EN_MASK >> 5) & 1) { for (int it = blockIdx.x; it < 256; it += G) ssd_out_item(p, l, it, wid, lane); } break;
            case 8: if constexpr ((EN_MASK >> 8) & 1) { norm_mod_rows(X, PIN(22) + l * 1024, modl + 3072, modl + 4096, H, gw, NGW, lane); } break;
            }
        }
        if (ph + 1 < p.ph_hi) grid.sync();
    }
}

#ifndef N_LAUNCH_MODE
#define N_LAUNCH_MODE 1
#endif
#if N_LAUNCH_MODE == 1
__global__ void __launch_bounds__(512, 2) fwd_all(Params p) { fwd_body<0x7ff, true>(p); }
#define KERNEL_FOR_ATTR fwd_all
#else
__global__ void __launch_bounds__(512, 2) fwd_gemm(Params p) { fwd_body<0, true>(p); }
__global__ void __launch_bounds__(512, 2) fwd_misc(Params p) { fwd_body<0x7ff, false>(p); }
#endif
extern "C" void kernel_launch(void* const* d_in, const int* in_sizes, int n_in, void* d_out, int out_size, void* d_ws, size_t ws_size, hipStream_t stream) {
    static int grid = 0;
    if (grid == 0) {
        if (n_in != 26 || out_size != T * DM || ws_size < WS_END) { fprintf(stderr, "kernel_launch: unexpected shapes (n_in %d out %d ws %zu need %zu)\n", n_in, out_size, ws_size, (size_t)WS_END); grid = -1; return; }
        int dev = 0, cus = 0;
        (void)hipGetDevice(&dev); (void)hipDeviceGetAttribute(&cus, hipDeviceAttributeMultiprocessorCount, dev);
#if N_LAUNCH_MODE == 1
        if (hipFuncSetAttribute((const void*)fwd_all, hipFuncAttributeMaxDynamicSharedMemorySize, LDS_BYTES) != hipSuccess) { fprintf(stderr, "kernel_launch: hipFuncSetAttribute failed\n"); grid = -1; return; }
#else
        if (hipFuncSetAttribute((const void*)fwd_gemm, hipFuncAttributeMaxDynamicSharedMemorySize, LDS_BYTES) != hipSuccess || hipFuncSetAttribute((const void*)fwd_misc, hipFuncAttributeMaxDynamicSharedMemorySize, LDS_BYTES) != hipSuccess) { fprintf(stderr, "kernel_launch: hipFuncSetAttribute failed\n"); grid = -1; return; }
#endif
        (void)hipGetLastError();
        grid = cus > 0 ? cus : 256;
    }
    if (grid < 0) return;
    Params p{};
    for (int i = 0; i < 26; ++i) p.in[i] = (const float*)d_in[i];
    p.out = (float*)d_out; p.ws = (unsigned char*)d_ws;
#if N_LAUNCH_MODE == 1
    p.ph_lo = 0; p.ph_hi = N_PHASES;
    void* args[] = {&p};
    hipError_t e = hipLaunchCooperativeKernel((const void*)fwd_all, dim3(grid), dim3(512), args, LDS_BYTES, stream);
    if (e != hipSuccess) fprintf(stderr, "kernel_launch: cooperative launch failed: %s (grid %d)\n", hipGetErrorString(e), grid);
#else
    for (int ph = 0; ph < N_PHASES; ++ph) { p.ph_lo = ph; p.ph_hi = ph + 1;
        const int k = (ph >= 1 && ph < N_PHASES - 1) ? (ph - 1) % PH_PER_LAYER : -1;
        if (k == 1 || k == 6 || k == 7 || k == 9 || k == 10) hipLaunchKernelGGL(fwd_gemm, dim3(grid), dim3(512), LDS_BYTES, stream, p);
        else hipLaunchKernelGGL(fwd_misc, dim3(grid), dim3(512), LDS_BYTES, stream, p); }
#endif
}
```

```cpp
#include <hip/hip_runtime.h>
#include <hip/hip_cooperative_groups.h>
#include <cstdio>
#include <cstdint>
#include <cmath>
namespace cg = cooperative_groups;
namespace pg8 {
#define PG8_LAS __attribute__((address_space(3)))
typedef unsigned short bf16_t;
typedef short bf16x8 __attribute__((ext_vector_type(8)));
typedef float f32x4 __attribute__((ext_vector_type(4)));
typedef unsigned u32x4 __attribute__((ext_vector_type(4)));
constexpr int BM = 256, BK = 64, HALF = 128, HTB = HALF * BK * 2  , STAGE_BYTES = 8 * HTB, NXCD = 8, WGM = 8;

__host__ __device__ __forceinline__ int lds_byte(int r, int c) { const int st = (r >> 4) * 2 + (c >> 5), rr = r & 15, cc = c & 31, ob = rr * 64 + cc * 2; return st * 1024 + (ob ^ (((ob >> 9) & 1) << 5)); }
__host__ __device__ __forceinline__ void stage_rc(int b, int& R, int& C) { const int st = b / 1024, sb = b % 1024, swz = sb ^ (((sb >> 9) & 1) << 5); R = (st >> 1) * 16 + swz / 64; C = (st & 1) * 32 + (swz % 64) / 2; }
__host__ __device__ __forceinline__ int perm32(int rho) { const int n = rho >> 4, i = rho & 15; return 8 * (i >> 2) + 4 * n + (i & 3); }

struct Unit { int pm, pn; };
struct Gemm { const bf16_t* A; const bf16_t* Bt; int M, N, K, lda; };

struct StaticOrder {
    int nM, nN, nwg, G, c;
    __host__ __device__ void init(int M, int N, int G_, int c_) { nM = M / BM; nN = N / BM; nwg = nM * nN; G = G_; c = c_; }
    __host__ __device__ bool next(int i, Unit& u) const {
        const long L = (long)i * G + c; if (L >= nwg) return false;
        int wgid = (int)L; { const int q = nwg / NXCD, r = nwg % NXCD, xcd = wgid % NXCD, off = wgid / NXCD; wgid = (xcd < r ? xcd * (q + 1) : r * (q + 1) + (xcd - r) * q) + off; }
        const int nig = WGM * nN, gid = wgid / nig, fm = gid * WGM, gsz = (nM - fm) < WGM ? (nM - fm) : WGM;
        u.pm = fm + ((wgid % nig) % gsz); u.pn = (wgid % nig) / gsz; return true;
    }
    __device__ __forceinline__ void a_ready(const Unit&) const {}
    __device__ __forceinline__ void done(const Unit&) const {}
};


template <class Epi, class Sched, bool ALIGN_EPI = false, bool SP2 = false>
__device__ __forceinline__ void gemm_phase(PG8_LAS unsigned char* lds, const Gemm g, const Sched& S, const Epi& E) {
    const int tid = threadIdx.x, wid = __builtin_amdgcn_readfirstlane(tid >> 6), lane = tid & 63, wr = wid >> 2, wc = wid & 3, fr = lane & 15, fq = lane >> 4;
    const int K = g.K, nt = K / BK;
    unsigned voffA[2], voffB[2];
#pragma unroll
    for (int i = 0; i < 2; ++i) { int R, C; stage_rc(tid * 16 + i * 8192, R, C); const int Rb = Epi::PERM ? ((R & ~31) + perm32(R & 31)) : R;
        voffA[i] = (unsigned)(R * g.lda + C) * 2u; voffB[i] = (unsigned)(Rb * K + C) * 2u; }
    const size_t kstep = (size_t)(BK * 2);
    const size_t hstepB = (size_t)HALF * K * 2, hstepA = (size_t)HALF * g.lda * 2;
    const size_t tstepB = 2 * hstepB, tstepA = 2 * hstepA;
    const unsigned ldsw = (unsigned)wid * 1024u;
    const int aoff = lds_byte(wr * 64 + fr, fq * 8), boff = lds_byte(wc * 32 + fr, fq * 8);
#define PG8_SA(b, h) (((b) * 2 + (h)) * HTB)
#define PG8_SB(b, h) ((4 + (b) * 2 + (h)) * HTB)
#define PG8_STAGE(bufoff, gbase, voff) do { _Pragma("unroll") for (int _i = 0; _i < 2; ++_i) \
        __builtin_amdgcn_global_load_lds((const unsigned*)((const char*)(gbase) + (voff)[_i]), (PG8_LAS unsigned*)(lds + (bufoff) + ldsw + _i * 8192), 16, 0, 0); } while (0)
#define PG8_LDA(dst, b, h) do { _Pragma("unroll") for (int m = 0; m < 4; ++m) _Pragma("unroll") for (int k = 0; k < 2; ++k) dst[m][k] = *(const PG8_LAS bf16x8*)(lds + PG8_SA(b, h) + aoff + m * 2048 + k * 1024); } while (0)
#define PG8_LDB(dst, b, h) do { _Pragma("unroll") for (int n = 0; n < 2; ++n) _Pragma("unroll") for (int k = 0; k < 2; ++k) dst[n][k] = *(const PG8_LAS bf16x8*)(lds + PG8_SB(b, h) + boff + n * 2048 + k * 1024); } while (0)
#define PG8_MMA(ai, bj, At, Bt) do { __builtin_amdgcn_s_setprio(1); _Pragma("unroll") for (int m = 0; m < 4; ++m) _Pragma("unroll") for (int n = 0; n < 2; ++n) _Pragma("unroll") for (int k = 0; k < 2; ++k) \
        acc[ai][bj][m][n] = __builtin_amdgcn_mfma_f32_16x16x32_bf16(Bt[n][k], At[m][k], acc[ai][bj][m][n], 0, 0, 0); __builtin_amdgcn_s_setprio(0); } while (0)
#define PG8_WAIT_V(n) asm volatile("s_waitcnt vmcnt(" #n ")" ::: "memory")
#define PG8_WAIT_L(n) asm volatile("s_waitcnt lgkmcnt(" #n ")" ::: "memory")
#define PG8_BAR __builtin_amdgcn_s_barrier()
#define PG8_SCHED __builtin_amdgcn_sched_barrier(0)
    Unit cur, nxt; int ui = 0;
    if (!S.next(0, cur)) return;
    f32x4 acc[2][2][4][2];
#pragma unroll
    for (int a = 0; a < 2; ++a)
#pragma unroll
        for (int b = 0; b < 2; ++b)
#pragma unroll
            for (int m = 0; m < 4; ++m)
#pragma unroll
                for (int n = 0; n < 2; ++n) acc[a][b][m][n] = (f32x4){0.f, 0.f, 0.f, 0.f};
    bf16x8 At[4][2], B0[2][2], B1[2][2];
    const char* cA = (const char*)g.A + (size_t)cur.pm * tstepA; const char* cB = (const char*)g.Bt + (size_t)cur.pn * tstepB;
    S.a_ready(cur);
    if constexpr (SP2) {
        PG8_STAGE(PG8_SB(0, 0), cB, voffB); PG8_STAGE(PG8_SB(0, 1), cB + hstepB, voffB); PG8_STAGE(PG8_SA(0, 0), cA, voffA); PG8_STAGE(PG8_SA(0, 1), cA + hstepA, voffA);
        if (wr == 1) PG8_BAR;
        PG8_WAIT_V(2); PG8_BAR;
        PG8_STAGE(PG8_SB(1, 0), cB + kstep, voffB); PG8_STAGE(PG8_SA(1, 0), cA + kstep, voffA); PG8_STAGE(PG8_SB(1, 1), cB + hstepB + kstep, voffB);
        PG8_WAIT_V(6); PG8_BAR;
    } else {
        PG8_STAGE(PG8_SB(0, 0), cB, voffB); PG8_STAGE(PG8_SA(0, 0), cA, voffA); PG8_STAGE(PG8_SB(0, 1), cB + hstepB, voffB); PG8_STAGE(PG8_SA(0, 1), cA + hstepA, voffA);
        if (wr == 1) PG8_BAR;
        PG8_WAIT_V(4); PG8_BAR;
        PG8_STAGE(PG8_SB(1, 0), cB + kstep, voffB); PG8_STAGE(PG8_SA(1, 0), cA + kstep, voffA); PG8_STAGE(PG8_SB(1, 1), cB + hstepB + kstep, voffB);
        PG8_WAIT_V(6); PG8_BAR;
    }
    for (;;) {
        const bool has_next = S.next(ui + 1, nxt);
        const char* nA = has_next ? (const char*)g.A + (size_t)nxt.pm * tstepA : cA; const char* nB = has_next ? (const char*)g.Bt + (size_t)nxt.pn * tstepB : cB;
        for (int t = 0; t < nt; t += 2) {
            const bool last = (t == nt - 2);
            const char* a1 = cA + (size_t)(t + 1) * kstep;
            const char* a2 = last ? nA : cA + (size_t)(t + 2) * kstep; const char* b2 = last ? nB : cB + (size_t)(t + 2) * kstep;
            const char* a3 = a2 + kstep; const char* b3 = b2 + kstep;
            if (last && has_next) S.a_ready(nxt);
            if constexpr (SP2) {
            PG8_LDB(B0, 0, 0); PG8_LDB(B1, 0, 1); PG8_SCHED; PG8_LDA(At, 0, 0); PG8_STAGE(PG8_SA(1, 1), a1 + hstepA, voffA);
            PG8_WAIT_V(8); PG8_WAIT_L(0); PG8_BAR; PG8_MMA(0, 0, At, B0); PG8_MMA(0, 1, At, B1); PG8_BAR; PG8_SCHED;
            PG8_LDA(At, 0, 1); PG8_STAGE(PG8_SB(0, 0), b2, voffB); PG8_STAGE(PG8_SB(0, 1), b2 + hstepB, voffB); PG8_STAGE(PG8_SA(0, 0), a2, voffA);
            PG8_WAIT_V(8); PG8_WAIT_L(0); PG8_BAR; PG8_MMA(1, 0, At, B0); PG8_MMA(1, 1, At, B1); PG8_BAR; PG8_SCHED;
            PG8_LDB(B0, 1, 0); PG8_LDB(B1, 1, 1); PG8_SCHED; PG8_LDA(At, 1, 0); PG8_STAGE(PG8_SA(0, 1), a2 + hstepA, voffA);
            PG8_WAIT_V(8); PG8_WAIT_L(0); PG8_BAR; PG8_MMA(0, 0, At, B0); PG8_MMA(0, 1, At, B1); PG8_BAR; PG8_SCHED;
            PG8_LDA(At, 1, 1); PG8_STAGE(PG8_SB(1, 0), b3, voffB); PG8_STAGE(PG8_SB(1, 1), b3 + hstepB, voffB); PG8_STAGE(PG8_SA(1, 0), a3, voffA);
            PG8_WAIT_V(8); PG8_WAIT_L(0); PG8_BAR; PG8_MMA(1, 0, At, B0); PG8_MMA(1, 1, At, B1); PG8_BAR; PG8_SCHED;
            } else {
            PG8_LDB(B0, 0, 0); PG8_SCHED; PG8_LDA(At, 0, 0); PG8_STAGE(PG8_SA(1, 1), a1 + hstepA, voffA);
            PG8_WAIT_L(8); PG8_BAR; PG8_WAIT_L(0); PG8_MMA(0, 0, At, B0); PG8_BAR; PG8_SCHED;
            PG8_LDB(B1, 0, 1); PG8_STAGE(PG8_SB(0, 0), b2, voffB);
            PG8_BAR; PG8_WAIT_L(0); PG8_MMA(0, 1, At, B1); PG8_BAR;
            PG8_LDA(At, 0, 1); PG8_STAGE(PG8_SA(0, 0), a2, voffA);
            PG8_BAR; PG8_WAIT_L(0); PG8_MMA(1, 0, At, B0); PG8_BAR; PG8_SCHED;
            PG8_STAGE(PG8_SB(0, 1), b2 + hstepB, voffB);
            PG8_WAIT_V(6); PG8_BAR; PG8_MMA(1, 1, At, B1); PG8_BAR;
            PG8_LDB(B0, 1, 0); PG8_SCHED; PG8_LDA(At, 1, 0); PG8_STAGE(PG8_SA(0, 1), a2 + hstepA, voffA);
            PG8_WAIT_L(8); PG8_BAR; PG8_WAIT_L(0); PG8_MMA(0, 0, At, B0); PG8_BAR; PG8_SCHED;
            PG8_LDB(B1, 1, 1); PG8_STAGE(PG8_SB(1, 0), b3, voffB);
            PG8_BAR; PG8_WAIT_L(0); PG8_MMA(0, 1, At, B1); PG8_BAR;
            PG8_LDA(At, 1, 1); PG8_STAGE(PG8_SA(1, 0), a3, voffA);
            PG8_BAR; PG8_WAIT_L(0); PG8_MMA(1, 0, At, B0); PG8_BAR; PG8_SCHED;
            PG8_STAGE(PG8_SB(1, 1), b3 + hstepB, voffB);
            PG8_WAIT_V(6); PG8_BAR; PG8_MMA(1, 1, At, B1); PG8_BAR;
            }
        }
        if constexpr (ALIGN_EPI) { if (wr == 0) PG8_BAR; }
        if constexpr (!Epi::AFTER_DRAIN) { E(acc, cur, wr, wc, fr, fq); S.done(cur); }
        if (!has_next) break;
#pragma unroll
        for (int a = 0; a < 2; ++a)
#pragma unroll
            for (int b = 0; b < 2; ++b)
#pragma unroll
                for (int m = 0; m < 4; ++m)
#pragma unroll
                    for (int n = 0; n < 2; ++n) acc[a][b][m][n] = (f32x4){0.f, 0.f, 0.f, 0.f};
        cur = nxt; cA = nA; cB = nB; ++ui;
        if constexpr (ALIGN_EPI) { if (wr == 1) PG8_BAR; }
    }
    PG8_WAIT_V(0);
    if constexpr (!ALIGN_EPI) { if (wr == 0) PG8_BAR; }
    PG8_BAR;
    if constexpr (Epi::AFTER_DRAIN) { E.fused(acc, cur, wr, wc, fr, fq, lds, wid, lane); S.done(cur); }
#undef PG8_SA
#undef PG8_SB
#undef PG8_STAGE
#undef PG8_LDA
#undef PG8_LDB
#undef PG8_MMA
#undef PG8_WAIT_V
#undef PG8_WAIT_L
#undef PG8_BAR
#undef PG8_SCHED
}
}

constexpr int NB = 4, SEQ = 4096, T = NB * SEQ, DM = 1024, DEPTH = 4;
constexpr int NPROJ = 10496;
constexpr int IN_COLS = 10260;
constexpr float NORM_EPS = 1e-6f;
constexpr float LOG2E = 1.4426950408889634f;

typedef unsigned short bf16_t;
typedef short bf16x8 __attribute__((ext_vector_type(8)));
typedef float f32x4 __attribute__((ext_vector_type(4)));
typedef float f32x2 __attribute__((ext_vector_type(2)));
typedef unsigned u32x4 __attribute__((ext_vector_type(4)));
typedef unsigned u32x2 __attribute__((ext_vector_type(2)));
typedef __bf16 bf16x2_t __attribute__((ext_vector_type(2)));

constexpr size_t MiB = 1u << 20;
constexpr size_t O_MOD = 0, O_X = 1 * MiB, O_H = 65 * MiB, O_UV = 97 * MiB, O_FQKV = 129 * MiB, O_MQKV = 177 * MiB, O_Z = 225 * MiB,
                 O_XBC = 249 * MiB, O_GATE = 289 * MiB, O_SMALL = 417 * MiB, O_VTF = 419 * MiB, O_VTM = 435 * MiB, O_XT = 451 * MiB,
                 O_BC = 475 * MiB, O_BT = 491 * MiB, O_ST = 499 * MiB, O_CUMF = 547 * MiB, O_ACUM = 548 * MiB, O_KMEAN = 549 * MiB,
                 O_WIN = 550 * MiB, O_WA = 571 * MiB, O_WB = 572 * MiB, O_WC = 573 * MiB, O_WD = 574 * MiB, O_WO = 576 * MiB,
                 O_W1 = 578 * MiB, O_W2 = 586 * MiB, O_GWS = 594 * MiB, WS_END = 595 * MiB;
constexpr size_t O_DT = O_KMEAN + 256 * 1024;
constexpr size_t O_CTL = 512 * 1024;
constexpr size_t O_PREV = O_XBC;
constexpr size_t O_HID = O_GATE;
constexpr size_t O_MF32 = O_VTF;
constexpr int LDS_BYTES = 147456;

struct Params { const float* in[26]; float* out; unsigned char* ws; int ph_lo, ph_hi; };

__device__ __forceinline__ int opq(int i) { asm volatile("" : "+s"(i)); return i; }
#define PIN(i) (p.in[opq(i)])
__device__ __forceinline__ unsigned cvtpk(float lo, float hi) { f32x2 v = {lo, hi}; bf16x2_t b = __builtin_convertvector(v, bf16x2_t); return __builtin_bit_cast(unsigned, b); }
__device__ __forceinline__ float bf2f(short h) { return __uint_as_float(((unsigned)(unsigned short)h) << 16); }
__device__ __forceinline__ float bflo(unsigned w) { return __uint_as_float(w << 16); }
__device__ __forceinline__ float bfhi(unsigned w) { return __uint_as_float(w & 0xffff0000u); }
__device__ __forceinline__ bf16x8 pack8(float a0, float a1, float a2, float a3, float a4, float a5, float a6, float a7) {
    u32x4 w = {cvtpk(a0, a1), cvtpk(a2, a3), cvtpk(a4, a5), cvtpk(a6, a7)}; return __builtin_bit_cast(bf16x8, w); }
__device__ __forceinline__ bf16x8 ld2x8(const bf16_t* p0, const bf16_t* p1) { const u32x2 a = *(const u32x2*)p0, b = *(const u32x2*)p1; u32x4 w = {a.x, a.y, b.x, b.y}; return __builtin_bit_cast(bf16x8, w); }
__device__ __forceinline__ f32x4 mfma16(bf16x8 a, bf16x8 b, f32x4 c) { return __builtin_amdgcn_mfma_f32_16x16x32_bf16(a, b, c, 0, 0, 0); }
__device__ __forceinline__ float wave_sum(float v) {
#pragma unroll
    for (int o = 1; o < 64; o <<= 1) v += __shfl_xor(v, o);
    return v; }
__device__ __forceinline__ float ex2(float x) { return __builtin_amdgcn_exp2f(x); }
__device__ __forceinline__ float sigmoidf_(float x) { return 1.f / (1.f + __expf(-x)); }
__device__ __forceinline__ float softplusf_(float x) { return fmaxf(x, 0.f) + log1pf(expf(-fabsf(x))); }
#define LDS_WAIT() asm volatile("s_waitcnt lgkmcnt(0)" ::: "memory")
#define VM_WAIT() asm volatile("s_waitcnt vmcnt(0)" ::: "memory")

#define EPI_LANE_SETUP() int t_ = threadIdx.x; asm volatile("" : "+v"(t_)); const int fr = t_ & 15, fq = (t_ >> 4) & 3; const int wv_ = __builtin_amdgcn_readfirstlane(t_ >> 6); const int wr = wv_ >> 2, wc = wv_ & 3
struct EpiInproj {
    static constexpr bool PERM = false, AFTER_DRAIN = false;
    unsigned char* ws;
    __device__ __forceinline__ void operator()(const f32x4 (&acc)[2][2][4][2], const pg8::Unit& u, int, int, int, int) const {
        EPI_LANE_SETUP();
        const int pn = u.pn; const int row0 = u.pm * 256 + wr * 64 + fr;
        if (pn == 40) {
            if (wc == 0) {
                float* sm = (float*)(ws + O_SMALL);
#pragma unroll
                for (int ai = 0; ai < 2; ++ai)
#pragma unroll
                    for (int m = 0; m < 4; ++m) { float* rp = sm + (size_t)(row0 + ai * 128 + m * 16) * 32 + 4 * fq;
                        *(f32x4*)rp = acc[ai][0][m][0]; *(f32x4*)(rp + 16) = acc[ai][0][m][1]; }
            }
            return;
        }
        bf16_t* base; int pitch, ct, act;
        if (pn < 4) { base = (bf16_t*)(ws + O_UV); pitch = 1024; ct = pn; act = 1; }
        else if (pn < 10) { base = (bf16_t*)(ws + O_FQKV); pitch = 1536; ct = pn - 4; act = 0; }
        else if (pn < 16) { base = (bf16_t*)(ws + O_MQKV); pitch = 1536; ct = pn - 10; act = 0; }
        else if (pn < 19) { base = (bf16_t*)(ws + O_Z); pitch = 768; ct = pn - 16; act = 2; }
        else if (pn < 24) { base = (bf16_t*)(ws + O_XBC); pitch = 1280; ct = pn - 19; act = 0; }
        else { base = (bf16_t*)(ws + O_GATE); pitch = 4096; ct = pn - 24; act = 3; }
        const int col0 = ct * 256 + wc * 32 + 4 * fq;
#pragma unroll
        for (int ai = 0; ai < 2; ++ai)
#pragma unroll
            for (int m = 0; m < 4; ++m) { bf16_t* rowp = base + (size_t)(row0 + ai * 128 + m * 16) * pitch + col0;
#pragma unroll
                for (int bj = 0; bj < 2; ++bj)
#pragma unroll
                    for (int n = 0; n < 2; ++n) { f32x4 v = acc[ai][bj][m][n];
#pragma unroll
                        for (int j = 0; j < 4; ++j) { const float x = v[j];
                            const float uu = 1.5957691216057308f * (x + 0.044715f * x * x * x);
                            const float arg = (act == 1) ? uu : (act == 0) ? INFINITY : x;
                            const float num = (act == 3) ? 1.f : x;
                            v[j] = num / (1.f + __expf(-arg)); }
                        u32x2 w; w.x = cvtpk(v[0], v[1]); w.y = cvtpk(v[2], v[3]);
                        *(u32x2*)(rowp + bj * 128 + n * 16) = w; }
                asm volatile("" ::: "memory"); }
    }
};
struct EpiMerge {
    static constexpr bool PERM = false, AFTER_DRAIN = false;
    const bf16_t* gate; float* mf; bf16_t* outb; int mode;
    __device__ __forceinline__ void operator()(const f32x4 (&acc)[2][2][4][2], const pg8::Unit& u, int, int, int, int) const {
        EPI_LANE_SETUP();
        const int row0 = u.pm * 256 + wr * 64 + fr, col0 = u.pn * 256 + wc * 32 + 4 * fq;
#pragma unroll
        for (int ai = 0; ai < 2; ++ai)
#pragma unroll
            for (int m = 0; m < 4; ++m) { const size_t row = (size_t)(row0 + ai * 128 + m * 16);
#pragma unroll
                for (int bj = 0; bj < 2; ++bj)
#pragma unroll
                    for (int n = 0; n < 2; ++n) { const int col = col0 + bj * 128 + n * 16;
                        const u32x2 gw = *(const u32x2*)(gate + row * 4096 + col);
                        f32x4 v = acc[ai][bj][m][n]; v[0] *= bflo(gw.x); v[1] *= bfhi(gw.x); v[2] *= bflo(gw.y); v[3] *= bfhi(gw.y);
                        float* mp = mf + row * 1024 + col;
                        if (mode == 0) *(f32x4*)mp = v;
                        else if (mode == 1) *(f32x4*)mp = *(const f32x4*)mp + v;
                        else { v = *(const f32x4*)mp + v; u32x2 w; w.x = cvtpk(v[0], v[1]); w.y = cvtpk(v[2], v[3]); *(u32x2*)(outb + row * 1024 + col) = w; } }
                asm volatile("" ::: "memory"); }
    }
};
struct EpiResid {
    static constexpr bool PERM = false, AFTER_DRAIN = false;
    const float* xin; float* xout; const float* gmod;
    __device__ __forceinline__ void operator()(const f32x4 (&acc)[2][2][4][2], const pg8::Unit& u, int, int, int, int) const {
        EPI_LANE_SETUP();
        const int row0 = u.pm * 256 + wr * 64 + fr, col0 = u.pn * 256 + wc * 32 + 4 * fq; const int b = u.pm >> 4;
        const float* gp = gmod + (size_t)b * 6144 + col0;
#pragma unroll
        for (int ai = 0; ai < 2; ++ai)
#pragma unroll
            for (int m = 0; m < 4; ++m) { const size_t off = (size_t)(row0 + ai * 128 + m * 16) * 1024 + col0;
#pragma unroll
                for (int bj = 0; bj < 2; ++bj)
#pragma unroll
                    for (int n = 0; n < 2; ++n) { const int co = bj * 128 + n * 16; const f32x4 g = *(const f32x4*)(gp + co);
                        *(f32x4*)(xout + off + co) = *(const f32x4*)(xin + off + co) + g * acc[ai][bj][m][n]; }
                asm volatile("" ::: "memory"); }
    }
};
struct EpiRelu2 {
    static constexpr bool PERM = false, AFTER_DRAIN = false;
    bf16_t* out;
    __device__ __forceinline__ void operator()(const f32x4 (&acc)[2][2][4][2], const pg8::Unit& u, int, int, int, int) const {
        EPI_LANE_SETUP();
        const int row0 = u.pm * 256 + wr * 64 + fr, col0 = u.pn * 256 + wc * 32 + 4 * fq;
#pragma unroll
        for (int ai = 0; ai < 2; ++ai)
#pragma unroll
            for (int m = 0; m < 4; ++m) { bf16_t* rowp = out + (size_t)(row0 + ai * 128 + m * 16) * 4096 + col0;
#pragma unroll
                for (int bj = 0; bj < 2; ++bj)
#pragma unroll
                    for (int n = 0; n < 2; ++n) { f32x4 v = acc[ai][bj][m][n];
#pragma unroll
                        for (int j = 0; j < 4; ++j) { const float r = fmaxf(v[j], 0.f); v[j] = r * r; }
                        u32x2 w; w.x = cvtpk(v[0], v[1]); w.y = cvtpk(v[2], v[3]); *(u32x2*)(rowp + bj * 128 + n * 16) = w; }
                asm volatile("" ::: "memory"); }
    }
};
struct EpiU {
    static constexpr bool PERM = false, AFTER_DRAIN = false;
    int kind, mode; const void* p0; void* p1; void* p2; int dry;
    __device__ __forceinline__ void operator()(const f32x4 (&acc)[2][2][4][2], const pg8::Unit& u, int a, int b, int c, int d) const {
        if (dry) return;
        if (kind == 0) { EpiInproj e{(unsigned char*)p1}; e(acc, u, a, b, c, d); }
        else if (kind == 1) { EpiMerge e{(const bf16_t*)p0, (float*)p1, (bf16_t*)p2, mode}; e(acc, u, a, b, c, d); }
        else if (kind == 2) { EpiResid e{(const float*)p0, (float*)p1, (const float*)p2}; e(acc, u, a, b, c, d); }
        else { EpiRelu2 e{(bf16_t*)p1}; e(acc, u, a, b, c, d); }
    }
};
template <class Epi>
__device__ __forceinline__ void run_gemm(unsigned char* lds, const bf16_t* A, int lda, const bf16_t* Bt, int N, int K, const Epi& E) {
    pg8::Gemm g{A, Bt, T, N, K, lda}; pg8::StaticOrder S; S.init(T, N, (int)gridDim.x, (int)blockIdx.x);
    pg8::gemm_phase<Epi, pg8::StaticOrder, true, true>((PG8_LAS unsigned char*)lds, g, S, E);
}

__device__ __forceinline__ void phase_pre(const Params& p, unsigned char* lds, const int tid) {
    float* cs = (float*)lds; float* red = cs + 4096;
    const float* c = PIN(1); const float* ada_w = PIN(2); const float* ada_b = PIN(3);
    float* mod = (float*)(p.ws + O_MOD);
    for (int i = tid; i < 4096; i += 512) { const float v = c[i]; cs[i] = v / (1.f + expf(-v)); }
    __syncthreads();
    const int jj = tid & 63, ks = tid >> 6;
    for (int it = blockIdx.x; it < DEPTH * 96; it += gridDim.x) {
        const int l = it / 96, jb = it % 96;
        const float* w = ada_w + (size_t)l * 1024 * 6144 + jb * 64 + jj;
        float a0 = 0.f, a1 = 0.f, a2 = 0.f, a3 = 0.f;
#pragma unroll 8
        for (int k = ks * 128; k < ks * 128 + 128; ++k) { const float wv = w[(size_t)k * 6144]; a0 += cs[k] * wv; a1 += cs[1024 + k] * wv; a2 += cs[2048 + k] * wv; a3 += cs[3072 + k] * wv; }
        red[(ks * 64 + jj) * 4 + 0] = a0; red[(ks * 64 + jj) * 4 + 1] = a1; red[(ks * 64 + jj) * 4 + 2] = a2; red[(ks * 64 + jj) * 4 + 3] = a3;
        __syncthreads();
        if (tid < 256) { const int b = tid >> 6, j2 = tid & 63; float s = 0.f;
#pragma unroll
            for (int q = 0; q < 8; ++q) s += red[(q * 64 + j2) * 4 + b];
            const int cc = jb * 64 + j2; mod[((size_t)l * 4 + b) * 6144 + cc] = s + ada_b[l * 6144 + cc]; }
        __syncthreads();
    }
}

__device__ __forceinline__ int inproj_src_col(int n) {
    if (n < 2560) return n;
    if (n < 6144) return n + 8;
    if (n < 10240) return n + 20;
    if (n < 10248) return 2560 + (n - 10240);
    if (n < 10260) return 6152 + (n - 10248);
    return -1;
}
__device__ __forceinline__ void transpose_item(const float* W, int K, int Nsrc, bf16_t* WT, float* scr, int k0, int n0, int lane, bool remap) {
    const int nd = n0 + (lane & 31); const int sc = remap ? inproj_src_col(nd) : nd;
#pragma unroll
    for (int i = 0; i < 32; ++i) { const int kk = 2 * i + (lane >> 5); scr[kk * 33 + (lane & 31)] = (sc >= 0) ? W[(size_t)(k0 + kk) * Nsrc + sc] : 0.f; }
    LDS_WAIT();
    const int c = lane & 7;
#pragma unroll
    for (int j = 0; j < 4; ++j) { const int n = (lane >> 3) + 8 * j; const float* s = scr + (8 * c) * 33 + n;
        u32x4 o; o.x = cvtpk(s[0 * 33], s[1 * 33]); o.y = cvtpk(s[2 * 33], s[3 * 33]); o.z = cvtpk(s[4 * 33], s[5 * 33]); o.w = cvtpk(s[6 * 33], s[7 * 33]);
        *(u32x4*)(WT + (size_t)(n0 + n) * K + k0 + 8 * c) = o; }
    LDS_WAIT();
}
__device__ __forceinline__ void convert_weights(const Params& p, int l, unsigned char* lds, int gw, int NGW, int wid, int lane) {
    float* scr = (float*)(lds + wid * 16384);
    unsigned char* ws = p.ws;
    constexpr int I_IN = 16 * (NPROJ / 32), I_BR = 8 * 32, I_D = 12 * 32, I_O = 16 * 32, I_1 = 16 * 128, I_2 = 64 * 32;
    constexpr int TOT = I_IN + 3 * I_BR + I_D + I_O + I_1 + I_2;
    for (int it = gw; it < TOT; it += NGW) {
        int r = it; const float* W; bf16_t* WT; int K, Nsrc, Nd; bool remap = false;
        if (r < I_IN) { W = PIN(5) + (size_t)l * 1024 * IN_COLS; WT = (bf16_t*)(ws + O_WIN); K = 1024; Nsrc = IN_COLS; Nd = NPROJ; remap = true; }
        else if ((r -= I_IN) < I_BR) { W = PIN(17) + (size_t)l * 512 * 1024; WT = (bf16_t*)(ws + O_WA); K = 512; Nsrc = 1024; Nd = 1024; }
        else if ((r -= I_BR) < I_BR) { W = PIN(18) + (size_t)l * 512 * 1024; WT = (bf16_t*)(ws + O_WB); K = 512; Nsrc = 1024; Nd = 1024; }
        else if ((r -= I_BR) < I_BR) { W = PIN(19) + (size_t)l * 512 * 1024; WT = (bf16_t*)(ws + O_WC); K = 512; Nsrc = 1024; Nd = 1024; }
        else if ((r -= I_BR) < I_D) { W = PIN(20) + (size_t)l * 768 * 1024; WT = (bf16_t*)(ws + O_WD); K = 768; Nsrc = 1024; Nd = 1024; }
        else if ((r -= I_D) < I_O) { W = PIN(21) + (size_t)l * 1024 * 1024; WT = (bf16_t*)(ws + O_WO); K = 1024; Nsrc = 1024; Nd = 1024; }
        else if ((r -= I_O) < I_1) { W = PIN(23) + (size_t)l * 1024 * 4096; WT = (bf16_t*)(ws + O_W1); K = 1024; Nsrc = 4096; Nd = 4096; }
        else { r -= I_1; W = PIN(24) + (size_t)l * 4096 * 1024; WT = (bf16_t*)(ws + O_W2); K = 4096; Nsrc = 1024; Nd = 1024; }
        const int nblk = Nd / 32, kb = r / nblk, nb = r % nblk;
        transpose_item(W, K, Nsrc, WT, scr, 64 * kb, 32 * nb, lane, remap);
    }
    const float* gws = PIN(8) + (size_t)l * 8 * 128 * 128; bf16_t* gd = (bf16_t*)(ws + O_GWS);
    for (int e = gw * 64 + lane; e < 8 * 128 * 128; e += NGW * 64) { const int s = e & 127, t = (e >> 7) & 127; const float v = (s <= t) ? gws[e] : 0.f; gd[e] = (bf16_t)(cvtpk(v, 0.f) & 0xffffu); }
}
__device__ __forceinline__ void norm_mod_rows(const float* x, const float* w, const float* sh, const float* sc, bf16_t* out, int gw, int NGW, int lane) {
    for (int row = gw; row < T; row += NGW) {
        const int b = row >> 12; const f32x4* xr = (const f32x4*)(x + (size_t)row * 1024) + lane;
        f32x4 v[4]; float ss = 0.f;
#pragma unroll
        for (int j = 0; j < 4; ++j) { v[j] = xr[64 * j]; ss += (v[j][0] * v[j][0] + v[j][1] * v[j][1]) + (v[j][2] * v[j][2] + v[j][3] * v[j][3]); }
        const float rstd = rsqrtf(wave_sum(ss) * (1.f / 1024.f) + NORM_EPS);
#pragma unroll
        for (int j = 0; j < 4; ++j) { const int col = 4 * (64 * j + lane);
            const f32x4 wv = *(const f32x4*)(w + col), sv = *(const f32x4*)(sc + (size_t)b * 6144 + col), hv = *(const f32x4*)(sh + (size_t)b * 6144 + col);
            const f32x4 o = (v[j] * rstd * wv) * (sv + 1.f) + hv;
            u32x2 pk; pk.x = cvtpk(o[0], o[1]); pk.y = cvtpk(o[2], o[3]); *(u32x2*)(out + (size_t)row * 1024 + col) = pk; }
    }
}
__device__ __forceinline__ void final_norm_rows(const float* x, const float* w, float* out, int gw, int NGW, int lane) {
    for (int row = gw; row < T; row += NGW) {
        const f32x4* xr = (const f32x4*)(x + (size_t)row * 1024) + lane;
        f32x4 v[4]; float ss = 0.f;
#pragma unroll
        for (int j = 0; j < 4; ++j) { v[j] = xr[64 * j]; ss += (v[j][0] * v[j][0] + v[j][1] * v[j][1]) + (v[j][2] * v[j][2] + v[j][3] * v[j][3]); }
        const float rstd = rsqrtf(wave_sum(ss) * (1.f / 1024.f) + NORM_EPS);
#pragma unroll
        for (int j = 0; j < 4; ++j) { const int col = 4 * (64 * j + lane); const f32x4 wv = *(const f32x4*)(w + col);
            *(f32x4*)(out + (size_t)row * 1024 + col) = v[j] * rstd * wv; }
    }
}

__device__ __forceinline__ void gmlp_item(const Params& p, int l, unsigned char* lds, int item, int wid, int lane, bool dry = false) {
    const int grp = item & 7, ch = (item >> 3) & 31, b = item >> 8;
    const int fr = lane & 15, fq = lane >> 4;
    bf16_t* UV = (bf16_t*)(p.ws + O_UV); const bf16_t* GWS = (const bf16_t*)(p.ws + O_GWS);
    const float* lnw = PIN(6) + l * 512; const float* lnb = PIN(7) + l * 512; const float* bs = PIN(9) + (size_t)l * 8 * 128 + grp * 128;
    bf16_t* vnT = (bf16_t*)lds;
    const size_t row0 = (size_t)b * SEQ + ch * 128;
#pragma unroll 8
    for (int r = 0; r < 16; ++r) {
        const int s = wid * 16 + r;
        const bf16x8 raw = *(const bf16x8*)(UV + (row0 + s) * 1024 + 512 + 8 * lane);
        float x[8]; float sum = 0.f;
#pragma unroll
        for (int j = 0; j < 8; ++j) { x[j] = bf2f(raw[j]); sum += x[j]; }
        const float mean = wave_sum(sum) * (1.f / 512.f); float sq = 0.f;
#pragma unroll
        for (int j = 0; j < 8; ++j) { x[j] -= mean; sq += x[j] * x[j]; }
        const float rstd = rsqrtf(wave_sum(sq) * (1.f / 512.f) + NORM_EPS);
        if ((lane >> 3) == grp) { const int c0 = (lane & 7) * 8;
#pragma unroll
            for (int j = 0; j < 8; ++j) { const int cc = grp * 64 + c0 + j; const float o = x[j] * rstd * lnw[cc] + lnb[cc]; vnT[(c0 + j) * 136 + s] = (bf16_t)(cvtpk(o, 0.f) & 0xffffu); } }
    }
    __syncthreads();
    const int t0 = wid * 16;
    f32x4 acc[4];
#pragma unroll
    for (int ct = 0; ct < 4; ++ct) acc[ct] = (f32x4){0.f, 0.f, 0.f, 0.f};
    const int nks = (t0 + 15) / 32 + 1;
    for (int ks = 0; ks < nks; ++ks) {
        const bf16x8 bw = *(const bf16x8*)(GWS + ((size_t)grp * 128 + t0 + fr) * 128 + ks * 32 + 8 * fq);
#pragma unroll
        for (int ct = 0; ct < 4; ++ct) { const bf16x8 av = *(const bf16x8*)(vnT + (ct * 16 + fr) * 136 + ks * 32 + 8 * fq); acc[ct] = mfma16(av, bw, acc[ct]); }
    }
    const float bsv = bs[t0 + fr];
#pragma unroll
    for (int ct = 0; ct < 4; ++ct) { bf16_t* up = UV + (row0 + t0 + fr) * 1024 + grp * 64 + ct * 16 + 4 * fq;
        const u32x2 uw = *(const u32x2*)up; u32x2 o;
        o.x = cvtpk(bflo(uw.x) * (acc[ct][0] + bsv), bfhi(uw.x) * (acc[ct][1] + bsv)); o.y = cvtpk(bflo(uw.y) * (acc[ct][2] + bsv), bfhi(uw.y) * (acc[ct][3] + bsv));
        if (!dry) *(u32x2*)up = o; }
    __syncthreads();
}
__device__ __forceinline__ void rotary_item(const Params& p, unsigned char* lds, int item, int tid, bool dry = false) {
    const int h = item & 7, nb = (item >> 3) & 15, b = item >> 7;
    float* sums = (float*)lds;
    if (tid < 64) sums[tid] = 0.f;
    __syncthreads();
    bf16_t* MQ = (bf16_t*)(p.ws + O_MQKV);
    const int tt = tid >> 1, half = tid & 1; const int pos = nb * 256 + tt; const size_t row = (size_t)b * SEQ + pos;
    bf16_t* kp = MQ + row * 1536 + 512 + h * 64 + half * 32;
    float kv[32];
#pragma unroll
    for (int q = 0; q < 4; ++q) { const bf16x8 raw = *(const bf16x8*)(kp + 8 * q);
#pragma unroll
        for (int j = 0; j < 8; ++j) kv[8 * q + j] = bf2f(raw[j]); }
    if (half == 0 && !dry) {
        bf16_t* qp = MQ + row * 1536 + h * 64;
        float qv[16];
        { const bf16x8 r0 = *(const bf16x8*)qp, r1 = *(const bf16x8*)(qp + 8);
#pragma unroll
          for (int j = 0; j < 8; ++j) { qv[j] = bf2f(r0[j]); qv[8 + j] = bf2f(r1[j]); } }
#pragma unroll
        for (int j = 0; j < 8; ++j) {
            const float inv_freq = powf(500000.0f, -(float)j * 0.125f); const float ang = (float)pos * inv_freq;
            const float cs = cosf(ang), sn = sinf(ang);
            const float k1 = kv[j], k2 = kv[8 + j]; kv[j] = k1 * cs - k2 * sn; kv[8 + j] = k2 * cs + k1 * sn;
            const float q1 = qv[j], q2 = qv[8 + j]; qv[j] = q1 * cs - q2 * sn; qv[8 + j] = q2 * cs + q1 * sn;
        }
        *(bf16x8*)kp = pack8(kv[0], kv[1], kv[2], kv[3], kv[4], kv[5], kv[6], kv[7]);
        *(bf16x8*)(kp + 8) = pack8(kv[8], kv[9], kv[10], kv[11], kv[12], kv[13], kv[14], kv[15]);
        *(bf16x8*)qp = pack8(qv[0], qv[1], qv[2], qv[3], qv[4], qv[5], qv[6], qv[7]);
        *(bf16x8*)(qp + 8) = pack8(qv[8], qv[9], qv[10], qv[11], qv[12], qv[13], qv[14], qv[15]);
    }
#pragma unroll
    for (int d = 0; d < 32; ++d) {
        float v = kv[d];
#pragma unroll
        for (int o = 2; o < 64; o <<= 1) v += __shfl_xor(v, o);
        if ((tid & 63) < 2) atomicAdd(&sums[half * 32 + d], v);
    }
    __syncthreads();
    if (tid < 64) ((float*)(p.ws + O_KMEAN))[(((size_t)b * 8 + h) * 16 + nb) * 64 + tid] = sums[tid] * (1.f / 256.f);
    __syncthreads();
}
__device__ __forceinline__ void vt_item(const Params& p, unsigned char* lds, int item, int tid) {
    const int tb = item & 31, h = (item >> 5) & 7, b = (item >> 8) & 3, which = item >> 10;
    const bf16_t* src = (const bf16_t*)(p.ws + (which ? O_MQKV : O_FQKV)) + ((size_t)b * SEQ + tb * 128) * 1536 + 1024 + h * 64;
    bf16_t* dst = (bf16_t*)(p.ws + (which ? O_VTM : O_VTF)) + ((size_t)(b * 8 + h) * 64) * 4096 + tb * 128;
    bf16_t* tl = (bf16_t*)lds;
    { const int tok = tid >> 2, dq = tid & 3;
      const bf16x8 r0 = *(const bf16x8*)(src + (size_t)tok * 1536 + dq * 16), r1 = *(const bf16x8*)(src + (size_t)tok * 1536 + dq * 16 + 8);
#pragma unroll
      for (int j = 0; j < 8; ++j) { tl[(dq * 16 + j) * 136 + tok] = (bf16_t)r0[j]; tl[(dq * 16 + 8 + j) * 136 + tok] = (bf16_t)r1[j]; } }
    __syncthreads();
    { const int d = tid >> 3, c = tid & 7;
      const bf16x8 a = *(const bf16x8*)(tl + d * 136 + c * 16), bq = *(const bf16x8*)(tl + d * 136 + c * 16 + 8);
      *(bf16x8*)(dst + (size_t)d * 4096 + c * 16) = a; *(bf16x8*)(dst + (size_t)d * 4096 + c * 16 + 8) = bq; }
    __syncthreads();
}
__device__ __forceinline__ void conv_item(const Params& p, int l, int item, int tid) {
    const int cb = item % 20, ch = (item / 20) & 31, b = item / 640;
    const int c = tid & 63, tg = tid >> 6; const int gc = cb * 64 + c;
    const int t00 = ch * 128 + tg * 16 - 3;
    const bf16_t* xp = (const bf16_t*)(p.ws + O_XBC) + ((size_t)b * SEQ) * 1280 + gc;
    float v[19];
#pragma unroll
    for (int r = 0; r < 19; ++r) { const int t = t00 + r; v[r] = (t >= 0) ? bf2f((short)xp[(size_t)(t < 0 ? 0 : t) * 1280]) : 0.f; }
    const float* cw = PIN(11) + (size_t)l * 4 * 1280 + gc; const float w0 = cw[0], w1 = cw[1280], w2 = cw[2560], w3 = cw[3840], cbv = PIN(12)[l * 1280 + gc];
    float o[16];
#pragma unroll
    for (int tt = 0; tt < 16; ++tt) { const float x = cbv + w0 * v[tt] + w1 * v[tt + 1] + w2 * v[tt + 2] + w3 * v[tt + 3]; o[tt] = x / (1.f + __expf(-x)); }
    const size_t tok0 = (size_t)b * SEQ + ch * 128 + tg * 16;
    const bf16x8 p0 = pack8(o[0], o[1], o[2], o[3], o[4], o[5], o[6], o[7]), p1 = pack8(o[8], o[9], o[10], o[11], o[12], o[13], o[14], o[15]);
    if (cb < 12) { bf16_t* d = (bf16_t*)(p.ws + O_XT) + ((size_t)(b * 12 + cb) * 64 + c) * 4096 + ch * 128 + tg * 16; *(bf16x8*)d = p0; *(bf16x8*)(d + 8) = p1; }
    else {
        bf16_t* BC = (bf16_t*)(p.ws + O_BC); const int bc = gc - 768;
#pragma unroll
        for (int tt = 0; tt < 8; ++tt) { BC[(tok0 + tt) * 512 + bc] = (bf16_t)p0[tt]; BC[(tok0 + 8 + tt) * 512 + bc] = (bf16_t)p1[tt]; }
        if (cb < 16) { bf16_t* d = (bf16_t*)(p.ws + O_BT) + ((size_t)b * 256 + bc) * 4096 + ch * 128 + tg * 16; *(bf16x8*)d = p0; *(bf16x8*)(d + 8) = p1; }
    }
}
__device__ __forceinline__ void acum_item(const Params& p, int l, int item, int lane) {
    const int ch = item & 31, h = (item >> 5) % 12, b = item / 384;
    const float* sm = (const float*)(p.ws + O_SMALL); const float a = -expf(PIN(14)[l * 12 + h]);
    const size_t tok = (size_t)b * SEQ + ch * 128 + 2 * lane;
    const float dtb = PIN(13)[l * 12 + h];
    const float d0 = softplusf_(sm[tok * 32 + 8 + h] + dtb), d1 = softplusf_(sm[(tok + 1) * 32 + 8 + h] + dtb);
    { f32x2 dd = {d0, d1}; *(f32x2*)((float*)(p.ws + O_DT) + ((size_t)(b * 12 + h)) * 4096 + ch * 128 + 2 * lane) = dd; }
    const float v0 = d0 * a, v1 = d1 * a;
    float sc = v0 + v1;
#pragma unroll
    for (int o = 1; o < 64; o <<= 1) { const float t = __shfl_up(sc, o); if (lane >= o) sc += t; }
    const float ex = sc - (v0 + v1);
    f32x2 r = {ex + v0, ex + v0 + v1};
    *(f32x2*)((float*)(p.ws + O_ACUM) + ((size_t)(b * 12 + h)) * 4096 + ch * 128 + 2 * lane) = r;
}
__device__ __forceinline__ void foxcum_item(const Params& p, int l, int item, int lane) {
    const int h = item & 7, b = item >> 3; const float fb = PIN(10)[l * 8 + h];
    const float* sm = (const float*)(p.ws + O_SMALL) + ((size_t)b * SEQ + lane * 64) * 32 + h;
    float* cum = (float*)(p.ws + O_CUMF) + (size_t)(b * 8 + h) * 4096 + lane * 64;
    float v[64];
#pragma unroll
    for (int i = 0; i < 64; ++i) v[i] = sm[(size_t)i * 32];
    float run = 0.f;
#pragma unroll
    for (int i = 0; i < 64; ++i) { const float x = v[i] + fb; run += fminf(x, 0.f) - __logf(1.f + __expf(-fabsf(x))); v[i] = run; }
    float sc = run;
#pragma unroll
    for (int o = 1; o < 64; o <<= 1) { const float t = __shfl_up(sc, o); if (lane >= o) sc += t; }
    const float ex = sc - run;
#pragma unroll
    for (int i = 0; i < 64; i += 4) { f32x4 w = {v[i] + ex, v[i + 1] + ex, v[i + 2] + ex, v[i + 3] + ex}; *(f32x4*)(cum + i) = w; }
}

template <bool MOBA>
__device__ __forceinline__ void attn_tile(const bf16_t* KL, const bf16_t* VL, const float* __restrict__ cum, int k0, bool diag, int kb,
                                          const bf16x8 (&qf)[2][2], const float (&cq)[2], const unsigned (&sel)[2], int qpos0, int fr, int fq,
                                          float (&m)[2], float (&lsum)[2], f32x4 (&o)[4][2]) {
    bf16x8 kf[2][2];
#pragma unroll
    for (int jk = 0; jk < 2; ++jk)
#pragma unroll
        for (int ks = 0; ks < 2; ++ks) kf[jk][ks] = *(const bf16x8*)(KL + (16 * jk + fr) * 72 + ks * 32 + 8 * fq);
    bf16x8 vf[4];
#pragma unroll
    for (int dt = 0; dt < 4; ++dt) { const bf16_t* vp = VL + (dt * 16 + fr) * 72 + 4 * fq; vf[dt] = ld2x8(vp, vp + 16); }
    f32x4 s[2][2];
#pragma unroll
    for (int jk = 0; jk < 2; ++jk)
#pragma unroll
        for (int jq = 0; jq < 2; ++jq) { f32x4 z = {0.f, 0.f, 0.f, 0.f}; z = mfma16(kf[jk][0], qf[jq][0], z); s[jk][jq] = mfma16(kf[jk][1], qf[jq][1], z); }
    constexpr float C2 = 0.125f * LOG2E;
#pragma unroll
    for (int jk = 0; jk < 2; ++jk) {
        f32x4 ck = {0.f, 0.f, 0.f, 0.f};
        if (!MOBA) ck = *(const f32x4*)(cum + k0 + 16 * jk + 4 * fq) * LOG2E;
#pragma unroll
        for (int jq = 0; jq < 2; ++jq) {
            const bool blocked = MOBA && kb >= 0 && !((sel[jq] >> kb) & 1u);
#pragma unroll
            for (int i = 0; i < 4; ++i) { const int key = k0 + 16 * jk + 4 * fq + i; const int qp = qpos0 + 16 * jq + fr;
                float v = s[jk][jq][i] * C2; if (!MOBA) v += cq[jq] - ck[i];
                if ((diag && key > qp) || blocked) v = -INFINITY;
                s[jk][jq][i] = v; } }
    }
    bf16x8 pb[2];
#pragma unroll
    for (int jq = 0; jq < 2; ++jq) {
        float mx = fmaxf(fmaxf(fmaxf(s[0][jq][0], s[0][jq][1]), fmaxf(s[0][jq][2], s[0][jq][3])), fmaxf(fmaxf(s[1][jq][0], s[1][jq][1]), fmaxf(s[1][jq][2], s[1][jq][3])));
        mx = fmaxf(mx, __shfl_xor(mx, 16)); mx = fmaxf(mx, __shfl_xor(mx, 32));
        const float mnew = fmaxf(m[jq], mx); const float alpha = ex2(m[jq] - mnew); m[jq] = mnew;
        float pv[8]; float ps = 0.f;
#pragma unroll
        for (int i = 0; i < 4; ++i) { pv[i] = ex2(s[0][jq][i] - mnew); pv[4 + i] = ex2(s[1][jq][i] - mnew); ps += pv[i] + pv[4 + i]; }
        lsum[jq] = lsum[jq] * alpha + ps;
#pragma unroll
        for (int dt = 0; dt < 4; ++dt) o[dt][jq] = o[dt][jq] * alpha;
        pb[jq] = pack8(pv[0], pv[1], pv[2], pv[3], pv[4], pv[5], pv[6], pv[7]);
    }
#pragma unroll
    for (int dt = 0; dt < 4; ++dt)
#pragma unroll
        for (int jq = 0; jq < 2; ++jq) o[dt][jq] = mfma16(vf[dt], pb[jq], o[dt][jq]);
}
template <bool MOBA>
__device__ __forceinline__ void attn_block_item(const Params& p, unsigned char* lds, int b, int h, int qb, int tid, int wid, int lane) {
    const int fr = lane & 15, fq = lane >> 4; const int q0 = qb * 256 + wid * 32;
    bf16_t* KLb = (bf16_t*)lds; bf16_t* VLb = KLb + 2 * 64 * 72;
    bf16_t* qkv = (bf16_t*)(p.ws + (MOBA ? O_MQKV : O_FQKV)) + ((size_t)b * SEQ) * 1536 + h * 64;
    const bf16_t* kbase = qkv + 512; const bf16_t* vtbase = (const bf16_t*)(p.ws + (MOBA ? O_VTM : O_VTF)) + ((size_t)(b * 8 + h) * 64) * 4096;
    const float* cum = (const float*)(p.ws + O_CUMF) + (size_t)(b * 8 + h) * 4096;
    bf16x8 qf[2][2];
#pragma unroll
    for (int jq = 0; jq < 2; ++jq)
#pragma unroll
        for (int ks = 0; ks < 2; ++ks) qf[jq][ks] = *(const bf16x8*)(qkv + (size_t)(q0 + 16 * jq + fr) * 1536 + ks * 32 + 8 * fq);
    float cq[2] = {0.f, 0.f}; unsigned sel[2] = {0u, 0u}; unsigned umask = 0u;
    const int own = qb;
    if (!MOBA) { cq[0] = cum[q0 + fr] * LOG2E; cq[1] = cum[q0 + 16 + fr] * LOG2E; }
    else if (own > 0) {
        const float* km = (const float*)(p.ws + O_KMEAN) + ((size_t)(b * 8 + h) * 16) * 64 + 16 * fq;
#pragma unroll
        for (int jq = 0; jq < 2; ++jq) {
            const bf16_t* qp = qkv + (size_t)(q0 + 16 * jq + fr) * 1536 + 16 * fq;
            const bf16x8 r0 = *(const bf16x8*)qp, r1 = *(const bf16x8*)(qp + 8);
            float qd[16];
#pragma unroll
            for (int j = 0; j < 8; ++j) { qd[j] = bf2f(r0[j]); qd[8 + j] = bf2f(r1[j]); }
            float gate[15];
#pragma unroll
            for (int n = 0; n < 15; ++n) {
                float a = -INFINITY;
                if (n < own) { a = 0.f;
#pragma unroll
                    for (int d = 0; d < 16; d += 4) { const f32x4 kk = *(const f32x4*)(km + n * 64 + d); a += qd[d] * kk[0] + qd[d + 1] * kk[1] + qd[d + 2] * kk[2] + qd[d + 3] * kk[3]; }
                    a += __shfl_xor(a, 16); a += __shfl_xor(a, 32); }
                gate[n] = a;
            }
            unsigned msk = 0u;
#pragma unroll
            for (int pass = 0; pass < 3; ++pass) { float best = -INFINITY; int bi = -1;
#pragma unroll
                for (int n = 0; n < 15; ++n) { const float v = ((msk >> n) & 1u) ? -INFINITY : gate[n]; if (v > best) { best = v; bi = n; } }
                if (bi >= 0) msk |= 1u << bi; }
            sel[jq] = msk;
        }
        umask = sel[0] | sel[1];
#pragma unroll
        for (int o2 = 1; o2 < 16; o2 <<= 1) umask |= __shfl_xor(umask, o2);
        umask = __builtin_amdgcn_readfirstlane(umask);
    }
    float m[2] = {-1e30f, -1e30f}, lsum[2] = {0.f, 0.f}; f32x4 o[4][2];
#pragma unroll
    for (int dt = 0; dt < 4; ++dt) { o[dt][0] = (f32x4){0.f, 0.f, 0.f, 0.f}; o[dt][1] = (f32x4){0.f, 0.f, 0.f, 0.f}; }
    const int NT = 4 * (qb + 1);
    const int lr = tid >> 3, lc = (tid & 7) * 8;
    #define TILE_KT(i) (MOBA ? (((i) < 4) ? 4 * qb + (i) : (i) - 4) : (i))
    bf16x8 kreg, vreg;
    { const int k0 = TILE_KT(0) * 64; kreg = *(const bf16x8*)(kbase + (size_t)(k0 + lr) * 1536 + lc); vreg = *(const bf16x8*)(vtbase + (size_t)lr * 4096 + k0 + lc); }
    *(bf16x8*)(KLb + lr * 72 + lc) = kreg; *(bf16x8*)(VLb + lr * 72 + lc) = vreg;
    __syncthreads();
#pragma unroll 1
    for (int i = 0; i < NT; ++i) {
        const int k0 = TILE_KT(i) * 64; const int buf = i & 1;
        if (i + 1 < NT) { const int k1 = TILE_KT(i + 1) * 64; kreg = *(const bf16x8*)(kbase + (size_t)(k1 + lr) * 1536 + lc); vreg = *(const bf16x8*)(vtbase + (size_t)lr * 4096 + k1 + lc); }
        const bf16_t* KL = KLb + buf * 64 * 72; const bf16_t* VL = VLb + buf * 64 * 72;
        const int kb = k0 >> 8;
        const bool live = !MOBA || kb == own || ((umask >> kb) & 1u);
        if (live) {
#pragma unroll
            for (int kk = 0; kk < 2; ++kk) { const int k0h = k0 + 32 * kk;
                if (k0h <= q0 + 31) attn_tile<MOBA>(KL + kk * 32 * 72, VL + kk * 32, cum, k0h, k0h + 31 > q0, (MOBA && kb < own) ? kb : -1, qf, cq, sel, q0, fr, fq, m, lsum, o); }
        }
        if (i + 1 < NT) { *(bf16x8*)((bf16_t*)KLb + (buf ^ 1) * 64 * 72 + lr * 72 + lc) = kreg; *(bf16x8*)((bf16_t*)VLb + (buf ^ 1) * 64 * 72 + lr * 72 + lc) = vreg; }
        __syncthreads();
    }
    #undef TILE_KT
#pragma unroll
    for (int jq = 0; jq < 2; ++jq) {
        float ls = lsum[jq]; ls += __shfl_xor(ls, 16); ls += __shfl_xor(ls, 32); const float inv = 1.f / ls;
        bf16_t* op = qkv + (size_t)(q0 + 16 * jq + fr) * 1536 + 4 * fq;
#pragma unroll
        for (int dt = 0; dt < 4; ++dt) { const f32x4 v = o[dt][jq] * inv; u32x2 w; w.x = cvtpk(v[0], v[1]); w.y = cvtpk(v[2], v[3]); *(u32x2*)(op + dt * 16) = w; }
    }
}
__device__ __forceinline__ void ssd_states_item(const Params& p, int item, int lane) {
    const int h = item % 12, c = (item / 12) & 31, b = item / 384; const int grp = h / 6;
    const int fr = lane & 15, fq = lane >> 4;
    const float* ac = (const float*)(p.ws + O_ACUM) + (size_t)(b * 12 + h) * 4096 + c * 128;
    const float* dtp = (const float*)(p.ws + O_DT) + (size_t)(b * 12 + h) * 4096 + c * 128;
    const bf16_t* XT = (const bf16_t*)(p.ws + O_XT) + ((size_t)(b * 12 + h) * 64) * 4096 + c * 128;
    const bf16_t* BT = (const bf16_t*)(p.ws + O_BT) + ((size_t)(b * 2 + grp) * 128) * 4096 + c * 128;
    float* ST = (float*)(p.ws + O_ST) + ((size_t)((b * 32 + c) * 12 + h)) * 8192;
    const float total = ac[127];
#pragma unroll 1
    for (int q2 = 0; q2 < 4; ++q2) {
        f32x4 acc[4][2];
#pragma unroll
        for (int pt = 0; pt < 4; ++pt) { acc[pt][0] = (f32x4){0.f, 0.f, 0.f, 0.f}; acc[pt][1] = (f32x4){0.f, 0.f, 0.f, 0.f}; }
#pragma unroll 1
        for (int ks = 0; ks < 4; ++ks) {
            const int s0 = ks * 32 + 8 * fq;
            const f32x4 a0 = *(const f32x4*)(ac + s0), a1 = *(const f32x4*)(ac + s0 + 4);
            const f32x4 d0 = *(const f32x4*)(dtp + s0), d1 = *(const f32x4*)(dtp + s0 + 4);
            float w8[8];
#pragma unroll
            for (int j = 0; j < 4; ++j) { w8[j] = expf(total - a0[j]) * d0[j]; w8[4 + j] = expf(total - a1[j]) * d1[j]; }
            const bf16x8 b0 = *(const bf16x8*)(BT + (size_t)((q2 * 2 + 0) * 16 + fr) * 4096 + s0), b1 = *(const bf16x8*)(BT + (size_t)((q2 * 2 + 1) * 16 + fr) * 4096 + s0);
#pragma unroll
            for (int pt = 0; pt < 4; ++pt) { const bf16x8 xa = *(const bf16x8*)(XT + (size_t)(pt * 16 + fr) * 4096 + s0);
                const bf16x8 af = pack8(bf2f(xa[0]) * w8[0], bf2f(xa[1]) * w8[1], bf2f(xa[2]) * w8[2], bf2f(xa[3]) * w8[3], bf2f(xa[4]) * w8[4], bf2f(xa[5]) * w8[5], bf2f(xa[6]) * w8[6], bf2f(xa[7]) * w8[7]);
                acc[pt][0] = mfma16(af, b0, acc[pt][0]); acc[pt][1] = mfma16(af, b1, acc[pt][1]); }
        }
#pragma unroll
        for (int pt = 0; pt < 4; ++pt)
#pragma unroll
            for (int nt = 0; nt < 2; ++nt)
#pragma unroll
                for (int i = 0; i < 4; ++i) ST[(size_t)(pt * 16 + 4 * fq + i) * 128 + (q2 * 2 + nt) * 16 + fr] = acc[pt][nt][i];
    }
}
__device__ __forceinline__ void ssd_scan(const Params& p, int gtid, int gthreads) {
    const float* ST = (const float*)(p.ws + O_ST); bf16_t* PV = (bf16_t*)(p.ws + O_PREV); const float* ACUM = (const float*)(p.ws + O_ACUM);
    for (int e = gtid; e < NB * 12 * 8192; e += gthreads) {
        const int pn = e & 8191, h = (e >> 13) % 12, b = e / (12 * 8192);
        const float* ac = ACUM + (size_t)(b * 12 + h) * 4096 + 127;
        const size_t base = ((size_t)(b * 32) * 12 + h) * 8192 + pn;
        float st[32], dc[32];
#pragma unroll
        for (int c = 0; c < 32; ++c) { st[c] = ST[base + (size_t)c * 12 * 8192]; dc[c] = ac[c * 128]; }
        float hs = 0.f;
#pragma unroll
        for (int c = 0; c < 32; ++c) { PV[base + (size_t)c * 12 * 8192] = (bf16_t)(cvtpk(hs, 0.f) & 0xffffu); hs = hs * __expf(dc[c]) + st[c]; }
    }
}
__device__ __forceinline__ void ssd_out_item(const Params& p, int l, int item, int wid, int lane, bool dry = false) {
    const int grp = item & 1, c = (item >> 1) & 31, b = item >> 6;
    const int fr = lane & 15, fq = lane >> 4; const int w = wid; const int tl = 16 * w + fr;
    const size_t row0 = (size_t)b * SEQ + c * 128; const size_t row = row0 + tl;
    const bf16_t* BC = (const bf16_t*)(p.ws + O_BC);
    bf16_t* Z = (bf16_t*)(p.ws + O_Z);
    bf16x8 cf[4];
#pragma unroll
    for (int ks = 0; ks < 4; ++ks) cf[ks] = *(const bf16x8*)(BC + row * 512 + 256 + grp * 128 + ks * 32 + 8 * fq);
    f32x4 cbt[8];
#pragma unroll
    for (int js = 0; js < 8; ++js) { cbt[js] = (f32x4){0.f, 0.f, 0.f, 0.f};
        if (js <= w) {
#pragma unroll
            for (int ks = 0; ks < 4; ++ks) { const bf16x8 a = *(const bf16x8*)(BC + (row0 + js * 16 + fr) * 512 + grp * 128 + ks * 32 + 8 * fq); cbt[js] = mfma16(a, cf[ks], cbt[js]); } } }
    float ssq = 0.f;
#pragma unroll 1
    for (int r = 0; r < 6; ++r) {
        const int h = grp * 6 + r;
        const float* ac = (const float*)(p.ws + O_ACUM) + (size_t)(b * 12 + h) * 4096 + c * 128;
        const float* dtp = (const float*)(p.ws + O_DT) + (size_t)(b * 12 + h) * 4096 + c * 128;
        const float acl = ac[tl]; const float eacl = expf(acl); const float Dh = PIN(15)[l * 12 + h];
        const bf16_t* PV = (const bf16_t*)(p.ws + O_PREV) + ((size_t)((b * 32 + c) * 12 + h)) * 8192;
        const bf16_t* XT = (const bf16_t*)(p.ws + O_XT) + ((size_t)(b * 12 + h) * 64) * 4096 + c * 128;
        f32x4 yt[4];
#pragma unroll
        for (int pt = 0; pt < 4; ++pt) yt[pt] = (f32x4){0.f, 0.f, 0.f, 0.f};
#pragma unroll
        for (int ks = 0; ks < 4; ++ks)
#pragma unroll
            for (int pt = 0; pt < 4; ++pt) { const bf16x8 a = *(const bf16x8*)(PV + (size_t)(pt * 16 + fr) * 128 + ks * 32 + 8 * fq); yt[pt] = mfma16(a, cf[ks], yt[pt]); }
#pragma unroll
        for (int pt = 0; pt < 4; ++pt) yt[pt] = yt[pt] * eacl;
#pragma unroll
        for (int jp = 0; jp < 4; ++jp) {
            if (2 * jp <= w) {
                const int sA = 32 * jp + 4 * fq, sB = sA + 16;
                const f32x4 a0 = *(const f32x4*)(ac + sA), a1 = *(const f32x4*)(ac + sB), dv0 = *(const f32x4*)(dtp + sA), dv1 = *(const f32x4*)(dtp + sB);
                float mv[8];
#pragma unroll
                for (int j = 0; j < 4; ++j) {
                    const int s = sA + j; const float d0 = dv0[j];
                    float v = (s <= tl) ? cbt[2 * jp][j] * expf(acl - a0[j]) * d0 : 0.f; if (s == tl) v += Dh; mv[j] = v;
                    const int s2 = sB + j; const float d1 = dv1[j];
                    float v2 = (s2 <= tl) ? cbt[2 * jp + 1][j] * expf(acl - a1[j]) * d1 : 0.f; if (s2 == tl) v2 += Dh; mv[4 + j] = v2;
                }
                const bf16x8 mb = pack8(mv[0], mv[1], mv[2], mv[3], mv[4], mv[5], mv[6], mv[7]);
#pragma unroll
                for (int pt = 0; pt < 4; ++pt) { const bf16_t* xp = XT + (size_t)(pt * 16 + fr) * 4096 + sA; yt[pt] = mfma16(ld2x8(xp, xp + 16), mb, yt[pt]); }
            }
        }
#pragma unroll
        for (int pt = 0; pt < 4; ++pt) { bf16_t* zp = Z + row * 768 + h * 64 + pt * 16 + 4 * fq; const u32x2 zw = *(const u32x2*)zp;
            const float y0 = yt[pt][0] * bflo(zw.x), y1 = yt[pt][1] * bfhi(zw.x), y2 = yt[pt][2] * bflo(zw.y), y3 = yt[pt][3] * bfhi(zw.y);
            ssq += (y0 * y0 + y1 * y1) + (y2 * y2 + y3 * y3);
            u32x2 o; o.x = cvtpk(y0, y1); o.y = cvtpk(y2, y3); if (!dry) *(u32x2*)zp = o; }
    }
    ssq += __shfl_xor(ssq, 16); ssq += __shfl_xor(ssq, 32);
    if (dry) return;
    const float rstd = rsqrtf(ssq * (1.f / 384.f) + NORM_EPS);
    VM_WAIT();
    const float* nw = PIN(16) + l * 768 + grp * 384;
    bf16_t* zp0 = Z + row * 768 + grp * 384 + 4 * fq;
#pragma unroll 4
    for (int q = 0; q < 24; ++q) { bf16_t* zp = zp0 + q * 16; const u32x2 zw = *(const u32x2*)zp; const f32x4 nv = *(const f32x4*)(nw + q * 16 + 4 * fq);
        u32x2 o; o.x = cvtpk(bflo(zw.x) * rstd * nv[0], bfhi(zw.x) * rstd * nv[1]); o.y = cvtpk(bflo(zw.y) * rstd * nv[2], bfhi(zw.y) * rstd * nv[3]); *(u32x2*)zp = o; }
}

#define LAS __attribute__((address_space(3)))
#define XB_TMO      128
#define XB_XCNT(j)  (256  + 64 * (j))
#define XB_XSUB(j)  (1280 + 64 * (j))
#define XB_XGEN(j)  (2304 + 64 * (j))
#define XB_TOP      3328
#define XB_TOPGEN   3392
#define XCD_BAR_WORDS 3456
#define XB_SPIN_CAP (1u << 18)

__device__ __forceinline__ unsigned xb_ld(unsigned* p)              { return __hip_atomic_load(p, __ATOMIC_RELAXED, __HIP_MEMORY_SCOPE_AGENT); }
__device__ __forceinline__ unsigned xb_add(unsigned* p, unsigned v) { return __hip_atomic_fetch_add(p, v, __ATOMIC_RELAXED, __HIP_MEMORY_SCOPE_AGENT); }
__device__ __forceinline__ unsigned xb_xcc_id() { return (unsigned)__builtin_amdgcn_s_getreg((3 << 11) | 20) & 0xFu; }
#define XB_SPIN(cond, bar) do { unsigned _sp = 0; while (cond) { __builtin_amdgcn_s_sleep(1); \
    if ((++_sp & 255u) == 0u) { if (xb_ld(&(bar)[XB_TMO])) break; if (_sp > XB_SPIN_CAP) { atomicAdd(&(bar)[XB_TMO], 1u); break; } } } } while (0)

struct XcdBarrier {
    unsigned* bar; unsigned x;
    volatile LAS unsigned* st;
};

__device__ __forceinline__ XcdBarrier xcd_barrier_post(unsigned* bar, volatile LAS unsigned* st) {
    XcdBarrier b; b.bar = bar; b.x = xb_xcc_id(); b.st = st;
    if (threadIdx.x == 0) (void)xb_add(&bar[XB_XCNT(b.x)], 1u);
    return b;
}
__device__ __forceinline__ void xcd_barrier_complete(unsigned* bar, unsigned x, unsigned& nloc, unsigned& nx) {
    const unsigned G = gridDim.x * gridDim.y * gridDim.z;
    unsigned sum, cnt, mine, sp = 0u;
    for (;;) {
        sum = 0u; cnt = 0u; mine = 0u;
#pragma unroll
        for (unsigned j = 0; j < 16; ++j) { const unsigned c = xb_ld(&bar[XB_XCNT(j)]); sum += c; cnt += (c > 0u) ? 1u : 0u; mine = (j == x) ? c : mine; }
        if (sum == G) break;
        __builtin_amdgcn_s_sleep(1);
        if ((++sp & 255u) == 0u) { if (xb_ld(&bar[XB_TMO])) break; if (sp > XB_SPIN_CAP) { atomicAdd(&bar[XB_TMO], 1u); break; } }
    }
    nloc = mine > 0u ? mine : 1u; nx = cnt > 0u ? cnt : 1u;
}

__device__ __forceinline__ void xcd_barrier(const XcdBarrier& b) {
    asm volatile("s_waitcnt vmcnt(0)" ::: "memory");
    __syncthreads();
    if (threadIdx.x == 0) {
        unsigned* bar = b.bar;
        __builtin_amdgcn_s_waitcnt(0);
        unsigned nloc = b.st[0], nx = b.st[1];
        if (nloc == 0u) { xcd_barrier_complete(bar, b.x, nloc, nx); b.st[0] = nloc; b.st[1] = nx; }
        const unsigned old = xb_add(&bar[XB_XSUB(b.x)], 1u);
        const unsigned gen = old / nloc;
        if (old + 1u == (gen + 1u) * nloc) {
            __builtin_amdgcn_fence(__ATOMIC_RELEASE, "agent");
            asm volatile("s_waitcnt vmcnt(0)" ::: "memory");
            const unsigned og = xb_add(&bar[XB_TOP], 1u);
            const unsigned tg = og / nx;
            if (og + 1u == (tg + 1u) * nx) xb_add(&bar[XB_TOPGEN], 1u);
            else XB_SPIN(xb_ld(&bar[XB_TOPGEN]) == tg, bar);
            __builtin_amdgcn_fence(__ATOMIC_ACQUIRE, "agent");
            xb_add(&bar[XB_XGEN(b.x)], 1u);
            asm volatile("s_waitcnt vmcnt(0)" ::: "memory");
        } else {
            XB_SPIN(xb_ld(&bar[XB_XGEN(b.x)]) == gen, bar);
            __builtin_amdgcn_fence(__ATOMIC_ACQUIRE, "agent");
            asm volatile("s_waitcnt vmcnt(0)" ::: "memory");
        }
    }
    __syncthreads();
}

constexpr int PH_PER_LAYER = 11, N_PHASES = 1 + DEPTH * PH_PER_LAYER + 1;
template <int EN_MASK, bool EN_GEMM>
__device__ __forceinline__ void fwd_body(const Params& p) {
    extern __shared__ __attribute__((aligned(16))) unsigned char lds[];
    cg::grid_group grid = cg::this_grid();
    const int G = gridDim.x, NGW = G * 8;
    unsigned char* ws = p.ws;
    volatile LAS unsigned* MISC = (volatile LAS unsigned*)((LAS unsigned char*)lds + 132096);
    if (threadIdx.x < 2) MISC[threadIdx.x] = 0u;
    __syncthreads();
    XcdBarrier xbar = xcd_barrier_post((unsigned*)(ws + O_CTL), MISC);
    float* mod = (float*)(ws + O_MOD); float* X = (float*)(ws + O_X); bf16_t* H = (bf16_t*)(ws + O_H);
    for (int ph = p.ph_lo; ph < p.ph_hi; ++ph) {
        int tid = threadIdx.x; asm volatile("" : "+v"(tid));
        const int lane = tid & 63, wid = __builtin_amdgcn_readfirstlane(tid >> 6); const int gw = blockIdx.x * 8 + wid;
        if (ph == 0) { if constexpr (EN_MASK != 0) phase_pre(p, lds, tid); }
        else if (ph == N_PHASES - 1) { if constexpr (EN_MASK != 0) final_norm_rows(X, PIN(25), p.out, gw, NGW, lane); }
        else {
            const int l = (ph - 1) / PH_PER_LAYER, k = (ph - 1) % PH_PER_LAYER;
            const float* modl = mod + (size_t)l * 4 * 6144;
            const float* xin = (l == 0) ? PIN(0) : X;
            if (k == 1 || k == 6 || k == 7 || k == 9 || k == 10) { if constexpr (EN_GEMM) {
                const int nsub = (k == 6) ? 4 : 1;
#pragma unroll 1
                for (int br = 0; br < nsub; ++br) {
                    EpiU E{}; const bf16_t* A; const bf16_t* Bt; int lda, N, K;
                    if (k == 1) { E.kind = 0; E.p1 = ws; A = H; lda = 1024; Bt = (const bf16_t*)(ws + O_WIN); N = NPROJ; K = 1024; }
                    else if (k == 6) {
                        const size_t aoffs = (br == 0) ? O_UV : (br == 1) ? O_FQKV : (br == 2) ? O_MQKV : O_Z;
                        const size_t woffs = (br == 0) ? O_WA : (br == 1) ? O_WB : (br == 2) ? O_WC : O_WD;
                        E.kind = 1; E.p0 = (const bf16_t*)(ws + O_GATE) + br * 1024; E.p1 = (float*)(ws + O_MF32); E.p2 = H; E.mode = (br == 0) ? 0 : (br == 3) ? 2 : 1;
                        A = (const bf16_t*)(ws + aoffs); lda = (br == 0) ? 1024 : (br == 3) ? 768 : 1536; Bt = (const bf16_t*)(ws + woffs); N = 1024; K = (br == 3) ? 768 : 512; }
                    else if (k == 7) { E.kind = 2; E.p0 = xin; E.p1 = X; E.p2 = (void*)(modl + 2048); A = H; lda = 1024; Bt = (const bf16_t*)(ws + O_WO); N = 1024; K = 1024; }
                    else if (k == 9) { E.kind = 3; E.p1 = (bf16_t*)(ws + O_HID); A = H; lda = 1024; Bt = (const bf16_t*)(ws + O_W1); N = 4096; K = 1024; }
                    else { E.kind = 2; E.p0 = X; E.p1 = X; E.p2 = (void*)(modl + 5120); A = (const bf16_t*)(ws + O_HID); lda = 4096; Bt = (const bf16_t*)(ws + O_W2); N = 1024; K = 4096; }
#ifdef PROBE_DUP_GEMM
                    E.dry = (p.ph_lo == 0); run_gemm(lds, A, lda, Bt, N, K, E); E.dry = 0;
#endif
                    run_gemm(lds, A, lda, Bt, N, K, E);
                }
            } } else switch (k) {
            case 0: if constexpr ((EN_MASK >> 0) & 1) {
#ifdef PROBE_A
                convert_weights(p, l, lds, gw, NGW, wid, lane); norm_mod_rows(xin, PIN(4) + l * 1024, modl + 0, modl + 1024, H, gw, NGW, lane);
#endif
                convert_weights(p, l, lds, gw, NGW, wid, lane);
                norm_mod_rows(xin, PIN(4) + l * 1024, modl + 0, modl + 1024, H, gw, NGW, lane);
            } break;
            case 2: if constexpr ((EN_MASK >> 2) & 1) {
#ifdef PROBE_C
                { const bool dry = (p.ph_lo == 0);
                for (int it = blockIdx.x; it < 1024; it += G) gmlp_item(p, l, lds, it, wid, lane, dry);
                for (int it = blockIdx.x; it < 512; it += G) rotary_item(p, lds, it, tid, dry);
                for (int it = blockIdx.x; it < 2048; it += G) vt_item(p, lds, it, tid);
                for (int it = blockIdx.x; it < 2560; it += G) conv_item(p, l, it, tid);
                for (int it = gw; it < 1536; it += NGW) acum_item(p, l, it, lane);
                for (int it = NGW - 1 - gw; it < 32; it += NGW) foxcum_item(p, l, it, lane); }
#endif
                for (int it = blockIdx.x; it < 1024; it += G) gmlp_item(p, l, lds, it, wid, lane);
                for (int it = blockIdx.x; it < 512; it += G) rotary_item(p, lds, it, tid);
                for (int it = blockIdx.x; it < 2048; it += G) vt_item(p, lds, it, tid);
                for (int it = blockIdx.x; it < 2560; it += G) conv_item(p, l, it, tid);
                for (int it = gw; it < 1536; it += NGW) acum_item(p, l, it, lane);
                for (int it = NGW - 1 - gw; it < 32; it += NGW) foxcum_item(p, l, it, lane);
            } break;
            case 3: if constexpr ((EN_MASK >> 3) & 1) {
#ifndef EN3
#define EN3 7
#endif
                for (int i = blockIdx.x; i < 512; i += G) { const int bh = i & 31, r = i >> 5; const int qb = (r < 8) ? 15 - r : r - 8;
                    if constexpr (EN3 & 1) attn_block_item<false>(p, lds, bh >> 3, bh & 7, qb, tid, wid, lane);
                    if constexpr (EN3 & 2) attn_block_item<true>(p, lds, bh >> 3, bh & 7, qb, tid, wid, lane); }
#ifdef PROBE_EF
                for (int i = NGW - 1 - gw; i < 1536; i += NGW) ssd_states_item(p, i, lane);
#endif
                if constexpr (EN3 & 4) for (int i = NGW - 1 - gw; i < 1536; i += NGW) ssd_states_item(p, i, lane);
            } break;
            case 4: if constexpr ((EN_MASK >> 4) & 1) {
#ifdef PROBE_EF
                ssd_scan(p, blockIdx.x * 512 + tid, G * 512);
#endif
                ssd_scan(p, blockIdx.x * 512 + tid, G * 512); } break;
            case 5: if constexpr ((EN_MASK >> 5) & 1) {
#ifdef PROBE_EF
                for (int it = blockIdx.x; it < 256; it += G) ssd_out_item(p, l, it, wid, lane, p.ph_lo == 0);
#endif
                for (int it = blockIdx.x; it < 256; it += G) ssd_out_item(p, l, it, wid, lane); } break;
            case 8: if constexpr ((EN_MASK >> 8) & 1) { norm_mod_rows(X, PIN(22) + l * 1024, modl + 3072, modl + 4096, H, gw, NGW, lane); } break;
            }
        }
        if (ph + 1 < p.ph_hi) { if (ph == 0) grid.sync(); else xcd_barrier(xbar); }
#ifdef PROBE_SYNC
        if (ph + 1 < p.ph_hi) { xcd_barrier(xbar); xcd_barrier(xbar); }
#endif
    }
}

#ifndef N_LAUNCH_MODE
#define N_LAUNCH_MODE 1
#endif
#if N_LAUNCH_MODE == 1
__global__ void __launch_bounds__(512, 2) fwd_all(Params p) { fwd_body<0x7ff, true>(p); }
#define KERNEL_FOR_ATTR fwd_all
#else
__global__ void __launch_bounds__(512, 2) fwd_gemm(Params p) { fwd_body<0, true>(p); }
__global__ void __launch_bounds__(512, 2) fwd_misc(Params p) { fwd_body<0x7ff, false>(p); }
#endif
extern "C" void kernel_launch(void* const* d_in, const int* in_sizes, int n_in, void* d_out, int out_size, void* d_ws, size_t ws_size, hipStream_t stream) {
    static int grid = 0;
    if (grid == 0) {
        if (n_in != 26 || out_size != T * DM || ws_size < WS_END) { fprintf(stderr, "kernel_launch: unexpected shapes (n_in %d out %d ws %zu need %zu)\n", n_in, out_size, ws_size, (size_t)WS_END); grid = -1; return; }
        int dev = 0, cus = 0;
        (void)hipGetDevice(&dev); (void)hipDeviceGetAttribute(&cus, hipDeviceAttributeMultiprocessorCount, dev);
#if N_LAUNCH_MODE == 1
        if (hipFuncSetAttribute((const void*)fwd_all, hipFuncAttributeMaxDynamicSharedMemorySize, LDS_BYTES) != hipSuccess) { fprintf(stderr, "kernel_launch: hipFuncSetAttribute failed\n"); grid = -1; return; }
#else
        if (hipFuncSetAttribute((const void*)fwd_gemm, hipFuncAttributeMaxDynamicSharedMemorySize, LDS_BYTES) != hipSuccess || hipFuncSetAttribute((const void*)fwd_misc, hipFuncAttributeMaxDynamicSharedMemorySize, LDS_BYTES) != hipSuccess) { fprintf(stderr, "kernel_launch: hipFuncSetAttribute failed\n"); grid = -1; return; }
#endif
        (void)hipGetLastError();
        grid = cus > 0 ? cus : 256;
    }
    if (grid < 0) return;
    if (hipMemsetAsync((char*)d_ws + O_CTL, 0, 16384, stream) != hipSuccess) { fprintf(stderr, "kernel_launch: memset failed\n"); return; }
    Params p{};
    for (int i = 0; i < 26; ++i) p.in[i] = (const float*)d_in[i];
    p.out = (float*)d_out; p.ws = (unsigned char*)d_ws;
#if N_LAUNCH_MODE == 1
    p.ph_lo = 0; p.ph_hi = N_PHASES;
    void* args[] = {&p};
    hipError_t e = hipLaunchCooperativeKernel((const void*)fwd_all, dim3(grid), dim3(512), args, LDS_BYTES, stream);
    if (e != hipSuccess) fprintf(stderr, "kernel_launch: cooperative launch failed: %s (grid %d)\n", hipGetErrorString(e), grid);
#else
    for (int ph = 0; ph < N_PHASES; ++ph) { p.ph_lo = ph; p.ph_hi = ph + 1;
        const int k = (ph >= 1 && ph < N_PHASES - 1) ? (ph - 1) % PH_PER_LAYER : -1;
        if (k == 1 || k == 6 || k == 7 || k == 9 || k == 10) hipLaunchKernelGGL(fwd_gemm, dim3(grid), dim3(512), LDS_BYTES, stream, p);
        else hipLaunchKernelGGL(fwd_misc, dim3(grid), dim3(512), LDS_BYTES, stream, p); }
#endif
}
```

```cpp
#include <hip/hip_runtime.h>
#include <hip/hip_cooperative_groups.h>
#include <cstdio>
#include <cstdint>
#include <cmath>
namespace cg = cooperative_groups;
namespace pg8 {
#define PG8_LAS __attribute__((address_space(3)))
typedef unsigned short bf16_t;
typedef short bf16x8 __attribute__((ext_vector_type(8)));
typedef float f32x4 __attribute__((ext_vector_type(4)));
typedef unsigned u32x4 __attribute__((ext_vector_type(4)));
constexpr int BM = 256, BK = 64, HALF = 128, HTB = HALF * BK * 2  , STAGE_BYTES = 8 * HTB, NXCD = 8, WGM = 8;

__host__ __device__ __forceinline__ int lds_byte(int r, int c) { const int st = (r >> 4) * 2 + (c >> 5), rr = r & 15, cc = c & 31, ob = rr * 64 + cc * 2; return st * 1024 + (ob ^ (((ob >> 9) & 1) << 5)); }
__host__ __device__ __forceinline__ void stage_rc(int b, int& R, int& C) { const int st = b / 1024, sb = b % 1024, swz = sb ^ (((sb >> 9) & 1) << 5); R = (st >> 1) * 16 + swz / 64; C = (st & 1) * 32 + (swz % 64) / 2; }
__host__ __device__ __forceinline__ int perm32(int rho) { const int n = rho >> 4, i = rho & 15; return 8 * (i >> 2) + 4 * n + (i & 3); }

struct Unit { int pm, pn; };
struct Gemm { const bf16_t* A; const bf16_t* Bt; int M, N, K, lda; };

struct StaticOrder {
    int nM, nN, nwg, G, c;
    __host__ __device__ void init(int M, int N, int G_, int c_) { nM = M / BM; nN = N / BM; nwg = nM * nN; G = G_; c = c_; }
    __host__ __device__ bool next(int i, Unit& u) const {
        const long L = (long)i * G + c; if (L >= nwg) return false;
        int wgid = (int)L; { const int q = nwg / NXCD, r = nwg % NXCD, xcd = wgid % NXCD, off = wgid / NXCD; wgid = (xcd < r ? xcd * (q + 1) : r * (q + 1) + (xcd - r) * q) + off; }
        const int nig = WGM * nN, gid = wgid / nig, fm = gid * WGM, gsz = (nM - fm) < WGM ? (nM - fm) : WGM;
        u.pm = fm + ((wgid % nig) % gsz); u.pn = (wgid % nig) / gsz; return true;
    }
    __device__ __forceinline__ void a_ready(const Unit&) const {}
    __device__ __forceinline__ void done(const Unit&) const {}
};


template <class Epi, class Sched, bool ALIGN_EPI = false, bool SP2 = false>
__device__ __forceinline__ void gemm_phase(PG8_LAS unsigned char* lds, const Gemm g, const Sched& S, const Epi& E) {
    const int tid = threadIdx.x, wid = __builtin_amdgcn_readfirstlane(tid >> 6), lane = tid & 63, wr = wid >> 2, wc = wid & 3, fr = lane & 15, fq = lane >> 4;
    const int K = g.K, nt = K / BK;
    unsigned voffA[2], voffB[2];
#pragma unroll
    for (int i = 0; i < 2; ++i) { int R, C; stage_rc(tid * 16 + i * 8192, R, C); const int Rb = Epi::PERM ? ((R & ~31) + perm32(R & 31)) : R;
        voffA[i] = (unsigned)(R * g.lda + C) * 2u; voffB[i] = (unsigned)(Rb * K + C) * 2u; }
    const size_t kstep = (size_t)(BK * 2);
    const size_t hstepB = (size_t)HALF * K * 2, hstepA = (size_t)HALF * g.lda * 2;
    const size_t tstepB = 2 * hstepB, tstepA = 2 * hstepA;
    const unsigned ldsw = (unsigned)wid * 1024u;
    const int aoff = lds_byte(wr * 64 + fr, fq * 8), boff = lds_byte(wc * 32 + fr, fq * 8);
#define PG8_SA(b, h) (((b) * 2 + (h)) * HTB)
#define PG8_SB(b, h) ((4 + (b) * 2 + (h)) * HTB)
#define PG8_STAGE(bufoff, gbase, voff) do { _Pragma("unroll") for (int _i = 0; _i < 2; ++_i) \
        __builtin_amdgcn_global_load_lds((const unsigned*)((const char*)(gbase) + (voff)[_i]), (PG8_LAS unsigned*)(lds + (bufoff) + ldsw + _i * 8192), 16, 0, 0); } while (0)
#define PG8_LDA(dst, b, h) do { _Pragma("unroll") for (int m = 0; m < 4; ++m) _Pragma("unroll") for (int k = 0; k < 2; ++k) dst[m][k] = *(const PG8_LAS bf16x8*)(lds + PG8_SA(b, h) + aoff + m * 2048 + k * 1024); } while (0)
#define PG8_LDB(dst, b, h) do { _Pragma("unroll") for (int n = 0; n < 2; ++n) _Pragma("unroll") for (int k = 0; k < 2; ++k) dst[n][k] = *(const PG8_LAS bf16x8*)(lds + PG8_SB(b, h) + boff + n * 2048 + k * 1024); } while (0)
#define PG8_MMA(ai, bj, At, Bt) do { __builtin_amdgcn_s_setprio(1); _Pragma("unroll") for (int m = 0; m < 4; ++m) _Pragma("unroll") for (int n = 0; n < 2; ++n) _Pragma("unroll") for (int k = 0; k < 2; ++k) \
        acc[ai][bj][m][n] = __builtin_amdgcn_mfma_f32_16x16x32_bf16(Bt[n][k], At[m][k], acc[ai][bj][m][n], 0, 0, 0); __builtin_amdgcn_s_setprio(0); } while (0)
#define PG8_WAIT_V(n) asm volatile("s_waitcnt vmcnt(" #n ")" ::: "memory")
#define PG8_WAIT_L(n) asm volatile("s_waitcnt lgkmcnt(" #n ")" ::: "memory")
#define PG8_BAR __builtin_amdgcn_s_barrier()
#define PG8_SCHED __builtin_amdgcn_sched_barrier(0)
    Unit cur, nxt; int ui = 0;
    if (!S.next(0, cur)) return;
    f32x4 acc[2][2][4][2];
#pragma unroll
    for (int a = 0; a < 2; ++a)
#pragma unroll
        for (int b = 0; b < 2; ++b)
#pragma unroll
            for (int m = 0; m < 4; ++m)
#pragma unroll
                for (int n = 0; n < 2; ++n) acc[a][b][m][n] = (f32x4){0.f, 0.f, 0.f, 0.f};
    bf16x8 At[4][2], B0[2][2], B1[2][2];
    const char* cA = (const char*)g.A + (size_t)cur.pm * tstepA; const char* cB = (const char*)g.Bt + (size_t)cur.pn * tstepB;
    S.a_ready(cur);
    if constexpr (SP2) {
        PG8_STAGE(PG8_SB(0, 0), cB, voffB); PG8_STAGE(PG8_SB(0, 1), cB + hstepB, voffB); PG8_STAGE(PG8_SA(0, 0), cA, voffA); PG8_STAGE(PG8_SA(0, 1), cA + hstepA, voffA);
        if (wr == 1) PG8_BAR;
        PG8_WAIT_V(2); PG8_BAR;
        PG8_STAGE(PG8_SB(1, 0), cB + kstep, voffB); PG8_STAGE(PG8_SA(1, 0), cA + kstep, voffA); PG8_STAGE(PG8_SB(1, 1), cB + hstepB + kstep, voffB);
        PG8_WAIT_V(6); PG8_BAR;
    } else {
        PG8_STAGE(PG8_SB(0, 0), cB, voffB); PG8_STAGE(PG8_SA(0, 0), cA, voffA); PG8_STAGE(PG8_SB(0, 1), cB + hstepB, voffB); PG8_STAGE(PG8_SA(0, 1), cA + hstepA, voffA);
        if (wr == 1) PG8_BAR;
        PG8_WAIT_V(4); PG8_BAR;
        PG8_STAGE(PG8_SB(1, 0), cB + kstep, voffB); PG8_STAGE(PG8_SA(1, 0), cA + kstep, voffA); PG8_STAGE(PG8_SB(1, 1), cB + hstepB + kstep, voffB);
        PG8_WAIT_V(6); PG8_BAR;
    }
    for (;;) {
        const bool has_next = S.next(ui + 1, nxt);
        const char* nA = has_next ? (const char*)g.A + (size_t)nxt.pm * tstepA : cA; const char* nB = has_next ? (const char*)g.Bt + (size_t)nxt.pn * tstepB : cB;
        for (int t = 0; t < nt; t += 2) {
            const bool last = (t == nt - 2);
            const char* a1 = cA + (size_t)(t + 1) * kstep;
            const char* a2 = last ? nA : cA + (size_t)(t + 2) * kstep; const char* b2 = last ? nB : cB + (size_t)(t + 2) * kstep;
            const char* a3 = a2 + kstep; const char* b3 = b2 + kstep;
            if (last && has_next) S.a_ready(nxt);
            if constexpr (SP2) {
            PG8_LDB(B0, 0, 0); PG8_LDB(B1, 0, 1); PG8_SCHED; PG8_LDA(At, 0, 0); PG8_STAGE(PG8_SA(1, 1), a1 + hstepA, voffA);
            PG8_WAIT_V(8); PG8_WAIT_L(0); PG8_BAR; PG8_MMA(0, 0, At, B0); PG8_MMA(0, 1, At, B1); PG8_BAR; PG8_SCHED;
            PG8_LDA(At, 0, 1); PG8_STAGE(PG8_SB(0, 0), b2, voffB); PG8_STAGE(PG8_SB(0, 1), b2 + hstepB, voffB); PG8_STAGE(PG8_SA(0, 0), a2, voffA);
            PG8_WAIT_V(8); PG8_WAIT_L(0); PG8_BAR; PG8_MMA(1, 0, At, B0); PG8_MMA(1, 1, At, B1); PG8_BAR; PG8_SCHED;
            PG8_LDB(B0, 1, 0); PG8_LDB(B1, 1, 1); PG8_SCHED; PG8_LDA(At, 1, 0); PG8_STAGE(PG8_SA(0, 1), a2 + hstepA, voffA);
            PG8_WAIT_V(8); PG8_WAIT_L(0); PG8_BAR; PG8_MMA(0, 0, At, B0); PG8_MMA(0, 1, At, B1); PG8_BAR; PG8_SCHED;
            PG8_LDA(At, 1, 1); PG8_STAGE(PG8_SB(1, 0), b3, voffB); PG8_STAGE(PG8_SB(1, 1), b3 + hstepB, voffB); PG8_STAGE(PG8_SA(1, 0), a3, voffA);
            PG8_WAIT_V(8); PG8_WAIT_L(0); PG8_BAR; PG8_MMA(1, 0, At, B0); PG8_MMA(1, 1, At, B1); PG8_BAR; PG8_SCHED;
            } else {
            PG8_LDB(B0, 0, 0); PG8_SCHED; PG8_LDA(At, 0, 0); PG8_STAGE(PG8_SA(1, 1), a1 + hstepA, voffA);
            PG8_WAIT_L(8); PG8_BAR; PG8_WAIT_L(0); PG8_MMA(0, 0, At, B0); PG8_BAR; PG8_SCHED;
            PG8_LDB(B1, 0, 1); PG8_STAGE(PG8_SB(0, 0), b2, voffB);
            PG8_BAR; PG8_WAIT_L(0); PG8_MMA(0, 1, At, B1); PG8_BAR;
            PG8_LDA(At, 0, 1); PG8_STAGE(PG8_SA(0, 0), a2, voffA);
            PG8_BAR; PG8_WAIT_L(0); PG8_MMA(1, 0, At, B0); PG8_BAR; PG8_SCHED;
            PG8_STAGE(PG8_SB(0, 1), b2 + hstepB, voffB);
            PG8_WAIT_V(6); PG8_BAR; PG8_MMA(1, 1, At, B1); PG8_BAR;
            PG8_LDB(B0, 1, 0); PG8_SCHED; PG8_LDA(At, 1, 0); PG8_STAGE(PG8_SA(0, 1), a2 + hstepA, voffA);
            PG8_WAIT_L(8); PG8_BAR; PG8_WAIT_L(0); PG8_MMA(0, 0, At, B0); PG8_BAR; PG8_SCHED;
            PG8_LDB(B1, 1, 1); PG8_STAGE(PG8_SB(1, 0), b3, voffB);
            PG8_BAR; PG8_WAIT_L(0); PG8_MMA(0, 1, At, B1); PG8_BAR;
            PG8_LDA(At, 1, 1); PG8_STAGE(PG8_SA(1, 0), a3, voffA);
            PG8_BAR; PG8_WAIT_L(0); PG8_MMA(1, 0, At, B0); PG8_BAR; PG8_SCHED;
            PG8_STAGE(PG8_SB(1, 1), b3 + hstepB, voffB);
            PG8_WAIT_V(6); PG8_BAR; PG8_MMA(1, 1, At, B1); PG8_BAR;
            }
        }
        if constexpr (ALIGN_EPI) { if (wr == 0) PG8_BAR; }
        if constexpr (!Epi::AFTER_DRAIN) { E(acc, cur, wr, wc, fr, fq); S.done(cur); }
        if (!has_next) break;
#pragma unroll
        for (int a = 0; a < 2; ++a)
#pragma unroll
            for (int b = 0; b < 2; ++b)
#pragma unroll
                for (int m = 0; m < 4; ++m)
#pragma unroll
                    for (int n = 0; n < 2; ++n) acc[a][b][m][n] = (f32x4){0.f, 0.f, 0.f, 0.f};
        cur = nxt; cA = nA; cB = nB; ++ui;
        if constexpr (ALIGN_EPI) { if (wr == 1) PG8_BAR; }
    }
    PG8_WAIT_V(0);
    if constexpr (!ALIGN_EPI) { if (wr == 0) PG8_BAR; }
    PG8_BAR;
    if constexpr (Epi::AFTER_DRAIN) { E.fused(acc, cur, wr, wc, fr, fq, lds, wid, lane); S.done(cur); }
#undef PG8_SA
#undef PG8_SB
#undef PG8_STAGE
#undef PG8_LDA
#undef PG8_LDB
#undef PG8_MMA
#undef PG8_WAIT_V
#undef PG8_WAIT_L
#undef PG8_BAR
#undef PG8_SCHED
}
}

constexpr int NB = 4, SEQ = 4096, T = NB * SEQ, DM = 1024, DEPTH = 4;
constexpr int NPROJ = 10496;
constexpr int IN_COLS = 10260;
constexpr float NORM_EPS = 1e-6f;
constexpr float LOG2E = 1.4426950408889634f;

typedef unsigned short bf16_t;
typedef short bf16x8 __attribute__((ext_vector_type(8)));
typedef float f32x4 __attribute__((ext_vector_type(4)));
typedef float f32x2 __attribute__((ext_vector_type(2)));
typedef unsigned u32x4 __attribute__((ext_vector_type(4)));
typedef unsigned u32x2 __attribute__((ext_vector_type(2)));
typedef __bf16 bf16x2_t __attribute__((ext_vector_type(2)));

constexpr size_t MiB = 1u << 20;
constexpr size_t O_MOD = 0, O_X = 1 * MiB, O_H = 65 * MiB, O_UV = 97 * MiB, O_FQKV = 129 * MiB, O_MQKV = 177 * MiB, O_Z = 225 * MiB,
                 O_XBC = 249 * MiB, O_GATE = 289 * MiB, O_SMALL = 417 * MiB, O_VTF = 419 * MiB, O_VTM = 435 * MiB, O_XT = 451 * MiB,
                 O_BC = 475 * MiB, O_BT = 491 * MiB, O_ST = 499 * MiB, O_CUMF = 547 * MiB, O_ACUM = 548 * MiB, O_KMEAN = 549 * MiB,
                 O_WIN = 550 * MiB, O_WA = 571 * MiB, O_WB = 572 * MiB, O_WC = 573 * MiB, O_WD = 574 * MiB, O_WO = 576 * MiB,
                 O_W1 = 578 * MiB, O_W2 = 586 * MiB, O_GWS = 594 * MiB, WS_END = 595 * MiB;
constexpr size_t O_DT = O_KMEAN + 256 * 1024;
constexpr size_t O_CTL = 512 * 1024;
constexpr size_t O_PREV = O_XBC;
constexpr size_t O_HID = O_GATE;
constexpr size_t O_MF32 = O_VTF;
constexpr int LDS_BYTES = 147456;

struct Params { const float* in[26]; float* out; unsigned char* ws; int ph_lo, ph_hi; };

__device__ __forceinline__ int opq(int i) { asm volatile("" : "+s"(i)); return i; }
#define PIN(i) (p.in[opq(i)])
__device__ __forceinline__ unsigned cvtpk(float lo, float hi) { f32x2 v = {lo, hi}; bf16x2_t b = __builtin_convertvector(v, bf16x2_t); return __builtin_bit_cast(unsigned, b); }
__device__ __forceinline__ float bf2f(short h) { return __uint_as_float(((unsigned)(unsigned short)h) << 16); }
__device__ __forceinline__ float bflo(unsigned w) { return __uint_as_float(w << 16); }
__device__ __forceinline__ float bfhi(unsigned w) { return __uint_as_float(w & 0xffff0000u); }
__device__ __forceinline__ bf16x8 pack8(float a0, float a1, float a2, float a3, float a4, float a5, float a6, float a7) {
    u32x4 w = {cvtpk(a0, a1), cvtpk(a2, a3), cvtpk(a4, a5), cvtpk(a6, a7)}; return __builtin_bit_cast(bf16x8, w); }
__device__ __forceinline__ bf16x8 ld2x8(const bf16_t* p0, const bf16_t* p1) { const u32x2 a = *(const u32x2*)p0, b = *(const u32x2*)p1; u32x4 w = {a.x, a.y, b.x, b.y}; return __builtin_bit_cast(bf16x8, w); }
__device__ __forceinline__ f32x4 mfma16(bf16x8 a, bf16x8 b, f32x4 c) { return __builtin_amdgcn_mfma_f32_16x16x32_bf16(a, b, c, 0, 0, 0); }
__device__ __forceinline__ float wave_sum(float v) {
#pragma unroll
    for (int o = 1; o < 64; o <<= 1) v += __shfl_xor(v, o);
    return v; }
__device__ __forceinline__ float ex2(float x) { return __builtin_amdgcn_exp2f(x); }
__device__ __forceinline__ float sigmoidf_(float x) { return 1.f / (1.f + __expf(-x)); }
__device__ __forceinline__ float softplusf_(float x) { return fmaxf(x, 0.f) + log1pf(expf(-fabsf(x))); }
#define LDS_WAIT() asm volatile("s_waitcnt lgkmcnt(0)" ::: "memory")
#define VM_WAIT() asm volatile("s_waitcnt vmcnt(0)" ::: "memory")

#define EPI_LANE_SETUP() int t_ = threadIdx.x; asm volatile("" : "+v"(t_)); const int fr = t_ & 15, fq = (t_ >> 4) & 3; const int wv_ = __builtin_amdgcn_readfirstlane(t_ >> 6); const int wr = wv_ >> 2, wc = wv_ & 3
struct EpiInproj {
    static constexpr bool PERM = false, AFTER_DRAIN = false;
    unsigned char* ws;
    __device__ __forceinline__ void operator()(const f32x4 (&acc)[2][2][4][2], const pg8::Unit& u, int, int, int, int) const {
        EPI_LANE_SETUP();
        const int pn = u.pn; const int row0 = u.pm * 256 + wr * 64 + fr;
        if (pn == 40) {
            if (wc == 0) {
                float* sm = (float*)(ws + O_SMALL);
#pragma unroll
                for (int ai = 0; ai < 2; ++ai)
#pragma unroll
                    for (int m = 0; m < 4; ++m) { float* rp = sm + (size_t)(row0 + ai * 128 + m * 16) * 32 + 4 * fq;
                        *(f32x4*)rp = acc[ai][0][m][0]; *(f32x4*)(rp + 16) = acc[ai][0][m][1]; }
            }
            return;
        }
        bf16_t* base; int pitch, ct, act;
        if (pn < 4) { base = (bf16_t*)(ws + O_UV); pitch = 1024; ct = pn; act = 1; }
        else if (pn < 10) { base = (bf16_t*)(ws + O_FQKV); pitch = 1536; ct = pn - 4; act = 0; }
        else if (pn < 16) { base = (bf16_t*)(ws + O_MQKV); pitch = 1536; ct = pn - 10; act = 0; }
        else if (pn < 19) { base = (bf16_t*)(ws + O_Z); pitch = 768; ct = pn - 16; act = 2; }
        else if (pn < 24) { base = (bf16_t*)(ws + O_XBC); pitch = 1280; ct = pn - 19; act = 0; }
        else { base = (bf16_t*)(ws + O_GATE); pitch = 4096; ct = pn - 24; act = 3; }
        const int col0 = ct * 256 + wc * 32 + 4 * fq;
#pragma unroll
        for (int ai = 0; ai < 2; ++ai)
#pragma unroll
            for (int m = 0; m < 4; ++m) { bf16_t* rowp = base + (size_t)(row0 + ai * 128 + m * 16) * pitch + col0;
#pragma unroll
                for (int bj = 0; bj < 2; ++bj)
#pragma unroll
                    for (int n = 0; n < 2; ++n) { f32x4 v = acc[ai][bj][m][n];
#pragma unroll
                        for (int j = 0; j < 4; ++j) { const float x = v[j];
                            const float uu = 1.5957691216057308f * (x + 0.044715f * x * x * x);
                            const float arg = (act == 1) ? uu : (act == 0) ? INFINITY : x;
                            const float num = (act == 3) ? 1.f : x;
                            v[j] = num / (1.f + __expf(-arg)); }
                        u32x2 w; w.x = cvtpk(v[0], v[1]); w.y = cvtpk(v[2], v[3]);
                        *(u32x2*)(rowp + bj * 128 + n * 16) = w; }
                asm volatile("" ::: "memory"); }
    }
};
struct EpiMerge {
    static constexpr bool PERM = false, AFTER_DRAIN = false;
    const bf16_t* gate; float* mf; bf16_t* outb; int mode;
    __device__ __forceinline__ void operator()(const f32x4 (&acc)[2][2][4][2], const pg8::Unit& u, int, int, int, int) const {
        EPI_LANE_SETUP();
        const int row0 = u.pm * 256 + wr * 64 + fr, col0 = u.pn * 256 + wc * 32 + 4 * fq;
#pragma unroll
        for (int ai = 0; ai < 2; ++ai)
#pragma unroll
            for (int m = 0; m < 4; ++m) { const size_t row = (size_t)(row0 + ai * 128 + m * 16);
#pragma unroll
                for (int bj = 0; bj < 2; ++bj)
#pragma unroll
                    for (int n = 0; n < 2; ++n) { const int col = col0 + bj * 128 + n * 16;
                        const u32x2 gw = *(const u32x2*)(gate + row * 4096 + col);
                        f32x4 v = acc[ai][bj][m][n]; v[0] *= bflo(gw.x); v[1] *= bfhi(gw.x); v[2] *= bflo(gw.y); v[3] *= bfhi(gw.y);
                        float* mp = mf + row * 1024 + col;
                        if (mode == 0) *(f32x4*)mp = v;
                        else if (mode == 1) *(f32x4*)mp = *(const f32x4*)mp + v;
                        else { v = *(const f32x4*)mp + v; u32x2 w; w.x = cvtpk(v[0], v[1]); w.y = cvtpk(v[2], v[3]); *(u32x2*)(outb + row * 1024 + col) = w; } }
                asm volatile("" ::: "memory"); }
    }
};
struct EpiResid {
    static constexpr bool PERM = false, AFTER_DRAIN = false;
    const float* xin; float* xout; const float* gmod;
    __device__ __forceinline__ void operator()(const f32x4 (&acc)[2][2][4][2], const pg8::Unit& u, int, int, int, int) const {
        EPI_LANE_SETUP();
        const int row0 = u.pm * 256 + wr * 64 + fr, col0 = u.pn * 256 + wc * 32 + 4 * fq; const int b = u.pm >> 4;
        const float* gp = gmod + (size_t)b * 6144 + col0;
#pragma unroll
        for (int ai = 0; ai < 2; ++ai)
#pragma unroll
            for (int m = 0; m < 4; ++m) { const size_t off = (size_t)(row0 + ai * 128 + m * 16) * 1024 + col0;
#pragma unroll
                for (int bj = 0; bj < 2; ++bj)
#pragma unroll
                    for (int n = 0; n < 2; ++n) { const int co = bj * 128 + n * 16; const f32x4 g = *(const f32x4*)(gp + co);
                        *(f32x4*)(xout + off + co) = *(const f32x4*)(xin + off + co) + g * acc[ai][bj][m][n]; }
                asm volatile("" ::: "memory"); }
    }
};
struct EpiRelu2 {
    static constexpr bool PERM = false, AFTER_DRAIN = false;
    bf16_t* out;
    __device__ __forceinline__ void operator()(const f32x4 (&acc)[2][2][4][2], const pg8::Unit& u, int, int, int, int) const {
        EPI_LANE_SETUP();
        const int row0 = u.pm * 256 + wr * 64 + fr, col0 = u.pn * 256 + wc * 32 + 4 * fq;
#pragma unroll
        for (int ai = 0; ai < 2; ++ai)
#pragma unroll
            for (int m = 0; m < 4; ++m) { bf16_t* rowp = out + (size_t)(row0 + ai * 128 + m * 16) * 4096 + col0;
#pragma unroll
                for (int bj = 0; bj < 2; ++bj)
#pragma unroll
                    for (int n = 0; n < 2; ++n) { f32x4 v = acc[ai][bj][m][n];
#pragma unroll
                        for (int j = 0; j < 4; ++j) { const float r = fmaxf(v[j], 0.f); v[j] = r * r; }
                        u32x2 w; w.x = cvtpk(v[0], v[1]); w.y = cvtpk(v[2], v[3]); *(u32x2*)(rowp + bj * 128 + n * 16) = w; }
                asm volatile("" ::: "memory"); }
    }
};
struct EpiU {
    static constexpr bool PERM = false, AFTER_DRAIN = false;
    int kind, mode; const void* p0; void* p1; void* p2; int dry;
    __device__ __forceinline__ void operator()(const f32x4 (&acc)[2][2][4][2], const pg8::Unit& u, int a, int b, int c, int d) const {
        if (dry) return;
        if (kind == 0) { EpiInproj e{(unsigned char*)p1}; e(acc, u, a, b, c, d); }
        else if (kind == 1) { EpiMerge e{(const bf16_t*)p0, (float*)p1, (bf16_t*)p2, mode}; e(acc, u, a, b, c, d); }
        else if (kind == 2) { EpiResid e{(const float*)p0, (float*)p1, (const float*)p2}; e(acc, u, a, b, c, d); }
        else { EpiRelu2 e{(bf16_t*)p1}; e(acc, u, a, b, c, d); }
    }
};
template <class Epi>
__device__ __forceinline__ void run_gemm(unsigned char* lds, const bf16_t* A, int lda, const bf16_t* Bt, int N, int K, const Epi& E) {
    pg8::Gemm g{A, Bt, T, N, K, lda}; pg8::StaticOrder S; S.init(T, N, (int)gridDim.x, (int)blockIdx.x);
    pg8::gemm_phase<Epi, pg8::StaticOrder, true, true>((PG8_LAS unsigned char*)lds, g, S, E);
}

__device__ __forceinline__ void phase_pre(const Params& p, unsigned char* lds, const int tid) {
    float* cs = (float*)lds; float* red = cs + 4096;
    const float* c = PIN(1); const float* ada_w = PIN(2); const float* ada_b = PIN(3);
    float* mod = (float*)(p.ws + O_MOD);
    for (int i = tid; i < 4096; i += 512) { const float v = c[i]; cs[i] = v / (1.f + expf(-v)); }
    __syncthreads();
    const int jj = tid & 63, ks = tid >> 6;
    for (int it = blockIdx.x; it < DEPTH * 96; it += gridDim.x) {
        const int l = it / 96, jb = it % 96;
        const float* w = ada_w + (size_t)l * 1024 * 6144 + jb * 64 + jj;
        float a0 = 0.f, a1 = 0.f, a2 = 0.f, a3 = 0.f;
#pragma unroll 8
        for (int k = ks * 128; k < ks * 128 + 128; ++k) { const float wv = w[(size_t)k * 6144]; a0 += cs[k] * wv; a1 += cs[1024 + k] * wv; a2 += cs[2048 + k] * wv; a3 += cs[3072 + k] * wv; }
        red[(ks * 64 + jj) * 4 + 0] = a0; red[(ks * 64 + jj) * 4 + 1] = a1; red[(ks * 64 + jj) * 4 + 2] = a2; red[(ks * 64 + jj) * 4 + 3] = a3;
        __syncthreads();
        if (tid < 256) { const int b = tid >> 6, j2 = tid & 63; float s = 0.f;
#pragma unroll
            for (int q = 0; q < 8; ++q) s += red[(q * 64 + j2) * 4 + b];
            const int cc = jb * 64 + j2; mod[((size_t)l * 4 + b) * 6144 + cc] = s + ada_b[l * 6144 + cc]; }
        __syncthreads();
    }
}

__device__ __forceinline__ int inproj_src_col(int n) {
    if (n < 2560) return n;
    if (n < 6144) return n + 8;
    if (n < 10240) return n + 20;
    if (n < 10248) return 2560 + (n - 10240);
    if (n < 10260) return 6152 + (n - 10248);
    return -1;
}
__device__ __forceinline__ void transpose_item(const float* W, int K, int Nsrc, bf16_t* WT, float* scr, int k0, int n0, int lane, bool remap) {
    const int nd = n0 + (lane & 31); const int sc = remap ? inproj_src_col(nd) : nd;
#pragma unroll
    for (int i = 0; i < 32; ++i) { const int kk = 2 * i + (lane >> 5); scr[kk * 33 + (lane & 31)] = (sc >= 0) ? W[(size_t)(k0 + kk) * Nsrc + sc] : 0.f; }
    LDS_WAIT();
    const int c = lane & 7;
#pragma unroll
    for (int j = 0; j < 4; ++j) { const int n = (lane >> 3) + 8 * j; const float* s = scr + (8 * c) * 33 + n;
        u32x4 o; o.x = cvtpk(s[0 * 33], s[1 * 33]); o.y = cvtpk(s[2 * 33], s[3 * 33]); o.z = cvtpk(s[4 * 33], s[5 * 33]); o.w = cvtpk(s[6 * 33], s[7 * 33]);
        *(u32x4*)(WT + (size_t)(n0 + n) * K + k0 + 8 * c) = o; }
    LDS_WAIT();
}
__device__ __forceinline__ void convert_weights(const Params& p, int l, unsigned char* lds, int gw, int NGW, int wid, int lane) {
    float* scr = (float*)(lds + wid * 16384);
    unsigned char* ws = p.ws;
    constexpr int I_IN = 16 * (NPROJ / 32), I_BR = 8 * 32, I_D = 12 * 32, I_O = 16 * 32, I_1 = 16 * 128, I_2 = 64 * 32;
    constexpr int TOT = I_IN + 3 * I_BR + I_D + I_O + I_1 + I_2;
    for (int it = gw; it < TOT; it += NGW) {
        int r = it; const float* W; bf16_t* WT; int K, Nsrc, Nd; bool remap = false;
        if (r < I_IN) { W = PIN(5) + (size_t)l * 1024 * IN_COLS; WT = (bf16_t*)(ws + O_WIN); K = 1024; Nsrc = IN_COLS; Nd = NPROJ; remap = true; }
        else if ((r -= I_IN) < I_BR) { W = PIN(17) + (size_t)l * 512 * 1024; WT = (bf16_t*)(ws + O_WA); K = 512; Nsrc = 1024; Nd = 1024; }
        else if ((r -= I_BR) < I_BR) { W = PIN(18) + (size_t)l * 512 * 1024; WT = (bf16_t*)(ws + O_WB); K = 512; Nsrc = 1024; Nd = 1024; }
        else if ((r -= I_BR) < I_BR) { W = PIN(19) + (size_t)l * 512 * 1024; WT = (bf16_t*)(ws + O_WC); K = 512; Nsrc = 1024; Nd = 1024; }
        else if ((r -= I_BR) < I_D) { W = PIN(20) + (size_t)l * 768 * 1024; WT = (bf16_t*)(ws + O_WD); K = 768; Nsrc = 1024; Nd = 1024; }
        else if ((r -= I_D) < I_O) { W = PIN(21) + (size_t)l * 1024 * 1024; WT = (bf16_t*)(ws + O_WO); K = 1024; Nsrc = 1024; Nd = 1024; }
        else if ((r -= I_O) < I_1) { W = PIN(23) + (size_t)l * 1024 * 4096; WT = (bf16_t*)(ws + O_W1); K = 1024; Nsrc = 4096; Nd = 4096; }
        else { r -= I_1; W = PIN(24) + (size_t)l * 4096 * 1024; WT = (bf16_t*)(ws + O_W2); K = 4096; Nsrc = 1024; Nd = 1024; }
        const int nblk = Nd / 32, kb = r / nblk, nb = r % nblk;
        transpose_item(W, K, Nsrc, WT, scr, 64 * kb, 32 * nb, lane, remap);
    }
    const float* gws = PIN(8) + (size_t)l * 8 * 128 * 128; bf16_t* gd = (bf16_t*)(ws + O_GWS);
    for (int e = gw * 64 + lane; e < 8 * 128 * 128; e += NGW * 64) { const int s = e & 127, t = (e >> 7) & 127; const float v = (s <= t) ? gws[e] : 0.f; gd[e] = (bf16_t)(cvtpk(v, 0.f) & 0xffffu); }
}
__device__ __forceinline__ void norm_mod_rows(const float* x, const float* w, const float* sh, const float* sc, bf16_t* out, int gw, int NGW, int lane) {
    for (int row = gw; row < T; row += NGW) {
        const int b = row >> 12; const f32x4* xr = (const f32x4*)(x + (size_t)row * 1024) + lane;
        f32x4 v[4]; float ss = 0.f;
#pragma unroll
        for (int j = 0; j < 4; ++j) { v[j] = xr[64 * j]; ss += (v[j][0] * v[j][0] + v[j][1] * v[j][1]) + (v[j][2] * v[j][2] + v[j][3] * v[j][3]); }
        const float rstd = rsqrtf(wave_sum(ss) * (1.f / 1024.f) + NORM_EPS);
#pragma unroll
        for (int j = 0; j < 4; ++j) { const int col = 4 * (64 * j + lane);
            const f32x4 wv = *(const f32x4*)(w + col), sv = *(const f32x4*)(sc + (size_t)b * 6144 + col), hv = *(const f32x4*)(sh + (size_t)b * 6144 + col);
            const f32x4 o = (v[j] * rstd * wv) * (sv + 1.f) + hv;
            u32x2 pk; pk.x = cvtpk(o[0], o[1]); pk.y = cvtpk(o[2], o[3]); *(u32x2*)(out + (size_t)row * 1024 + col) = pk; }
    }
}
__device__ __forceinline__ void final_norm_rows(const float* x, const float* w, float* out, int gw, int NGW, int lane) {
    for (int row = gw; row < T; row += NGW) {
        const f32x4* xr = (const f32x4*)(x + (size_t)row * 1024) + lane;
        f32x4 v[4]; float ss = 0.f;
#pragma unroll
        for (int j = 0; j < 4; ++j) { v[j] = xr[64 * j]; ss += (v[j][0] * v[j][0] + v[j][1] * v[j][1]) + (v[j][2] * v[j][2] + v[j][3] * v[j][3]); }
        const float rstd = rsqrtf(wave_sum(ss) * (1.f / 1024.f) + NORM_EPS);
#pragma unroll
        for (int j = 0; j < 4; ++j) { const int col = 4 * (64 * j + lane); const f32x4 wv = *(const f32x4*)(w + col);
            *(f32x4*)(out + (size_t)row * 1024 + col) = v[j] * rstd * wv; }
    }
}

__device__ __forceinline__ void gmlp_item(const Params& p, int l, unsigned char* lds, int item, int wid, int lane, bool dry = false) {
    const int grp = item & 7, ch = (item >> 3) & 31, b = item >> 8;
    const int fr = lane & 15, fq = lane >> 4;
    bf16_t* UV = (bf16_t*)(p.ws + O_UV); const bf16_t* GWS = (const bf16_t*)(p.ws + O_GWS);
    const float* lnw = PIN(6) + l * 512; const float* lnb = PIN(7) + l * 512; const float* bs = PIN(9) + (size_t)l * 8 * 128 + grp * 128;
    bf16_t* vnT = (bf16_t*)lds;
    const size_t row0 = (size_t)b * SEQ + ch * 128;
#pragma unroll 8
    for (int r = 0; r < 16; ++r) {
        const int s = wid * 16 + r;
        const bf16x8 raw = *(const bf16x8*)(UV + (row0 + s) * 1024 + 512 + 8 * lane);
        float x[8]; float sum = 0.f;
#pragma unroll
        for (int j = 0; j < 8; ++j) { x[j] = bf2f(raw[j]); sum += x[j]; }
        const float mean = wave_sum(sum) * (1.f / 512.f); float sq = 0.f;
#pragma unroll
        for (int j = 0; j < 8; ++j) { x[j] -= mean; sq += x[j] * x[j]; }
        const float rstd = rsqrtf(wave_sum(sq) * (1.f / 512.f) + NORM_EPS);
        if ((lane >> 3) == grp) { const int c0 = (lane & 7) * 8;
#pragma unroll
            for (int j = 0; j < 8; ++j) { const int cc = grp * 64 + c0 + j; const float o = x[j] * rstd * lnw[cc] + lnb[cc]; vnT[(c0 + j) * 136 + s] = (bf16_t)(cvtpk(o, 0.f) & 0xffffu); } }
    }
    __syncthreads();
    const int t0 = wid * 16;
    f32x4 acc[4];
#pragma unroll
    for (int ct = 0; ct < 4; ++ct) acc[ct] = (f32x4){0.f, 0.f, 0.f, 0.f};
    const int nks = (t0 + 15) / 32 + 1;
    for (int ks = 0; ks < nks; ++ks) {
        const bf16x8 bw = *(const bf16x8*)(GWS + ((size_t)grp * 128 + t0 + fr) * 128 + ks * 32 + 8 * fq);
#pragma unroll
        for (int ct = 0; ct < 4; ++ct) { const bf16x8 av = *(const bf16x8*)(vnT + (ct * 16 + fr) * 136 + ks * 32 + 8 * fq); acc[ct] = mfma16(av, bw, acc[ct]); }
    }
    const float bsv = bs[t0 + fr];
#pragma unroll
    for (int ct = 0; ct < 4; ++ct) { bf16_t* up = UV + (row0 + t0 + fr) * 1024 + grp * 64 + ct * 16 + 4 * fq;
        const u32x2 uw = *(const u32x2*)up; u32x2 o;
        o.x = cvtpk(bflo(uw.x) * (acc[ct][0] + bsv), bfhi(uw.x) * (acc[ct][1] + bsv)); o.y = cvtpk(bflo(uw.y) * (acc[ct][2] + bsv), bfhi(uw.y) * (acc[ct][3] + bsv));
        if (!dry) *(u32x2*)up = o; }
    __syncthreads();
}
__device__ __forceinline__ void rotary_item(const Params& p, unsigned char* lds, int item, int tid, bool dry = false) {
    const int h = item & 7, nb = (item >> 3) & 15, b = item >> 7;
    float* sums = (float*)lds;
    if (tid < 64) sums[tid] = 0.f;
    __syncthreads();
    bf16_t* MQ = (bf16_t*)(p.ws + O_MQKV);
    const int tt = tid >> 1, half = tid & 1; const int pos = nb * 256 + tt; const size_t row = (size_t)b * SEQ + pos;
    bf16_t* kp = MQ + row * 1536 + 512 + h * 64 + half * 32;
    float kv[32];
#pragma unroll
    for (int q = 0; q < 4; ++q) { const bf16x8 raw = *(const bf16x8*)(kp + 8 * q);
#pragma unroll
        for (int j = 0; j < 8; ++j) kv[8 * q + j] = bf2f(raw[j]); }
    if (half == 0 && !dry) {
        bf16_t* qp = MQ + row * 1536 + h * 64;
        float qv[16];
        { const bf16x8 r0 = *(const bf16x8*)qp, r1 = *(const bf16x8*)(qp + 8);
#pragma unroll
          for (int j = 0; j < 8; ++j) { qv[j] = bf2f(r0[j]); qv[8 + j] = bf2f(r1[j]); } }
#pragma unroll
        for (int j = 0; j < 8; ++j) {
            const float inv_freq = powf(500000.0f, -(float)j * 0.125f); const float ang = (float)pos * inv_freq;
            const float cs = cosf(ang), sn = sinf(ang);
            const float k1 = kv[j], k2 = kv[8 + j]; kv[j] = k1 * cs - k2 * sn; kv[8 + j] = k2 * cs + k1 * sn;
            const float q1 = qv[j], q2 = qv[8 + j]; qv[j] = q1 * cs - q2 * sn; qv[8 + j] = q2 * cs + q1 * sn;
        }
        *(bf16x8*)kp = pack8(kv[0], kv[1], kv[2], kv[3], kv[4], kv[5], kv[6], kv[7]);
        *(bf16x8*)(kp + 8) = pack8(kv[8], kv[9], kv[10], kv[11], kv[12], kv[13], kv[14], kv[15]);
        *(bf16x8*)qp = pack8(qv[0], qv[1], qv[2], qv[3], qv[4], qv[5], qv[6], qv[7]);
        *(bf16x8*)(qp + 8) = pack8(qv[8], qv[9], qv[10], qv[11], qv[12], qv[13], qv[14], qv[15]);
    }
#pragma unroll
    for (int d = 0; d < 32; ++d) {
        float v = kv[d];
#pragma unroll
        for (int o = 2; o < 64; o <<= 1) v += __shfl_xor(v, o);
        if ((tid & 63) < 2) atomicAdd(&sums[half * 32 + d], v);
    }
    __syncthreads();
    if (tid < 64) ((float*)(p.ws + O_KMEAN))[(((size_t)b * 8 + h) * 16 + nb) * 64 + tid] = sums[tid] * (1.f / 256.f);
    __syncthreads();
}
__device__ __forceinline__ void vt_item(const Params& p, unsigned char* lds, int item, int tid) {
    const int tb = item & 31, h = (item >> 5) & 7, b = (item >> 8) & 3, which = item >> 10;
    const bf16_t* src = (const bf16_t*)(p.ws + (which ? O_MQKV : O_FQKV)) + ((size_t)b * SEQ + tb * 128) * 1536 + 1024 + h * 64;
    bf16_t* dst = (bf16_t*)(p.ws + (which ? O_VTM : O_VTF)) + ((size_t)(b * 8 + h) * 64) * 4096 + tb * 128;
    bf16_t* tl = (bf16_t*)lds;
    { const int tok = tid >> 2, dq = tid & 3;
      const bf16x8 r0 = *(const bf16x8*)(src + (size_t)tok * 1536 + dq * 16), r1 = *(const bf16x8*)(src + (size_t)tok * 1536 + dq * 16 + 8);
#pragma unroll
      for (int j = 0; j < 8; ++j) { tl[(dq * 16 + j) * 136 + tok] = (bf16_t)r0[j]; tl[(dq * 16 + 8 + j) * 136 + tok] = (bf16_t)r1[j]; } }
    __syncthreads();
    { const int d = tid >> 3, c = tid & 7;
      const bf16x8 a = *(const bf16x8*)(tl + d * 136 + c * 16), bq = *(const bf16x8*)(tl + d * 136 + c * 16 + 8);
      *(bf16x8*)(dst + (size_t)d * 4096 + c * 16) = a; *(bf16x8*)(dst + (size_t)d * 4096 + c * 16 + 8) = bq; }
    __syncthreads();
}
__device__ __forceinline__ void conv_item(const Params& p, int l, int item, int tid) {
    const int cb = item % 20, ch = (item / 20) & 31, b = item / 640;
    const int c = tid & 63, tg = tid >> 6; const int gc = cb * 64 + c;
    const int t00 = ch * 128 + tg * 16 - 3;
    const bf16_t* xp = (const bf16_t*)(p.ws + O_XBC) + ((size_t)b * SEQ) * 1280 + gc;
    float v[19];
#pragma unroll
    for (int r = 0; r < 19; ++r) { const int t = t00 + r; v[r] = (t >= 0) ? bf2f((short)xp[(size_t)(t < 0 ? 0 : t) * 1280]) : 0.f; }
    const float* cw = PIN(11) + (size_t)l * 4 * 1280 + gc; const float w0 = cw[0], w1 = cw[1280], w2 = cw[2560], w3 = cw[3840], cbv = PIN(12)[l * 1280 + gc];
    float o[16];
#pragma unroll
    for (int tt = 0; tt < 16; ++tt) { const float x = cbv + w0 * v[tt] + w1 * v[tt + 1] + w2 * v[tt + 2] + w3 * v[tt + 3]; o[tt] = x / (1.f + __expf(-x)); }
    const size_t tok0 = (size_t)b * SEQ + ch * 128 + tg * 16;
    const bf16x8 p0 = pack8(o[0], o[1], o[2], o[3], o[4], o[5], o[6], o[7]), p1 = pack8(o[8], o[9], o[10], o[11], o[12], o[13], o[14], o[15]);
    if (cb < 12) { bf16_t* d = (bf16_t*)(p.ws + O_XT) + ((size_t)(b * 12 + cb) * 64 + c) * 4096 + ch * 128 + tg * 16; *(bf16x8*)d = p0; *(bf16x8*)(d + 8) = p1; }
    else {
        bf16_t* BC = (bf16_t*)(p.ws + O_BC); const int bc = gc - 768;
#pragma unroll
        for (int tt = 0; tt < 8; ++tt) { BC[(tok0 + tt) * 512 + bc] = (bf16_t)p0[tt]; BC[(tok0 + 8 + tt) * 512 + bc] = (bf16_t)p1[tt]; }
        if (cb < 16) { bf16_t* d = (bf16_t*)(p.ws + O_BT) + ((size_t)b * 256 + bc) * 4096 + ch * 128 + tg * 16; *(bf16x8*)d = p0; *(bf16x8*)(d + 8) = p1; }
    }
}
__device__ __forceinline__ void acum_item(const Params& p, int l, int item, int lane) {
    const int ch = item & 31, h = (item >> 5) % 12, b = item / 384;
    const float* sm = (const float*)(p.ws + O_SMALL); const float a = -expf(PIN(14)[l * 12 + h]);
    const size_t tok = (size_t)b * SEQ + ch * 128 + 2 * lane;
    const float dtb = PIN(13)[l * 12 + h];
    const float d0 = softplusf_(sm[tok * 32 + 8 + h] + dtb), d1 = softplusf_(sm[(tok + 1) * 32 + 8 + h] + dtb);
    { f32x2 dd = {d0, d1}; *(f32x2*)((float*)(p.ws + O_DT) + ((size_t)(b * 12 + h)) * 4096 + ch * 128 + 2 * lane) = dd; }
    const float v0 = d0 * a, v1 = d1 * a;
    float sc = v0 + v1;
#pragma unroll
    for (int o = 1; o < 64; o <<= 1) { const float t = __shfl_up(sc, o); if (lane >= o) sc += t; }
    const float ex = sc - (v0 + v1);
    f32x2 r = {ex + v0, ex + v0 + v1};
    *(f32x2*)((float*)(p.ws + O_ACUM) + ((size_t)(b * 12 + h)) * 4096 + ch * 128 + 2 * lane) = r;
}
__device__ __forceinline__ void foxcum_item(const Params& p, int l, int item, int lane) {
    const int h = item & 7, b = item >> 3; const float fb = PIN(10)[l * 8 + h];
    const float* sm = (const float*)(p.ws + O_SMALL) + ((size_t)b * SEQ + lane * 64) * 32 + h;
    float* cum = (float*)(p.ws + O_CUMF) + (size_t)(b * 8 + h) * 4096 + lane * 64;
    float v[64];
#pragma unroll
    for (int i = 0; i < 64; ++i) v[i] = sm[(size_t)i * 32];
    float run = 0.f;
#pragma unroll
    for (int i = 0; i < 64; ++i) { const float x = v[i] + fb; run += fminf(x, 0.f) - __logf(1.f + __expf(-fabsf(x))); v[i] = run; }
    float sc = run;
#pragma unroll
    for (int o = 1; o < 64; o <<= 1) { const float t = __shfl_up(sc, o); if (lane >= o) sc += t; }
    const float ex = sc - run;
#pragma unroll
    for (int i = 0; i < 64; i += 4) { f32x4 w = {v[i] + ex, v[i + 1] + ex, v[i + 2] + ex, v[i + 3] + ex}; *(f32x4*)(cum + i) = w; }
}

template <bool MOBA>
__device__ __forceinline__ void attn_tile64(const bf16_t* KL, const bf16_t* VL, const float* __restrict__ cum, int k0, bool diag, int kb,
                                            const bf16x8 (&qf)[2][2], const unsigned (&sel)[2], int qpos0, int fr, int fq,
                                            float (&m)[2], float (&lsum)[2], f32x4 (&o)[4][2]) {
    f32x4 s[4][2];
#pragma unroll
    for (int jk = 0; jk < 4; ++jk) {
        const bf16x8 k0f = *(const bf16x8*)(KL + (16 * jk + fr) * 72 + 8 * fq), k1f = *(const bf16x8*)(KL + (16 * jk + fr) * 72 + 32 + 8 * fq);
#pragma unroll
        for (int jq = 0; jq < 2; ++jq) { f32x4 z = {0.f, 0.f, 0.f, 0.f}; z = mfma16(k0f, qf[jq][0], z); s[jk][jq] = mfma16(k1f, qf[jq][1], z); }
    }
    constexpr float C2 = 0.125f * LOG2E;
#pragma unroll
    for (int jk = 0; jk < 4; ++jk) {
        f32x4 nck = {0.f, 0.f, 0.f, 0.f};
        if (!MOBA) nck = *(const f32x4*)(cum + k0 + 16 * jk + 4 * fq) * (-LOG2E);
#pragma unroll
        for (int jq = 0; jq < 2; ++jq)
#pragma unroll
            for (int i = 0; i < 4; ++i) s[jk][jq][i] = MOBA ? s[jk][jq][i] * C2 : fmaf(s[jk][jq][i], C2, nck[i]);
    }
    if (diag) {
#pragma unroll
        for (int jk = 0; jk < 4; ++jk)
#pragma unroll
            for (int jq = 0; jq < 2; ++jq)
#pragma unroll
                for (int i = 0; i < 4; ++i) if (k0 + 16 * jk + 4 * fq + i > qpos0 + 16 * jq + fr) s[jk][jq][i] = -INFINITY;
    }
    if (MOBA && kb >= 0) {
#pragma unroll
        for (int jq = 0; jq < 2; ++jq) if (!((sel[jq] >> kb) & 1u)) {
#pragma unroll
            for (int jk = 0; jk < 4; ++jk) s[jk][jq] = (f32x4){-INFINITY, -INFINITY, -INFINITY, -INFINITY}; }
    }
    bf16x8 pb[2][2];
#pragma unroll
    for (int jq = 0; jq < 2; ++jq) {
        float mx = -INFINITY;
#pragma unroll
        for (int jk = 0; jk < 4; ++jk) mx = fmaxf(mx, fmaxf(fmaxf(s[jk][jq][0], s[jk][jq][1]), fmaxf(s[jk][jq][2], s[jk][jq][3])));
        mx = fmaxf(mx, __shfl_xor(mx, 16)); mx = fmaxf(mx, __shfl_xor(mx, 32));
        const float mnew = fmaxf(m[jq], mx); const float alpha = ex2(m[jq] - mnew); m[jq] = mnew;
        float ps = 0.f;
#pragma unroll
        for (int jk = 0; jk < 4; ++jk)
#pragma unroll
            for (int i = 0; i < 4; ++i) { const float e = ex2(s[jk][jq][i] - mnew); s[jk][jq][i] = e; ps += e; }
        lsum[jq] = lsum[jq] * alpha + ps;
#pragma unroll
        for (int dt = 0; dt < 4; ++dt) o[dt][jq] = o[dt][jq] * alpha;
        pb[jq][0] = pack8(s[0][jq][0], s[0][jq][1], s[0][jq][2], s[0][jq][3], s[1][jq][0], s[1][jq][1], s[1][jq][2], s[1][jq][3]);
        pb[jq][1] = pack8(s[2][jq][0], s[2][jq][1], s[2][jq][2], s[2][jq][3], s[3][jq][0], s[3][jq][1], s[3][jq][2], s[3][jq][3]);
    }
#pragma unroll
    for (int hh = 0; hh < 2; ++hh)
#pragma unroll
        for (int dt = 0; dt < 4; ++dt) { const bf16_t* vp = VL + (dt * 16 + fr) * 72 + hh * 32 + 4 * fq; const bf16x8 vf = ld2x8(vp, vp + 16);
#pragma unroll
            for (int jq = 0; jq < 2; ++jq) o[dt][jq] = mfma16(vf, pb[jq][hh], o[dt][jq]); }
}
template <bool MOBA>
__device__ __forceinline__ void attn_block_item(const Params& p, unsigned char* lds, int b, int h, int qb, int tid, int wid, int lane) {
    const int fr = lane & 15, fq = lane >> 4; const int q0 = qb * 256 + wid * 32;
    bf16_t* KLb = (bf16_t*)lds; bf16_t* VLb = KLb + 2 * 64 * 72;
    bf16_t* qkv = (bf16_t*)(p.ws + (MOBA ? O_MQKV : O_FQKV)) + ((size_t)b * SEQ) * 1536 + h * 64;
    const bf16_t* kbase = qkv + 512; const bf16_t* vtbase = (const bf16_t*)(p.ws + (MOBA ? O_VTM : O_VTF)) + ((size_t)(b * 8 + h) * 64) * 4096;
    const float* cum = (const float*)(p.ws + O_CUMF) + (size_t)(b * 8 + h) * 4096;
    bf16x8 qf[2][2];
#pragma unroll
    for (int jq = 0; jq < 2; ++jq)
#pragma unroll
        for (int ks = 0; ks < 2; ++ks) qf[jq][ks] = *(const bf16x8*)(qkv + (size_t)(q0 + 16 * jq + fr) * 1536 + ks * 32 + 8 * fq);
    unsigned sel[2] = {0u, 0u}; unsigned umask = 0u;
    const int own = qb;
    if (MOBA && own > 0) {
        const float* km = (const float*)(p.ws + O_KMEAN) + ((size_t)(b * 8 + h) * 16) * 64 + 16 * fq;
#pragma unroll
        for (int jq = 0; jq < 2; ++jq) {
            const bf16_t* qp = qkv + (size_t)(q0 + 16 * jq + fr) * 1536 + 16 * fq;
            const bf16x8 r0 = *(const bf16x8*)qp, r1 = *(const bf16x8*)(qp + 8);
            float qd[16];
#pragma unroll
            for (int j = 0; j < 8; ++j) { qd[j] = bf2f(r0[j]); qd[8 + j] = bf2f(r1[j]); }
            float gate[15];
#pragma unroll
            for (int n = 0; n < 15; ++n) {
                float a = -INFINITY;
                if (n < own) { a = 0.f;
#pragma unroll
                    for (int d = 0; d < 16; d += 4) { const f32x4 kk = *(const f32x4*)(km + n * 64 + d); a += qd[d] * kk[0] + qd[d + 1] * kk[1] + qd[d + 2] * kk[2] + qd[d + 3] * kk[3]; }
                    a += __shfl_xor(a, 16); a += __shfl_xor(a, 32); }
                gate[n] = a;
            }
            unsigned msk = 0u;
#pragma unroll
            for (int pass = 0; pass < 3; ++pass) { float best = -INFINITY; int bi = -1;
#pragma unroll
                for (int n = 0; n < 15; ++n) { const float v = ((msk >> n) & 1u) ? -INFINITY : gate[n]; if (v > best) { best = v; bi = n; } }
                if (bi >= 0) msk |= 1u << bi; }
            sel[jq] = msk;
        }
        umask = sel[0] | sel[1];
#pragma unroll
        for (int o2 = 1; o2 < 16; o2 <<= 1) umask |= __shfl_xor(umask, o2);
        umask = __builtin_amdgcn_readfirstlane(umask);
    }
    float m[2] = {-1e30f, -1e30f}, lsum[2] = {0.f, 0.f}; f32x4 o[4][2];
#pragma unroll
    for (int dt = 0; dt < 4; ++dt) { o[dt][0] = (f32x4){0.f, 0.f, 0.f, 0.f}; o[dt][1] = (f32x4){0.f, 0.f, 0.f, 0.f}; }
    const int NT = 4 * (qb + 1);
    const int lr = tid >> 3, lc = (tid & 7) * 8;
    #define TILE_KT(i) (MOBA ? (((i) < 4) ? 4 * qb + (i) : (i) - 4) : (i))
    bf16x8 kreg, vreg;
    { const int k0 = TILE_KT(0) * 64; kreg = *(const bf16x8*)(kbase + (size_t)(k0 + lr) * 1536 + lc); vreg = *(const bf16x8*)(vtbase + (size_t)lr * 4096 + k0 + lc); }
    *(bf16x8*)(KLb + lr * 72 + lc) = kreg; *(bf16x8*)(VLb + lr * 72 + lc) = vreg;
    __syncthreads();
#pragma unroll 1
    for (int i = 0; i < NT; ++i) {
        const int k0 = TILE_KT(i) * 64; const int buf = i & 1;
        if (i + 1 < NT) { const int k1 = TILE_KT(i + 1) * 64; kreg = *(const bf16x8*)(kbase + (size_t)(k1 + lr) * 1536 + lc); vreg = *(const bf16x8*)(vtbase + (size_t)lr * 4096 + k1 + lc); }
        const bf16_t* KL = KLb + buf * 64 * 72; const bf16_t* VL = VLb + buf * 64 * 72;
        const int kb = k0 >> 8;
        const bool live = !MOBA || kb == own || ((umask >> kb) & 1u);
        if (live && k0 <= q0 + 31)
            attn_tile64<MOBA>(KL, VL, cum, k0, k0 + 63 > q0, (MOBA && kb < own) ? kb : -1, qf, sel, q0, fr, fq, m, lsum, o);
        if (i + 1 < NT) { *(bf16x8*)((bf16_t*)KLb + (buf ^ 1) * 64 * 72 + lr * 72 + lc) = kreg; *(bf16x8*)((bf16_t*)VLb + (buf ^ 1) * 64 * 72 + lr * 72 + lc) = vreg; }
        __syncthreads();
    }
    #undef TILE_KT
#pragma unroll
    for (int jq = 0; jq < 2; ++jq) {
        float ls = lsum[jq]; ls += __shfl_xor(ls, 16); ls += __shfl_xor(ls, 32); const float inv = 1.f / ls;
        bf16_t* op = qkv + (size_t)(q0 + 16 * jq + fr) * 1536 + 4 * fq;
#pragma unroll
        for (int dt = 0; dt < 4; ++dt) { const f32x4 v = o[dt][jq] * inv; u32x2 w; w.x = cvtpk(v[0], v[1]); w.y = cvtpk(v[2], v[3]); *(u32x2*)(op + dt * 16) = w; }
    }
}
__device__ __forceinline__ void ssd_states_item(const Params& p, int item, int lane) {
    const int h = item % 12, c = (item / 12) & 31, b = item / 384; const int grp = h / 6;
    const int fr = lane & 15, fq = lane >> 4;
    const float* ac = (const float*)(p.ws + O_ACUM) + (size_t)(b * 12 + h) * 4096 + c * 128;
    const float* dtp = (const float*)(p.ws + O_DT) + (size_t)(b * 12 + h) * 4096 + c * 128;
    const bf16_t* XT = (const bf16_t*)(p.ws + O_XT) + ((size_t)(b * 12 + h) * 64) * 4096 + c * 128;
    const bf16_t* BT = (const bf16_t*)(p.ws + O_BT) + ((size_t)(b * 2 + grp) * 128) * 4096 + c * 128;
    float* ST = (float*)(p.ws + O_ST) + ((size_t)((b * 32 + c) * 12 + h)) * 8192;
    const float total = ac[127];
#pragma unroll 1
    for (int q2 = 0; q2 < 4; ++q2) {
        f32x4 acc[4][2];
#pragma unroll
        for (int pt = 0; pt < 4; ++pt) { acc[pt][0] = (f32x4){0.f, 0.f, 0.f, 0.f}; acc[pt][1] = (f32x4){0.f, 0.f, 0.f, 0.f}; }
#pragma unroll 1
        for (int ks = 0; ks < 4; ++ks) {
            const int s0 = ks * 32 + 8 * fq;
            const f32x4 a0 = *(const f32x4*)(ac + s0), a1 = *(const f32x4*)(ac + s0 + 4);
            const f32x4 d0 = *(const f32x4*)(dtp + s0), d1 = *(const f32x4*)(dtp + s0 + 4);
            float w8[8];
#pragma unroll
            for (int j = 0; j < 4; ++j) { w8[j] = expf(total - a0[j]) * d0[j]; w8[4 + j] = expf(total - a1[j]) * d1[j]; }
            const bf16x8 b0 = *(const bf16x8*)(BT + (size_t)((q2 * 2 + 0) * 16 + fr) * 4096 + s0), b1 = *(const bf16x8*)(BT + (size_t)((q2 * 2 + 1) * 16 + fr) * 4096 + s0);
#pragma unroll
            for (int pt = 0; pt < 4; ++pt) { const bf16x8 xa = *(const bf16x8*)(XT + (size_t)(pt * 16 + fr) * 4096 + s0);
                const bf16x8 af = pack8(bf2f(xa[0]) * w8[0], bf2f(xa[1]) * w8[1], bf2f(xa[2]) * w8[2], bf2f(xa[3]) * w8[3], bf2f(xa[4]) * w8[4], bf2f(xa[5]) * w8[5], bf2f(xa[6]) * w8[6], bf2f(xa[7]) * w8[7]);
                acc[pt][0] = mfma16(af, b0, acc[pt][0]); acc[pt][1] = mfma16(af, b1, acc[pt][1]); }
        }
#pragma unroll
        for (int pt = 0; pt < 4; ++pt)
#pragma unroll
            for (int nt = 0; nt < 2; ++nt)
#pragma unroll
                for (int i = 0; i < 4; ++i) ST[(size_t)(pt * 16 + 4 * fq + i) * 128 + (q2 * 2 + nt) * 16 + fr] = acc[pt][nt][i];
    }
}
__device__ __forceinline__ void ssd_scan(const Params& p, int gtid, int gthreads) {
    const float* ST = (const float*)(p.ws + O_ST); bf16_t* PV = (bf16_t*)(p.ws + O_PREV); const float* ACUM = (const float*)(p.ws + O_ACUM);
    for (int e = gtid; e < NB * 12 * 8192; e += gthreads) {
        const int pn = e & 8191, h = (e >> 13) % 12, b = e / (12 * 8192);
        const float* ac = ACUM + (size_t)(b * 12 + h) * 4096 + 127;
        const size_t base = ((size_t)(b * 32) * 12 + h) * 8192 + pn;
        float st[32], dc[32];
#pragma unroll
        for (int c = 0; c < 32; ++c) { st[c] = ST[base + (size_t)c * 12 * 8192]; dc[c] = ac[c * 128]; }
        float hs = 0.f;
#pragma unroll
        for (int c = 0; c < 32; ++c) { PV[base + (size_t)c * 12 * 8192] = (bf16_t)(cvtpk(hs, 0.f) & 0xffffu); hs = hs * __expf(dc[c]) + st[c]; }
    }
}
__device__ __forceinline__ void ssd_out_item(const Params& p, int l, int item, int wid, int lane, bool dry = false) {
    const int grp = item & 1, c = (item >> 1) & 31, b = item >> 6;
    const int fr = lane & 15, fq = lane >> 4; const int w = wid; const int tl = 16 * w + fr;
    const size_t row0 = (size_t)b * SEQ + c * 128; const size_t row = row0 + tl;
    const bf16_t* BC = (const bf16_t*)(p.ws + O_BC);
    bf16_t* Z = (bf16_t*)(p.ws + O_Z);
    bf16x8 cf[4];
#pragma unroll
    for (int ks = 0; ks < 4; ++ks) cf[ks] = *(const bf16x8*)(BC + row * 512 + 256 + grp * 128 + ks * 32 + 8 * fq);
    f32x4 cbt[8];
#pragma unroll
    for (int js = 0; js < 8; ++js) { cbt[js] = (f32x4){0.f, 0.f, 0.f, 0.f};
        if (js <= w) {
#pragma unroll
            for (int ks = 0; ks < 4; ++ks) { const bf16x8 a = *(const bf16x8*)(BC + (row0 + js * 16 + fr) * 512 + grp * 128 + ks * 32 + 8 * fq); cbt[js] = mfma16(a, cf[ks], cbt[js]); } } }
    float ssq = 0.f;
#pragma unroll 1
    for (int r = 0; r < 6; ++r) {
        const int h = grp * 6 + r;
        const float* ac = (const float*)(p.ws + O_ACUM) + (size_t)(b * 12 + h) * 4096 + c * 128;
        const float* dtp = (const float*)(p.ws + O_DT) + (size_t)(b * 12 + h) * 4096 + c * 128;
        const float acl = ac[tl]; const float eacl = expf(acl); const float Dh = PIN(15)[l * 12 + h];
        const bf16_t* PV = (const bf16_t*)(p.ws + O_PREV) + ((size_t)((b * 32 + c) * 12 + h)) * 8192;
        const bf16_t* XT = (const bf16_t*)(p.ws + O_XT) + ((size_t)(b * 12 + h) * 64) * 4096 + c * 128;
        f32x4 yt[4];
#pragma unroll
        for (int pt = 0; pt < 4; ++pt) yt[pt] = (f32x4){0.f, 0.f, 0.f, 0.f};
#pragma unroll
        for (int ks = 0; ks < 4; ++ks)
#pragma unroll
            for (int pt = 0; pt < 4; ++pt) { const bf16x8 a = *(const bf16x8*)(PV + (size_t)(pt * 16 + fr) * 128 + ks * 32 + 8 * fq); yt[pt] = mfma16(a, cf[ks], yt[pt]); }
#pragma unroll
        for (int pt = 0; pt < 4; ++pt) yt[pt] = yt[pt] * eacl;
#pragma unroll
        for (int jp = 0; jp < 4; ++jp) {
            if (2 * jp <= w) {
                const int sA = 32 * jp + 4 * fq, sB = sA + 16;
                const f32x4 a0 = *(const f32x4*)(ac + sA), a1 = *(const f32x4*)(ac + sB), dv0 = *(const f32x4*)(dtp + sA), dv1 = *(const f32x4*)(dtp + sB);
                float mv[8];
#pragma unroll
                for (int j = 0; j < 4; ++j) {
                    const int s = sA + j; const float d0 = dv0[j];
                    float v = (s <= tl) ? cbt[2 * jp][j] * expf(acl - a0[j]) * d0 : 0.f; if (s == tl) v += Dh; mv[j] = v;
                    const int s2 = sB + j; const float d1 = dv1[j];
                    float v2 = (s2 <= tl) ? cbt[2 * jp + 1][j] * expf(acl - a1[j]) * d1 : 0.f; if (s2 == tl) v2 += Dh; mv[4 + j] = v2;
                }
                const bf16x8 mb = pack8(mv[0], mv[1], mv[2], mv[3], mv[4], mv[5], mv[6], mv[7]);
#pragma unroll
                for (int pt = 0; pt < 4; ++pt) { const bf16_t* xp = XT + (size_t)(pt * 16 + fr) * 4096 + sA; yt[pt] = mfma16(ld2x8(xp, xp + 16), mb, yt[pt]); }
            }
        }
#pragma unroll
        for (int pt = 0; pt < 4; ++pt) { bf16_t* zp = Z + row * 768 + h * 64 + pt * 16 + 4 * fq; const u32x2 zw = *(const u32x2*)zp;
            const float y0 = yt[pt][0] * bflo(zw.x), y1 = yt[pt][1] * bfhi(zw.x), y2 = yt[pt][2] * bflo(zw.y), y3 = yt[pt][3] * bfhi(zw.y);
            ssq += (y0 * y0 + y1 * y1) + (y2 * y2 + y3 * y3);
            u32x2 o; o.x = cvtpk(y0, y1); o.y = cvtpk(y2, y3); if (!dry) *(u32x2*)zp = o; }
    }
    ssq += __shfl_xor(ssq, 16); ssq += __shfl_xor(ssq, 32);
    if (dry) return;
    const float rstd = rsqrtf(ssq * (1.f / 384.f) + NORM_EPS);
    VM_WAIT();
    const float* nw = PIN(16) + l * 768 + grp * 384;
    bf16_t* zp0 = Z + row * 768 + grp * 384 + 4 * fq;
#pragma unroll 4
    for (int q = 0; q < 24; ++q) { bf16_t* zp = zp0 + q * 16; const u32x2 zw = *(const u32x2*)zp; const f32x4 nv = *(const f32x4*)(nw + q * 16 + 4 * fq);
        u32x2 o; o.x = cvtpk(bflo(zw.x) * rstd * nv[0], bfhi(zw.x) * rstd * nv[1]); o.y = cvtpk(bflo(zw.y) * rstd * nv[2], bfhi(zw.y) * rstd * nv[3]); *(u32x2*)zp = o; }
}

#define LAS __attribute__((address_space(3)))
#define XB_TMO      128
#define XB_XCNT(j)  (256  + 64 * (j))
#define XB_XSUB(j)  (1280 + 64 * (j))
#define XB_XGEN(j)  (2304 + 64 * (j))
#define XB_TOP      3328
#define XB_TOPGEN   3392
#define XCD_BAR_WORDS 3456
#define XB_SPIN_CAP (1u << 18)

__device__ __forceinline__ unsigned xb_ld(unsigned* p)              { return __hip_atomic_load(p, __ATOMIC_RELAXED, __HIP_MEMORY_SCOPE_AGENT); }
__device__ __forceinline__ unsigned xb_add(unsigned* p, unsigned v) { return __hip_atomic_fetch_add(p, v, __ATOMIC_RELAXED, __HIP_MEMORY_SCOPE_AGENT); }
__device__ __forceinline__ unsigned xb_xcc_id() { return (unsigned)__builtin_amdgcn_s_getreg((3 << 11) | 20) & 0xFu; }
#define XB_SPIN(cond, bar) do { unsigned _sp = 0; while (cond) { __builtin_amdgcn_s_sleep(1); \
    if ((++_sp & 255u) == 0u) { if (xb_ld(&(bar)[XB_TMO])) break; if (_sp > XB_SPIN_CAP) { atomicAdd(&(bar)[XB_TMO], 1u); break; } } } } while (0)

struct XcdBarrier {
    unsigned* bar; unsigned x;
    volatile LAS unsigned* st;
};

__device__ __forceinline__ XcdBarrier xcd_barrier_post(unsigned* bar, volatile LAS unsigned* st) {
    XcdBarrier b; b.bar = bar; b.x = xb_xcc_id(); b.st = st;
    if (threadIdx.x == 0) (void)xb_add(&bar[XB_XCNT(b.x)], 1u);
    return b;
}
__device__ __forceinline__ void xcd_barrier_complete(unsigned* bar, unsigned x, unsigned& nloc, unsigned& nx) {
    const unsigned G = gridDim.x * gridDim.y * gridDim.z;
    unsigned sum, cnt, mine, sp = 0u;
    for (;;) {
        sum = 0u; cnt = 0u; mine = 0u;
#pragma unroll
        for (unsigned j = 0; j < 16; ++j) { const unsigned c = xb_ld(&bar[XB_XCNT(j)]); sum += c; cnt += (c > 0u) ? 1u : 0u; mine = (j == x) ? c : mine; }
        if (sum == G) break;
        __builtin_amdgcn_s_sleep(1);
        if ((++sp & 255u) == 0u) { if (xb_ld(&bar[XB_TMO])) break; if (sp > XB_SPIN_CAP) { atomicAdd(&bar[XB_TMO], 1u); break; } }
    }
    nloc = mine > 0u ? mine : 1u; nx = cnt > 0u ? cnt : 1u;
}

__device__ __forceinline__ void xcd_barrier(const XcdBarrier& b) {
    asm volatile("s_waitcnt vmcnt(0)" ::: "memory");
    __syncthreads();
    if (threadIdx.x == 0) {
        unsigned* bar = b.bar;
        __builtin_amdgcn_s_waitcnt(0);
        unsigned nloc = b.st[0], nx = b.st[1];
        if (nloc == 0u) { xcd_barrier_complete(bar, b.x, nloc, nx); b.st[0] = nloc; b.st[1] = nx; }
        const unsigned old = xb_add(&bar[XB_XSUB(b.x)], 1u);
        const unsigned gen = old / nloc;
        if (old + 1u == (gen + 1u) * nloc) {
            __builtin_amdgcn_fence(__ATOMIC_RELEASE, "agent");
            asm volatile("s_waitcnt vmcnt(0)" ::: "memory");
            const unsigned og = xb_add(&bar[XB_TOP], 1u);
            const unsigned tg = og / nx;
            if (og + 1u == (tg + 1u) * nx) xb_add(&bar[XB_TOPGEN], 1u);
            else XB_SPIN(xb_ld(&bar[XB_TOPGEN]) == tg, bar);
            __builtin_amdgcn_fence(__ATOMIC_ACQUIRE, "agent");
            xb_add(&bar[XB_XGEN(b.x)], 1u);
            asm volatile("s_waitcnt vmcnt(0)" ::: "memory");
        } else {
            XB_SPIN(xb_ld(&bar[XB_XGEN(b.x)]) == gen, bar);
            __builtin_amdgcn_fence(__ATOMIC_ACQUIRE, "agent");
            asm volatile("s_waitcnt vmcnt(0)" ::: "memory");
        }
    }
    __syncthreads();
}

constexpr int PH_PER_LAYER = 11, N_PHASES = 1 + DEPTH * PH_PER_LAYER + 1;
template <int EN_MASK, bool EN_GEMM>
__device__ __forceinline__ void fwd_body(const Params& p) {
    extern __shared__ __attribute__((aligned(16))) unsigned char lds[];
    cg::grid_group grid = cg::this_grid();
    const int G = gridDim.x, NGW = G * 8;
    unsigned char* ws = p.ws;
    volatile LAS unsigned* MISC = (volatile LAS unsigned*)((LAS unsigned char*)lds + 132096);
    if (threadIdx.x < 2) MISC[threadIdx.x] = 0u;
    __syncthreads();
    XcdBarrier xbar = xcd_barrier_post((unsigned*)(ws + O_CTL), MISC);
    float* mod = (float*)(ws + O_MOD); float* X = (float*)(ws + O_X); bf16_t* H = (bf16_t*)(ws + O_H);
    for (int ph = p.ph_lo; ph < p.ph_hi; ++ph) {
        int tid = threadIdx.x; asm volatile("" : "+v"(tid));
        const int lane = tid & 63, wid = __builtin_amdgcn_readfirstlane(tid >> 6); const int gw = blockIdx.x * 8 + wid;
        if (ph == 0) { if constexpr (EN_MASK != 0) phase_pre(p, lds, tid); }
        else if (ph == N_PHASES - 1) { if constexpr (EN_MASK != 0) final_norm_rows(X, PIN(25), p.out, gw, NGW, lane); }
        else {
            const int l = (ph - 1) / PH_PER_LAYER, k = (ph - 1) % PH_PER_LAYER;
            const float* modl = mod + (size_t)l * 4 * 6144;
            const float* xin = (l == 0) ? PIN(0) : X;
            if (k == 1 || k == 6 || k == 7 || k == 9 || k == 10) { if constexpr (EN_GEMM) {
                const int nsub = (k == 6) ? 4 : 1;
#pragma unroll 1
                for (int br = 0; br < nsub; ++br) {
                    EpiU E{}; const bf16_t* A; const bf16_t* Bt; int lda, N, K;
                    if (k == 1) { E.kind = 0; E.p1 = ws; A = H; lda = 1024; Bt = (const bf16_t*)(ws + O_WIN); N = NPROJ; K = 1024; }
                    else if (k == 6) {
                        const size_t aoffs = (br == 0) ? O_UV : (br == 1) ? O_FQKV : (br == 2) ? O_MQKV : O_Z;
                        const size_t woffs = (br == 0) ? O_WA : (br == 1) ? O_WB : (br == 2) ? O_WC : O_WD;
                        E.kind = 1; E.p0 = (const bf16_t*)(ws + O_GATE) + br * 1024; E.p1 = (float*)(ws + O_MF32); E.p2 = H; E.mode = (br == 0) ? 0 : (br == 3) ? 2 : 1;
                        A = (const bf16_t*)(ws + aoffs); lda = (br == 0) ? 1024 : (br == 3) ? 768 : 1536; Bt = (const bf16_t*)(ws + woffs); N = 1024; K = (br == 3) ? 768 : 512; }
                    else if (k == 7) { E.kind = 2; E.p0 = xin; E.p1 = X; E.p2 = (void*)(modl + 2048); A = H; lda = 1024; Bt = (const bf16_t*)(ws + O_WO); N = 1024; K = 1024; }
                    else if (k == 9) { E.kind = 3; E.p1 = (bf16_t*)(ws + O_HID); A = H; lda = 1024; Bt = (const bf16_t*)(ws + O_W1); N = 4096; K = 1024; }
                    else { E.kind = 2; E.p0 = X; E.p1 = X; E.p2 = (void*)(modl + 5120); A = (const bf16_t*)(ws + O_HID); lda = 4096; Bt = (const bf16_t*)(ws + O_W2); N = 1024; K = 4096; }
#ifdef PROBE_DUP_GEMM
                    E.dry = (p.ph_lo == 0); run_gemm(lds, A, lda, Bt, N, K, E); E.dry = 0;
#endif
                    run_gemm(lds, A, lda, Bt, N, K, E);
                }
            } } else switch (k) {
            case 0: if constexpr ((EN_MASK >> 0) & 1) {
#ifdef PROBE_A
                convert_weights(p, l, lds, gw, NGW, wid, lane); norm_mod_rows(xin, PIN(4) + l * 1024, modl + 0, modl + 1024, H, gw, NGW, lane);
#endif
                convert_weights(p, l, lds, gw, NGW, wid, lane);
                norm_mod_rows(xin, PIN(4) + l * 1024, modl + 0, modl + 1024, H, gw, NGW, lane);
            } break;
            case 2: if constexpr ((EN_MASK >> 2) & 1) {
#ifdef PROBE_C
                { const bool dry = (p.ph_lo == 0);
                for (int it = blockIdx.x; it < 1024; it += G) gmlp_item(p, l, lds, it, wid, lane, dry);
                for (int it = blockIdx.x; it < 512; it += G) rotary_item(p, lds, it, tid, dry);
                for (int it = blockIdx.x; it < 2048; it += G) vt_item(p, lds, it, tid);
                for (int it = blockIdx.x; it < 2560; it += G) conv_item(p, l, it, tid);
                for (int it = gw; it < 1536; it += NGW) acum_item(p, l, it, lane);
                for (int it = NGW - 1 - gw; it < 32; it += NGW) foxcum_item(p, l, it, lane); }
#endif
                for (int it = blockIdx.x; it < 1024; it += G) gmlp_item(p, l, lds, it, wid, lane);
                for (int it = blockIdx.x; it < 512; it += G) rotary_item(p, lds, it, tid);
                for (int it = blockIdx.x; it < 2048; it += G) vt_item(p, lds, it, tid);
                for (int it = blockIdx.x; it < 2560; it += G) conv_item(p, l, it, tid);
                for (int it = gw; it < 1536; it += NGW) acum_item(p, l, it, lane);
                for (int it = NGW - 1 - gw; it < 32; it += NGW) foxcum_item(p, l, it, lane);
            } break;
            case 3: if constexpr ((EN_MASK >> 3) & 1) {
#ifndef EN3
#define EN3 7
#endif
                for (int i = blockIdx.x; i < 512; i += G) { const int bh = i & 31, r = i >> 5; const int qb = (r < 8) ? 15 - r : r - 8;
                    if constexpr (EN3 & 1) attn_block_item<false>(p, lds, bh >> 3, bh & 7, qb, tid, wid, lane);
                    if constexpr (EN3 & 2) attn_block_item<true>(p, lds, bh >> 3, bh & 7, qb, tid, wid, lane); }
#ifdef PROBE_EF
                for (int i = NGW - 1 - gw; i < 1536; i += NGW) ssd_states_item(p, i, lane);
#endif
                if constexpr (EN3 & 4) for (int i = NGW - 1 - gw; i < 1536; i += NGW) ssd_states_item(p, i, lane);
            } break;
            case 4: if constexpr ((EN_MASK >> 4) & 1) {
#ifdef PROBE_EF
                ssd_scan(p, blockIdx.x * 512 + tid, G * 512);
#endif
                ssd_scan(p, blockIdx.x * 512 + tid, G * 512); } break;
            case 5: if constexpr ((EN_MASK >> 5) & 1) {
#ifdef PROBE_EF
                for (int it = blockIdx.x; it < 256; it += G) ssd_out_item(p, l, it, wid, lane, p.ph_lo == 0);
#endif
                for (int it = blockIdx.x; it < 256; it += G) ssd_out_item(p, l, it, wid, lane); } break;
            case 8: if constexpr ((EN_MASK >> 8) & 1) { norm_mod_rows(X, PIN(22) + l * 1024, modl + 3072, modl + 4096, H, gw, NGW, lane); } break;
            }
        }
        if (ph + 1 < p.ph_hi) { if (ph == 0) grid.sync(); else xcd_barrier(xbar); }
#ifdef PROBE_SYNC
        if (ph + 1 < p.ph_hi) { xcd_barrier(xbar); xcd_barrier(xbar); }
#endif
    }
}

#ifndef N_LAUNCH_MODE
#define N_LAUNCH_MODE 1
#endif
#if N_LAUNCH_MODE == 1
__global__ void __launch_bounds__(512, 2) fwd_all(Params p) { fwd_body<0x7ff, true>(p); }
#define KERNEL_FOR_ATTR fwd_all
#else
__global__ void __launch_bounds__(512, 2) fwd_gemm(Params p) { fwd_body<0, true>(p); }
__global__ void __launch_bounds__(512, 2) fwd_misc(Params p) { fwd_body<0x7ff, false>(p); }
#endif
extern "C" void kernel_launch(void* const* d_in, const int* in_sizes, int n_in, void* d_out, int out_size, void* d_ws, size_t ws_size, hipStream_t stream) {
    static int grid = 0;
    if (grid == 0) {
        if (n_in != 26 || out_size != T * DM || ws_size < WS_END) { fprintf(stderr, "kernel_launch: unexpected shapes (n_in %d out %d ws %zu need %zu)\n", n_in, out_size, ws_size, (size_t)WS_END); grid = -1; return; }
        int dev = 0, cus = 0;
        (void)hipGetDevice(&dev); (void)hipDeviceGetAttribute(&cus, hipDeviceAttributeMultiprocessorCount, dev);
#if N_LAUNCH_MODE == 1
        if (hipFuncSetAttribute((const void*)fwd_all, hipFuncAttributeMaxDynamicSharedMemorySize, LDS_BYTES) != hipSuccess) { fprintf(stderr, "kernel_launch: hipFuncSetAttribute failed\n"); grid = -1; return; }
#else
        if (hipFuncSetAttribute((const void*)fwd_gemm, hipFuncAttributeMaxDynamicSharedMemorySize, LDS_BYTES) != hipSuccess || hipFuncSetAttribute((const void*)fwd_misc, hipFuncAttributeMaxDynamicSharedMemorySize, LDS_BYTES) != hipSuccess) { fprintf(stderr, "kernel_launch: hipFuncSetAttribute failed\n"); grid = -1; return; }
#endif
        (void)hipGetLastError();
        grid = cus > 0 ? cus : 256;
    }
    if (grid < 0) return;
    if (hipMemsetAsync((char*)d_ws + O_CTL, 0, 16384, stream) != hipSuccess) { fprintf(stderr, "kernel_launch: memset failed\n"); return; }
    Params p{};
    for (int i = 0; i < 26; ++i) p.in[i] = (const float*)d_in[i];
    p.out = (float*)d_out; p.ws = (unsigned char*)d_ws;
#if N_LAUNCH_MODE == 1
    p.ph_lo = 0; p.ph_hi = N_PHASES;
    void* args[] = {&p};
    hipError_t e = hipLaunchCooperativeKernel((const void*)fwd_all, dim3(grid), dim3(512), args, LDS_BYTES, stream);
    if (e != hipSuccess) fprintf(stderr, "kernel_launch: cooperative launch failed: %s (grid %d)\n", hipGetErrorString(e), grid);
#else
    for (int ph = 0; ph < N_PHASES; ++ph) { p.ph_lo = ph; p.ph_hi = ph + 1;
        const int k = (ph >= 1 && ph < N_PHASES - 1) ? (ph - 1) % PH_PER_LAYER : -1;
        if (k == 1 || k == 6 || k == 7 || k == 9 || k == 10) hipLaunchKernelGGL(fwd_gemm, dim3(grid), dim3(512), LDS_BYTES, stream, p);
        else hipLaunchKernelGGL(fwd_misc, dim3(grid), dim3(512), LDS_BYTES, stream, p); }
#endif
}
```

```cpp
#include <hip/hip_runtime.h>
#include <hip/hip_cooperative_groups.h>
#include <cstdio>
#include <cstdint>
#include <cmath>
namespace cg = cooperative_groups;
namespace pg8 {
#define PG8_LAS __attribute__((address_space(3)))
typedef unsigned short bf16_t;
typedef short bf16x8 __attribute__((ext_vector_type(8)));
typedef float f32x4 __attribute__((ext_vector_type(4)));
typedef unsigned u32x4 __attribute__((ext_vector_type(4)));
constexpr int BM = 256, BK = 64, HALF = 128, HTB = HALF * BK * 2  , STAGE_BYTES = 8 * HTB, NXCD = 8, WGM = 8;

__host__ __device__ __forceinline__ int lds_byte(int r, int c) { const int st = (r >> 4) * 2 + (c >> 5), rr = r & 15, cc = c & 31, ob = rr * 64 + cc * 2; return st * 1024 + (ob ^ (((ob >> 9) & 1) << 5)); }
__host__ __device__ __forceinline__ void stage_rc(int b, int& R, int& C) { const int st = b / 1024, sb = b % 1024, swz = sb ^ (((sb >> 9) & 1) << 5); R = (st >> 1) * 16 + swz / 64; C = (st & 1) * 32 + (swz % 64) / 2; }
__host__ __device__ __forceinline__ int perm32(int rho) { const int n = rho >> 4, i = rho & 15; return 8 * (i >> 2) + 4 * n + (i & 3); }

struct Unit { int pm, pn; };
struct Gemm { const bf16_t* A; const bf16_t* Bt; int M, N, K, lda; };

struct StaticOrder {
    int nM, nN, nwg, G, c;
    __host__ __device__ void init(int M, int N, int G_, int c_) { nM = M / BM; nN = N / BM; nwg = nM * nN; G = G_; c = c_; }
    __host__ __device__ bool next(int i, Unit& u) const {
        const long L = (long)i * G + c; if (L >= nwg) return false;
        int wgid = (int)L; { const int q = nwg / NXCD, r = nwg % NXCD, xcd = wgid % NXCD, off = wgid / NXCD; wgid = (xcd < r ? xcd * (q + 1) : r * (q + 1) + (xcd - r) * q) + off; }
        const int nig = WGM * nN, gid = wgid / nig, fm = gid * WGM, gsz = (nM - fm) < WGM ? (nM - fm) : WGM;
        u.pm = fm + ((wgid % nig) % gsz); u.pn = (wgid % nig) / gsz; return true;
    }
    __device__ __forceinline__ void a_ready(const Unit&) const {}
    __device__ __forceinline__ void done(const Unit&) const {}
};


template <class Epi, class Sched, bool ALIGN_EPI = false, bool SP2 = false>
__device__ __forceinline__ void gemm_phase(PG8_LAS unsigned char* lds, const Gemm g, const Sched& S, const Epi& E) {
    const int tid = threadIdx.x, wid = __builtin_amdgcn_readfirstlane(tid >> 6), lane = tid & 63, wr = wid >> 2, wc = wid & 3, fr = lane & 15, fq = lane >> 4;
    const int K = g.K, nt = K / BK;
    unsigned voffA[2], voffB[2];
#pragma unroll
    for (int i = 0; i < 2; ++i) { int R, C; stage_rc(tid * 16 + i * 8192, R, C); const int Rb = Epi::PERM ? ((R & ~31) + perm32(R & 31)) : R;
        voffA[i] = (unsigned)(R * g.lda + C) * 2u; voffB[i] = (unsigned)(Rb * K + C) * 2u; }
    const size_t kstep = (size_t)(BK * 2);
    const size_t hstepB = (size_t)HALF * K * 2, hstepA = (size_t)HALF * g.lda * 2;
    const size_t tstepB = 2 * hstepB, tstepA = 2 * hstepA;
    const unsigned ldsw = (unsigned)wid * 1024u;
    const int aoff = lds_byte(wr * 64 + fr, fq * 8), boff = lds_byte(wc * 32 + fr, fq * 8);
#define PG8_SA(b, h) (((b) * 2 + (h)) * HTB)
#define PG8_SB(b, h) ((4 + (b) * 2 + (h)) * HTB)
#define PG8_STAGE(bufoff, gbase, voff) do { _Pragma("unroll") for (int _i = 0; _i < 2; ++_i) \
        __builtin_amdgcn_global_load_lds((const unsigned*)((const char*)(gbase) + (voff)[_i]), (PG8_LAS unsigned*)(lds + (bufoff) + ldsw + _i * 8192), 16, 0, 0); } while (0)
#define PG8_LDA(dst, b, h) do { _Pragma("unroll") for (int m = 0; m < 4; ++m) _Pragma("unroll") for (int k = 0; k < 2; ++k) dst[m][k] = *(const PG8_LAS bf16x8*)(lds + PG8_SA(b, h) + aoff + m * 2048 + k * 1024); } while (0)
#define PG8_LDB(dst, b, h) do { _Pragma("unroll") for (int n = 0; n < 2; ++n) _Pragma("unroll") for (int k = 0; k < 2; ++k) dst[n][k] = *(const PG8_LAS bf16x8*)(lds + PG8_SB(b, h) + boff + n * 2048 + k * 1024); } while (0)
#define PG8_MMA(ai, bj, At, Bt) do { __builtin_amdgcn_s_setprio(1); _Pragma("unroll") for (int m = 0; m < 4; ++m) _Pragma("unroll") for (int n = 0; n < 2; ++n) _Pragma("unroll") for (int k = 0; k < 2; ++k) \
        acc[ai][bj][m][n] = __builtin_amdgcn_mfma_f32_16x16x32_bf16(Bt[n][k], At[m][k], acc[ai][bj][m][n], 0, 0, 0); __builtin_amdgcn_s_setprio(0); } while (0)
#define PG8_WAIT_V(n) asm volatile("s_waitcnt vmcnt(" #n ")" ::: "memory")
#define PG8_WAIT_L(n) asm volatile("s_waitcnt lgkmcnt(" #n ")" ::: "memory")
#define PG8_BAR __builtin_amdgcn_s_barrier()
#define PG8_SCHED __builtin_amdgcn_sched_barrier(0)
    Unit cur, nxt; int ui = 0;
    if (!S.next(0, cur)) return;
    f32x4 acc[2][2][4][2];
#pragma unroll
    for (int a = 0; a < 2; ++a)
#pragma unroll
        for (int b = 0; b < 2; ++b)
#pragma unroll
            for (int m = 0; m < 4; ++m)
#pragma unroll
                for (int n = 0; n < 2; ++n) acc[a][b][m][n] = (f32x4){0.f, 0.f, 0.f, 0.f};
    bf16x8 At[4][2], B0[2][2], B1[2][2];
    const char* cA = (const char*)g.A + (size_t)cur.pm * tstepA; const char* cB = (const char*)g.Bt + (size_t)cur.pn * tstepB;
    S.a_ready(cur);
    if constexpr (SP2) {
        PG8_STAGE(PG8_SB(0, 0), cB, voffB); PG8_STAGE(PG8_SB(0, 1), cB + hstepB, voffB); PG8_STAGE(PG8_SA(0, 0), cA, voffA); PG8_STAGE(PG8_SA(0, 1), cA + hstepA, voffA);
        if (wr == 1) PG8_BAR;
        PG8_WAIT_V(2); PG8_BAR;
        PG8_STAGE(PG8_SB(1, 0), cB + kstep, voffB); PG8_STAGE(PG8_SA(1, 0), cA + kstep, voffA); PG8_STAGE(PG8_SB(1, 1), cB + hstepB + kstep, voffB);
        PG8_WAIT_V(6); PG8_BAR;
    } else {
        PG8_STAGE(PG8_SB(0, 0), cB, voffB); PG8_STAGE(PG8_SA(0, 0), cA, voffA); PG8_STAGE(PG8_SB(0, 1), cB + hstepB, voffB); PG8_STAGE(PG8_SA(0, 1), cA + hstepA, voffA);
        if (wr == 1) PG8_BAR;
        PG8_WAIT_V(4); PG8_BAR;
        PG8_STAGE(PG8_SB(1, 0), cB + kstep, voffB); PG8_STAGE(PG8_SA(1, 0), cA + kstep, voffA); PG8_STAGE(PG8_SB(1, 1), cB + hstepB + kstep, voffB);
        PG8_WAIT_V(6); PG8_BAR;
    }
    for (;;) {
        const bool has_next = S.next(ui + 1, nxt);
        const char* nA = has_next ? (const char*)g.A + (size_t)nxt.pm * tstepA : cA; const char* nB = has_next ? (const char*)g.Bt + (size_t)nxt.pn * tstepB : cB;
        for (int t = 0; t < nt; t += 2) {
            const bool last = (t == nt - 2);
            const char* a1 = cA + (size_t)(t + 1) * kstep;
            const char* a2 = last ? nA : cA + (size_t)(t + 2) * kstep; const char* b2 = last ? nB : cB + (size_t)(t + 2) * kstep;
            const char* a3 = a2 + kstep; const char* b3 = b2 + kstep;
            if (last && has_next) S.a_ready(nxt);
            if constexpr (SP2) {
            PG8_LDB(B0, 0, 0); PG8_LDB(B1, 0, 1); PG8_SCHED; PG8_LDA(At, 0, 0); PG8_STAGE(PG8_SA(1, 1), a1 + hstepA, voffA);
            PG8_WAIT_V(8); PG8_WAIT_L(0); PG8_BAR; PG8_MMA(0, 0, At, B0); PG8_MMA(0, 1, At, B1); PG8_BAR; PG8_SCHED;
            PG8_LDA(At, 0, 1); PG8_STAGE(PG8_SB(0, 0), b2, voffB); PG8_STAGE(PG8_SB(0, 1), b2 + hstepB, voffB); PG8_STAGE(PG8_SA(0, 0), a2, voffA);
            PG8_WAIT_V(8); PG8_WAIT_L(0); PG8_BAR; PG8_MMA(1, 0, At, B0); PG8_MMA(1, 1, At, B1); PG8_BAR; PG8_SCHED;
            PG8_LDB(B0, 1, 0); PG8_LDB(B1, 1, 1); PG8_SCHED; PG8_LDA(At, 1, 0); PG8_STAGE(PG8_SA(0, 1), a2 + hstepA, voffA);
            PG8_WAIT_V(8); PG8_WAIT_L(0); PG8_BAR; PG8_MMA(0, 0, At, B0); PG8_MMA(0, 1, At, B1); PG8_BAR; PG8_SCHED;
            PG8_LDA(At, 1, 1); PG8_STAGE(PG8_SB(1, 0), b3, voffB); PG8_STAGE(PG8_SB(1, 1), b3 + hstepB, voffB); PG8_STAGE(PG8_SA(1, 0), a3, voffA);
            PG8_WAIT_V(8); PG8_WAIT_L(0); PG8_BAR; PG8_MMA(1, 0, At, B0); PG8_MMA(1, 1, At, B1); PG8_BAR; PG8_SCHED;
            } else {
            PG8_LDB(B0, 0, 0); PG8_SCHED; PG8_LDA(At, 0, 0); PG8_STAGE(PG8_SA(1, 1), a1 + hstepA, voffA);
            PG8_WAIT_L(8); PG8_BAR; PG8_WAIT_L(0); PG8_MMA(0, 0, At, B0); PG8_BAR; PG8_SCHED;
            PG8_LDB(B1, 0, 1); PG8_STAGE(PG8_SB(0, 0), b2, voffB);
            PG8_BAR; PG8_WAIT_L(0); PG8_MMA(0, 1, At, B1); PG8_BAR;
            PG8_LDA(At, 0, 1); PG8_STAGE(PG8_SA(0, 0), a2, voffA);
            PG8_BAR; PG8_WAIT_L(0); PG8_MMA(1, 0, At, B0); PG8_BAR; PG8_SCHED;
            PG8_STAGE(PG8_SB(0, 1), b2 + hstepB, voffB);
            PG8_WAIT_V(6); PG8_BAR; PG8_MMA(1, 1, At, B1); PG8_BAR;
            PG8_LDB(B0, 1, 0); PG8_SCHED; PG8_LDA(At, 1, 0); PG8_STAGE(PG8_SA(0, 1), a2 + hstepA, voffA);
            PG8_WAIT_L(8); PG8_BAR; PG8_WAIT_L(0); PG8_MMA(0, 0, At, B0); PG8_BAR; PG8_SCHED;
            PG8_LDB(B1, 1, 1); PG8_STAGE(PG8_SB(1, 0), b3, voffB);
            PG8_BAR; PG8_WAIT_L(0); PG8_MMA(0, 1, At, B1); PG8_BAR;
            PG8_LDA(At, 1, 1); PG8_STAGE(PG8_SA(1, 0), a3, voffA);
            PG8_BAR; PG8_WAIT_L(0); PG8_MMA(1, 0, At, B0); PG8_BAR; PG8_SCHED;
            PG8_STAGE(PG8_SB(1, 1), b3 + hstepB, voffB);
            PG8_WAIT_V(6); PG8_BAR; PG8_MMA(1, 1, At, B1); PG8_BAR;
            }
        }
        if constexpr (ALIGN_EPI) { if (wr == 0) PG8_BAR; }
        if constexpr (!Epi::AFTER_DRAIN) { E(acc, cur, wr, wc, fr, fq); S.done(cur); }
        if (!has_next) break;
#pragma unroll
        for (int a = 0; a < 2; ++a)
#pragma unroll
            for (int b = 0; b < 2; ++b)
#pragma unroll
                for (int m = 0; m < 4; ++m)
#pragma unroll
                    for (int n = 0; n < 2; ++n) acc[a][b][m][n] = (f32x4){0.f, 0.f, 0.f, 0.f};
        cur = nxt; cA = nA; cB = nB; ++ui;
        if constexpr (ALIGN_EPI) { if (wr == 1) PG8_BAR; }
    }
    PG8_WAIT_V(0);
    if constexpr (!ALIGN_EPI) { if (wr == 0) PG8_BAR; }
    PG8_BAR;
    if constexpr (Epi::AFTER_DRAIN) { E.fused(acc, cur, wr, wc, fr, fq, lds, wid, lane); S.done(cur); }
#undef PG8_SA
#undef PG8_SB
#undef PG8_STAGE
#undef PG8_LDA
#undef PG8_LDB
#undef PG8_MMA
#undef PG8_WAIT_V
#undef PG8_WAIT_L
#undef PG8_BAR
#undef PG8_SCHED
}
}

constexpr int NB = 4, SEQ = 4096, T = NB * SEQ, DM = 1024, DEPTH = 4;
constexpr int NPROJ = 10496;
constexpr int IN_COLS = 10260;
constexpr float NORM_EPS = 1e-6f;
constexpr float LOG2E = 1.4426950408889634f;

typedef unsigned short bf16_t;
typedef short bf16x8 __attribute__((ext_vector_type(8)));
typedef float f32x4 __attribute__((ext_vector_type(4)));
typedef float f32x2 __attribute__((ext_vector_type(2)));
typedef unsigned u32x4 __attribute__((ext_vector_type(4)));
typedef unsigned u32x2 __attribute__((ext_vector_type(2)));
typedef __bf16 bf16x2_t __attribute__((ext_vector_type(2)));

constexpr size_t MiB = 1u << 20;
constexpr size_t O_MOD = 0, O_X = 1 * MiB, O_H = 65 * MiB, O_UV = 97 * MiB, O_FQKV = 129 * MiB, O_MQKV = 177 * MiB, O_Z = 225 * MiB,
                 O_XBC = 249 * MiB, O_GATE = 289 * MiB, O_SMALL = 417 * MiB, O_VTF = 419 * MiB, O_VTM = 435 * MiB, O_XT = 451 * MiB,
                 O_BC = 475 * MiB, O_BT = 491 * MiB, O_ST = 499 * MiB, O_CUMF = 547 * MiB, O_ACUM = 548 * MiB, O_KMEAN = 549 * MiB,
                 O_WIN = 550 * MiB, O_WA = 571 * MiB, O_WB = 572 * MiB, O_WC = 573 * MiB, O_WD = 574 * MiB, O_WO = 576 * MiB,
                 O_W1 = 578 * MiB, O_W2 = 586 * MiB, O_GWS = 594 * MiB, WS_END = 595 * MiB;
constexpr size_t O_DT = O_KMEAN + 256 * 1024;
constexpr size_t O_CTL = 512 * 1024;
constexpr size_t O_PREV = O_XBC;
constexpr size_t O_HID = O_GATE;
constexpr size_t O_MF32 = O_VTF;
constexpr int LDS_BYTES = 147456;

struct Params { const float* in[26]; float* out; unsigned char* ws; int ph_lo, ph_hi; };

__device__ __forceinline__ int opq(int i) { asm volatile("" : "+s"(i)); return i; }
#define PIN(i) (p.in[opq(i)])
__device__ __forceinline__ unsigned cvtpk(float lo, float hi) { f32x2 v = {lo, hi}; bf16x2_t b = __builtin_convertvector(v, bf16x2_t); return __builtin_bit_cast(unsigned, b); }
__device__ __forceinline__ float bf2f(short h) { return __uint_as_float(((unsigned)(unsigned short)h) << 16); }
__device__ __forceinline__ float bflo(unsigned w) { return __uint_as_float(w << 16); }
__device__ __forceinline__ float bfhi(unsigned w) { return __uint_as_float(w & 0xffff0000u); }
__device__ __forceinline__ bf16x8 pack8(float a0, float a1, float a2, float a3, float a4, float a5, float a6, float a7) {
    u32x4 w = {cvtpk(a0, a1), cvtpk(a2, a3), cvtpk(a4, a5), cvtpk(a6, a7)}; return __builtin_bit_cast(bf16x8, w); }
__device__ __forceinline__ bf16x8 ld2x8(const bf16_t* p0, const bf16_t* p1) { const u32x2 a = *(const u32x2*)p0, b = *(const u32x2*)p1; u32x4 w = {a.x, a.y, b.x, b.y}; return __builtin_bit_cast(bf16x8, w); }
__device__ __forceinline__ f32x4 mfma16(bf16x8 a, bf16x8 b, f32x4 c) { return __builtin_amdgcn_mfma_f32_16x16x32_bf16(a, b, c, 0, 0, 0); }
__device__ __forceinline__ float wave_sum(float v) {
#pragma unroll
    for (int o = 1; o < 64; o <<= 1) v += __shfl_xor(v, o);
    return v; }
__device__ __forceinline__ float ex2(float x) { return __builtin_amdgcn_exp2f(x); }
__device__ __forceinline__ float sigmoidf_(float x) { return 1.f / (1.f + __expf(-x)); }
__device__ __forceinline__ float softplusf_(float x) { return fmaxf(x, 0.f) + log1pf(expf(-fabsf(x))); }
#define LDS_WAIT() asm volatile("s_waitcnt lgkmcnt(0)" ::: "memory")
#define VM_WAIT() asm volatile("s_waitcnt vmcnt(0)" ::: "memory")

#define EPI_LANE_SETUP() int t_ = threadIdx.x; asm volatile("" : "+v"(t_)); const int fr = t_ & 15, fq = (t_ >> 4) & 3; const int wv_ = __builtin_amdgcn_readfirstlane(t_ >> 6); const int wr = wv_ >> 2, wc = wv_ & 3
__device__ __forceinline__ float act_unified(float x, int act) {
    const float uu = 1.5957691216057308f * (x + 0.044715f * x * x * x);
    const float arg = (act == 1) ? uu : (act == 0) ? INFINITY : x;
    const float num = (act == 3) ? 1.f : x;
    return num * __builtin_amdgcn_rcpf(1.f + ex2(-LOG2E * arg));
}
struct EpiInproj {
    static constexpr bool PERM = true, AFTER_DRAIN = false;
    unsigned char* ws;
    __device__ __forceinline__ void operator()(const f32x4 (&acc)[2][2][4][2], const pg8::Unit& u, int, int, int, int) const {
        EPI_LANE_SETUP();
        const int pn = u.pn; const int row0 = u.pm * 256 + wr * 64 + fr;
        if (pn == 40) {
            if (wc == 0) {
                float* sm = (float*)(ws + O_SMALL);
#pragma unroll
                for (int ai = 0; ai < 2; ++ai)
#pragma unroll
                    for (int m = 0; m < 4; ++m) { float* rp = sm + (size_t)(row0 + ai * 128 + m * 16) * 32 + 8 * fq;
                        *(f32x4*)rp = acc[ai][0][m][0]; *(f32x4*)(rp + 4) = acc[ai][0][m][1]; }
            }
            return;
        }
        bf16_t* base; int pitch, ct, act;
        if (pn < 4) { base = (bf16_t*)(ws + O_UV); pitch = 1024; ct = pn; act = 1; }
        else if (pn < 10) { base = (bf16_t*)(ws + O_FQKV); pitch = 1536; ct = pn - 4; act = 0; }
        else if (pn < 16) { base = (bf16_t*)(ws + O_MQKV); pitch = 1536; ct = pn - 10; act = 0; }
        else if (pn < 19) { base = (bf16_t*)(ws + O_Z); pitch = 768; ct = pn - 16; act = 2; }
        else if (pn < 24) { base = (bf16_t*)(ws + O_XBC); pitch = 1280; ct = pn - 19; act = 0; }
        else { base = (bf16_t*)(ws + O_GATE); pitch = 4096; ct = pn - 24; act = 3; }
        const int col0 = ct * 256 + wc * 32 + 8 * fq;
#pragma unroll
        for (int ai = 0; ai < 2; ++ai)
#pragma unroll
            for (int m = 0; m < 4; ++m) { bf16_t* rowp = base + (size_t)(row0 + ai * 128 + m * 16) * pitch + col0;
#pragma unroll
                for (int bj = 0; bj < 2; ++bj) { f32x4 v0 = acc[ai][bj][m][0], v1 = acc[ai][bj][m][1];
#pragma unroll
                    for (int j = 0; j < 4; ++j) { v0[j] = act_unified(v0[j], act); v1[j] = act_unified(v1[j], act); }
                    u32x4 w; w.x = cvtpk(v0[0], v0[1]); w.y = cvtpk(v0[2], v0[3]); w.z = cvtpk(v1[0], v1[1]); w.w = cvtpk(v1[2], v1[3]);
                    *(u32x4*)(rowp + bj * 128) = w; }
                asm volatile("" ::: "memory"); }
    }
};
struct EpiMerge {
    static constexpr bool PERM = true, AFTER_DRAIN = false;
    const bf16_t* gate; float* mf; bf16_t* outb; int mode;
    __device__ __forceinline__ void operator()(const f32x4 (&acc)[2][2][4][2], const pg8::Unit& u, int, int, int, int) const {
        EPI_LANE_SETUP();
        const int row0 = u.pm * 256 + wr * 64 + fr, col0 = u.pn * 256 + wc * 32 + 8 * fq;
#pragma unroll
        for (int ai = 0; ai < 2; ++ai)
#pragma unroll
            for (int m = 0; m < 4; ++m) { const size_t row = (size_t)(row0 + ai * 128 + m * 16);
#pragma unroll
                for (int bj = 0; bj < 2; ++bj) { const int col = col0 + bj * 128;
                    const u32x4 gw = *(const u32x4*)(gate + row * 4096 + col);
                    f32x4 v0 = acc[ai][bj][m][0], v1 = acc[ai][bj][m][1];
                    v0[0] *= bflo(gw.x); v0[1] *= bfhi(gw.x); v0[2] *= bflo(gw.y); v0[3] *= bfhi(gw.y); v1[0] *= bflo(gw.z); v1[1] *= bfhi(gw.z); v1[2] *= bflo(gw.w); v1[3] *= bfhi(gw.w);
                    float* mp = mf + row * 1024 + col;
                    if (mode == 0) { *(f32x4*)mp = v0; *(f32x4*)(mp + 4) = v1; }
                    else if (mode == 1) { *(f32x4*)mp = *(const f32x4*)mp + v0; *(f32x4*)(mp + 4) = *(const f32x4*)(mp + 4) + v1; }
                    else { v0 = *(const f32x4*)mp + v0; v1 = *(const f32x4*)(mp + 4) + v1; u32x4 w; w.x = cvtpk(v0[0], v0[1]); w.y = cvtpk(v0[2], v0[3]); w.z = cvtpk(v1[0], v1[1]); w.w = cvtpk(v1[2], v1[3]);
                        *(u32x4*)(outb + row * 1024 + col) = w; } }
                asm volatile("" ::: "memory"); }
    }
};
struct EpiResid {
    static constexpr bool PERM = true, AFTER_DRAIN = false;
    const float* xin; float* xout; const float* gmod;
    __device__ __forceinline__ void operator()(const f32x4 (&acc)[2][2][4][2], const pg8::Unit& u, int, int, int, int) const {
        EPI_LANE_SETUP();
        const int row0 = u.pm * 256 + wr * 64 + fr, col0 = u.pn * 256 + wc * 32 + 8 * fq; const int b = u.pm >> 4;
        const float* gp = gmod + (size_t)b * 6144 + col0;
#pragma unroll
        for (int ai = 0; ai < 2; ++ai)
#pragma unroll
            for (int m = 0; m < 4; ++m) { const size_t off = (size_t)(row0 + ai * 128 + m * 16) * 1024 + col0;
#pragma unroll
                for (int bj = 0; bj < 2; ++bj) { const int co = bj * 128; const f32x4 g0 = *(const f32x4*)(gp + co), g1 = *(const f32x4*)(gp + co + 4);
                    *(f32x4*)(xout + off + co) = *(const f32x4*)(xin + off + co) + g0 * acc[ai][bj][m][0];
                    *(f32x4*)(xout + off + co + 4) = *(const f32x4*)(xin + off + co + 4) + g1 * acc[ai][bj][m][1]; }
                asm volatile("" ::: "memory"); }
    }
};
struct EpiRelu2 {
    static constexpr bool PERM = true, AFTER_DRAIN = false;
    bf16_t* out;
    __device__ __forceinline__ void operator()(const f32x4 (&acc)[2][2][4][2], const pg8::Unit& u, int, int, int, int) const {
        EPI_LANE_SETUP();
        const int row0 = u.pm * 256 + wr * 64 + fr, col0 = u.pn * 256 + wc * 32 + 8 * fq;
#pragma unroll
        for (int ai = 0; ai < 2; ++ai)
#pragma unroll
            for (int m = 0; m < 4; ++m) { bf16_t* rowp = out + (size_t)(row0 + ai * 128 + m * 16) * 4096 + col0;
#pragma unroll
                for (int bj = 0; bj < 2; ++bj) { f32x4 v0 = acc[ai][bj][m][0], v1 = acc[ai][bj][m][1];
#pragma unroll
                    for (int j = 0; j < 4; ++j) { const float r0 = fmaxf(v0[j], 0.f), r1 = fmaxf(v1[j], 0.f); v0[j] = r0 * r0; v1[j] = r1 * r1; }
                    u32x4 w; w.x = cvtpk(v0[0], v0[1]); w.y = cvtpk(v0[2], v0[3]); w.z = cvtpk(v1[0], v1[1]); w.w = cvtpk(v1[2], v1[3]);
                    *(u32x4*)(rowp + bj * 128) = w; }
                asm volatile("" ::: "memory"); }
    }
};
struct EpiU {
    static constexpr bool PERM = true, AFTER_DRAIN = false;
    int kind, mode; const void* p0; void* p1; void* p2; int dry;
    __device__ __forceinline__ void operator()(const f32x4 (&acc)[2][2][4][2], const pg8::Unit& u, int a, int b, int c, int d) const {
        if (dry) return;
        if (kind == 0) { EpiInproj e{(unsigned char*)p1}; e(acc, u, a, b, c, d); }
        else if (kind == 1) { EpiMerge e{(const bf16_t*)p0, (float*)p1, (bf16_t*)p2, mode}; e(acc, u, a, b, c, d); }
        else if (kind == 2) { EpiResid e{(const float*)p0, (float*)p1, (const float*)p2}; e(acc, u, a, b, c, d); }
        else { EpiRelu2 e{(bf16_t*)p1}; e(acc, u, a, b, c, d); }
    }
};
template <class Epi>
__device__ __forceinline__ void run_gemm(unsigned char* lds, const bf16_t* A, int lda, const bf16_t* Bt, int N, int K, const Epi& E) {
    pg8::Gemm g{A, Bt, T, N, K, lda}; pg8::StaticOrder S; S.init(T, N, (int)gridDim.x, (int)blockIdx.x);
    pg8::gemm_phase<Epi, pg8::StaticOrder, true, true>((PG8_LAS unsigned char*)lds, g, S, E);
}

__device__ __forceinline__ void phase_pre(const Params& p, unsigned char* lds, const int tid) {
    float* cs = (float*)lds; float* red = cs + 4096;
    const float* c = PIN(1); const float* ada_w = PIN(2); const float* ada_b = PIN(3);
    float* mod = (float*)(p.ws + O_MOD);
    for (int i = tid; i < 4096; i += 512) { const float v = c[i]; cs[i] = v / (1.f + expf(-v)); }
    __syncthreads();
    const int jj = tid & 63, ks = tid >> 6;
    for (int it = blockIdx.x; it < DEPTH * 96; it += gridDim.x) {
        const int l = it / 96, jb = it % 96;
        const float* w = ada_w + (size_t)l * 1024 * 6144 + jb * 64 + jj;
        float a0 = 0.f, a1 = 0.f, a2 = 0.f, a3 = 0.f;
#pragma unroll 8
        for (int k = ks * 128; k < ks * 128 + 128; ++k) { const float wv = w[(size_t)k * 6144]; a0 += cs[k] * wv; a1 += cs[1024 + k] * wv; a2 += cs[2048 + k] * wv; a3 += cs[3072 + k] * wv; }
        red[(ks * 64 + jj) * 4 + 0] = a0; red[(ks * 64 + jj) * 4 + 1] = a1; red[(ks * 64 + jj) * 4 + 2] = a2; red[(ks * 64 + jj) * 4 + 3] = a3;
        __syncthreads();
        if (tid < 256) { const int b = tid >> 6, j2 = tid & 63; float s = 0.f;
#pragma unroll
            for (int q = 0; q < 8; ++q) s += red[(q * 64 + j2) * 4 + b];
            const int cc = jb * 64 + j2; mod[((size_t)l * 4 + b) * 6144 + cc] = s + ada_b[l * 6144 + cc]; }
        __syncthreads();
    }
}

__device__ __forceinline__ int inproj_src_col(int n) {
    if (n < 2560) return n;
    if (n < 6144) return n + 8;
    if (n < 10240) return n + 20;
    if (n < 10248) return 2560 + (n - 10240);
    if (n < 10260) return 6152 + (n - 10248);
    return -1;
}
__device__ __forceinline__ void transpose_item(const float* W, int K, int Nsrc, bf16_t* WT, float* scr, int k0, int n0, int lane, bool remap) {
    const int nd = n0 + (lane & 31); const int sc = remap ? inproj_src_col(nd) : nd;
#pragma unroll
    for (int i = 0; i < 32; ++i) { const int kk = 2 * i + (lane >> 5); scr[kk * 33 + (lane & 31)] = (sc >= 0) ? W[(size_t)(k0 + kk) * Nsrc + sc] : 0.f; }
    LDS_WAIT();
    const int c = lane & 7;
#pragma unroll
    for (int j = 0; j < 4; ++j) { const int n = (lane >> 3) + 8 * j; const float* s = scr + (8 * c) * 33 + n;
        u32x4 o; o.x = cvtpk(s[0 * 33], s[1 * 33]); o.y = cvtpk(s[2 * 33], s[3 * 33]); o.z = cvtpk(s[4 * 33], s[5 * 33]); o.w = cvtpk(s[6 * 33], s[7 * 33]);
        *(u32x4*)(WT + (size_t)(n0 + n) * K + k0 + 8 * c) = o; }
    LDS_WAIT();
}
__device__ __forceinline__ void convert_weights(const Params& p, int l, unsigned char* lds, int gw, int NGW, int wid, int lane) {
    float* scr = (float*)(lds + wid * 16384);
    unsigned char* ws = p.ws;
    constexpr int I_IN = 16 * (NPROJ / 32), I_BR = 8 * 32, I_D = 12 * 32, I_O = 16 * 32, I_1 = 16 * 128, I_2 = 64 * 32;
    constexpr int TOT = I_IN + 3 * I_BR + I_D + I_O + I_1 + I_2;
    for (int it = gw; it < TOT; it += NGW) {
        int r = it; const float* W; bf16_t* WT; int K, Nsrc, Nd; bool remap = false;
        if (r < I_IN) { W = PIN(5) + (size_t)l * 1024 * IN_COLS; WT = (bf16_t*)(ws + O_WIN); K = 1024; Nsrc = IN_COLS; Nd = NPROJ; remap = true; }
        else if ((r -= I_IN) < I_BR) { W = PIN(17) + (size_t)l * 512 * 1024; WT = (bf16_t*)(ws + O_WA); K = 512; Nsrc = 1024; Nd = 1024; }
        else if ((r -= I_BR) < I_BR) { W = PIN(18) + (size_t)l * 512 * 1024; WT = (bf16_t*)(ws + O_WB); K = 512; Nsrc = 1024; Nd = 1024; }
        else if ((r -= I_BR) < I_BR) { W = PIN(19) + (size_t)l * 512 * 1024; WT = (bf16_t*)(ws + O_WC); K = 512; Nsrc = 1024; Nd = 1024; }
        else if ((r -= I_BR) < I_D) { W = PIN(20) + (size_t)l * 768 * 1024; WT = (bf16_t*)(ws + O_WD); K = 768; Nsrc = 1024; Nd = 1024; }
        else if ((r -= I_D) < I_O) { W = PIN(21) + (size_t)l * 1024 * 1024; WT = (bf16_t*)(ws + O_WO); K = 1024; Nsrc = 1024; Nd = 1024; }
        else if ((r -= I_O) < I_1) { W = PIN(23) + (size_t)l * 1024 * 4096; WT = (bf16_t*)(ws + O_W1); K = 1024; Nsrc = 4096; Nd = 4096; }
        else { r -= I_1; W = PIN(24) + (size_t)l * 4096 * 1024; WT = (bf16_t*)(ws + O_W2); K = 4096; Nsrc = 1024; Nd = 1024; }
        const int nblk = Nd / 32, kb = r / nblk, nb = r % nblk;
        transpose_item(W, K, Nsrc, WT, scr, 64 * kb, 32 * nb, lane, remap);
    }
    const float* gws = PIN(8) + (size_t)l * 8 * 128 * 128; bf16_t* gd = (bf16_t*)(ws + O_GWS);
    for (int e = gw * 64 + lane; e < 8 * 128 * 128; e += NGW * 64) { const int s = e & 127, t = (e >> 7) & 127; const float v = (s <= t) ? gws[e] : 0.f; gd[e] = (bf16_t)(cvtpk(v, 0.f) & 0xffffu); }
}
__device__ __forceinline__ void norm_mod_rows(const float* x, const float* w, const float* sh, const float* sc, bf16_t* out, int gw, int NGW, int lane) {
    for (int row = gw; row < T; row += NGW) {
        const int b = row >> 12; const f32x4* xr = (const f32x4*)(x + (size_t)row * 1024) + lane;
        f32x4 v[4]; float ss = 0.f;
#pragma unroll
        for (int j = 0; j < 4; ++j) { v[j] = xr[64 * j]; ss += (v[j][0] * v[j][0] + v[j][1] * v[j][1]) + (v[j][2] * v[j][2] + v[j][3] * v[j][3]); }
        const float rstd = rsqrtf(wave_sum(ss) * (1.f / 1024.f) + NORM_EPS);
#pragma unroll
        for (int j = 0; j < 4; ++j) { const int col = 4 * (64 * j + lane);
            const f32x4 wv = *(const f32x4*)(w + col), sv = *(const f32x4*)(sc + (size_t)b * 6144 + col), hv = *(const f32x4*)(sh + (size_t)b * 6144 + col);
            const f32x4 o = (v[j] * rstd * wv) * (sv + 1.f) + hv;
            u32x2 pk; pk.x = cvtpk(o[0], o[1]); pk.y = cvtpk(o[2], o[3]); *(u32x2*)(out + (size_t)row * 1024 + col) = pk; }
    }
}
__device__ __forceinline__ void final_norm_rows(const float* x, const float* w, float* out, int gw, int NGW, int lane) {
    for (int row = gw; row < T; row += NGW) {
        const f32x4* xr = (const f32x4*)(x + (size_t)row * 1024) + lane;
        f32x4 v[4]; float ss = 0.f;
#pragma unroll
        for (int j = 0; j < 4; ++j) { v[j] = xr[64 * j]; ss += (v[j][0] * v[j][0] + v[j][1] * v[j][1]) + (v[j][2] * v[j][2] + v[j][3] * v[j][3]); }
        const float rstd = rsqrtf(wave_sum(ss) * (1.f / 1024.f) + NORM_EPS);
#pragma unroll
        for (int j = 0; j < 4; ++j) { const int col = 4 * (64 * j + lane); const f32x4 wv = *(const f32x4*)(w + col);
            *(f32x4*)(out + (size_t)row * 1024 + col) = v[j] * rstd * wv; }
    }
}

__device__ __forceinline__ void gmlp_item(const Params& p, int l, unsigned char* lds, int item, int wid, int lane, bool dry = false) {
    const int grp = item & 7, ch = (item >> 3) & 31, b = item >> 8;
    const int fr = lane & 15, fq = lane >> 4;
    bf16_t* UV = (bf16_t*)(p.ws + O_UV); const bf16_t* GWS = (const bf16_t*)(p.ws + O_GWS);
    const float* lnw = PIN(6) + l * 512; const float* lnb = PIN(7) + l * 512; const float* bs = PIN(9) + (size_t)l * 8 * 128 + grp * 128;
    bf16_t* vnT = (bf16_t*)lds;
    const size_t row0 = (size_t)b * SEQ + ch * 128;
#pragma unroll 8
    for (int r = 0; r < 16; ++r) {
        const int s = wid * 16 + r;
        const bf16x8 raw = *(const bf16x8*)(UV + (row0 + s) * 1024 + 512 + 8 * lane);
        float x[8]; float sum = 0.f;
#pragma unroll
        for (int j = 0; j < 8; ++j) { x[j] = bf2f(raw[j]); sum += x[j]; }
        const float mean = wave_sum(sum) * (1.f / 512.f); float sq = 0.f;
#pragma unroll
        for (int j = 0; j < 8; ++j) { x[j] -= mean; sq += x[j] * x[j]; }
        const float rstd = rsqrtf(wave_sum(sq) * (1.f / 512.f) + NORM_EPS);
        if ((lane >> 3) == grp) { const int c0 = (lane & 7) * 8;
#pragma unroll
            for (int j = 0; j < 8; ++j) { const int cc = grp * 64 + c0 + j; const float o = x[j] * rstd * lnw[cc] + lnb[cc]; vnT[(c0 + j) * 136 + s] = (bf16_t)(cvtpk(o, 0.f) & 0xffffu); } }
    }
    __syncthreads();
    const int t0 = wid * 16;
    f32x4 acc[4];
#pragma unroll
    for (int ct = 0; ct < 4; ++ct) acc[ct] = (f32x4){0.f, 0.f, 0.f, 0.f};
    const int nks = (t0 + 15) / 32 + 1;
    for (int ks = 0; ks < nks; ++ks) {
        const bf16x8 bw = *(const bf16x8*)(GWS + ((size_t)grp * 128 + t0 + fr) * 128 + ks * 32 + 8 * fq);
#pragma unroll
        for (int ct = 0; ct < 4; ++ct) { const bf16x8 av = *(const bf16x8*)(vnT + (ct * 16 + fr) * 136 + ks * 32 + 8 * fq); acc[ct] = mfma16(av, bw, acc[ct]); }
    }
    const float bsv = bs[t0 + fr];
#pragma unroll
    for (int ct = 0; ct < 4; ++ct) { bf16_t* up = UV + (row0 + t0 + fr) * 1024 + grp * 64 + ct * 16 + 4 * fq;
        const u32x2 uw = *(const u32x2*)up; u32x2 o;
        o.x = cvtpk(bflo(uw.x) * (acc[ct][0] + bsv), bfhi(uw.x) * (acc[ct][1] + bsv)); o.y = cvtpk(bflo(uw.y) * (acc[ct][2] + bsv), bfhi(uw.y) * (acc[ct][3] + bsv));
        if (!dry) *(u32x2*)up = o; }
    __syncthreads();
}
__device__ __forceinline__ void rotary_item(const Params& p, unsigned char* lds, int item, int tid, bool dry = false) {
    const int h = item & 7, nb = (item >> 3) & 15, b = item >> 7;
    float* sums = (float*)lds;
    if (tid < 64) sums[tid] = 0.f;
    __syncthreads();
    bf16_t* MQ = (bf16_t*)(p.ws + O_MQKV);
    const int tt = tid >> 1, half = tid & 1; const int pos = nb * 256 + tt; const size_t row = (size_t)b * SEQ + pos;
    bf16_t* kp = MQ + row * 1536 + 512 + h * 64 + half * 32;
    float kv[32];
#pragma unroll
    for (int q = 0; q < 4; ++q) { const bf16x8 raw = *(const bf16x8*)(kp + 8 * q);
#pragma unroll
        for (int j = 0; j < 8; ++j) kv[8 * q + j] = bf2f(raw[j]); }
    if (half == 0 && !dry) {
        bf16_t* qp = MQ + row * 1536 + h * 64;
        float qv[16];
        { const bf16x8 r0 = *(const bf16x8*)qp, r1 = *(const bf16x8*)(qp + 8);
#pragma unroll
          for (int j = 0; j < 8; ++j) { qv[j] = bf2f(r0[j]); qv[8 + j] = bf2f(r1[j]); } }
#pragma unroll
        for (int j = 0; j < 8; ++j) {
            const float inv_freq = powf(500000.0f, -(float)j * 0.125f); const float ang = (float)pos * inv_freq;
            const float cs = cosf(ang), sn = sinf(ang);
            const float k1 = kv[j], k2 = kv[8 + j]; kv[j] = k1 * cs - k2 * sn; kv[8 + j] = k2 * cs + k1 * sn;
            const float q1 = qv[j], q2 = qv[8 + j]; qv[j] = q1 * cs - q2 * sn; qv[8 + j] = q2 * cs + q1 * sn;
        }
        *(bf16x8*)kp = pack8(kv[0], kv[1], kv[2], kv[3], kv[4], kv[5], kv[6], kv[7]);
        *(bf16x8*)(kp + 8) = pack8(kv[8], kv[9], kv[10], kv[11], kv[12], kv[13], kv[14], kv[15]);
        *(bf16x8*)qp = pack8(qv[0], qv[1], qv[2], qv[3], qv[4], qv[5], qv[6], qv[7]);
        *(bf16x8*)(qp + 8) = pack8(qv[8], qv[9], qv[10], qv[11], qv[12], qv[13], qv[14], qv[15]);
    }
#pragma unroll
    for (int d = 0; d < 32; ++d) {
        float v = kv[d];
#pragma unroll
        for (int o = 2; o < 64; o <<= 1) v += __shfl_xor(v, o);
        if ((tid & 63) < 2) atomicAdd(&sums[half * 32 + d], v);
    }
    __syncthreads();
    if (tid < 64) ((float*)(p.ws + O_KMEAN))[(((size_t)b * 8 + h) * 16 + nb) * 64 + tid] = sums[tid] * (1.f / 256.f);
    __syncthreads();
}
__device__ __forceinline__ void vt_item(const Params& p, unsigned char* lds, int item, int tid) {
    const int tb = item & 31, h = (item >> 5) & 7, b = (item >> 8) & 3, which = item >> 10;
    const bf16_t* src = (const bf16_t*)(p.ws + (which ? O_MQKV : O_FQKV)) + ((size_t)b * SEQ + tb * 128) * 1536 + 1024 + h * 64;
    bf16_t* dst = (bf16_t*)(p.ws + (which ? O_VTM : O_VTF)) + ((size_t)(b * 8 + h) * 64) * 4096 + tb * 128;
    bf16_t* tl = (bf16_t*)lds;
    { const int tok = tid >> 2, dq = tid & 3;
      const bf16x8 r0 = *(const bf16x8*)(src + (size_t)tok * 1536 + dq * 16), r1 = *(const bf16x8*)(src + (size_t)tok * 1536 + dq * 16 + 8);
#pragma unroll
      for (int j = 0; j < 8; ++j) { tl[(dq * 16 + j) * 136 + tok] = (bf16_t)r0[j]; tl[(dq * 16 + 8 + j) * 136 + tok] = (bf16_t)r1[j]; } }
    __syncthreads();
    { const int d = tid >> 3, c = tid & 7;
      const bf16x8 a = *(const bf16x8*)(tl + d * 136 + c * 16), bq = *(const bf16x8*)(tl + d * 136 + c * 16 + 8);
      *(bf16x8*)(dst + (size_t)d * 4096 + c * 16) = a; *(bf16x8*)(dst + (size_t)d * 4096 + c * 16 + 8) = bq; }
    __syncthreads();
}
__device__ __forceinline__ void conv_item(const Params& p, int l, int item, int tid) {
    const int cb = item % 20, ch = (item / 20) & 31, b = item / 640;
    const int c = tid & 63, tg = tid >> 6; const int gc = cb * 64 + c;
    const int t00 = ch * 128 + tg * 16 - 3;
    const bf16_t* xp = (const bf16_t*)(p.ws + O_XBC) + ((size_t)b * SEQ) * 1280 + gc;
    float v[19];
#pragma unroll
    for (int r = 0; r < 19; ++r) { const int t = t00 + r; v[r] = (t >= 0) ? bf2f((short)xp[(size_t)(t < 0 ? 0 : t) * 1280]) : 0.f; }
    const float* cw = PIN(11) + (size_t)l * 4 * 1280 + gc; const float w0 = cw[0], w1 = cw[1280], w2 = cw[2560], w3 = cw[3840], cbv = PIN(12)[l * 1280 + gc];
    float o[16];
#pragma unroll
    for (int tt = 0; tt < 16; ++tt) { const float x = cbv + w0 * v[tt] + w1 * v[tt + 1] + w2 * v[tt + 2] + w3 * v[tt + 3]; o[tt] = x / (1.f + __expf(-x)); }
    const size_t tok0 = (size_t)b * SEQ + ch * 128 + tg * 16;
    const bf16x8 p0 = pack8(o[0], o[1], o[2], o[3], o[4], o[5], o[6], o[7]), p1 = pack8(o[8], o[9], o[10], o[11], o[12], o[13], o[14], o[15]);
    if (cb < 12) { bf16_t* d = (bf16_t*)(p.ws + O_XT) + ((size_t)(b * 12 + cb) * 64 + c) * 4096 + ch * 128 + tg * 16; *(bf16x8*)d = p0; *(bf16x8*)(d + 8) = p1; }
    else {
        bf16_t* BC = (bf16_t*)(p.ws + O_BC); const int bc = gc - 768;
#pragma unroll
        for (int tt = 0; tt < 8; ++tt) { BC[(tok0 + tt) * 512 + bc] = (bf16_t)p0[tt]; BC[(tok0 + 8 + tt) * 512 + bc] = (bf16_t)p1[tt]; }
        if (cb < 16) { bf16_t* d = (bf16_t*)(p.ws + O_BT) + ((size_t)b * 256 + bc) * 4096 + ch * 128 + tg * 16; *(bf16x8*)d = p0; *(bf16x8*)(d + 8) = p1; }
    }
}
__device__ __forceinline__ void acum_item(const Params& p, int l, int item, int lane) {
    const int ch = item & 31, h = (item >> 5) % 12, b = item / 384;
    const float* sm = (const float*)(p.ws + O_SMALL); const float a = -expf(PIN(14)[l * 12 + h]);
    const size_t tok = (size_t)b * SEQ + ch * 128 + 2 * lane;
    const float dtb = PIN(13)[l * 12 + h];
    const float d0 = softplusf_(sm[tok * 32 + 8 + h] + dtb), d1 = softplusf_(sm[(tok + 1) * 32 + 8 + h] + dtb);
    { f32x2 dd = {d0, d1}; *(f32x2*)((float*)(p.ws + O_DT) + ((size_t)(b * 12 + h)) * 4096 + ch * 128 + 2 * lane) = dd; }
    const float v0 = d0 * a, v1 = d1 * a;
    float sc = v0 + v1;
#pragma unroll
    for (int o = 1; o < 64; o <<= 1) { const float t = __shfl_up(sc, o); if (lane >= o) sc += t; }
    const float ex = sc - (v0 + v1);
    f32x2 r = {ex + v0, ex + v0 + v1};
    *(f32x2*)((float*)(p.ws + O_ACUM) + ((size_t)(b * 12 + h)) * 4096 + ch * 128 + 2 * lane) = r;
}
__device__ __forceinline__ void foxcum_item(const Params& p, int l, int item, int lane) {
    const int h = item & 7, b = item >> 3; const float fb = PIN(10)[l * 8 + h];
    const float* sm = (const float*)(p.ws + O_SMALL) + ((size_t)b * SEQ + lane * 64) * 32 + h;
    float* cum = (float*)(p.ws + O_CUMF) + (size_t)(b * 8 + h) * 4096 + lane * 64;
    float v[64];
#pragma unroll
    for (int i = 0; i < 64; ++i) v[i] = sm[(size_t)i * 32];
    float run = 0.f;
#pragma unroll
    for (int i = 0; i < 64; ++i) { const float x = v[i] + fb; run += fminf(x, 0.f) - __logf(1.f + __expf(-fabsf(x))); v[i] = run; }
    float sc = run;
#pragma unroll
    for (int o = 1; o < 64; o <<= 1) { const float t = __shfl_up(sc, o); if (lane >= o) sc += t; }
    const float ex = sc - run;
#pragma unroll
    for (int i = 0; i < 64; i += 4) { f32x4 w = {v[i] + ex, v[i + 1] + ex, v[i + 2] + ex, v[i + 3] + ex}; *(f32x4*)(cum + i) = w; }
}

template <bool MOBA>
__device__ __forceinline__ void attn_tile64(const bf16_t* KL, const bf16_t* VL, const float* __restrict__ cum, int k0, bool diag, int kb,
                                            const bf16x8 (&qf)[2][2], const unsigned (&sel)[2], int qpos0, int fr, int fq,
                                            float (&m)[2], float (&lsum)[2], f32x4 (&o)[4][2]) {
    f32x4 s[4][2];
#pragma unroll
    for (int jk = 0; jk < 4; ++jk) {
        const bf16x8 k0f = *(const bf16x8*)(KL + (16 * jk + fr) * 72 + 8 * fq), k1f = *(const bf16x8*)(KL + (16 * jk + fr) * 72 + 32 + 8 * fq);
#pragma unroll
        for (int jq = 0; jq < 2; ++jq) { f32x4 z = {0.f, 0.f, 0.f, 0.f}; z = mfma16(k0f, qf[jq][0], z); s[jk][jq] = mfma16(k1f, qf[jq][1], z); }
    }
    constexpr float C2 = 0.125f * LOG2E;
#pragma unroll
    for (int jk = 0; jk < 4; ++jk) {
        f32x4 nck = {0.f, 0.f, 0.f, 0.f};
        if (!MOBA) nck = *(const f32x4*)(cum + k0 + 16 * jk + 4 * fq) * (-LOG2E);
#pragma unroll
        for (int jq = 0; jq < 2; ++jq)
#pragma unroll
            for (int i = 0; i < 4; ++i) s[jk][jq][i] = MOBA ? s[jk][jq][i] * C2 : fmaf(s[jk][jq][i], C2, nck[i]);
    }
    if (diag) {
#pragma unroll
        for (int jk = 0; jk < 4; ++jk)
#pragma unroll
            for (int jq = 0; jq < 2; ++jq)
#pragma unroll
                for (int i = 0; i < 4; ++i) if (k0 + 16 * jk + 4 * fq + i > qpos0 + 16 * jq + fr) s[jk][jq][i] = -INFINITY;
    }
    if (MOBA && kb >= 0) {
#pragma unroll
        for (int jq = 0; jq < 2; ++jq) if (!((sel[jq] >> kb) & 1u)) {
#pragma unroll
            for (int jk = 0; jk < 4; ++jk) s[jk][jq] = (f32x4){-INFINITY, -INFINITY, -INFINITY, -INFINITY}; }
    }
    bf16x8 pb[2][2];
#pragma unroll
    for (int jq = 0; jq < 2; ++jq) {
        float mx = -INFINITY;
#pragma unroll
        for (int jk = 0; jk < 4; ++jk) mx = fmaxf(mx, fmaxf(fmaxf(s[jk][jq][0], s[jk][jq][1]), fmaxf(s[jk][jq][2], s[jk][jq][3])));
        mx = fmaxf(mx, __shfl_xor(mx, 16)); mx = fmaxf(mx, __shfl_xor(mx, 32));
        const float mnew = fmaxf(m[jq], mx); const float alpha = ex2(m[jq] - mnew); m[jq] = mnew;
        float ps = 0.f;
#pragma unroll
        for (int jk = 0; jk < 4; ++jk)
#pragma unroll
            for (int i = 0; i < 4; ++i) { const float e = ex2(s[jk][jq][i] - mnew); s[jk][jq][i] = e; ps += e; }
        lsum[jq] = lsum[jq] * alpha + ps;
#pragma unroll
        for (int dt = 0; dt < 4; ++dt) o[dt][jq] = o[dt][jq] * alpha;
        pb[jq][0] = pack8(s[0][jq][0], s[0][jq][1], s[0][jq][2], s[0][jq][3], s[1][jq][0], s[1][jq][1], s[1][jq][2], s[1][jq][3]);
        pb[jq][1] = pack8(s[2][jq][0], s[2][jq][1], s[2][jq][2], s[2][jq][3], s[3][jq][0], s[3][jq][1], s[3][jq][2], s[3][jq][3]);
    }
#pragma unroll
    for (int hh = 0; hh < 2; ++hh)
#pragma unroll
        for (int dt = 0; dt < 4; ++dt) { const bf16_t* vp = VL + (dt * 16 + fr) * 72 + hh * 32 + 4 * fq; const bf16x8 vf = ld2x8(vp, vp + 16);
#pragma unroll
            for (int jq = 0; jq < 2; ++jq) o[dt][jq] = mfma16(vf, pb[jq][hh], o[dt][jq]); }
}
template <bool MOBA>
__device__ __forceinline__ void attn_block_item(const Params& p, unsigned char* lds, int b, int h, int qb, int tid, int wid, int lane) {
    const int fr = lane & 15, fq = lane >> 4; const int q0 = qb * 256 + wid * 32;
    bf16_t* KLb = (bf16_t*)lds; bf16_t* VLb = KLb + 2 * 64 * 72;
    bf16_t* qkv = (bf16_t*)(p.ws + (MOBA ? O_MQKV : O_FQKV)) + ((size_t)b * SEQ) * 1536 + h * 64;
    const bf16_t* kbase = qkv + 512; const bf16_t* vtbase = (const bf16_t*)(p.ws + (MOBA ? O_VTM : O_VTF)) + ((size_t)(b * 8 + h) * 64) * 4096;
    const float* cum = (const float*)(p.ws + O_CUMF) + (size_t)(b * 8 + h) * 4096;
    bf16x8 qf[2][2];
#pragma unroll
    for (int jq = 0; jq < 2; ++jq)
#pragma unroll
        for (int ks = 0; ks < 2; ++ks) qf[jq][ks] = *(const bf16x8*)(qkv + (size_t)(q0 + 16 * jq + fr) * 1536 + ks * 32 + 8 * fq);
    unsigned sel[2] = {0u, 0u}; unsigned umask = 0u;
    const int own = qb;
    if (MOBA && own > 0) {
        const float* km = (const float*)(p.ws + O_KMEAN) + ((size_t)(b * 8 + h) * 16) * 64 + 16 * fq;
#pragma unroll
        for (int jq = 0; jq < 2; ++jq) {
            const bf16_t* qp = qkv + (size_t)(q0 + 16 * jq + fr) * 1536 + 16 * fq;
            const bf16x8 r0 = *(const bf16x8*)qp, r1 = *(const bf16x8*)(qp + 8);
            float qd[16];
#pragma unroll
            for (int j = 0; j < 8; ++j) { qd[j] = bf2f(r0[j]); qd[8 + j] = bf2f(r1[j]); }
            float gate[15];
#pragma unroll
            for (int n = 0; n < 15; ++n) {
                float a = -INFINITY;
                if (n < own) { a = 0.f;
#pragma unroll
                    for (int d = 0; d < 16; d += 4) { const f32x4 kk = *(const f32x4*)(km + n * 64 + d); a += qd[d] * kk[0] + qd[d + 1] * kk[1] + qd[d + 2] * kk[2] + qd[d + 3] * kk[3]; }
                    a += __shfl_xor(a, 16); a += __shfl_xor(a, 32); }
                gate[n] = a;
            }
            unsigned msk = 0u;
#pragma unroll
            for (int pass = 0; pass < 3; ++pass) { float best = -INFINITY; int bi = -1;
#pragma unroll
                for (int n = 0; n < 15; ++n) { const float v = ((msk >> n) & 1u) ? -INFINITY : gate[n]; if (v > best) { best = v; bi = n; } }
                if (bi >= 0) msk |= 1u << bi; }
            sel[jq] = msk;
        }
        umask = sel[0] | sel[1];
#pragma unroll
        for (int o2 = 1; o2 < 16; o2 <<= 1) umask |= __shfl_xor(umask, o2);
        umask = __builtin_amdgcn_readfirstlane(umask);
    }
    float m[2] = {-1e30f, -1e30f}, lsum[2] = {0.f, 0.f}; f32x4 o[4][2];
#pragma unroll
    for (int dt = 0; dt < 4; ++dt) { o[dt][0] = (f32x4){0.f, 0.f, 0.f, 0.f}; o[dt][1] = (f32x4){0.f, 0.f, 0.f, 0.f}; }
    const int NT = 4 * (qb + 1);
    const int lr = tid >> 3, lc = (tid & 7) * 8;
    #define TILE_KT(i) (MOBA ? (((i) < 4) ? 4 * qb + (i) : (i) - 4) : (i))
    bf16x8 kreg, vreg;
    { const int k0 = TILE_KT(0) * 64; kreg = *(const bf16x8*)(kbase + (size_t)(k0 + lr) * 1536 + lc); vreg = *(const bf16x8*)(vtbase + (size_t)lr * 4096 + k0 + lc); }
    *(bf16x8*)(KLb + lr * 72 + lc) = kreg; *(bf16x8*)(VLb + lr * 72 + lc) = vreg;
    __syncthreads();
#pragma unroll 1
    for (int i = 0; i < NT; ++i) {
        const int k0 = TILE_KT(i) * 64; const int buf = i & 1;
        if (i + 1 < NT) { const int k1 = TILE_KT(i + 1) * 64; kreg = *(const bf16x8*)(kbase + (size_t)(k1 + lr) * 1536 + lc); vreg = *(const bf16x8*)(vtbase + (size_t)lr * 4096 + k1 + lc); }
        const bf16_t* KL = KLb + buf * 64 * 72; const bf16_t* VL = VLb + buf * 64 * 72;
        const int kb = k0 >> 8;
        const bool live = !MOBA || kb == own || ((umask >> kb) & 1u);
        if (live && k0 <= q0 + 31)
            attn_tile64<MOBA>(KL, VL, cum, k0, k0 + 63 > q0, (MOBA && kb < own) ? kb : -1, qf, sel, q0, fr, fq, m, lsum, o);
        if (i + 1 < NT) { *(bf16x8*)((bf16_t*)KLb + (buf ^ 1) * 64 * 72 + lr * 72 + lc) = kreg; *(bf16x8*)((bf16_t*)VLb + (buf ^ 1) * 64 * 72 + lr * 72 + lc) = vreg; }
        __syncthreads();
    }
    #undef TILE_KT
#pragma unroll
    for (int jq = 0; jq < 2; ++jq) {
        float ls = lsum[jq]; ls += __shfl_xor(ls, 16); ls += __shfl_xor(ls, 32); const float inv = 1.f / ls;
        bf16_t* op = qkv + (size_t)(q0 + 16 * jq + fr) * 1536 + 4 * fq;
#pragma unroll
        for (int dt = 0; dt < 4; ++dt) { const f32x4 v = o[dt][jq] * inv; u32x2 w; w.x = cvtpk(v[0], v[1]); w.y = cvtpk(v[2], v[3]); *(u32x2*)(op + dt * 16) = w; }
    }
}
__device__ __forceinline__ void ssd_states_item(const Params& p, int item, int lane) {
    const int h = item % 12, c = (item / 12) & 31, b = item / 384; const int grp = h / 6;
    const int fr = lane & 15, fq = lane >> 4;
    const float* ac = (const float*)(p.ws + O_ACUM) + (size_t)(b * 12 + h) * 4096 + c * 128;
    const float* dtp = (const float*)(p.ws + O_DT) + (size_t)(b * 12 + h) * 4096 + c * 128;
    const bf16_t* XT = (const bf16_t*)(p.ws + O_XT) + ((size_t)(b * 12 + h) * 64) * 4096 + c * 128;
    const bf16_t* BT = (const bf16_t*)(p.ws + O_BT) + ((size_t)(b * 2 + grp) * 128) * 4096 + c * 128;
    float* ST = (float*)(p.ws + O_ST) + ((size_t)((b * 32 + c) * 12 + h)) * 8192;
    const float total = ac[127];
#pragma unroll 1
    for (int q2 = 0; q2 < 4; ++q2) {
        f32x4 acc[4][2];
#pragma unroll
        for (int pt = 0; pt < 4; ++pt) { acc[pt][0] = (f32x4){0.f, 0.f, 0.f, 0.f}; acc[pt][1] = (f32x4){0.f, 0.f, 0.f, 0.f}; }
#pragma unroll 1
        for (int ks = 0; ks < 4; ++ks) {
            const int s0 = ks * 32 + 8 * fq;
            const f32x4 a0 = *(const f32x4*)(ac + s0), a1 = *(const f32x4*)(ac + s0 + 4);
            const f32x4 d0 = *(const f32x4*)(dtp + s0), d1 = *(const f32x4*)(dtp + s0 + 4);
            float w8[8];
#pragma unroll
            for (int j = 0; j < 4; ++j) { w8[j] = expf(total - a0[j]) * d0[j]; w8[4 + j] = expf(total - a1[j]) * d1[j]; }
            const bf16x8 b0 = *(const bf16x8*)(BT + (size_t)((q2 * 2 + 0) * 16 + fr) * 4096 + s0), b1 = *(const bf16x8*)(BT + (size_t)((q2 * 2 + 1) * 16 + fr) * 4096 + s0);
#pragma unroll
            for (int pt = 0; pt < 4; ++pt) { const bf16x8 xa = *(const bf16x8*)(XT + (size_t)(pt * 16 + fr) * 4096 + s0);
                const bf16x8 af = pack8(bf2f(xa[0]) * w8[0], bf2f(xa[1]) * w8[1], bf2f(xa[2]) * w8[2], bf2f(xa[3]) * w8[3], bf2f(xa[4]) * w8[4], bf2f(xa[5]) * w8[5], bf2f(xa[6]) * w8[6], bf2f(xa[7]) * w8[7]);
                acc[pt][0] = mfma16(af, b0, acc[pt][0]); acc[pt][1] = mfma16(af, b1, acc[pt][1]); }
        }
#pragma unroll
        for (int pt = 0; pt < 4; ++pt)
#pragma unroll
            for (int nt = 0; nt < 2; ++nt)
#pragma unroll
                for (int i = 0; i < 4; ++i) ST[(size_t)(pt * 16 + 4 * fq + i) * 128 + (q2 * 2 + nt) * 16 + fr] = acc[pt][nt][i];
    }
}
__device__ __forceinline__ void ssd_scan(const Params& p, int gtid, int gthreads) {
    const float* ST = (const float*)(p.ws + O_ST); bf16_t* PV = (bf16_t*)(p.ws + O_PREV); const float* ACUM = (const float*)(p.ws + O_ACUM);
    for (int e = gtid; e < NB * 12 * 8192; e += gthreads) {
        const int pn = e & 8191, h = (e >> 13) % 12, b = e / (12 * 8192);
        const float* ac = ACUM + (size_t)(b * 12 + h) * 4096 + 127;
        const size_t base = ((size_t)(b * 32) * 12 + h) * 8192 + pn;
        float st[32], dc[32];
#pragma unroll
        for (int c = 0; c < 32; ++c) { st[c] = ST[base + (size_t)c * 12 * 8192]; dc[c] = ac[c * 128]; }
        float hs = 0.f;
#pragma unroll
        for (int c = 0; c < 32; ++c) { PV[base + (size_t)c * 12 * 8192] = (bf16_t)(cvtpk(hs, 0.f) & 0xffffu); hs = hs * __expf(dc[c]) + st[c]; }
    }
}
__device__ __forceinline__ void ssd_out_item(const Params& p, int l, int item, int wid, int lane, bool dry = false) {
    const int grp = item & 1, c = (item >> 1) & 31, b = item >> 6;
    const int fr = lane & 15, fq = lane >> 4; const int w = wid; const int tl = 16 * w + fr;
    const size_t row0 = (size_t)b * SEQ + c * 128; const size_t row = row0 + tl;
    const bf16_t* BC = (const bf16_t*)(p.ws + O_BC);
    bf16_t* Z = (bf16_t*)(p.ws + O_Z);
    bf16x8 cf[4];
#pragma unroll
    for (int ks = 0; ks < 4; ++ks) cf[ks] = *(const bf16x8*)(BC + row * 512 + 256 + grp * 128 + ks * 32 + 8 * fq);
    f32x4 cbt[8];
#pragma unroll
    for (int js = 0; js < 8; ++js) { cbt[js] = (f32x4){0.f, 0.f, 0.f, 0.f};
        if (js <= w) {
#pragma unroll
            for (int ks = 0; ks < 4; ++ks) { const bf16x8 a = *(const bf16x8*)(BC + (row0 + js * 16 + fr) * 512 + grp * 128 + ks * 32 + 8 * fq); cbt[js] = mfma16(a, cf[ks], cbt[js]); } } }
    float ssq = 0.f;
#pragma unroll 1
    for (int r = 0; r < 6; ++r) {
        const int h = grp * 6 + r;
        const float* ac = (const float*)(p.ws + O_ACUM) + (size_t)(b * 12 + h) * 4096 + c * 128;
        const float* dtp = (const float*)(p.ws + O_DT) + (size_t)(b * 12 + h) * 4096 + c * 128;
        const float acl = ac[tl]; const float eacl = expf(acl); const float Dh = PIN(15)[l * 12 + h];
        const bf16_t* PV = (const bf16_t*)(p.ws + O_PREV) + ((size_t)((b * 32 + c) * 12 + h)) * 8192;
        const bf16_t* XT = (const bf16_t*)(p.ws + O_XT) + ((size_t)(b * 12 + h) * 64) * 4096 + c * 128;
        f32x4 yt[4];
#pragma unroll
        for (int pt = 0; pt < 4; ++pt) yt[pt] = (f32x4){0.f, 0.f, 0.f, 0.f};
#pragma unroll
        for (int ks = 0; ks < 4; ++ks)
#pragma unroll
            for (int pt = 0; pt < 4; ++pt) { const bf16x8 a = *(const bf16x8*)(PV + (size_t)(pt * 16 + fr) * 128 + ks * 32 + 8 * fq); yt[pt] = mfma16(a, cf[ks], yt[pt]); }
#pragma unroll
        for (int pt = 0; pt < 4; ++pt) yt[pt] = yt[pt] * eacl;
#pragma unroll
        for (int jp = 0; jp < 4; ++jp) {
            if (2 * jp <= w) {
                const int sA = 32 * jp + 4 * fq, sB = sA + 16;
                const f32x4 a0 = *(const f32x4*)(ac + sA), a1 = *(const f32x4*)(ac + sB), dv0 = *(const f32x4*)(dtp + sA), dv1 = *(const f32x4*)(dtp + sB);
                float mv[8];
#pragma unroll
                for (int j = 0; j < 4; ++j) {
                    const int s = sA + j; const float d0 = dv0[j];
                    float v = (s <= tl) ? cbt[2 * jp][j] * expf(acl - a0[j]) * d0 : 0.f; if (s == tl) v += Dh; mv[j] = v;
                    const int s2 = sB + j; const float d1 = dv1[j];
                    float v2 = (s2 <= tl) ? cbt[2 * jp + 1][j] * expf(acl - a1[j]) * d1 : 0.f; if (s2 == tl) v2 += Dh; mv[4 + j] = v2;
                }
                const bf16x8 mb = pack8(mv[0], mv[1], mv[2], mv[3], mv[4], mv[5], mv[6], mv[7]);
#pragma unroll
                for (int pt = 0; pt < 4; ++pt) { const bf16_t* xp = XT + (size_t)(pt * 16 + fr) * 4096 + sA; yt[pt] = mfma16(ld2x8(xp, xp + 16), mb, yt[pt]); }
            }
        }
#pragma unroll
        for (int pt = 0; pt < 4; ++pt) { bf16_t* zp = Z + row * 768 + h * 64 + pt * 16 + 4 * fq; const u32x2 zw = *(const u32x2*)zp;
            const float y0 = yt[pt][0] * bflo(zw.x), y1 = yt[pt][1] * bfhi(zw.x), y2 = yt[pt][2] * bflo(zw.y), y3 = yt[pt][3] * bfhi(zw.y);
            ssq += (y0 * y0 + y1 * y1) + (y2 * y2 + y3 * y3);
            u32x2 o; o.x = cvtpk(y0, y1); o.y = cvtpk(y2, y3); if (!dry) *(u32x2*)zp = o; }
    }
    ssq += __shfl_xor(ssq, 16); ssq += __shfl_xor(ssq, 32);
    if (dry) return;
    const float rstd = rsqrtf(ssq * (1.f / 384.f) + NORM_EPS);
    VM_WAIT();
    const float* nw = PIN(16) + l * 768 + grp * 384;
    bf16_t* zp0 = Z + row * 768 + grp * 384 + 4 * fq;
#pragma unroll 4
    for (int q = 0; q < 24; ++q) { bf16_t* zp = zp0 + q * 16; const u32x2 zw = *(const u32x2*)zp; const f32x4 nv = *(const f32x4*)(nw + q * 16 + 4 * fq);
        u32x2 o; o.x = cvtpk(bflo(zw.x) * rstd * nv[0], bfhi(zw.x) * rstd * nv[1]); o.y = cvtpk(bflo(zw.y) * rstd * nv[2], bfhi(zw.y) * rstd * nv[3]); *(u32x2*)zp = o; }
}

#define LAS __attribute__((address_space(3)))
#define XB_TMO      128
#define XB_XCNT(j)  (256  + 64 * (j))
#define XB_XSUB(j)  (1280 + 64 * (j))
#define XB_XGEN(j)  (2304 + 64 * (j))
#define XB_TOP      3328
#define XB_TOPGEN   3392
#define XCD_BAR_WORDS 3456
#define XB_SPIN_CAP (1u << 18)

__device__ __forceinline__ unsigned xb_ld(unsigned* p)              { return __hip_atomic_load(p, __ATOMIC_RELAXED, __HIP_MEMORY_SCOPE_AGENT); }
__device__ __forceinline__ unsigned xb_add(unsigned* p, unsigned v) { return __hip_atomic_fetch_add(p, v, __ATOMIC_RELAXED, __HIP_MEMORY_SCOPE_AGENT); }
__device__ __forceinline__ unsigned xb_xcc_id() { return (unsigned)__builtin_amdgcn_s_getreg((3 << 11) | 20) & 0xFu; }
#define XB_SPIN(cond, bar) do { unsigned _sp = 0; while (cond) { __builtin_amdgcn_s_sleep(1); \
    if ((++_sp & 255u) == 0u) { if (xb_ld(&(bar)[XB_TMO])) break; if (_sp > XB_SPIN_CAP) { atomicAdd(&(bar)[XB_TMO], 1u); break; } } } } while (0)

struct XcdBarrier {
    unsigned* bar; unsigned x;
    volatile LAS unsigned* st;
};

__device__ __forceinline__ XcdBarrier xcd_barrier_post(unsigned* bar, volatile LAS unsigned* st) {
    XcdBarrier b; b.bar = bar; b.x = xb_xcc_id(); b.st = st;
    if (threadIdx.x == 0) (void)xb_add(&bar[XB_XCNT(b.x)], 1u);
    return b;
}
__device__ __forceinline__ void xcd_barrier_complete(unsigned* bar, unsigned x, unsigned& nloc, unsigned& nx) {
    const unsigned G = gridDim.x * gridDim.y * gridDim.z;
    unsigned sum, cnt, mine, sp = 0u;
    for (;;) {
        sum = 0u; cnt = 0u; mine = 0u;
#pragma unroll
        for (unsigned j = 0; j < 16; ++j) { const unsigned c = xb_ld(&bar[XB_XCNT(j)]); sum += c; cnt += (c > 0u) ? 1u : 0u; mine = (j == x) ? c : mine; }
        if (sum == G) break;
        __builtin_amdgcn_s_sleep(1);
        if ((++sp & 255u) == 0u) { if (xb_ld(&bar[XB_TMO])) break; if (sp > XB_SPIN_CAP) { atomicAdd(&bar[XB_TMO], 1u); break; } }
    }
    nloc = mine > 0u ? mine : 1u; nx = cnt > 0u ? cnt : 1u;
}

__device__ __forceinline__ void xcd_barrier(const XcdBarrier& b) {
    asm volatile("s_waitcnt vmcnt(0)" ::: "memory");
    __syncthreads();
    if (threadIdx.x == 0) {
        unsigned* bar = b.bar;
        __builtin_amdgcn_s_waitcnt(0);
        unsigned nloc = b.st[0], nx = b.st[1];
        if (nloc == 0u) { xcd_barrier_complete(bar, b.x, nloc, nx); b.st[0] = nloc; b.st[1] = nx; }
        const unsigned old = xb_add(&bar[XB_XSUB(b.x)], 1u);
        const unsigned gen = old / nloc;
        if (old + 1u == (gen + 1u) * nloc) {
            __builtin_amdgcn_fence(__ATOMIC_RELEASE, "agent");
            asm volatile("s_waitcnt vmcnt(0)" ::: "memory");
            const unsigned og = xb_add(&bar[XB_TOP], 1u);
            const unsigned tg = og / nx;
            if (og + 1u == (tg + 1u) * nx) xb_add(&bar[XB_TOPGEN], 1u);
            else XB_SPIN(xb_ld(&bar[XB_TOPGEN]) == tg, bar);
            __builtin_amdgcn_fence(__ATOMIC_ACQUIRE, "agent");
            xb_add(&bar[XB_XGEN(b.x)], 1u);
            asm volatile("s_waitcnt vmcnt(0)" ::: "memory");
        } else {
            XB_SPIN(xb_ld(&bar[XB_XGEN(b.x)]) == gen, bar);
            __builtin_amdgcn_fence(__ATOMIC_ACQUIRE, "agent");
            asm volatile("s_waitcnt vmcnt(0)" ::: "memory");
        }
    }
    __syncthreads();
}

constexpr int PH_PER_LAYER = 11, N_PHASES = 1 + DEPTH * PH_PER_LAYER + 1;
template <int EN_MASK, bool EN_GEMM>
__device__ __forceinline__ void fwd_body(const Params& p) {
    extern __shared__ __attribute__((aligned(16))) unsigned char lds[];
    cg::grid_group grid = cg::this_grid();
    const int G = gridDim.x, NGW = G * 8;
    unsigned char* ws = p.ws;
    volatile LAS unsigned* MISC = (volatile LAS unsigned*)((LAS unsigned char*)lds + 132096);
    if (threadIdx.x < 2) MISC[threadIdx.x] = 0u;
    __syncthreads();
    XcdBarrier xbar = xcd_barrier_post((unsigned*)(ws + O_CTL), MISC);
    float* mod = (float*)(ws + O_MOD); float* X = (float*)(ws + O_X); bf16_t* H = (bf16_t*)(ws + O_H);
    for (int ph = p.ph_lo; ph < p.ph_hi; ++ph) {
        int tid = threadIdx.x; asm volatile("" : "+v"(tid));
        const int lane = tid & 63, wid = __builtin_amdgcn_readfirstlane(tid >> 6); const int gw = blockIdx.x * 8 + wid;
        if (ph == 0) { if constexpr (EN_MASK != 0) phase_pre(p, lds, tid); }
        else if (ph == N_PHASES - 1) { if constexpr (EN_MASK != 0) final_norm_rows(X, PIN(25), p.out, gw, NGW, lane); }
        else {
            const int l = (ph - 1) / PH_PER_LAYER, k = (ph - 1) % PH_PER_LAYER;
            const float* modl = mod + (size_t)l * 4 * 6144;
            const float* xin = (l == 0) ? PIN(0) : X;
            if (k == 1 || k == 6 || k == 7 || k == 9 || k == 10) { if constexpr (EN_GEMM) {
                const int nsub = (k == 6) ? 4 : 1;
#pragma unroll 1
                for (int br = 0; br < nsub; ++br) {
                    EpiU E{}; const bf16_t* A; const bf16_t* Bt; int lda, N, K;
                    if (k == 1) { E.kind = 0; E.p1 = ws; A = H; lda = 1024; Bt = (const bf16_t*)(ws + O_WIN); N = NPROJ; K = 1024; }
                    else if (k == 6) {
                        const size_t aoffs = (br == 0) ? O_UV : (br == 1) ? O_FQKV : (br == 2) ? O_MQKV : O_Z;
                        const size_t woffs = (br == 0) ? O_WA : (br == 1) ? O_WB : (br == 2) ? O_WC : O_WD;
                        E.kind = 1; E.p0 = (const bf16_t*)(ws + O_GATE) + br * 1024; E.p1 = (float*)(ws + O_MF32); E.p2 = H; E.mode = (br == 0) ? 0 : (br == 3) ? 2 : 1;
                        A = (const bf16_t*)(ws + aoffs); lda = (br == 0) ? 1024 : (br == 3) ? 768 : 1536; Bt = (const bf16_t*)(ws + woffs); N = 1024; K = (br == 3) ? 768 : 512; }
                    else if (k == 7) { E.kind = 2; E.p0 = xin; E.p1 = X; E.p2 = (void*)(modl + 2048); A = H; lda = 1024; Bt = (const bf16_t*)(ws + O_WO); N = 1024; K = 1024; }
                    else if (k == 9) { E.kind = 3; E.p1 = (bf16_t*)(ws + O_HID); A = H; lda = 1024; Bt = (const bf16_t*)(ws + O_W1); N = 4096; K = 1024; }
                    else { E.kind = 2; E.p0 = X; E.p1 = X; E.p2 = (void*)(modl + 5120); A = (const bf16_t*)(ws + O_HID); lda = 4096; Bt = (const bf16_t*)(ws + O_W2); N = 1024; K = 4096; }
#ifdef PROBE_DUP_GEMM
                    E.dry = (p.ph_lo == 0); run_gemm(lds, A, lda, Bt, N, K, E); E.dry = 0;
#endif
                    run_gemm(lds, A, lda, Bt, N, K, E);
                }
            } } else switch (k) {
            case 0: if constexpr ((EN_MASK >> 0) & 1) {
#ifdef PROBE_A
                convert_weights(p, l, lds, gw, NGW, wid, lane); norm_mod_rows(xin, PIN(4) + l * 1024, modl + 0, modl + 1024, H, gw, NGW, lane);
#endif
                convert_weights(p, l, lds, gw, NGW, wid, lane);
                norm_mod_rows(xin, PIN(4) + l * 1024, modl + 0, modl + 1024, H, gw, NGW, lane);
            } break;
            case 2: if constexpr ((EN_MASK >> 2) & 1) {
#ifdef PROBE_C
                { const bool dry = (p.ph_lo == 0);
                for (int it = blockIdx.x; it < 1024; it += G) gmlp_item(p, l, lds, it, wid, lane, dry);
                for (int it = blockIdx.x; it < 512; it += G) rotary_item(p, lds, it, tid, dry);
                for (int it = blockIdx.x; it < 2048; it += G) vt_item(p, lds, it, tid);
                for (int it = blockIdx.x; it < 2560; it += G) conv_item(p, l, it, tid);
                for (int it = gw; it < 1536; it += NGW) acum_item(p, l, it, lane);
                for (int it = NGW - 1 - gw; it < 32; it += NGW) foxcum_item(p, l, it, lane); }
#endif
                for (int it = blockIdx.x; it < 1024; it += G) gmlp_item(p, l, lds, it, wid, lane);
                for (int it = blockIdx.x; it < 512; it += G) rotary_item(p, lds, it, tid);
                for (int it = blockIdx.x; it < 2048; it += G) vt_item(p, lds, it, tid);
                for (int it = blockIdx.x; it < 2560; it += G) conv_item(p, l, it, tid);
                for (int it = gw; it < 1536; it += NGW) acum_item(p, l, it, lane);
                for (int it = NGW - 1 - gw; it < 32; it += NGW) foxcum_item(p, l, it, lane);
            } break;
            case 3: if constexpr ((EN_MASK >> 3) & 1) {
#ifndef EN3
#define EN3 7
#endif
                for (int i = blockIdx.x; i < 512; i += G) { const int bh = i & 31, r = i >> 5; const int qb = (r < 8) ? 15 - r : r - 8;
                    if constexpr (EN3 & 1) attn_block_item<false>(p, lds, bh >> 3, bh & 7, qb, tid, wid, lane);
                    if constexpr (EN3 & 2) attn_block_item<true>(p, lds, bh >> 3, bh & 7, qb, tid, wid, lane); }
#ifdef PROBE_EF
                for (int i = NGW - 1 - gw; i < 1536; i += NGW) ssd_states_item(p, i, lane);
#endif
                if constexpr (EN3 & 4) for (int i = NGW - 1 - gw; i < 1536; i += NGW) ssd_states_item(p, i, lane);
            } break;
            case 4: if constexpr ((EN_MASK >> 4) & 1) {
#ifdef PROBE_EF
                ssd_scan(p, blockIdx.x * 512 + tid, G * 512);
#endif
                ssd_scan(p, blockIdx.x * 512 + tid, G * 512); } break;
            case 5: if constexpr ((EN_MASK >> 5) & 1) {
#ifdef PROBE_EF
                for (int it = blockIdx.x; it < 256; it += G) ssd_out_item(p, l, it, wid, lane, p.ph_lo == 0);
#endif
                for (int it = blockIdx.x; it < 256; it += G) ssd_out_item(p, l, it, wid, lane); } break;
            case 8: if constexpr ((EN_MASK >> 8) & 1) { norm_mod_rows(X, PIN(22) + l * 1024, modl + 3072, modl + 4096, H, gw, NGW, lane); } break;
            }
        }
        if (ph + 1 < p.ph_hi) { if (ph == 0) grid.sync(); else xcd_barrier(xbar); }
#ifdef PROBE_SYNC
        if (ph + 1 < p.ph_hi) { xcd_barrier(xbar); xcd_barrier(xbar); }
#endif
    }
}

#ifndef N_LAUNCH_MODE
#define N_LAUNCH_MODE 1
#endif
#if N_LAUNCH_MODE == 1
__global__ void __launch_bounds__(512, 2) fwd_all(Params p) { fwd_body<0x7ff, true>(p); }
#define KERNEL_FOR_ATTR fwd_all
#else
__global__ void __launch_bounds__(512, 2) fwd_gemm(Params p) { fwd_body<0, true>(p); }
__global__ void __launch_bounds__(512, 2) fwd_misc(Params p) { fwd_body<0x7ff, false>(p); }
#endif
extern "C" void kernel_launch(void* const* d_in, const int* in_sizes, int n_in, void* d_out, int out_size, void* d_ws, size_t ws_size, hipStream_t stream) {
    static int grid = 0;
    if (grid == 0) {
        if (n_in != 26 || out_size != T * DM || ws_size < WS_END) { fprintf(stderr, "kernel_launch: unexpected shapes (n_in %d out %d ws %zu need %zu)\n", n_in, out_size, ws_size, (size_t)WS_END); grid = -1; return; }
        int dev = 0, cus = 0;
        (void)hipGetDevice(&dev); (void)hipDeviceGetAttribute(&cus, hipDeviceAttributeMultiprocessorCount, dev);
#if N_LAUNCH_MODE == 1
        if (hipFuncSetAttribute((const void*)fwd_all, hipFuncAttributeMaxDynamicSharedMemorySize, LDS_BYTES) != hipSuccess) { fprintf(stderr, "kernel_launch: hipFuncSetAttribute failed\n"); grid = -1; return; }
#else
        if (hipFuncSetAttribute((const void*)fwd_gemm, hipFuncAttributeMaxDynamicSharedMemorySize, LDS_BYTES) != hipSuccess || hipFuncSetAttribute((const void*)fwd_misc, hipFuncAttributeMaxDynamicSharedMemorySize, LDS_BYTES) != hipSuccess) { fprintf(stderr, "kernel_launch: hipFuncSetAttribute failed\n"); grid = -1; return; }
#endif
        (void)hipGetLastError();
        grid = cus > 0 ? cus : 256;
    }
    if (grid < 0) return;
    if (hipMemsetAsync((char*)d_ws + O_CTL, 0, 16384, stream) != hipSuccess) { fprintf(stderr, "kernel_launch: memset failed\n"); return; }
    Params p{};
    for (int i = 0; i < 26; ++i) p.in[i] = (const float*)d_in[i];
    p.out = (float*)d_out; p.ws = (unsigned char*)d_ws;
#if N_LAUNCH_MODE == 1
    p.ph_lo = 0; p.ph_hi = N_PHASES;
    void* args[] = {&p};
    hipError_t e = hipLaunchCooperativeKernel((const void*)fwd_all, dim3(grid), dim3(512), args, LDS_BYTES, stream);
    if (e != hipSuccess) fprintf(stderr, "kernel_launch: cooperative launch failed: %s (grid %d)\n", hipGetErrorString(e), grid);
#else
    for (int ph = 0; ph < N_PHASES; ++ph) { p.ph_lo = ph; p.ph_hi = ph + 1;
        const int k = (ph >= 1 && ph < N_PHASES - 1) ? (ph - 1) % PH_PER_LAYER : -1;
        if (k == 1 || k == 6 || k == 7 || k == 9 || k == 10) hipLaunchKernelGGL(fwd_gemm, dim3(grid), dim3(512), LDS_BYTES, stream, p);
        else hipLaunchKernelGGL(fwd_misc, dim3(grid), dim3(512), LDS_BYTES, stream, p); }
#endif
}
```

```cpp
#include <hip/hip_runtime.h>
#include <hip/hip_cooperative_groups.h>
#include <cstdio>
#include <cstdint>
#include <cmath>
namespace cg = cooperative_groups;
namespace pg8 {
#define PG8_LAS __attribute__((address_space(3)))
typedef unsigned short bf16_t;
typedef short bf16x8 __attribute__((ext_vector_type(8)));
typedef float f32x4 __attribute__((ext_vector_type(4)));
typedef unsigned u32x4 __attribute__((ext_vector_type(4)));
constexpr int BM = 256, BK = 64, HALF = 128, HTB = HALF * BK * 2  , STAGE_BYTES = 8 * HTB, NXCD = 8, WGM = 8;

__host__ __device__ __forceinline__ int lds_byte(int r, int c) { const int st = (r >> 4) * 2 + (c >> 5), rr = r & 15, cc = c & 31, ob = rr * 64 + cc * 2; return st * 1024 + (ob ^ (((ob >> 9) & 1) << 5)); }
__host__ __device__ __forceinline__ void stage_rc(int b, int& R, int& C) { const int st = b / 1024, sb = b % 1024, swz = sb ^ (((sb >> 9) & 1) << 5); R = (st >> 1) * 16 + swz / 64; C = (st & 1) * 32 + (swz % 64) / 2; }
__host__ __device__ __forceinline__ int perm32(int rho) { const int n = rho >> 4, i = rho & 15; return 8 * (i >> 2) + 4 * n + (i & 3); }

struct Unit { int pm, pn; };
struct Gemm { const bf16_t* A; const bf16_t* Bt; int M, N, K, lda; };

struct StaticOrder {
    int nM, nN, nwg, G, c;
    __host__ __device__ void init(int M, int N, int G_, int c_) { nM = M / BM; nN = N / BM; nwg = nM * nN; G = G_; c = c_; }
    __host__ __device__ bool next(int i, Unit& u) const {
        const long L = (long)i * G + c; if (L >= nwg) return false;
        int wgid = (int)L; { const int q = nwg / NXCD, r = nwg % NXCD, xcd = wgid % NXCD, off = wgid / NXCD; wgid = (xcd < r ? xcd * (q + 1) : r * (q + 1) + (xcd - r) * q) + off; }
        const int nig = WGM * nN, gid = wgid / nig, fm = gid * WGM, gsz = (nM - fm) < WGM ? (nM - fm) : WGM;
        u.pm = fm + ((wgid % nig) % gsz); u.pn = (wgid % nig) / gsz; return true;
    }
    __device__ __forceinline__ void a_ready(const Unit&) const {}
    __device__ __forceinline__ void done(const Unit&) const {}
};


template <class Epi, class Sched, bool ALIGN_EPI = false, bool SP2 = false>
__device__ __forceinline__ void gemm_phase(PG8_LAS unsigned char* lds, const Gemm g, const Sched& S, const Epi& E) {
    int tid_l = threadIdx.x; asm volatile("" : "+v"(tid_l));
    const int tid = tid_l, wid = __builtin_amdgcn_readfirstlane(tid >> 6), lane = tid & 63, wr = wid >> 2, wc = wid & 3, fr = lane & 15, fq = lane >> 4;
    const int K = g.K, nt = K / BK;
    unsigned voffA[2], voffB[2];
#pragma unroll
    for (int i = 0; i < 2; ++i) { int R, C; stage_rc(tid * 16 + i * 8192, R, C); const int Rb = Epi::PERM ? ((R & ~31) + perm32(R & 31)) : R;
        voffA[i] = (unsigned)(R * g.lda + C) * 2u; voffB[i] = (unsigned)(Rb * K + C) * 2u; }
    const size_t kstep = (size_t)(BK * 2);
    const size_t hstepB = (size_t)HALF * K * 2, hstepA = (size_t)HALF * g.lda * 2;
    const size_t tstepB = 2 * hstepB, tstepA = 2 * hstepA;
    const unsigned ldsw = (unsigned)wid * 1024u;
    const int aoff = lds_byte(wr * 64 + fr, fq * 8), boff = lds_byte(wc * 32 + fr, fq * 8);
#define PG8_SA(b, h) (((b) * 2 + (h)) * HTB)
#define PG8_SB(b, h) ((4 + (b) * 2 + (h)) * HTB)
#define PG8_STAGE(bufoff, gbase, voff) do { _Pragma("unroll") for (int _i = 0; _i < 2; ++_i) \
        __builtin_amdgcn_global_load_lds((const unsigned*)((const char*)(gbase) + (voff)[_i]), (PG8_LAS unsigned*)(lds + (bufoff) + ldsw + _i * 8192), 16, 0, 0); } while (0)
#define PG8_LDA(dst, b, h) do { _Pragma("unroll") for (int m = 0; m < 4; ++m) _Pragma("unroll") for (int k = 0; k < 2; ++k) dst[m][k] = *(const PG8_LAS bf16x8*)(lds + PG8_SA(b, h) + aoff + m * 2048 + k * 1024); } while (0)
#define PG8_LDB(dst, b, h) do { _Pragma("unroll") for (int n = 0; n < 2; ++n) _Pragma("unroll") for (int k = 0; k < 2; ++k) dst[n][k] = *(const PG8_LAS bf16x8*)(lds + PG8_SB(b, h) + boff + n * 2048 + k * 1024); } while (0)
#define PG8_MMA(ai, bj, At, Bt) do { __builtin_amdgcn_s_setprio(1); _Pragma("unroll") for (int m = 0; m < 4; ++m) _Pragma("unroll") for (int n = 0; n < 2; ++n) _Pragma("unroll") for (int k = 0; k < 2; ++k) \
        acc[ai][bj][m][n] = __builtin_amdgcn_mfma_f32_16x16x32_bf16(Bt[n][k], At[m][k], acc[ai][bj][m][n], 0, 0, 0); __builtin_amdgcn_s_setprio(0); } while (0)
#define PG8_WAIT_V(n) asm volatile("s_waitcnt vmcnt(" #n ")" ::: "memory")
#define PG8_WAIT_L(n) asm volatile("s_waitcnt lgkmcnt(" #n ")" ::: "memory")
#define PG8_BAR __builtin_amdgcn_s_barrier()
#define PG8_SCHED __builtin_amdgcn_sched_barrier(0)
    Unit cur, nxt; int ui = 0;
    if (!S.next(0, cur)) return;
    f32x4 acc[2][2][4][2];
#pragma unroll
    for (int a = 0; a < 2; ++a)
#pragma unroll
        for (int b = 0; b < 2; ++b)
#pragma unroll
            for (int m = 0; m < 4; ++m)
#pragma unroll
                for (int n = 0; n < 2; ++n) acc[a][b][m][n] = (f32x4){0.f, 0.f, 0.f, 0.f};
    bf16x8 At[4][2], B0[2][2], B1[2][2];
    const char* cA = (const char*)g.A + (size_t)cur.pm * tstepA; const char* cB = (const char*)g.Bt + (size_t)cur.pn * tstepB;
    S.a_ready(cur);
    if constexpr (SP2) {
        PG8_STAGE(PG8_SB(0, 0), cB, voffB); PG8_STAGE(PG8_SB(0, 1), cB + hstepB, voffB); PG8_STAGE(PG8_SA(0, 0), cA, voffA); PG8_STAGE(PG8_SA(0, 1), cA + hstepA, voffA);
        if (wr == 1) PG8_BAR;
        PG8_WAIT_V(2); PG8_BAR;
        PG8_STAGE(PG8_SB(1, 0), cB + kstep, voffB); PG8_STAGE(PG8_SA(1, 0), cA + kstep, voffA); PG8_STAGE(PG8_SB(1, 1), cB + hstepB + kstep, voffB);
        PG8_WAIT_V(6); PG8_BAR;
    } else {
        PG8_STAGE(PG8_SB(0, 0), cB, voffB); PG8_STAGE(PG8_SA(0, 0), cA, voffA); PG8_STAGE(PG8_SB(0, 1), cB + hstepB, voffB); PG8_STAGE(PG8_SA(0, 1), cA + hstepA, voffA);
        if (wr == 1) PG8_BAR;
        PG8_WAIT_V(4); PG8_BAR;
        PG8_STAGE(PG8_SB(1, 0), cB + kstep, voffB); PG8_STAGE(PG8_SA(1, 0), cA + kstep, voffA); PG8_STAGE(PG8_SB(1, 1), cB + hstepB + kstep, voffB);
        PG8_WAIT_V(6); PG8_BAR;
    }
    for (;;) {
        const bool has_next = S.next(ui + 1, nxt);
        const char* nA = has_next ? (const char*)g.A + (size_t)nxt.pm * tstepA : cA; const char* nB = has_next ? (const char*)g.Bt + (size_t)nxt.pn * tstepB : cB;
        for (int t = 0; t < nt; t += 2) {
            const bool last = (t == nt - 2);
            const char* a1 = cA + (size_t)(t + 1) * kstep;
            const char* a2 = last ? nA : cA + (size_t)(t + 2) * kstep; const char* b2 = last ? nB : cB + (size_t)(t + 2) * kstep;
            const char* a3 = a2 + kstep; const char* b3 = b2 + kstep;
            if (last && has_next) S.a_ready(nxt);
            if constexpr (SP2) {
            PG8_LDB(B0, 0, 0); PG8_LDB(B1, 0, 1); PG8_SCHED; PG8_LDA(At, 0, 0); PG8_STAGE(PG8_SA(1, 1), a1 + hstepA, voffA);
            PG8_WAIT_V(8); PG8_WAIT_L(0); PG8_BAR; PG8_MMA(0, 0, At, B0); PG8_MMA(0, 1, At, B1); PG8_BAR; PG8_SCHED;
            PG8_LDA(At, 0, 1); PG8_STAGE(PG8_SB(0, 0), b2, voffB); PG8_STAGE(PG8_SB(0, 1), b2 + hstepB, voffB); PG8_STAGE(PG8_SA(0, 0), a2, voffA);
            PG8_WAIT_V(8); PG8_WAIT_L(0); PG8_BAR; PG8_MMA(1, 0, At, B0); PG8_MMA(1, 1, At, B1); PG8_BAR; PG8_SCHED;
            PG8_LDB(B0, 1, 0); PG8_LDB(B1, 1, 1); PG8_SCHED; PG8_LDA(At, 1, 0); PG8_STAGE(PG8_SA(0, 1), a2 + hstepA, voffA);
            PG8_WAIT_V(8); PG8_WAIT_L(0); PG8_BAR; PG8_MMA(0, 0, At, B0); PG8_MMA(0, 1, At, B1); PG8_BAR; PG8_SCHED;
            PG8_LDA(At, 1, 1); PG8_STAGE(PG8_SB(1, 0), b3, voffB); PG8_STAGE(PG8_SB(1, 1), b3 + hstepB, voffB); PG8_STAGE(PG8_SA(1, 0), a3, voffA);
            PG8_WAIT_V(8); PG8_WAIT_L(0); PG8_BAR; PG8_MMA(1, 0, At, B0); PG8_MMA(1, 1, At, B1); PG8_BAR; PG8_SCHED;
            } else {
            PG8_LDB(B0, 0, 0); PG8_SCHED; PG8_LDA(At, 0, 0); PG8_STAGE(PG8_SA(1, 1), a1 + hstepA, voffA);
            PG8_WAIT_L(8); PG8_BAR; PG8_WAIT_L(0); PG8_MMA(0, 0, At, B0); PG8_BAR; PG8_SCHED;
            PG8_LDB(B1, 0, 1); PG8_STAGE(PG8_SB(0, 0), b2, voffB);
            PG8_BAR; PG8_WAIT_L(0); PG8_MMA(0, 1, At, B1); PG8_BAR;
            PG8_LDA(At, 0, 1); PG8_STAGE(PG8_SA(0, 0), a2, voffA);
            PG8_BAR; PG8_WAIT_L(0); PG8_MMA(1, 0, At, B0); PG8_BAR; PG8_SCHED;
            PG8_STAGE(PG8_SB(0, 1), b2 + hstepB, voffB);
            PG8_WAIT_V(6); PG8_BAR; PG8_MMA(1, 1, At, B1); PG8_BAR;
            PG8_LDB(B0, 1, 0); PG8_SCHED; PG8_LDA(At, 1, 0); PG8_STAGE(PG8_SA(0, 1), a2 + hstepA, voffA);
            PG8_WAIT_L(8); PG8_BAR; PG8_WAIT_L(0); PG8_MMA(0, 0, At, B0); PG8_BAR; PG8_SCHED;
            PG8_LDB(B1, 1, 1); PG8_STAGE(PG8_SB(1, 0), b3, voffB);
            PG8_BAR; PG8_WAIT_L(0); PG8_MMA(0, 1, At, B1); PG8_BAR;
            PG8_LDA(At, 1, 1); PG8_STAGE(PG8_SA(1, 0), a3, voffA);
            PG8_BAR; PG8_WAIT_L(0); PG8_MMA(1, 0, At, B0); PG8_BAR; PG8_SCHED;
            PG8_STAGE(PG8_SB(1, 1), b3 + hstepB, voffB);
            PG8_WAIT_V(6); PG8_BAR; PG8_MMA(1, 1, At, B1); PG8_BAR;
            }
        }
        if constexpr (ALIGN_EPI) { if (wr == 0) PG8_BAR; }
        if constexpr (!Epi::AFTER_DRAIN) { E(acc, cur, wr, wc, fr, fq); S.done(cur); }
        if (!has_next) break;
#pragma unroll
        for (int a = 0; a < 2; ++a)
#pragma unroll
            for (int b = 0; b < 2; ++b)
#pragma unroll
                for (int m = 0; m < 4; ++m)
#pragma unroll
                    for (int n = 0; n < 2; ++n) acc[a][b][m][n] = (f32x4){0.f, 0.f, 0.f, 0.f};
        cur = nxt; cA = nA; cB = nB; ++ui;
        if constexpr (ALIGN_EPI) { if (wr == 1) PG8_BAR; }
    }
    PG8_WAIT_V(0);
    if constexpr (!ALIGN_EPI) { if (wr == 0) PG8_BAR; }
    PG8_BAR;
    if constexpr (Epi::AFTER_DRAIN) { E.fused(acc, cur, wr, wc, fr, fq, lds, wid, lane); S.done(cur); }
#undef PG8_SA
#undef PG8_SB
#undef PG8_STAGE
#undef PG8_LDA
#undef PG8_LDB
#undef PG8_MMA
#undef PG8_WAIT_V
#undef PG8_WAIT_L
#undef PG8_BAR
#undef PG8_SCHED
}
}

constexpr int NB = 4, SEQ = 4096, T = NB * SEQ, DM = 1024, DEPTH = 4;
constexpr int NPROJ = 10496;
constexpr int IN_COLS = 10260;
constexpr float NORM_EPS = 1e-6f;
constexpr float LOG2E = 1.4426950408889634f;

typedef unsigned short bf16_t;
typedef short bf16x8 __attribute__((ext_vector_type(8)));
typedef float f32x4 __attribute__((ext_vector_type(4)));
typedef float f32x2 __attribute__((ext_vector_type(2)));
typedef unsigned u32x4 __attribute__((ext_vector_type(4)));
typedef unsigned u32x2 __attribute__((ext_vector_type(2)));
typedef __bf16 bf16x2_t __attribute__((ext_vector_type(2)));

constexpr size_t MiB = 1u << 20;
constexpr size_t O_MOD = 0, O_X = 1 * MiB, O_H = 65 * MiB, O_UV = 97 * MiB, O_FQKV = 129 * MiB, O_MQKV = 177 * MiB, O_Z = 225 * MiB,
                 O_XBC = 249 * MiB, O_GATE = 289 * MiB, O_SMALL = 417 * MiB, O_VTF = 419 * MiB, O_VTM = 435 * MiB, O_XT = 451 * MiB,
                 O_BC = 475 * MiB, O_BT = 491 * MiB, O_ST = 499 * MiB, O_CUMF = 547 * MiB, O_ACUM = 548 * MiB, O_KMEAN = 549 * MiB,
                 O_WIN = 550 * MiB, O_WA = 571 * MiB, O_WB = 572 * MiB, O_WC = 573 * MiB, O_WD = 574 * MiB, O_WO = 576 * MiB,
                 O_W1 = 578 * MiB, O_W2 = 586 * MiB, O_GWS = 594 * MiB, WS_END = 595 * MiB;
constexpr size_t O_DT = O_KMEAN + 256 * 1024;
constexpr size_t O_CTL = 512 * 1024;
constexpr size_t O_PREV = O_XBC;
constexpr size_t O_HID = O_GATE;
constexpr size_t O_MF32 = O_VTF;
constexpr int LDS_BYTES = 147456;

struct Params { const float* in[26]; float* out; unsigned char* ws; int ph_lo, ph_hi; };

__device__ __forceinline__ int opq(int i) { asm volatile("" : "+s"(i)); return i; }
#define PIN(i) (p.in[opq(i)])
__device__ __forceinline__ unsigned cvtpk(float lo, float hi) { f32x2 v = {lo, hi}; bf16x2_t b = __builtin_convertvector(v, bf16x2_t); return __builtin_bit_cast(unsigned, b); }
__device__ __forceinline__ float bf2f(short h) { return __uint_as_float(((unsigned)(unsigned short)h) << 16); }
__device__ __forceinline__ float bflo(unsigned w) { return __uint_as_float(w << 16); }
__device__ __forceinline__ float bfhi(unsigned w) { return __uint_as_float(w & 0xffff0000u); }
__device__ __forceinline__ bf16x8 pack8(float a0, float a1, float a2, float a3, float a4, float a5, float a6, float a7) {
    u32x4 w = {cvtpk(a0, a1), cvtpk(a2, a3), cvtpk(a4, a5), cvtpk(a6, a7)}; return __builtin_bit_cast(bf16x8, w); }
__device__ __forceinline__ bf16x8 ld2x8(const bf16_t* p0, const bf16_t* p1) { const u32x2 a = *(const u32x2*)p0, b = *(const u32x2*)p1; u32x4 w = {a.x, a.y, b.x, b.y}; return __builtin_bit_cast(bf16x8, w); }
__device__ __forceinline__ f32x4 mfma16(bf16x8 a, bf16x8 b, f32x4 c) { return __builtin_amdgcn_mfma_f32_16x16x32_bf16(a, b, c, 0, 0, 0); }
__device__ __forceinline__ float wave_sum(float v) {
#pragma unroll
    for (int o = 1; o < 64; o <<= 1) v += __shfl_xor(v, o);
    return v; }
__device__ __forceinline__ float ex2(float x) { return __builtin_amdgcn_exp2f(x); }
__device__ __forceinline__ float sigmoidf_(float x) { return 1.f / (1.f + __expf(-x)); }
__device__ __forceinline__ float softplusf_(float x) { return fmaxf(x, 0.f) + log1pf(expf(-fabsf(x))); }
#define LDS_WAIT() asm volatile("s_waitcnt lgkmcnt(0)" ::: "memory")
#define VM_WAIT() asm volatile("s_waitcnt vmcnt(0)" ::: "memory")

#define EPI_LANE_SETUP() int t_ = threadIdx.x; asm volatile("" : "+v"(t_)); const int fr = t_ & 15, fq = (t_ >> 4) & 3; const int wv_ = __builtin_amdgcn_readfirstlane(t_ >> 6); const int wr = wv_ >> 2, wc = wv_ & 3
__device__ __forceinline__ float act_unified(float x, int act) {
    const float uu = 1.5957691216057308f * (x + 0.044715f * x * x * x);
    const float arg = (act == 1) ? uu : (act == 0) ? INFINITY : x;
    const float num = (act == 3) ? 1.f : x;
    return num * __builtin_amdgcn_rcpf(1.f + ex2(-LOG2E * arg));
}
struct EpiInproj {
    static constexpr bool PERM = true, AFTER_DRAIN = false;
    unsigned char* ws;
    __device__ __forceinline__ void operator()(const f32x4 (&acc)[2][2][4][2], const pg8::Unit& u, int, int, int, int) const {
        EPI_LANE_SETUP();
        const int pn = u.pn; const int row0 = u.pm * 256 + wr * 64 + fr;
        if (pn == 40) {
            if (wc == 0) {
                float* sm = (float*)(ws + O_SMALL);
#pragma unroll
                for (int ai = 0; ai < 2; ++ai)
#pragma unroll
                    for (int m = 0; m < 4; ++m) { float* rp = sm + (size_t)(row0 + ai * 128 + m * 16) * 32 + 8 * fq;
                        *(f32x4*)rp = acc[ai][0][m][0]; *(f32x4*)(rp + 4) = acc[ai][0][m][1]; }
            }
            return;
        }
        bf16_t* base; int pitch, ct, act;
        if (pn < 4) { base = (bf16_t*)(ws + O_UV); pitch = 1024; ct = pn; act = 1; }
        else if (pn < 10) { base = (bf16_t*)(ws + O_FQKV); pitch = 1536; ct = pn - 4; act = 0; }
        else if (pn < 16) { base = (bf16_t*)(ws + O_MQKV); pitch = 1536; ct = pn - 10; act = 0; }
        else if (pn < 19) { base = (bf16_t*)(ws + O_Z); pitch = 768; ct = pn - 16; act = 2; }
        else if (pn < 24) { base = (bf16_t*)(ws + O_XBC); pitch = 1280; ct = pn - 19; act = 0; }
        else { base = (bf16_t*)(ws + O_GATE); pitch = 4096; ct = pn - 24; act = 3; }
        const int col0 = ct * 256 + wc * 32 + 8 * fq;
#pragma unroll
        for (int ai = 0; ai < 2; ++ai)
#pragma unroll
            for (int m = 0; m < 4; ++m) { bf16_t* rowp = base + (size_t)(row0 + ai * 128 + m * 16) * pitch + col0;
#pragma unroll
                for (int bj = 0; bj < 2; ++bj) { f32x4 v0 = acc[ai][bj][m][0], v1 = acc[ai][bj][m][1];
#pragma unroll
                    for (int j = 0; j < 4; ++j) { v0[j] = act_unified(v0[j], act); v1[j] = act_unified(v1[j], act); }
                    u32x4 w; w.x = cvtpk(v0[0], v0[1]); w.y = cvtpk(v0[2], v0[3]); w.z = cvtpk(v1[0], v1[1]); w.w = cvtpk(v1[2], v1[3]);
                    *(u32x4*)(rowp + bj * 128) = w; }
                asm volatile("" ::: "memory"); }
    }
};
struct EpiMerge {
    static constexpr bool PERM = true, AFTER_DRAIN = false;
    const bf16_t* gate; float* mf; bf16_t* outb; int mode;
    __device__ __forceinline__ void operator()(const f32x4 (&acc)[2][2][4][2], const pg8::Unit& u, int, int, int, int) const {
        EPI_LANE_SETUP();
        const int row0 = u.pm * 256 + wr * 64 + fr, col0 = u.pn * 256 + wc * 32 + 8 * fq;
#pragma unroll
        for (int ai = 0; ai < 2; ++ai)
#pragma unroll
            for (int m = 0; m < 4; ++m) { const size_t row = (size_t)(row0 + ai * 128 + m * 16);
#pragma unroll
                for (int bj = 0; bj < 2; ++bj) { const int col = col0 + bj * 128;
                    const u32x4 gw = *(const u32x4*)(gate + row * 4096 + col);
                    f32x4 v0 = acc[ai][bj][m][0], v1 = acc[ai][bj][m][1];
                    v0[0] *= bflo(gw.x); v0[1] *= bfhi(gw.x); v0[2] *= bflo(gw.y); v0[3] *= bfhi(gw.y); v1[0] *= bflo(gw.z); v1[1] *= bfhi(gw.z); v1[2] *= bflo(gw.w); v1[3] *= bfhi(gw.w);
                    float* mp = mf + row * 1024 + col;
                    if (mode == 0) { *(f32x4*)mp = v0; *(f32x4*)(mp + 4) = v1; }
                    else if (mode == 1) { *(f32x4*)mp = *(const f32x4*)mp + v0; *(f32x4*)(mp + 4) = *(const f32x4*)(mp + 4) + v1; }
                    else { v0 = *(const f32x4*)mp + v0; v1 = *(const f32x4*)(mp + 4) + v1; u32x4 w; w.x = cvtpk(v0[0], v0[1]); w.y = cvtpk(v0[2], v0[3]); w.z = cvtpk(v1[0], v1[1]); w.w = cvtpk(v1[2], v1[3]);
                        *(u32x4*)(outb + row * 1024 + col) = w; } }
                asm volatile("" ::: "memory"); }
    }
};
struct EpiResid {
    static constexpr bool PERM = true, AFTER_DRAIN = false;
    const float* xin; float* xout; const float* gmod;
    __device__ __forceinline__ void operator()(const f32x4 (&acc)[2][2][4][2], const pg8::Unit& u, int, int, int, int) const {
        EPI_LANE_SETUP();
        const int row0 = u.pm * 256 + wr * 64 + fr, col0 = u.pn * 256 + wc * 32 + 8 * fq; const int b = u.pm >> 4;
        const float* gp = gmod + (size_t)b * 6144 + col0;
#pragma unroll
        for (int ai = 0; ai < 2; ++ai)
#pragma unroll
            for (int m = 0; m < 4; ++m) { const size_t off = (size_t)(row0 + ai * 128 + m * 16) * 1024 + col0;
#pragma unroll
                for (int bj = 0; bj < 2; ++bj) { const int co = bj * 128; const f32x4 g0 = *(const f32x4*)(gp + co), g1 = *(const f32x4*)(gp + co + 4);
                    *(f32x4*)(xout + off + co) = *(const f32x4*)(xin + off + co) + g0 * acc[ai][bj][m][0];
                    *(f32x4*)(xout + off + co + 4) = *(const f32x4*)(xin + off + co + 4) + g1 * acc[ai][bj][m][1]; }
                asm volatile("" ::: "memory"); }
    }
};
struct EpiRelu2 {
    static constexpr bool PERM = true, AFTER_DRAIN = false;
    bf16_t* out;
    __device__ __forceinline__ void operator()(const f32x4 (&acc)[2][2][4][2], const pg8::Unit& u, int, int, int, int) const {
        EPI_LANE_SETUP();
        const int row0 = u.pm * 256 + wr * 64 + fr, col0 = u.pn * 256 + wc * 32 + 8 * fq;
#pragma unroll
        for (int ai = 0; ai < 2; ++ai)
#pragma unroll
            for (int m = 0; m < 4; ++m) { bf16_t* rowp = out + (size_t)(row0 + ai * 128 + m * 16) * 4096 + col0;
#pragma unroll
                for (int bj = 0; bj < 2; ++bj) { f32x4 v0 = acc[ai][bj][m][0], v1 = acc[ai][bj][m][1];
#pragma unroll
                    for (int j = 0; j < 4; ++j) { const float r0 = fmaxf(v0[j], 0.f), r1 = fmaxf(v1[j], 0.f); v0[j] = r0 * r0; v1[j] = r1 * r1; }
                    u32x4 w; w.x = cvtpk(v0[0], v0[1]); w.y = cvtpk(v0[2], v0[3]); w.z = cvtpk(v1[0], v1[1]); w.w = cvtpk(v1[2], v1[3]);
                    *(u32x4*)(rowp + bj * 128) = w; }
                asm volatile("" ::: "memory"); }
    }
};
struct EpiU {
    static constexpr bool PERM = true, AFTER_DRAIN = false;
    int kind, mode; const void* p0; void* p1; void* p2; int dry;
    __device__ __forceinline__ void operator()(const f32x4 (&acc)[2][2][4][2], const pg8::Unit& u, int a, int b, int c, int d) const {
        if (dry) return;
        if (kind == 0) { EpiInproj e{(unsigned char*)p1}; e(acc, u, a, b, c, d); }
        else if (kind == 1) { EpiMerge e{(const bf16_t*)p0, (float*)p1, (bf16_t*)p2, mode}; e(acc, u, a, b, c, d); }
        else if (kind == 2) { EpiResid e{(const float*)p0, (float*)p1, (const float*)p2}; e(acc, u, a, b, c, d); }
        else { EpiRelu2 e{(bf16_t*)p1}; e(acc, u, a, b, c, d); }
    }
};
template <class Epi>
__device__ __forceinline__ void run_gemm(unsigned char* lds, const bf16_t* A, int lda, const bf16_t* Bt, int N, int K, const Epi& E) {
    pg8::Gemm g{A, Bt, T, N, K, lda}; pg8::StaticOrder S; S.init(T, N, (int)gridDim.x, (int)blockIdx.x);
    pg8::gemm_phase<Epi, pg8::StaticOrder, true, true>((PG8_LAS unsigned char*)lds, g, S, E);
}

__device__ __forceinline__ void phase_pre(const Params& p, unsigned char* lds, const int tid) {
    float* cs = (float*)lds; float* red = cs + 4096;
    const float* c = PIN(1); const float* ada_w = PIN(2); const float* ada_b = PIN(3);
    float* mod = (float*)(p.ws + O_MOD);
    for (int i = tid; i < 4096; i += 512) { const float v = c[i]; cs[i] = v / (1.f + expf(-v)); }
    __syncthreads();
    const int jj = tid & 63, ks = tid >> 6;
    for (int it = blockIdx.x; it < DEPTH * 96; it += gridDim.x) {
        const int l = it / 96, jb = it % 96;
        const float* w = ada_w + (size_t)l * 1024 * 6144 + jb * 64 + jj;
        float a0 = 0.f, a1 = 0.f, a2 = 0.f, a3 = 0.f;
#pragma unroll 8
        for (int k = ks * 128; k < ks * 128 + 128; ++k) { const float wv = w[(size_t)k * 6144]; a0 += cs[k] * wv; a1 += cs[1024 + k] * wv; a2 += cs[2048 + k] * wv; a3 += cs[3072 + k] * wv; }
        red[(ks * 64 + jj) * 4 + 0] = a0; red[(ks * 64 + jj) * 4 + 1] = a1; red[(ks * 64 + jj) * 4 + 2] = a2; red[(ks * 64 + jj) * 4 + 3] = a3;
        __syncthreads();
        if (tid < 256) { const int b = tid >> 6, j2 = tid & 63; float s = 0.f;
#pragma unroll
            for (int q = 0; q < 8; ++q) s += red[(q * 64 + j2) * 4 + b];
            const int cc = jb * 64 + j2; mod[((size_t)l * 4 + b) * 6144 + cc] = s + ada_b[l * 6144 + cc]; }
        __syncthreads();
    }
}

__device__ __forceinline__ int inproj_src_col(int n) {
    if (n < 2560) return n;
    if (n < 6144) return n + 8;
    if (n < 10240) return n + 20;
    if (n < 10248) return 2560 + (n - 10240);
    if (n < 10260) return 6152 + (n - 10248);
    return -1;
}
__device__ __forceinline__ void transpose_item(const float* W, int K, int Nsrc, bf16_t* WT, float* scr, int k0, int n0, int lane, bool remap) {
    const int nd = n0 + (lane & 31); const int sc = remap ? inproj_src_col(nd) : nd;
#pragma unroll
    for (int i = 0; i < 32; ++i) { const int kk = 2 * i + (lane >> 5); scr[kk * 33 + (lane & 31)] = (sc >= 0) ? W[(size_t)(k0 + kk) * Nsrc + sc] : 0.f; }
    LDS_WAIT();
    const int c = lane & 7;
#pragma unroll
    for (int j = 0; j < 4; ++j) { const int n = (lane >> 3) + 8 * j; const float* s = scr + (8 * c) * 33 + n;
        u32x4 o; o.x = cvtpk(s[0 * 33], s[1 * 33]); o.y = cvtpk(s[2 * 33], s[3 * 33]); o.z = cvtpk(s[4 * 33], s[5 * 33]); o.w = cvtpk(s[6 * 33], s[7 * 33]);
        *(u32x4*)(WT + (size_t)(n0 + n) * K + k0 + 8 * c) = o; }
    LDS_WAIT();
}
__device__ __forceinline__ void convert_weights(const Params& p, int l, unsigned char* lds, int gw, int NGW, int wid, int lane) {
    float* scr = (float*)(lds + wid * 16384);
    unsigned char* ws = p.ws;
    constexpr int I_IN = 16 * (NPROJ / 32), I_BR = 8 * 32, I_D = 12 * 32, I_O = 16 * 32, I_1 = 16 * 128, I_2 = 64 * 32;
    constexpr int TOT = I_IN + 3 * I_BR + I_D + I_O + I_1 + I_2;
    for (int it = gw; it < TOT; it += NGW) {
        int r = it; const float* W; bf16_t* WT; int K, Nsrc, Nd; bool remap = false;
        if (r < I_IN) { W = PIN(5) + (size_t)l * 1024 * IN_COLS; WT = (bf16_t*)(ws + O_WIN); K = 1024; Nsrc = IN_COLS; Nd = NPROJ; remap = true; }
        else if ((r -= I_IN) < I_BR) { W = PIN(17) + (size_t)l * 512 * 1024; WT = (bf16_t*)(ws + O_WA); K = 512; Nsrc = 1024; Nd = 1024; }
        else if ((r -= I_BR) < I_BR) { W = PIN(18) + (size_t)l * 512 * 1024; WT = (bf16_t*)(ws + O_WB); K = 512; Nsrc = 1024; Nd = 1024; }
        else if ((r -= I_BR) < I_BR) { W = PIN(19) + (size_t)l * 512 * 1024; WT = (bf16_t*)(ws + O_WC); K = 512; Nsrc = 1024; Nd = 1024; }
        else if ((r -= I_BR) < I_D) { W = PIN(20) + (size_t)l * 768 * 1024; WT = (bf16_t*)(ws + O_WD); K = 768; Nsrc = 1024; Nd = 1024; }
        else if ((r -= I_D) < I_O) { W = PIN(21) + (size_t)l * 1024 * 1024; WT = (bf16_t*)(ws + O_WO); K = 1024; Nsrc = 1024; Nd = 1024; }
        else if ((r -= I_O) < I_1) { W = PIN(23) + (size_t)l * 1024 * 4096; WT = (bf16_t*)(ws + O_W1); K = 1024; Nsrc = 4096; Nd = 4096; }
        else { r -= I_1; W = PIN(24) + (size_t)l * 4096 * 1024; WT = (bf16_t*)(ws + O_W2); K = 4096; Nsrc = 1024; Nd = 1024; }
        const int nblk = Nd / 32, kb = r / nblk, nb = r % nblk;
        transpose_item(W, K, Nsrc, WT, scr, 64 * kb, 32 * nb, lane, remap);
    }
    const float* gws = PIN(8) + (size_t)l * 8 * 128 * 128; bf16_t* gd = (bf16_t*)(ws + O_GWS);
    for (int e = gw * 64 + lane; e < 8 * 128 * 128; e += NGW * 64) { const int s = e & 127, t = (e >> 7) & 127; const float v = (s <= t) ? gws[e] : 0.f; gd[e] = (bf16_t)(cvtpk(v, 0.f) & 0xffffu); }
}
__device__ __forceinline__ void norm_mod_rows(const float* x, const float* w, const float* sh, const float* sc, bf16_t* out, int gw, int NGW, int lane) {
    for (int row = gw; row < T; row += NGW) {
        const int b = row >> 12; const f32x4* xr = (const f32x4*)(x + (size_t)row * 1024) + lane;
        f32x4 v[4]; float ss = 0.f;
#pragma unroll
        for (int j = 0; j < 4; ++j) { v[j] = xr[64 * j]; ss += (v[j][0] * v[j][0] + v[j][1] * v[j][1]) + (v[j][2] * v[j][2] + v[j][3] * v[j][3]); }
        const float rstd = rsqrtf(wave_sum(ss) * (1.f / 1024.f) + NORM_EPS);
#pragma unroll
        for (int j = 0; j < 4; ++j) { const int col = 4 * (64 * j + lane);
            const f32x4 wv = *(const f32x4*)(w + col), sv = *(const f32x4*)(sc + (size_t)b * 6144 + col), hv = *(const f32x4*)(sh + (size_t)b * 6144 + col);
            const f32x4 o = (v[j] * rstd * wv) * (sv + 1.f) + hv;
            u32x2 pk; pk.x = cvtpk(o[0], o[1]); pk.y = cvtpk(o[2], o[3]); *(u32x2*)(out + (size_t)row * 1024 + col) = pk; }
    }
}
__device__ __forceinline__ void final_norm_rows(const float* x, const float* w, float* out, int gw, int NGW, int lane) {
    for (int row = gw; row < T; row += NGW) {
        const f32x4* xr = (const f32x4*)(x + (size_t)row * 1024) + lane;
        f32x4 v[4]; float ss = 0.f;
#pragma unroll
        for (int j = 0; j < 4; ++j) { v[j] = xr[64 * j]; ss += (v[j][0] * v[j][0] + v[j][1] * v[j][1]) + (v[j][2] * v[j][2] + v[j][3] * v[j][3]); }
        const float rstd = rsqrtf(wave_sum(ss) * (1.f / 1024.f) + NORM_EPS);
#pragma unroll
        for (int j = 0; j < 4; ++j) { const int col = 4 * (64 * j + lane); const f32x4 wv = *(const f32x4*)(w + col);
            *(f32x4*)(out + (size_t)row * 1024 + col) = v[j] * rstd * wv; }
    }
}

__device__ __forceinline__ void gmlp_item(const Params& p, int l, unsigned char* lds, int item, int wid, int lane, bool dry = false) {
    const int grp = item & 7, ch = (item >> 3) & 31, b = item >> 8;
    const int fr = lane & 15, fq = lane >> 4;
    bf16_t* UV = (bf16_t*)(p.ws + O_UV); const bf16_t* GWS = (const bf16_t*)(p.ws + O_GWS);
    const float* lnw = PIN(6) + l * 512; const float* lnb = PIN(7) + l * 512; const float* bs = PIN(9) + (size_t)l * 8 * 128 + grp * 128;
    bf16_t* vnT = (bf16_t*)lds;
    const size_t row0 = (size_t)b * SEQ + ch * 128;
#pragma unroll 8
    for (int r = 0; r < 16; ++r) {
        const int s = wid * 16 + r;
        const bf16x8 raw = *(const bf16x8*)(UV + (row0 + s) * 1024 + 512 + 8 * lane);
        float x[8]; float sum = 0.f;
#pragma unroll
        for (int j = 0; j < 8; ++j) { x[j] = bf2f(raw[j]); sum += x[j]; }
        const float mean = wave_sum(sum) * (1.f / 512.f); float sq = 0.f;
#pragma unroll
        for (int j = 0; j < 8; ++j) { x[j] -= mean; sq += x[j] * x[j]; }
        const float rstd = rsqrtf(wave_sum(sq) * (1.f / 512.f) + NORM_EPS);
        if ((lane >> 3) == grp) { const int c0 = (lane & 7) * 8;
#pragma unroll
            for (int j = 0; j < 8; ++j) { const int cc = grp * 64 + c0 + j; const float o = x[j] * rstd * lnw[cc] + lnb[cc]; vnT[(c0 + j) * 136 + s] = (bf16_t)(cvtpk(o, 0.f) & 0xffffu); } }
    }
    __syncthreads();
    const int t0 = wid * 16;
    f32x4 acc[4];
#pragma unroll
    for (int ct = 0; ct < 4; ++ct) acc[ct] = (f32x4){0.f, 0.f, 0.f, 0.f};
    const int nks = (t0 + 15) / 32 + 1;
    for (int ks = 0; ks < nks; ++ks) {
        const bf16x8 bw = *(const bf16x8*)(GWS + ((size_t)grp * 128 + t0 + fr) * 128 + ks * 32 + 8 * fq);
#pragma unroll
        for (int ct = 0; ct < 4; ++ct) { const bf16x8 av = *(const bf16x8*)(vnT + (ct * 16 + fr) * 136 + ks * 32 + 8 * fq); acc[ct] = mfma16(av, bw, acc[ct]); }
    }
    const float bsv = bs[t0 + fr];
#pragma unroll
    for (int ct = 0; ct < 4; ++ct) { bf16_t* up = UV + (row0 + t0 + fr) * 1024 + grp * 64 + ct * 16 + 4 * fq;
        const u32x2 uw = *(const u32x2*)up; u32x2 o;
        o.x = cvtpk(bflo(uw.x) * (acc[ct][0] + bsv), bfhi(uw.x) * (acc[ct][1] + bsv)); o.y = cvtpk(bflo(uw.y) * (acc[ct][2] + bsv), bfhi(uw.y) * (acc[ct][3] + bsv));
        if (!dry) *(u32x2*)up = o; }
    __syncthreads();
}
__device__ __forceinline__ void rotary_item(const Params& p, unsigned char* lds, int item, int tid, bool dry = false) {
    const int h = item & 7, nb = (item >> 3) & 15, b = item >> 7;
    float* sums = (float*)lds;
    if (tid < 64) sums[tid] = 0.f;
    __syncthreads();
    bf16_t* MQ = (bf16_t*)(p.ws + O_MQKV);
    const int tt = tid >> 1, half = tid & 1; const int pos = nb * 256 + tt; const size_t row = (size_t)b * SEQ + pos;
    bf16_t* kp = MQ + row * 1536 + 512 + h * 64 + half * 32;
    float kv[32];
#pragma unroll
    for (int q = 0; q < 4; ++q) { const bf16x8 raw = *(const bf16x8*)(kp + 8 * q);
#pragma unroll
        for (int j = 0; j < 8; ++j) kv[8 * q + j] = bf2f(raw[j]); }
    if (half == 0 && !dry) {
        bf16_t* qp = MQ + row * 1536 + h * 64;
        float qv[16];
        { const bf16x8 r0 = *(const bf16x8*)qp, r1 = *(const bf16x8*)(qp + 8);
#pragma unroll
          for (int j = 0; j < 8; ++j) { qv[j] = bf2f(r0[j]); qv[8 + j] = bf2f(r1[j]); } }
#pragma unroll
        for (int j = 0; j < 8; ++j) {
            const float inv_freq = powf(500000.0f, -(float)j * 0.125f); const float ang = (float)pos * inv_freq;
            const float cs = cosf(ang), sn = sinf(ang);
            const float k1 = kv[j], k2 = kv[8 + j]; kv[j] = k1 * cs - k2 * sn; kv[8 + j] = k2 * cs + k1 * sn;
            const float q1 = qv[j], q2 = qv[8 + j]; qv[j] = q1 * cs - q2 * sn; qv[8 + j] = q2 * cs + q1 * sn;
        }
        *(bf16x8*)kp = pack8(kv[0], kv[1], kv[2], kv[3], kv[4], kv[5], kv[6], kv[7]);
        *(bf16x8*)(kp + 8) = pack8(kv[8], kv[9], kv[10], kv[11], kv[12], kv[13], kv[14], kv[15]);
        *(bf16x8*)qp = pack8(qv[0], qv[1], qv[2], qv[3], qv[4], qv[5], qv[6], qv[7]);
        *(bf16x8*)(qp + 8) = pack8(qv[8], qv[9], qv[10], qv[11], qv[12], qv[13], qv[14], qv[15]);
    }
#pragma unroll
    for (int d = 0; d < 32; ++d) {
        float v = kv[d];
#pragma unroll
        for (int o = 2; o < 64; o <<= 1) v += __shfl_xor(v, o);
        if ((tid & 63) < 2) atomicAdd(&sums[half * 32 + d], v);
    }
    __syncthreads();
    if (tid < 64) ((float*)(p.ws + O_KMEAN))[(((size_t)b * 8 + h) * 16 + nb) * 64 + tid] = sums[tid] * (1.f / 256.f);
    __syncthreads();
}
__device__ __forceinline__ void vt_item(const Params& p, unsigned char* lds, int item, int tid) {
    const int tb = item & 31, h = (item >> 5) & 7, b = (item >> 8) & 3, which = item >> 10;
    const bf16_t* src = (const bf16_t*)(p.ws + (which ? O_MQKV : O_FQKV)) + ((size_t)b * SEQ + tb * 128) * 1536 + 1024 + h * 64;
    bf16_t* dst = (bf16_t*)(p.ws + (which ? O_VTM : O_VTF)) + ((size_t)(b * 8 + h) * 64) * 4096 + tb * 128;
    bf16_t* tl = (bf16_t*)lds;
    { const int tok = tid >> 2, dq = tid & 3;
      const bf16x8 r0 = *(const bf16x8*)(src + (size_t)tok * 1536 + dq * 16), r1 = *(const bf16x8*)(src + (size_t)tok * 1536 + dq * 16 + 8);
#pragma unroll
      for (int j = 0; j < 8; ++j) { tl[(dq * 16 + j) * 136 + tok] = (bf16_t)r0[j]; tl[(dq * 16 + 8 + j) * 136 + tok] = (bf16_t)r1[j]; } }
    __syncthreads();
    { const int d = tid >> 3, c = tid & 7;
      const bf16x8 a = *(const bf16x8*)(tl + d * 136 + c * 16), bq = *(const bf16x8*)(tl + d * 136 + c * 16 + 8);
      *(bf16x8*)(dst + (size_t)d * 4096 + c * 16) = a; *(bf16x8*)(dst + (size_t)d * 4096 + c * 16 + 8) = bq; }
    __syncthreads();
}
__device__ __forceinline__ void conv_item(const Params& p, int l, int item, int tid) {
    const int cb = item % 20, ch = (item / 20) & 31, b = item / 640;
    const int c = tid & 63, tg = tid >> 6; const int gc = cb * 64 + c;
    const int t00 = ch * 128 + tg * 16 - 3;
    const bf16_t* xp = (const bf16_t*)(p.ws + O_XBC) + ((size_t)b * SEQ) * 1280 + gc;
    float v[19];
#pragma unroll
    for (int r = 0; r < 19; ++r) { const int t = t00 + r; v[r] = (t >= 0) ? bf2f((short)xp[(size_t)(t < 0 ? 0 : t) * 1280]) : 0.f; }
    const float* cw = PIN(11) + (size_t)l * 4 * 1280 + gc; const float w0 = cw[0], w1 = cw[1280], w2 = cw[2560], w3 = cw[3840], cbv = PIN(12)[l * 1280 + gc];
    float o[16];
#pragma unroll
    for (int tt = 0; tt < 16; ++tt) { const float x = cbv + w0 * v[tt] + w1 * v[tt + 1] + w2 * v[tt + 2] + w3 * v[tt + 3]; o[tt] = x / (1.f + __expf(-x)); }
    const size_t tok0 = (size_t)b * SEQ + ch * 128 + tg * 16;
    const bf16x8 p0 = pack8(o[0], o[1], o[2], o[3], o[4], o[5], o[6], o[7]), p1 = pack8(o[8], o[9], o[10], o[11], o[12], o[13], o[14], o[15]);
    if (cb < 12) { bf16_t* d = (bf16_t*)(p.ws + O_XT) + ((size_t)(b * 12 + cb) * 64 + c) * 4096 + ch * 128 + tg * 16; *(bf16x8*)d = p0; *(bf16x8*)(d + 8) = p1; }
    else {
        bf16_t* BC = (bf16_t*)(p.ws + O_BC); const int bc = gc - 768;
#pragma unroll
        for (int tt = 0; tt < 8; ++tt) { BC[(tok0 + tt) * 512 + bc] = (bf16_t)p0[tt]; BC[(tok0 + 8 + tt) * 512 + bc] = (bf16_t)p1[tt]; }
        if (cb < 16) { bf16_t* d = (bf16_t*)(p.ws + O_BT) + ((size_t)b * 256 + bc) * 4096 + ch * 128 + tg * 16; *(bf16x8*)d = p0; *(bf16x8*)(d + 8) = p1; }
    }
}
__device__ __forceinline__ void acum_item(const Params& p, int l, int item, int lane) {
    const int ch = item & 31, h = (item >> 5) % 12, b = item / 384;
    const float* sm = (const float*)(p.ws + O_SMALL); const float a = -expf(PIN(14)[l * 12 + h]);
    const size_t tok = (size_t)b * SEQ + ch * 128 + 2 * lane;
    const float dtb = PIN(13)[l * 12 + h];
    const float d0 = softplusf_(sm[tok * 32 + 8 + h] + dtb), d1 = softplusf_(sm[(tok + 1) * 32 + 8 + h] + dtb);
    { f32x2 dd = {d0, d1}; *(f32x2*)((float*)(p.ws + O_DT) + ((size_t)(b * 12 + h)) * 4096 + ch * 128 + 2 * lane) = dd; }
    const float v0 = d0 * a, v1 = d1 * a;
    float sc = v0 + v1;
#pragma unroll
    for (int o = 1; o < 64; o <<= 1) { const float t = __shfl_up(sc, o); if (lane >= o) sc += t; }
    const float ex = sc - (v0 + v1);
    f32x2 r = {ex + v0, ex + v0 + v1};
    *(f32x2*)((float*)(p.ws + O_ACUM) + ((size_t)(b * 12 + h)) * 4096 + ch * 128 + 2 * lane) = r;
}
__device__ __forceinline__ void foxcum_item(const Params& p, int l, int item, int lane) {
    const int h = item & 7, b = item >> 3; const float fb = PIN(10)[l * 8 + h];
    const float* sm = (const float*)(p.ws + O_SMALL) + ((size_t)b * SEQ + lane * 64) * 32 + h;
    float* cum = (float*)(p.ws + O_CUMF) + (size_t)(b * 8 + h) * 4096 + lane * 64;
    float v[64];
#pragma unroll
    for (int i = 0; i < 64; ++i) v[i] = sm[(size_t)i * 32];
    float run = 0.f;
#pragma unroll
    for (int i = 0; i < 64; ++i) { const float x = v[i] + fb; run += fminf(x, 0.f) - __logf(1.f + __expf(-fabsf(x))); v[i] = run; }
    float sc = run;
#pragma unroll
    for (int o = 1; o < 64; o <<= 1) { const float t = __shfl_up(sc, o); if (lane >= o) sc += t; }
    const float ex = sc - run;
#pragma unroll
    for (int i = 0; i < 64; i += 4) { f32x4 w = {v[i] + ex, v[i + 1] + ex, v[i + 2] + ex, v[i + 3] + ex}; *(f32x4*)(cum + i) = w; }
}

template <bool MOBA, int VPITCH>
__device__ __forceinline__ void attn_tile64(const bf16_t* KL, const bf16_t* VL, const float* CL, int k0, bool diag, int kb,
                                            const bf16x8 (&qf)[2][2], const float (&cq)[2], const unsigned (&sel)[2], int qpos0, int fr, int fq,
                                            f32x4 (&lacc)[2], f32x4 (&o)[4][2]) {
    bf16x8 kf[4][2], vf[2][4]; f32x4 nck[4];
#pragma unroll
    for (int jk = 0; jk < 4; ++jk) { kf[jk][0] = *(const bf16x8*)(KL + (16 * jk + fr) * 72 + 8 * fq); kf[jk][1] = *(const bf16x8*)(KL + (16 * jk + fr) * 72 + 32 + 8 * fq); }
#pragma unroll
    for (int jk = 0; jk < 4; ++jk) nck[jk] = MOBA ? (f32x4){0.f, 0.f, 0.f, 0.f} : *(const f32x4*)(CL + 16 * jk + 4 * fq);
#pragma unroll
    for (int dt = 0; dt < 4; ++dt) { const bf16_t* vp = VL + (dt * 16 + fr) * VPITCH + 4 * fq; vf[0][dt] = ld2x8(vp, vp + 16); }
    __builtin_amdgcn_sched_barrier(0);
    f32x4 s[4][2];
#pragma unroll
    for (int jk = 0; jk < 4; ++jk)
#pragma unroll
        for (int jq = 0; jq < 2; ++jq) { f32x4 z = {0.f, 0.f, 0.f, 0.f}; z = mfma16(kf[jk][0], qf[jq][0], z); s[jk][jq] = mfma16(kf[jk][1], qf[jq][1], z); }
    __builtin_amdgcn_sched_barrier(0);
#pragma unroll
    for (int dt = 0; dt < 4; ++dt) { const bf16_t* vp = VL + (dt * 16 + fr) * VPITCH + 32 + 4 * fq; vf[1][dt] = ld2x8(vp, vp + 16); }
    __builtin_amdgcn_sched_barrier(0);
    constexpr float C2 = 0.125f * LOG2E;
#pragma unroll
    for (int jk = 0; jk < 4; ++jk)
#pragma unroll
        for (int jq = 0; jq < 2; ++jq)
#pragma unroll
            for (int i = 0; i < 4; ++i) s[jk][jq][i] = MOBA ? s[jk][jq][i] * C2 : fmaf(s[jk][jq][i], C2, nck[jk][i] + cq[jq]);
    if (diag) {
#pragma unroll
        for (int jk = 0; jk < 4; ++jk)
#pragma unroll
            for (int jq = 0; jq < 2; ++jq)
#pragma unroll
                for (int i = 0; i < 4; ++i) if (k0 + 16 * jk + 4 * fq + i > qpos0 + 16 * jq + fr) s[jk][jq][i] = -INFINITY;
    }
    if (MOBA && kb >= 0) {
#pragma unroll
        for (int jq = 0; jq < 2; ++jq) if (!((sel[jq] >> kb) & 1u)) {
#pragma unroll
            for (int jk = 0; jk < 4; ++jk) s[jk][jq] = (f32x4){-INFINITY, -INFINITY, -INFINITY, -INFINITY}; }
    }
    bf16x8 pb[2][2];
#pragma unroll
    for (int jq = 0; jq < 2; ++jq) {
#pragma unroll
        for (int jk = 0; jk < 4; ++jk)
#pragma unroll
            for (int i = 0; i < 4; ++i) s[jk][jq][i] = ex2(fminf(s[jk][jq][i], 100.f));
        pb[jq][0] = pack8(s[0][jq][0], s[0][jq][1], s[0][jq][2], s[0][jq][3], s[1][jq][0], s[1][jq][1], s[1][jq][2], s[1][jq][3]);
        pb[jq][1] = pack8(s[2][jq][0], s[2][jq][1], s[2][jq][2], s[2][jq][3], s[3][jq][0], s[3][jq][1], s[3][jq][2], s[3][jq][3]);
    }
    const u32x4 onesw = {0x3f803f80u, 0x3f803f80u, 0x3f803f80u, 0x3f803f80u}; const bf16x8 ones = __builtin_bit_cast(bf16x8, onesw);
#pragma unroll
    for (int hh = 0; hh < 2; ++hh) {
#pragma unroll
        for (int jq = 0; jq < 2; ++jq) lacc[jq] = mfma16(ones, pb[jq][hh], lacc[jq]);
#pragma unroll
        for (int dt = 0; dt < 4; ++dt)
#pragma unroll
            for (int jq = 0; jq < 2; ++jq) o[dt][jq] = mfma16(vf[hh][dt], pb[jq][hh], o[dt][jq]);
    }
}
template <bool MOBA>
__device__ __forceinline__ void attn_block_item(const Params& p, unsigned char* lds, int b, int h, int qb, int tid, int wid, int lane) {
    const int fr = lane & 15, fq = lane >> 4; const int q0 = qb * 256 + wid * 32;
    bf16_t* qkv = (bf16_t*)(p.ws + (MOBA ? O_MQKV : O_FQKV)) + ((size_t)b * SEQ) * 1536 + h * 64;
    const bf16_t* kbase = qkv + 512; const bf16_t* vtbase = (const bf16_t*)(p.ws + (MOBA ? O_VTM : O_VTF)) + ((size_t)(b * 8 + h) * 64) * 4096;
    const float* cum = (const float*)(p.ws + O_CUMF) + (size_t)(b * 8 + h) * 4096;
    bf16x8 qf[2][2];
#pragma unroll
    for (int jq = 0; jq < 2; ++jq)
#pragma unroll
        for (int ks = 0; ks < 2; ++ks) qf[jq][ks] = *(const bf16x8*)(qkv + (size_t)(q0 + 16 * jq + fr) * 1536 + ks * 32 + 8 * fq);
    float cq[2] = {0.f, 0.f}; unsigned sel[2] = {0u, 0u}; unsigned umask = 0u;
    const int own = qb;
    if (!MOBA) { cq[0] = cum[q0 + fr] * LOG2E; cq[1] = cum[q0 + 16 + fr] * LOG2E; }
    if (MOBA && own > 0) {
        const float* km = (const float*)(p.ws + O_KMEAN) + ((size_t)(b * 8 + h) * 16) * 64 + 16 * fq;
#pragma unroll
        for (int jq = 0; jq < 2; ++jq) {
            const bf16_t* qp = qkv + (size_t)(q0 + 16 * jq + fr) * 1536 + 16 * fq;
            const bf16x8 r0 = *(const bf16x8*)qp, r1 = *(const bf16x8*)(qp + 8);
            float qd[16];
#pragma unroll
            for (int j = 0; j < 8; ++j) { qd[j] = bf2f(r0[j]); qd[8 + j] = bf2f(r1[j]); }
            float gate[15];
#pragma unroll
            for (int n = 0; n < 15; ++n) {
                float a = -INFINITY;
                if (n < own) { a = 0.f;
#pragma unroll
                    for (int d = 0; d < 16; d += 4) { const f32x4 kk = *(const f32x4*)(km + n * 64 + d); a += qd[d] * kk[0] + qd[d + 1] * kk[1] + qd[d + 2] * kk[2] + qd[d + 3] * kk[3]; }
                    a += __shfl_xor(a, 16); a += __shfl_xor(a, 32); }
                gate[n] = a;
            }
            unsigned msk = 0u;
#pragma unroll
            for (int pass = 0; pass < 3; ++pass) { float best = -INFINITY; int bi = -1;
#pragma unroll
                for (int n = 0; n < 15; ++n) { const float v = ((msk >> n) & 1u) ? -INFINITY : gate[n]; if (v > best) { best = v; bi = n; } }
                if (bi >= 0) msk |= 1u << bi; }
            sel[jq] = msk;
        }
        umask = sel[0] | sel[1];
#pragma unroll
        for (int o2 = 1; o2 < 16; o2 <<= 1) umask |= __shfl_xor(umask, o2);
        umask = __builtin_amdgcn_readfirstlane(umask);
    }
    f32x4 lacc[2] = {(f32x4){0.f, 0.f, 0.f, 0.f}, (f32x4){0.f, 0.f, 0.f, 0.f}}; f32x4 o[4][2];
#pragma unroll
    for (int dt = 0; dt < 4; ++dt) { o[dt][0] = (f32x4){0.f, 0.f, 0.f, 0.f}; o[dt][1] = (f32x4){0.f, 0.f, 0.f, 0.f}; }
    const int NT = 2 * (qb + 1);
    constexpr int VP = 136;
    bf16_t* KLb = (bf16_t*)lds; bf16_t* VLb = KLb + 2 * 128 * 72;
    float* CLb = (float*)(VLb + 2 * 64 * VP);
    const int lr = tid >> 3, lc = (tid & 7) * 8;
    const int vr = tid >> 4, vc = (tid & 15) * 8;
    #define STEP_KT(i) (MOBA ? (((i) < 2) ? 2 * qb + (i) : (i) - 2) : (i))
    bf16x8 kreg0, kreg1, vreg0, vreg1; f32x4 creg = {0.f, 0.f, 0.f, 0.f};
    #define LOAD_STEP(kk0) do { kreg0 = *(const bf16x8*)(kbase + (size_t)((kk0) + lr) * 1536 + lc); kreg1 = *(const bf16x8*)(kbase + (size_t)((kk0) + 64 + lr) * 1536 + lc); \
        vreg0 = *(const bf16x8*)(vtbase + (size_t)vr * 4096 + (kk0) + vc); vreg1 = *(const bf16x8*)(vtbase + (size_t)(vr + 32) * 4096 + (kk0) + vc); \
        if (!MOBA && tid < 32) creg = *(const f32x4*)(cum + (kk0) + 4 * tid) * (-LOG2E); } while (0)
    #define STORE_STEP(bb) do { *(bf16x8*)(KLb + (bb) * 128 * 72 + lr * 72 + lc) = kreg0; *(bf16x8*)(KLb + (bb) * 128 * 72 + (lr + 64) * 72 + lc) = kreg1; \
        *(bf16x8*)(VLb + (bb) * 64 * VP + vr * VP + vc) = vreg0; *(bf16x8*)(VLb + (bb) * 64 * VP + (vr + 32) * VP + vc) = vreg1; \
        if (!MOBA && tid < 32) *(f32x4*)(CLb + (bb) * 128 + 4 * tid) = creg; } while (0)
    LOAD_STEP(STEP_KT(0) * 128); STORE_STEP(0);
    __syncthreads();
#pragma unroll 1
    for (int i = 0; i < NT; ++i) {
        const int k0 = STEP_KT(i) * 128; const int buf = i & 1;
        if (i + 1 < NT) LOAD_STEP(STEP_KT(i + 1) * 128);
        const bf16_t* KL = KLb + buf * 128 * 72; const bf16_t* VL = VLb + buf * 64 * VP; const float* CL = CLb + buf * 128;
        const int kb = k0 >> 8;
        const bool live = !MOBA || kb == own || ((umask >> kb) & 1u);
        if (live) {
#pragma unroll
            for (int hh = 0; hh < 2; ++hh) { const int k0h = k0 + 64 * hh;
                if (k0h <= q0 + 31) attn_tile64<MOBA, VP>(KL + hh * 64 * 72, VL + hh * 64, CL + hh * 64, k0h, k0h + 63 > q0, (MOBA && kb < own) ? kb : -1, qf, cq, sel, q0, fr, fq, lacc, o); }
        }
        if (i + 1 < NT) STORE_STEP(buf ^ 1);
        __syncthreads();
    }
    #undef STEP_KT
    #undef LOAD_STEP
    #undef STORE_STEP
#pragma unroll
    for (int jq = 0; jq < 2; ++jq) {
        const float inv = 1.f / lacc[jq][0];
        bf16_t* op = qkv + (size_t)(q0 + 16 * jq + fr) * 1536 + 4 * fq;
#pragma unroll
        for (int dt = 0; dt < 4; ++dt) { const f32x4 v = o[dt][jq] * inv; u32x2 w; w.x = cvtpk(v[0], v[1]); w.y = cvtpk(v[2], v[3]); *(u32x2*)(op + dt * 16) = w; }
    }
}
__device__ __forceinline__ void ssd_states_item(const Params& p, int item, int lane) {
    const int h = item % 12, c = (item / 12) & 31, b = item / 384; const int grp = h / 6;
    const int fr = lane & 15, fq = lane >> 4;
    const float* ac = (const float*)(p.ws + O_ACUM) + (size_t)(b * 12 + h) * 4096 + c * 128;
    const float* dtp = (const float*)(p.ws + O_DT) + (size_t)(b * 12 + h) * 4096 + c * 128;
    const bf16_t* XT = (const bf16_t*)(p.ws + O_XT) + ((size_t)(b * 12 + h) * 64) * 4096 + c * 128;
    const bf16_t* BT = (const bf16_t*)(p.ws + O_BT) + ((size_t)(b * 2 + grp) * 128) * 4096 + c * 128;
    float* ST = (float*)(p.ws + O_ST) + ((size_t)((b * 32 + c) * 12 + h)) * 8192;
    const float total = ac[127];
#pragma unroll 1
    for (int q2 = 0; q2 < 4; ++q2) {
        f32x4 acc[4][2];
#pragma unroll
        for (int pt = 0; pt < 4; ++pt) { acc[pt][0] = (f32x4){0.f, 0.f, 0.f, 0.f}; acc[pt][1] = (f32x4){0.f, 0.f, 0.f, 0.f}; }
#pragma unroll 1
        for (int ks = 0; ks < 4; ++ks) {
            const int s0 = ks * 32 + 8 * fq;
            const f32x4 a0 = *(const f32x4*)(ac + s0), a1 = *(const f32x4*)(ac + s0 + 4);
            const f32x4 d0 = *(const f32x4*)(dtp + s0), d1 = *(const f32x4*)(dtp + s0 + 4);
            float w8[8];
#pragma unroll
            for (int j = 0; j < 4; ++j) { w8[j] = expf(total - a0[j]) * d0[j]; w8[4 + j] = expf(total - a1[j]) * d1[j]; }
            const bf16x8 b0 = *(const bf16x8*)(BT + (size_t)((q2 * 2 + 0) * 16 + fr) * 4096 + s0), b1 = *(const bf16x8*)(BT + (size_t)((q2 * 2 + 1) * 16 + fr) * 4096 + s0);
#pragma unroll
            for (int pt = 0; pt < 4; ++pt) { const bf16x8 xa = *(const bf16x8*)(XT + (size_t)(pt * 16 + fr) * 4096 + s0);
                const bf16x8 af = pack8(bf2f(xa[0]) * w8[0], bf2f(xa[1]) * w8[1], bf2f(xa[2]) * w8[2], bf2f(xa[3]) * w8[3], bf2f(xa[4]) * w8[4], bf2f(xa[5]) * w8[5], bf2f(xa[6]) * w8[6], bf2f(xa[7]) * w8[7]);
                acc[pt][0] = mfma16(af, b0, acc[pt][0]); acc[pt][1] = mfma16(af, b1, acc[pt][1]); }
        }
#pragma unroll
        for (int pt = 0; pt < 4; ++pt)
#pragma unroll
            for (int nt = 0; nt < 2; ++nt)
#pragma unroll
                for (int i = 0; i < 4; ++i) ST[(size_t)(pt * 16 + 4 * fq + i) * 128 + (q2 * 2 + nt) * 16 + fr] = acc[pt][nt][i];
    }
}
__device__ __forceinline__ void ssd_scan(const Params& p, int gtid, int gthreads) {
    const float* ST = (const float*)(p.ws + O_ST); bf16_t* PV = (bf16_t*)(p.ws + O_PREV); const float* ACUM = (const float*)(p.ws + O_ACUM);
    for (int e = gtid; e < NB * 12 * 8192; e += gthreads) {
        const int pn = e & 8191, h = (e >> 13) % 12, b = e / (12 * 8192);
        const float* ac = ACUM + (size_t)(b * 12 + h) * 4096 + 127;
        const size_t base = ((size_t)(b * 32) * 12 + h) * 8192 + pn;
        float st[32], dc[32];
#pragma unroll
        for (int c = 0; c < 32; ++c) { st[c] = ST[base + (size_t)c * 12 * 8192]; dc[c] = ac[c * 128]; }
        float hs = 0.f;
#pragma unroll
        for (int c = 0; c < 32; ++c) { PV[base + (size_t)c * 12 * 8192] = (bf16_t)(cvtpk(hs, 0.f) & 0xffffu); hs = hs * __expf(dc[c]) + st[c]; }
    }
}
__device__ __forceinline__ void ssd_out_item(const Params& p, int l, int item, int wid, int lane, bool dry = false) {
    const int grp = item & 1, c = (item >> 1) & 31, b = item >> 6;
    const int fr = lane & 15, fq = lane >> 4; const int w = wid; const int tl = 16 * w + fr;
    const size_t row0 = (size_t)b * SEQ + c * 128; const size_t row = row0 + tl;
    const bf16_t* BC = (const bf16_t*)(p.ws + O_BC);
    bf16_t* Z = (bf16_t*)(p.ws + O_Z);
    bf16x8 cf[4];
#pragma unroll
    for (int ks = 0; ks < 4; ++ks) cf[ks] = *(const bf16x8*)(BC + row * 512 + 256 + grp * 128 + ks * 32 + 8 * fq);
    f32x4 cbt[8];
#pragma unroll
    for (int js = 0; js < 8; ++js) { cbt[js] = (f32x4){0.f, 0.f, 0.f, 0.f};
        if (js <= w) {
#pragma unroll
            for (int ks = 0; ks < 4; ++ks) { const bf16x8 a = *(const bf16x8*)(BC + (row0 + js * 16 + fr) * 512 + grp * 128 + ks * 32 + 8 * fq); cbt[js] = mfma16(a, cf[ks], cbt[js]); } } }
    float ssq = 0.f;
#pragma unroll 1
    for (int r = 0; r < 6; ++r) {
        const int h = grp * 6 + r;
        const float* ac = (const float*)(p.ws + O_ACUM) + (size_t)(b * 12 + h) * 4096 + c * 128;
        const float* dtp = (const float*)(p.ws + O_DT) + (size_t)(b * 12 + h) * 4096 + c * 128;
        const float acl = ac[tl]; const float eacl = expf(acl); const float Dh = PIN(15)[l * 12 + h];
        const bf16_t* PV = (const bf16_t*)(p.ws + O_PREV) + ((size_t)((b * 32 + c) * 12 + h)) * 8192;
        const bf16_t* XT = (const bf16_t*)(p.ws + O_XT) + ((size_t)(b * 12 + h) * 64) * 4096 + c * 128;
        f32x4 yt[4];
#pragma unroll
        for (int pt = 0; pt < 4; ++pt) yt[pt] = (f32x4){0.f, 0.f, 0.f, 0.f};
#pragma unroll
        for (int ks = 0; ks < 4; ++ks)
#pragma unroll
            for (int pt = 0; pt < 4; ++pt) { const bf16x8 a = *(const bf16x8*)(PV + (size_t)(pt * 16 + fr) * 128 + ks * 32 + 8 * fq); yt[pt] = mfma16(a, cf[ks], yt[pt]); }
#pragma unroll
        for (int pt = 0; pt < 4; ++pt) yt[pt] = yt[pt] * eacl;
#pragma unroll
        for (int jp = 0; jp < 4; ++jp) {
            if (2 * jp <= w) {
                const int sA = 32 * jp + 4 * fq, sB = sA + 16;
                const f32x4 a0 = *(const f32x4*)(ac + sA), a1 = *(const f32x4*)(ac + sB), dv0 = *(const f32x4*)(dtp + sA), dv1 = *(const f32x4*)(dtp + sB);
                float mv[8];
#pragma unroll
                for (int j = 0; j < 4; ++j) {
                    const int s = sA + j; const float d0 = dv0[j];
                    float v = (s <= tl) ? cbt[2 * jp][j] * expf(acl - a0[j]) * d0 : 0.f; if (s == tl) v += Dh; mv[j] = v;
                    const int s2 = sB + j; const float d1 = dv1[j];
                    float v2 = (s2 <= tl) ? cbt[2 * jp + 1][j] * expf(acl - a1[j]) * d1 : 0.f; if (s2 == tl) v2 += Dh; mv[4 + j] = v2;
                }
                const bf16x8 mb = pack8(mv[0], mv[1], mv[2], mv[3], mv[4], mv[5], mv[6], mv[7]);
#pragma unroll
                for (int pt = 0; pt < 4; ++pt) { const bf16_t* xp = XT + (size_t)(pt * 16 + fr) * 4096 + sA; yt[pt] = mfma16(ld2x8(xp, xp + 16), mb, yt[pt]); }
            }
        }
#pragma unroll
        for (int pt = 0; pt < 4; ++pt) { bf16_t* zp = Z + row * 768 + h * 64 + pt * 16 + 4 * fq; const u32x2 zw = *(const u32x2*)zp;
            const float y0 = yt[pt][0] * bflo(zw.x), y1 = yt[pt][1] * bfhi(zw.x), y2 = yt[pt][2] * bflo(zw.y), y3 = yt[pt][3] * bfhi(zw.y);
            ssq += (y0 * y0 + y1 * y1) + (y2 * y2 + y3 * y3);
            u32x2 o; o.x = cvtpk(y0, y1); o.y = cvtpk(y2, y3); if (!dry) *(u32x2*)zp = o; }
    }
    ssq += __shfl_xor(ssq, 16); ssq += __shfl_xor(ssq, 32);
    if (dry) return;
    const float rstd = rsqrtf(ssq * (1.f / 384.f) + NORM_EPS);
    VM_WAIT();
    const float* nw = PIN(16) + l * 768 + grp * 384;
    bf16_t* zp0 = Z + row * 768 + grp * 384 + 4 * fq;
#pragma unroll 4
    for (int q = 0; q < 24; ++q) { bf16_t* zp = zp0 + q * 16; const u32x2 zw = *(const u32x2*)zp; const f32x4 nv = *(const f32x4*)(nw + q * 16 + 4 * fq);
        u32x2 o; o.x = cvtpk(bflo(zw.x) * rstd * nv[0], bfhi(zw.x) * rstd * nv[1]); o.y = cvtpk(bflo(zw.y) * rstd * nv[2], bfhi(zw.y) * rstd * nv[3]); *(u32x2*)zp = o; }
}

#define LAS __attribute__((address_space(3)))
#define XB_TMO      128
#define XB_XCNT(j)  (256  + 64 * (j))
#define XB_XSUB(j)  (1280 + 64 * (j))
#define XB_XGEN(j)  (2304 + 64 * (j))
#define XB_TOP      3328
#define XB_TOPGEN   3392
#define XCD_BAR_WORDS 3456
#define XB_SPIN_CAP (1u << 18)

__device__ __forceinline__ unsigned xb_ld(unsigned* p)              { return __hip_atomic_load(p, __ATOMIC_RELAXED, __HIP_MEMORY_SCOPE_AGENT); }
__device__ __forceinline__ unsigned xb_add(unsigned* p, unsigned v) { return __hip_atomic_fetch_add(p, v, __ATOMIC_RELAXED, __HIP_MEMORY_SCOPE_AGENT); }
__device__ __forceinline__ unsigned xb_xcc_id() { return (unsigned)__builtin_amdgcn_s_getreg((3 << 11) | 20) & 0xFu; }
#define XB_SPIN(cond, bar) do { unsigned _sp = 0; while (cond) { __builtin_amdgcn_s_sleep(1); \
    if ((++_sp & 255u) == 0u) { if (xb_ld(&(bar)[XB_TMO])) break; if (_sp > XB_SPIN_CAP) { atomicAdd(&(bar)[XB_TMO], 1u); break; } } } } while (0)

struct XcdBarrier {
    unsigned* bar; unsigned x;
    volatile LAS unsigned* st;
};

__device__ __forceinline__ XcdBarrier xcd_barrier_post(unsigned* bar, volatile LAS unsigned* st) {
    XcdBarrier b; b.bar = bar; b.x = xb_xcc_id(); b.st = st;
    if (threadIdx.x == 0) (void)xb_add(&bar[XB_XCNT(b.x)], 1u);
    return b;
}
__device__ __forceinline__ void xcd_barrier_complete(unsigned* bar, unsigned x, unsigned& nloc, unsigned& nx) {
    const unsigned G = gridDim.x * gridDim.y * gridDim.z;
    unsigned sum, cnt, mine, sp = 0u;
    for (;;) {
        sum = 0u; cnt = 0u; mine = 0u;
#pragma unroll
        for (unsigned j = 0; j < 16; ++j) { const unsigned c = xb_ld(&bar[XB_XCNT(j)]); sum += c; cnt += (c > 0u) ? 1u : 0u; mine = (j == x) ? c : mine; }
        if (sum == G) break;
        __builtin_amdgcn_s_sleep(1);
        if ((++sp & 255u) == 0u) { if (xb_ld(&bar[XB_TMO])) break; if (sp > XB_SPIN_CAP) { atomicAdd(&bar[XB_TMO], 1u); break; } }
    }
    nloc = mine > 0u ? mine : 1u; nx = cnt > 0u ? cnt : 1u;
}

__device__ __forceinline__ void xcd_barrier(const XcdBarrier& b) {
    asm volatile("s_waitcnt vmcnt(0)" ::: "memory");
    __syncthreads();
    if (threadIdx.x == 0) {
        unsigned* bar = b.bar;
        __builtin_amdgcn_s_waitcnt(0);
        unsigned nloc = b.st[0], nx = b.st[1];
        if (nloc == 0u) { xcd_barrier_complete(bar, b.x, nloc, nx); b.st[0] = nloc; b.st[1] = nx; }
        const unsigned old = xb_add(&bar[XB_XSUB(b.x)], 1u);
        const unsigned gen = old / nloc;
        if (old + 1u == (gen + 1u) * nloc) {
            __builtin_amdgcn_fence(__ATOMIC_RELEASE, "agent");
            asm volatile("s_waitcnt vmcnt(0)" ::: "memory");
            const unsigned og = xb_add(&bar[XB_TOP], 1u);
            const unsigned tg = og / nx;
            if (og + 1u == (tg + 1u) * nx) xb_add(&bar[XB_TOPGEN], 1u);
            else XB_SPIN(xb_ld(&bar[XB_TOPGEN]) == tg, bar);
            __builtin_amdgcn_fence(__ATOMIC_ACQUIRE, "agent");
            xb_add(&bar[XB_XGEN(b.x)], 1u);
            asm volatile("s_waitcnt vmcnt(0)" ::: "memory");
        } else {
            XB_SPIN(xb_ld(&bar[XB_XGEN(b.x)]) == gen, bar);
            __builtin_amdgcn_fence(__ATOMIC_ACQUIRE, "agent");
            asm volatile("s_waitcnt vmcnt(0)" ::: "memory");
        }
    }
    __syncthreads();
}

constexpr int PH_PER_LAYER = 11, N_PHASES = 1 + DEPTH * PH_PER_LAYER + 1;
template <int EN_MASK, bool EN_GEMM>
__device__ __forceinline__ void fwd_body(const Params& p) {
    extern __shared__ __attribute__((aligned(16))) unsigned char lds[];
    cg::grid_group grid = cg::this_grid();
    const int G = gridDim.x, NGW = G * 8;
    unsigned char* ws = p.ws;
    volatile LAS unsigned* MISC = (volatile LAS unsigned*)((LAS unsigned char*)lds + 132096);
    if (threadIdx.x < 2) MISC[threadIdx.x] = 0u;
    __syncthreads();
    XcdBarrier xbar = xcd_barrier_post((unsigned*)(ws + O_CTL), MISC);
    float* mod = (float*)(ws + O_MOD); float* X = (float*)(ws + O_X); bf16_t* H = (bf16_t*)(ws + O_H);
    for (int ph = p.ph_lo; ph < p.ph_hi; ++ph) {
        int tid = threadIdx.x; asm volatile("" : "+v"(tid));
        const int lane = tid & 63, wid = __builtin_amdgcn_readfirstlane(tid >> 6); const int gw = blockIdx.x * 8 + wid;
        if (ph == 0) { if constexpr (EN_MASK != 0) phase_pre(p, lds, tid); }
        else if (ph == N_PHASES - 1) { if constexpr (EN_MASK != 0) final_norm_rows(X, PIN(25), p.out, gw, NGW, lane); }
        else {
            const int l = (ph - 1) / PH_PER_LAYER, k = (ph - 1) % PH_PER_LAYER;
            const float* modl = mod + (size_t)l * 4 * 6144;
            const float* xin = (l == 0) ? PIN(0) : X;
            if (k == 1 || k == 6 || k == 7 || k == 9 || k == 10) { if constexpr (EN_GEMM) {
                const int nsub = (k == 6) ? 4 : 1;
#pragma unroll 1
                for (int br = 0; br < nsub; ++br) {
                    EpiU E{}; const bf16_t* A; const bf16_t* Bt; int lda, N, K;
                    if (k == 1) { E.kind = 0; E.p1 = ws; A = H; lda = 1024; Bt = (const bf16_t*)(ws + O_WIN); N = NPROJ; K = 1024; }
                    else if (k == 6) {
                        const size_t aoffs = (br == 0) ? O_UV : (br == 1) ? O_FQKV : (br == 2) ? O_MQKV : O_Z;
                        const size_t woffs = (br == 0) ? O_WA : (br == 1) ? O_WB : (br == 2) ? O_WC : O_WD;
                        E.kind = 1; E.p0 = (const bf16_t*)(ws + O_GATE) + br * 1024; E.p1 = (float*)(ws + O_MF32); E.p2 = H; E.mode = (br == 0) ? 0 : (br == 3) ? 2 : 1;
                        A = (const bf16_t*)(ws + aoffs); lda = (br == 0) ? 1024 : (br == 3) ? 768 : 1536; Bt = (const bf16_t*)(ws + woffs); N = 1024; K = (br == 3) ? 768 : 512; }
                    else if (k == 7) { E.kind = 2; E.p0 = xin; E.p1 = X; E.p2 = (void*)(modl + 2048); A = H; lda = 1024; Bt = (const bf16_t*)(ws + O_WO); N = 1024; K = 1024; }
                    else if (k == 9) { E.kind = 3; E.p1 = (bf16_t*)(ws + O_HID); A = H; lda = 1024; Bt = (const bf16_t*)(ws + O_W1); N = 4096; K = 1024; }
                    else { E.kind = 2; E.p0 = X; E.p1 = X; E.p2 = (void*)(modl + 5120); A = (const bf16_t*)(ws + O_HID); lda = 4096; Bt = (const bf16_t*)(ws + O_W2); N = 1024; K = 4096; }
#ifdef PROBE_DUP_GEMM
                    E.dry = (p.ph_lo == 0); run_gemm(lds, A, lda, Bt, N, K, E); E.dry = 0;
#endif
                    run_gemm(lds, A, lda, Bt, N, K, E);
                }
            } } else switch (k) {
            case 0: if constexpr ((EN_MASK >> 0) & 1) {
#ifdef PROBE_A
                convert_weights(p, l, lds, gw, NGW, wid, lane); norm_mod_rows(xin, PIN(4) + l * 1024, modl + 0, modl + 1024, H, gw, NGW, lane);
#endif
                convert_weights(p, l, lds, gw, NGW, wid, lane);
                norm_mod_rows(xin, PIN(4) + l * 1024, modl + 0, modl + 1024, H, gw, NGW, lane);
            } break;
            case 2: if constexpr ((EN_MASK >> 2) & 1) {
#ifdef PROBE_C
                { const bool dry = (p.ph_lo == 0);
                for (int it = blockIdx.x; it < 1024; it += G) gmlp_item(p, l, lds, it, wid, lane, dry);
                for (int it = blockIdx.x; it < 512; it += G) rotary_item(p, lds, it, tid, dry);
                for (int it = blockIdx.x; it < 2048; it += G) vt_item(p, lds, it, tid);
                for (int it = blockIdx.x; it < 2560; it += G) conv_item(p, l, it, tid);
                for (int it = gw; it < 1536; it += NGW) acum_item(p, l, it, lane);
                for (int it = NGW - 1 - gw; it < 32; it += NGW) foxcum_item(p, l, it, lane); }
#endif
                for (int it = blockIdx.x; it < 1024; it += G) gmlp_item(p, l, lds, it, wid, lane);
                for (int it = blockIdx.x; it < 512; it += G) rotary_item(p, lds, it, tid);
                for (int it = blockIdx.x; it < 2048; it += G) vt_item(p, lds, it, tid);
                for (int it = blockIdx.x; it < 2560; it += G) conv_item(p, l, it, tid);
                for (int it = gw; it < 1536; it += NGW) acum_item(p, l, it, lane);
                for (int it = NGW - 1 - gw; it < 32; it += NGW) foxcum_item(p, l, it, lane);
            } break;
            case 3: if constexpr ((EN_MASK >> 3) & 1) {
#ifndef EN3
#define EN3 7
#endif
                for (int i = blockIdx.x; i < 512; i += G) { const int bh = i & 31, r = i >> 5; const int qb = (r < 8) ? 15 - r : r - 8;
                    if constexpr (EN3 & 1) attn_block_item<false>(p, lds, bh >> 3, bh & 7, qb, tid, wid, lane);
                    if constexpr (EN3 & 2) attn_block_item<true>(p, lds, bh >> 3, bh & 7, qb, tid, wid, lane); }
#ifdef PROBE_EF
                for (int i = NGW - 1 - gw; i < 1536; i += NGW) ssd_states_item(p, i, lane);
#endif
                if constexpr (EN3 & 4) for (int i = NGW - 1 - gw; i < 1536; i += NGW) ssd_states_item(p, i, lane);
            } break;
            case 4: if constexpr ((EN_MASK >> 4) & 1) {
#ifdef PROBE_EF
                ssd_scan(p, blockIdx.x * 512 + tid, G * 512);
#endif
                ssd_scan(p, blockIdx.x * 512 + tid, G * 512); } break;
            case 5: if constexpr ((EN_MASK >> 5) & 1) {
#ifdef PROBE_EF
                for (int it = blockIdx.x; it < 256; it += G) ssd_out_item(p, l, it, wid, lane, p.ph_lo == 0);
#endif
                for (int it = blockIdx.x; it < 256; it += G) ssd_out_item(p, l, it, wid, lane); } break;
            case 8: if constexpr ((EN_MASK >> 8) & 1) { norm_mod_rows(X, PIN(22) + l * 1024, modl + 3072, modl + 4096, H, gw, NGW, lane); } break;
            }
        }
        if (ph + 1 < p.ph_hi) { if (ph == 0) grid.sync(); else xcd_barrier(xbar); }
#ifdef PROBE_SYNC
        if (ph + 1 < p.ph_hi) { xcd_barrier(xbar); xcd_barrier(xbar); }
#endif
    }
}

#ifndef N_LAUNCH_MODE
#define N_LAUNCH_MODE 1
#endif
#if N_LAUNCH_MODE == 1
__global__ void __launch_bounds__(512, 2) fwd_all(Params p) { fwd_body<0x7ff, true>(p); }
#define KERNEL_FOR_ATTR fwd_all
#else
__global__ void __launch_bounds__(512, 2) fwd_gemm(Params p) { fwd_body<0, true>(p); }
__global__ void __launch_bounds__(512, 2) fwd_misc(Params p) { fwd_body<0x7ff, false>(p); }
#endif
extern "C" void kernel_launch(void* const* d_in, const int* in_sizes, int n_in, void* d_out, int out_size, void* d_ws, size_t ws_size, hipStream_t stream) {
    static int grid = 0;
    if (grid == 0) {
        if (n_in != 26 || out_size != T * DM || ws_size < WS_END) { fprintf(stderr, "kernel_launch: unexpected shapes (n_in %d out %d ws %zu need %zu)\n", n_in, out_size, ws_size, (size_t)WS_END); grid = -1; return; }
        int dev = 0, cus = 0;
        (void)hipGetDevice(&dev); (void)hipDeviceGetAttribute(&cus, hipDeviceAttributeMultiprocessorCount, dev);
#if N_LAUNCH_MODE == 1
        if (hipFuncSetAttribute((const void*)fwd_all, hipFuncAttributeMaxDynamicSharedMemorySize, LDS_BYTES) != hipSuccess) { fprintf(stderr, "kernel_launch: hipFuncSetAttribute failed\n"); grid = -1; return; }
#else
        if (hipFuncSetAttribute((const void*)fwd_gemm, hipFuncAttributeMaxDynamicSharedMemorySize, LDS_BYTES) != hipSuccess || hipFuncSetAttribute((const void*)fwd_misc, hipFuncAttributeMaxDynamicSharedMemorySize, LDS_BYTES) != hipSuccess) { fprintf(stderr, "kernel_launch: hipFuncSetAttribute failed\n"); grid = -1; return; }
#endif
        (void)hipGetLastError();
        grid = cus > 0 ? cus : 256;
    }
    if (grid < 0) return;
    if (hipMemsetAsync((char*)d_ws + O_CTL, 0, 16384, stream) != hipSuccess) { fprintf(stderr, "kernel_launch: memset failed\n"); return; }
    Params p{};
    for (int i = 0; i < 26; ++i) p.in[i] = (const float*)d_in[i];
    p.out = (float*)d_out; p.ws = (unsigned char*)d_ws;
#if N_LAUNCH_MODE == 1
    p.ph_lo = 0; p.ph_hi = N_PHASES;
    void* args[] = {&p};
    hipError_t e = hipLaunchCooperativeKernel((const void*)fwd_all, dim3(grid), dim3(512), args, LDS_BYTES, stream);
    if (e != hipSuccess) fprintf(stderr, "kernel_launch: cooperative launch failed: %s (grid %d)\n", hipGetErrorString(e), grid);
#else
    for (int ph = 0; ph < N_PHASES; ++ph) { p.ph_lo = ph; p.ph_hi = ph + 1;
        const int k = (ph >= 1 && ph < N_PHASES - 1) ? (ph - 1) % PH_PER_LAYER : -1;
        if (k == 1 || k == 6 || k == 7 || k == 9 || k == 10) hipLaunchKernelGGL(fwd_gemm, dim3(grid), dim3(512), LDS_BYTES, stream, p);
        else hipLaunchKernelGGL(fwd_misc, dim3(grid), dim3(512), LDS_BYTES, stream, p); }
#endif
}
```

```cpp
#include <hip/hip_runtime.h>
#include <hip/hip_cooperative_groups.h>
#include <cstdio>
#include <cstdint>
#include <cmath>
namespace cg = cooperative_groups;
namespace pg8 {
#define PG8_LAS __attribute__((address_space(3)))
typedef unsigned short bf16_t;
typedef short bf16x8 __attribute__((ext_vector_type(8)));
typedef float f32x4 __attribute__((ext_vector_type(4)));
typedef unsigned u32x4 __attribute__((ext_vector_type(4)));
constexpr int BM = 256, BK = 64, HALF = 128, HTB = HALF * BK * 2  , STAGE_BYTES = 8 * HTB, NXCD = 8, WGM = 8;

__host__ __device__ __forceinline__ int lds_byte(int r, int c) { const int st = (r >> 4) * 2 + (c >> 5), rr = r & 15, cc = c & 31, ob = rr * 64 + cc * 2; return st * 1024 + (ob ^ (((ob >> 9) & 1) << 5)); }
__host__ __device__ __forceinline__ void stage_rc(int b, int& R, int& C) { const int st = b / 1024, sb = b % 1024, swz = sb ^ (((sb >> 9) & 1) << 5); R = (st >> 1) * 16 + swz / 64; C = (st & 1) * 32 + (swz % 64) / 2; }
__host__ __device__ __forceinline__ int perm32(int rho) { const int n = rho >> 4, i = rho & 15; return 8 * (i >> 2) + 4 * n + (i & 3); }

struct Unit { int pm, pn; };
struct Gemm { const bf16_t* A; const bf16_t* Bt; int M, N, K, lda; };

struct StaticOrder {
    int nM, nN, nwg, G, c;
    __host__ __device__ void init(int M, int N, int G_, int c_) { nM = M / BM; nN = N / BM; nwg = nM * nN; G = G_; c = c_; }
    __host__ __device__ bool next(int i, Unit& u) const {
        const long L = (long)i * G + c; if (L >= nwg) return false;
        int wgid = (int)L; { const int q = nwg / NXCD, r = nwg % NXCD, xcd = wgid % NXCD, off = wgid / NXCD; wgid = (xcd < r ? xcd * (q + 1) : r * (q + 1) + (xcd - r) * q) + off; }
        const int nig = WGM * nN, gid = wgid / nig, fm = gid * WGM, gsz = (nM - fm) < WGM ? (nM - fm) : WGM;
        u.pm = fm + ((wgid % nig) % gsz); u.pn = (wgid % nig) / gsz; return true;
    }
    __device__ __forceinline__ void a_ready(const Unit&) const {}
    __device__ __forceinline__ void done(const Unit&) const {}
};


template <class Epi, class Sched, bool ALIGN_EPI = false, bool SP2 = false>
__device__ __forceinline__ void gemm_phase(PG8_LAS unsigned char* lds, const Gemm g, const Sched& S, const Epi& E) {
    int tid_l = threadIdx.x; asm volatile("" : "+v"(tid_l));
    const int tid = tid_l, wid = __builtin_amdgcn_readfirstlane(tid >> 6), lane = tid & 63, wr = wid >> 2, wc = wid & 3, fr = lane & 15, fq = lane >> 4;
    const int K = g.K, nt = K / BK;
    unsigned voffA[2], voffB[2];
#pragma unroll
    for (int i = 0; i < 2; ++i) { int R, C; stage_rc(tid * 16 + i * 8192, R, C); const int Rb = Epi::PERM ? ((R & ~31) + perm32(R & 31)) : R;
        voffA[i] = (unsigned)(R * g.lda + C) * 2u; voffB[i] = (unsigned)(Rb * K + C) * 2u; }
    const size_t kstep = (size_t)(BK * 2);
    const size_t hstepB = (size_t)HALF * K * 2, hstepA = (size_t)HALF * g.lda * 2;
    const size_t tstepB = 2 * hstepB, tstepA = 2 * hstepA;
    const unsigned ldsw = (unsigned)wid * 1024u;
    const int aoff = lds_byte(wr * 64 + fr, fq * 8), boff = lds_byte(wc * 32 + fr, fq * 8);
#define PG8_SA(b, h) (((b) * 2 + (h)) * HTB)
#define PG8_SB(b, h) ((4 + (b) * 2 + (h)) * HTB)
#define PG8_STAGE(bufoff, gbase, voff) do { _Pragma("unroll") for (int _i = 0; _i < 2; ++_i) \
        __builtin_amdgcn_global_load_lds((const unsigned*)((const char*)(gbase) + (voff)[_i]), (PG8_LAS unsigned*)(lds + (bufoff) + ldsw + _i * 8192), 16, 0, 0); } while (0)
#define PG8_LDA(dst, b, h) do { _Pragma("unroll") for (int m = 0; m < 4; ++m) _Pragma("unroll") for (int k = 0; k < 2; ++k) dst[m][k] = *(const PG8_LAS bf16x8*)(lds + PG8_SA(b, h) + aoff + m * 2048 + k * 1024); } while (0)
#define PG8_LDB(dst, b, h) do { _Pragma("unroll") for (int n = 0; n < 2; ++n) _Pragma("unroll") for (int k = 0; k < 2; ++k) dst[n][k] = *(const PG8_LAS bf16x8*)(lds + PG8_SB(b, h) + boff + n * 2048 + k * 1024); } while (0)
#define PG8_MMA(ai, bj, At, Bt) do { __builtin_amdgcn_s_setprio(1); _Pragma("unroll") for (int m = 0; m < 4; ++m) _Pragma("unroll") for (int n = 0; n < 2; ++n) _Pragma("unroll") for (int k = 0; k < 2; ++k) \
        acc[ai][bj][m][n] = __builtin_amdgcn_mfma_f32_16x16x32_bf16(Bt[n][k], At[m][k], acc[ai][bj][m][n], 0, 0, 0); __builtin_amdgcn_s_setprio(0); } while (0)
#define PG8_WAIT_V(n) asm volatile("s_waitcnt vmcnt(" #n ")" ::: "memory")
#define PG8_WAIT_L(n) asm volatile("s_waitcnt lgkmcnt(" #n ")" ::: "memory")
#define PG8_BAR __builtin_amdgcn_s_barrier()
#define PG8_SCHED __builtin_amdgcn_sched_barrier(0)
    Unit cur, nxt; int ui = 0;
    if (!S.next(0, cur)) return;
    f32x4 acc[2][2][4][2];
#pragma unroll
    for (int a = 0; a < 2; ++a)
#pragma unroll
        for (int b = 0; b < 2; ++b)
#pragma unroll
            for (int m = 0; m < 4; ++m)
#pragma unroll
                for (int n = 0; n < 2; ++n) acc[a][b][m][n] = (f32x4){0.f, 0.f, 0.f, 0.f};
    bf16x8 At[4][2], B0[2][2], B1[2][2];
    const char* cA = (const char*)g.A + (size_t)cur.pm * tstepA; const char* cB = (const char*)g.Bt + (size_t)cur.pn * tstepB;
    S.a_ready(cur);
    if constexpr (SP2) {
        PG8_STAGE(PG8_SB(0, 0), cB, voffB); PG8_STAGE(PG8_SB(0, 1), cB + hstepB, voffB); PG8_STAGE(PG8_SA(0, 0), cA, voffA); PG8_STAGE(PG8_SA(0, 1), cA + hstepA, voffA);
        if (wr == 1) PG8_BAR;
        PG8_WAIT_V(2); PG8_BAR;
        PG8_STAGE(PG8_SB(1, 0), cB + kstep, voffB); PG8_STAGE(PG8_SA(1, 0), cA + kstep, voffA); PG8_STAGE(PG8_SB(1, 1), cB + hstepB + kstep, voffB);
        PG8_WAIT_V(6); PG8_BAR;
    } else {
        PG8_STAGE(PG8_SB(0, 0), cB, voffB); PG8_STAGE(PG8_SA(0, 0), cA, voffA); PG8_STAGE(PG8_SB(0, 1), cB + hstepB, voffB); PG8_STAGE(PG8_SA(0, 1), cA + hstepA, voffA);
        if (wr == 1) PG8_BAR;
        PG8_WAIT_V(4); PG8_BAR;
        PG8_STAGE(PG8_SB(1, 0), cB + kstep, voffB); PG8_STAGE(PG8_SA(1, 0), cA + kstep, voffA); PG8_STAGE(PG8_SB(1, 1), cB + hstepB + kstep, voffB);
        PG8_WAIT_V(6); PG8_BAR;
    }
    for (;;) {
        const bool has_next = S.next(ui + 1, nxt);
        const char* nA = has_next ? (const char*)g.A + (size_t)nxt.pm * tstepA : cA; const char* nB = has_next ? (const char*)g.Bt + (size_t)nxt.pn * tstepB : cB;
        for (int t = 0; t < nt; t += 2) {
            const bool last = (t == nt - 2);
            const char* a1 = cA + (size_t)(t + 1) * kstep;
            const char* a2 = last ? nA : cA + (size_t)(t + 2) * kstep; const char* b2 = last ? nB : cB + (size_t)(t + 2) * kstep;
            const char* a3 = a2 + kstep; const char* b3 = b2 + kstep;
            if (last && has_next) S.a_ready(nxt);
            if constexpr (SP2) {
            PG8_LDB(B0, 0, 0); PG8_LDB(B1, 0, 1); PG8_SCHED; PG8_LDA(At, 0, 0); PG8_STAGE(PG8_SA(1, 1), a1 + hstepA, voffA);
            PG8_WAIT_V(8); PG8_WAIT_L(0); PG8_BAR; PG8_MMA(0, 0, At, B0); PG8_MMA(0, 1, At, B1); PG8_BAR; PG8_SCHED;
            PG8_LDA(At, 0, 1); PG8_STAGE(PG8_SB(0, 0), b2, voffB); PG8_STAGE(PG8_SB(0, 1), b2 + hstepB, voffB); PG8_STAGE(PG8_SA(0, 0), a2, voffA);
            PG8_WAIT_V(8); PG8_WAIT_L(0); PG8_BAR; PG8_MMA(1, 0, At, B0); PG8_MMA(1, 1, At, B1); PG8_BAR; PG8_SCHED;
            PG8_LDB(B0, 1, 0); PG8_LDB(B1, 1, 1); PG8_SCHED; PG8_LDA(At, 1, 0); PG8_STAGE(PG8_SA(0, 1), a2 + hstepA, voffA);
            PG8_WAIT_V(8); PG8_WAIT_L(0); PG8_BAR; PG8_MMA(0, 0, At, B0); PG8_MMA(0, 1, At, B1); PG8_BAR; PG8_SCHED;
            PG8_LDA(At, 1, 1); PG8_STAGE(PG8_SB(1, 0), b3, voffB); PG8_STAGE(PG8_SB(1, 1), b3 + hstepB, voffB); PG8_STAGE(PG8_SA(1, 0), a3, voffA);
            PG8_WAIT_V(8); PG8_WAIT_L(0); PG8_BAR; PG8_MMA(1, 0, At, B0); PG8_MMA(1, 1, At, B1); PG8_BAR; PG8_SCHED;
            } else {
            PG8_LDB(B0, 0, 0); PG8_SCHED; PG8_LDA(At, 0, 0); PG8_STAGE(PG8_SA(1, 1), a1 + hstepA, voffA);
            PG8_WAIT_L(8); PG8_BAR; PG8_WAIT_L(0); PG8_MMA(0, 0, At, B0); PG8_BAR; PG8_SCHED;
            PG8_LDB(B1, 0, 1); PG8_STAGE(PG8_SB(0, 0), b2, voffB);
            PG8_BAR; PG8_WAIT_L(0); PG8_MMA(0, 1, At, B1); PG8_BAR;
            PG8_LDA(At, 0, 1); PG8_STAGE(PG8_SA(0, 0), a2, voffA);
            PG8_BAR; PG8_WAIT_L(0); PG8_MMA(1, 0, At, B0); PG8_BAR; PG8_SCHED;
            PG8_STAGE(PG8_SB(0, 1), b2 + hstepB, voffB);
            PG8_WAIT_V(6); PG8_BAR; PG8_MMA(1, 1, At, B1); PG8_BAR;
            PG8_LDB(B0, 1, 0); PG8_SCHED; PG8_LDA(At, 1, 0); PG8_STAGE(PG8_SA(0, 1), a2 + hstepA, voffA);
            PG8_WAIT_L(8); PG8_BAR; PG8_WAIT_L(0); PG8_MMA(0, 0, At, B0); PG8_BAR; PG8_SCHED;
            PG8_LDB(B1, 1, 1); PG8_STAGE(PG8_SB(1, 0), b3, voffB);
            PG8_BAR; PG8_WAIT_L(0); PG8_MMA(0, 1, At, B1); PG8_BAR;
            PG8_LDA(At, 1, 1); PG8_STAGE(PG8_SA(1, 0), a3, voffA);
            PG8_BAR; PG8_WAIT_L(0); PG8_MMA(1, 0, At, B0); PG8_BAR; PG8_SCHED;
            PG8_STAGE(PG8_SB(1, 1), b3 + hstepB, voffB);
            PG8_WAIT_V(6); PG8_BAR; PG8_MMA(1, 1, At, B1); PG8_BAR;
            }
        }
        if constexpr (ALIGN_EPI) { if (wr == 0) PG8_BAR; }
        if constexpr (!Epi::AFTER_DRAIN) { E(acc, cur, wr, wc, fr, fq); S.done(cur); }
        if (!has_next) break;
#pragma unroll
        for (int a = 0; a < 2; ++a)
#pragma unroll
            for (int b = 0; b < 2; ++b)
#pragma unroll
                for (int m = 0; m < 4; ++m)
#pragma unroll
                    for (int n = 0; n < 2; ++n) acc[a][b][m][n] = (f32x4){0.f, 0.f, 0.f, 0.f};
        cur = nxt; cA = nA; cB = nB; ++ui;
        if constexpr (ALIGN_EPI) { if (wr == 1) PG8_BAR; }
    }
    PG8_WAIT_V(0);
    if constexpr (!ALIGN_EPI) { if (wr == 0) PG8_BAR; }
    PG8_BAR;
    if constexpr (Epi::AFTER_DRAIN) { E.fused(acc, cur, wr, wc, fr, fq, lds, wid, lane); S.done(cur); }
#undef PG8_SA
#undef PG8_SB
#undef PG8_STAGE
#undef PG8_LDA
#undef PG8_LDB
#undef PG8_MMA
#undef PG8_WAIT_V
#undef PG8_WAIT_L
#undef PG8_BAR
#undef PG8_SCHED
}
}

constexpr int NB = 4, SEQ = 4096, T = NB * SEQ, DM = 1024, DEPTH = 4;
constexpr int NPROJ = 10496;
constexpr int IN_COLS = 10260;
constexpr float NORM_EPS = 1e-6f;
constexpr float LOG2E = 1.4426950408889634f;

typedef unsigned short bf16_t;
typedef short bf16x8 __attribute__((ext_vector_type(8)));
typedef float f32x4 __attribute__((ext_vector_type(4)));
typedef float f32x2 __attribute__((ext_vector_type(2)));
typedef unsigned u32x4 __attribute__((ext_vector_type(4)));
typedef unsigned u32x2 __attribute__((ext_vector_type(2)));
typedef __bf16 bf16x2_t __attribute__((ext_vector_type(2)));

constexpr size_t MiB = 1u << 20;
constexpr size_t O_MOD = 0, O_X = 1 * MiB, O_H = 65 * MiB, O_UV = 97 * MiB, O_FQKV = 129 * MiB, O_MQKV = 177 * MiB, O_Z = 225 * MiB,
                 O_XBC = 249 * MiB, O_GATE = 289 * MiB, O_SMALL = 417 * MiB, O_VTF = 419 * MiB, O_VTM = 435 * MiB, O_XT = 451 * MiB,
                 O_BC = 475 * MiB, O_BT = 491 * MiB, O_ST = 499 * MiB, O_CUMF = 547 * MiB, O_ACUM = 548 * MiB, O_KMEAN = 549 * MiB,
                 O_WIN = 550 * MiB, O_WA = 571 * MiB, O_WB = 572 * MiB, O_WC = 573 * MiB, O_WD = 574 * MiB, O_WO = 576 * MiB,
                 O_W1 = 578 * MiB, O_W2 = 586 * MiB, O_GWS = 594 * MiB, WS_END = 595 * MiB;
constexpr size_t O_ROT = O_GWS + 512 * 1024;
constexpr size_t O_DT = O_KMEAN + 256 * 1024;
constexpr size_t O_CTL = 512 * 1024;
constexpr size_t O_PREV = O_XBC;
constexpr size_t O_HID = O_GATE;
constexpr size_t O_MF32 = O_VTF;
constexpr int LDS_BYTES = 147456;

struct Params { const float* in[26]; float* out; unsigned char* ws; int ph_lo, ph_hi; };

__device__ __forceinline__ int opq(int i) { asm volatile("" : "+s"(i)); return i; }
#define PIN(i) (p.in[opq(i)])
__device__ __forceinline__ unsigned cvtpk(float lo, float hi) { f32x2 v = {lo, hi}; bf16x2_t b = __builtin_convertvector(v, bf16x2_t); return __builtin_bit_cast(unsigned, b); }
__device__ __forceinline__ float bf2f(short h) { return __uint_as_float(((unsigned)(unsigned short)h) << 16); }
__device__ __forceinline__ float bflo(unsigned w) { return __uint_as_float(w << 16); }
__device__ __forceinline__ float bfhi(unsigned w) { return __uint_as_float(w & 0xffff0000u); }
__device__ __forceinline__ bf16x8 pack8(float a0, float a1, float a2, float a3, float a4, float a5, float a6, float a7) {
    u32x4 w = {cvtpk(a0, a1), cvtpk(a2, a3), cvtpk(a4, a5), cvtpk(a6, a7)}; return __builtin_bit_cast(bf16x8, w); }
__device__ __forceinline__ bf16x8 ld2x8(const bf16_t* p0, const bf16_t* p1) { const u32x2 a = *(const u32x2*)p0, b = *(const u32x2*)p1; u32x4 w = {a.x, a.y, b.x, b.y}; return __builtin_bit_cast(bf16x8, w); }
typedef short s16x4_t __attribute__((ext_vector_type(4)));
__device__ __forceinline__ s16x4_t lds_tr(const bf16_t* p) { return __builtin_bit_cast(s16x4_t, __builtin_amdgcn_ds_read_tr16_b64_v4i16((__attribute__((address_space(3))) s16x4_t*)p)); }
__device__ __forceinline__ bf16x8 cat4(s16x4_t a, s16x4_t b) { return (bf16x8){a[0], a[1], a[2], a[3], b[0], b[1], b[2], b[3]}; }
__device__ __forceinline__ f32x4 mfma16(bf16x8 a, bf16x8 b, f32x4 c) { return __builtin_amdgcn_mfma_f32_16x16x32_bf16(a, b, c, 0, 0, 0); }
__device__ __forceinline__ float dpp_add(float v, const int ctrl_sel) {
    const int iv = __builtin_bit_cast(int, v); int m;
    if (ctrl_sel == 0) m = __builtin_amdgcn_update_dpp(0, iv, 0xB1, 0xF, 0xF, true);
    else if (ctrl_sel == 1) m = __builtin_amdgcn_update_dpp(0, iv, 0x4E, 0xF, 0xF, true);
    else if (ctrl_sel == 2) m = __builtin_amdgcn_update_dpp(0, iv, 0x141, 0xF, 0xF, true);
    else m = __builtin_amdgcn_update_dpp(0, iv, 0x140, 0xF, 0xF, true);
    return v + __builtin_bit_cast(float, m); }
__device__ __forceinline__ float row16_sum(float v) { v = dpp_add(v, 0); v = dpp_add(v, 1); v = dpp_add(v, 2); v = dpp_add(v, 3); return v; }
__device__ __forceinline__ float wave_sum(float v) { v = row16_sum(v); v += __shfl_xor(v, 16); v += __shfl_xor(v, 32); return v; }
__device__ __forceinline__ float ex2(float x) { return __builtin_amdgcn_exp2f(x); }
__device__ __forceinline__ float sigmoidf_(float x) { return 1.f / (1.f + __expf(-x)); }
__device__ __forceinline__ float softplusf_(float x) { return fmaxf(x, 0.f) + log1pf(expf(-fabsf(x))); }
#define LDS_WAIT() asm volatile("s_waitcnt lgkmcnt(0)" ::: "memory")
#define VM_WAIT() asm volatile("s_waitcnt vmcnt(0)" ::: "memory")

#define EPI_LANE_SETUP() int t_ = threadIdx.x; asm volatile("" : "+v"(t_)); const int fr = t_ & 15, fq = (t_ >> 4) & 3; const int wv_ = __builtin_amdgcn_readfirstlane(t_ >> 6); const int wr = wv_ >> 2, wc = wv_ & 3
__device__ __forceinline__ unsigned pk4u8(float a, float b, float c, float d) {
    const unsigned ua = (unsigned)(a * 255.f + 0.5f), ub = (unsigned)(b * 255.f + 0.5f), uc = (unsigned)(c * 255.f + 0.5f), ud = (unsigned)(d * 255.f + 0.5f);
    return ua | (ub << 8) | (uc << 16) | (ud << 24); }
__device__ __forceinline__ float u8f(unsigned w, int i) { return (float)((w >> (8 * i)) & 255u); }
__device__ __forceinline__ float act_unified(float x, int act) {
    const float uu = 1.5957691216057308f * (x + 0.044715f * x * x * x);
    const float arg = (act == 1) ? uu : (act == 0) ? INFINITY : x;
    const float num = (act == 3) ? 1.f : x;
    return num * __builtin_amdgcn_rcpf(1.f + ex2(-LOG2E * arg));
}
struct EpiInproj {
    static constexpr bool PERM = true, AFTER_DRAIN = false;
    unsigned char* ws;
    __device__ __forceinline__ void operator()(const f32x4 (&acc)[2][2][4][2], const pg8::Unit& u, int, int, int, int) const {
        EPI_LANE_SETUP();
        const int pn = u.pn; const int row0 = u.pm * 256 + wr * 64 + fr;
        if (pn == 40) {
            if (wc == 0) {
                float* sm = (float*)(ws + O_SMALL);
#pragma unroll
                for (int ai = 0; ai < 2; ++ai)
#pragma unroll
                    for (int m = 0; m < 4; ++m) { float* rp = sm + (size_t)(row0 + ai * 128 + m * 16) * 32 + 8 * fq;
                        *(f32x4*)rp = acc[ai][0][m][0]; *(f32x4*)(rp + 4) = acc[ai][0][m][1]; }
            }
            return;
        }
        bf16_t* base; int pitch, ct, act;
        if (pn < 4) { base = (bf16_t*)(ws + O_UV); pitch = 1024; ct = pn; act = 1; }
        else if (pn < 10) { base = (bf16_t*)(ws + O_FQKV); pitch = 1536; ct = pn - 4; act = 0; }
        else if (pn < 16) { base = (bf16_t*)(ws + O_MQKV); pitch = 1536; ct = pn - 10; act = 0; }
        else if (pn < 19) { base = (bf16_t*)(ws + O_Z); pitch = 768; ct = pn - 16; act = 2; }
        else if (pn < 24) { base = (bf16_t*)(ws + O_XBC); pitch = 1280; ct = pn - 19; act = 0; }
        else { base = (bf16_t*)(ws + O_GATE); pitch = 4096; ct = pn - 24; act = 3; }
        const int col0 = ct * 256 + wc * 32 + 8 * fq;
#pragma unroll
        for (int ai = 0; ai < 2; ++ai)
#pragma unroll
            for (int m = 0; m < 4; ++m) { bf16_t* rowp = base + (size_t)(row0 + ai * 128 + m * 16) * pitch + col0;
#pragma unroll
                for (int bj = 0; bj < 2; ++bj) { f32x4 v0 = acc[ai][bj][m][0], v1 = acc[ai][bj][m][1];
#pragma unroll
                    for (int j = 0; j < 4; ++j) if (act != 0) { v0[j] = act_unified(v0[j], act); v1[j] = act_unified(v1[j], act); }
                    if (act == 3) {
                        unsigned char* gp = (unsigned char*)(ws + O_GATE) + (size_t)(row0 + ai * 128 + m * 16) * 4096 + col0 + bj * 128;
                        u32x2 q; q.x = pk4u8(v0[0], v0[1], v0[2], v0[3]); q.y = pk4u8(v1[0], v1[1], v1[2], v1[3]);
                        __builtin_nontemporal_store(q, (u32x2*)gp);
                    } else {
                        u32x4 w; w.x = cvtpk(v0[0], v0[1]); w.y = cvtpk(v0[2], v0[3]); w.z = cvtpk(v1[0], v1[1]); w.w = cvtpk(v1[2], v1[3]);
                        __builtin_nontemporal_store(w, (u32x4*)(rowp + bj * 128)); } }
                asm volatile("" ::: "memory"); }
    }
};
struct EpiMerge {
    static constexpr bool PERM = true, AFTER_DRAIN = false;
    const unsigned char* gate; float* mf; bf16_t* outb; int mode;
    __device__ __forceinline__ void operator()(const f32x4 (&acc)[2][2][4][2], const pg8::Unit& u, int, int, int, int) const {
        EPI_LANE_SETUP();
        const int row0 = u.pm * 256 + wr * 64 + fr, col0 = u.pn * 256 + wc * 32 + 8 * fq;
#pragma unroll
        for (int ai = 0; ai < 2; ++ai)
#pragma unroll
            for (int m = 0; m < 4; ++m) { const size_t row = (size_t)(row0 + ai * 128 + m * 16);
#pragma unroll
                for (int bj = 0; bj < 2; ++bj) { const int col = col0 + bj * 128;
                    const u32x2 gw = *(const u32x2*)(gate + row * 4096 + col);
                    f32x4 v0 = acc[ai][bj][m][0] * (1.f / 255.f), v1 = acc[ai][bj][m][1] * (1.f / 255.f);
                    v0[0] *= u8f(gw.x, 0); v0[1] *= u8f(gw.x, 1); v0[2] *= u8f(gw.x, 2); v0[3] *= u8f(gw.x, 3); v1[0] *= u8f(gw.y, 0); v1[1] *= u8f(gw.y, 1); v1[2] *= u8f(gw.y, 2); v1[3] *= u8f(gw.y, 3);
                    bf16_t* op = outb + row * 1024 + col;
                    if (mode != 0) { const u32x4 pw = *(const u32x4*)op;
                        v0[0] += bflo(pw.x); v0[1] += bfhi(pw.x); v0[2] += bflo(pw.y); v0[3] += bfhi(pw.y); v1[0] += bflo(pw.z); v1[1] += bfhi(pw.z); v1[2] += bflo(pw.w); v1[3] += bfhi(pw.w); }
                    u32x4 w; w.x = cvtpk(v0[0], v0[1]); w.y = cvtpk(v0[2], v0[3]); w.z = cvtpk(v1[0], v1[1]); w.w = cvtpk(v1[2], v1[3]);
                    *(u32x4*)op = w; }
                asm volatile("" ::: "memory"); }
    }
};
struct EpiResid {
    static constexpr bool PERM = true, AFTER_DRAIN = false;
    const float* xin; float* xout; const float* gmod;
    __device__ __forceinline__ void operator()(const f32x4 (&acc)[2][2][4][2], const pg8::Unit& u, int, int, int, int) const {
        EPI_LANE_SETUP();
        const int row0 = u.pm * 256 + wr * 64 + fr, col0 = u.pn * 256 + wc * 32 + 8 * fq; const int b = u.pm >> 4;
        const float* gp = gmod + (size_t)b * 6144 + col0;
#pragma unroll
        for (int ai = 0; ai < 2; ++ai)
#pragma unroll
            for (int m = 0; m < 4; ++m) { const size_t off = (size_t)(row0 + ai * 128 + m * 16) * 1024 + col0;
#pragma unroll
                for (int bj = 0; bj < 2; ++bj) { const int co = bj * 128; const f32x4 g0 = *(const f32x4*)(gp + co), g1 = *(const f32x4*)(gp + co + 4);
                    *(f32x4*)(xout + off + co) = *(const f32x4*)(xin + off + co) + g0 * acc[ai][bj][m][0];
                    *(f32x4*)(xout + off + co + 4) = *(const f32x4*)(xin + off + co + 4) + g1 * acc[ai][bj][m][1]; }
                asm volatile("" ::: "memory"); }
    }
};
struct EpiRelu2 {
    static constexpr bool PERM = true, AFTER_DRAIN = false;
    bf16_t* out;
    __device__ __forceinline__ void operator()(const f32x4 (&acc)[2][2][4][2], const pg8::Unit& u, int, int, int, int) const {
        EPI_LANE_SETUP();
        const int row0 = u.pm * 256 + wr * 64 + fr, col0 = u.pn * 256 + wc * 32 + 8 * fq;
#pragma unroll
        for (int ai = 0; ai < 2; ++ai)
#pragma unroll
            for (int m = 0; m < 4; ++m) { bf16_t* rowp = out + (size_t)(row0 + ai * 128 + m * 16) * 4096 + col0;
#pragma unroll
                for (int bj = 0; bj < 2; ++bj) { f32x4 v0 = acc[ai][bj][m][0], v1 = acc[ai][bj][m][1];
#pragma unroll
                    for (int j = 0; j < 4; ++j) { const float r0 = fmaxf(v0[j], 0.f), r1 = fmaxf(v1[j], 0.f); v0[j] = r0 * r0; v1[j] = r1 * r1; }
                    u32x4 w; w.x = cvtpk(v0[0], v0[1]); w.y = cvtpk(v0[2], v0[3]); w.z = cvtpk(v1[0], v1[1]); w.w = cvtpk(v1[2], v1[3]);
                    __builtin_nontemporal_store(w, (u32x4*)(rowp + bj * 128)); }
                asm volatile("" ::: "memory"); }
    }
};
struct EpiU {
    static constexpr bool PERM = true, AFTER_DRAIN = false;
    int kind, mode; const void* p0; void* p1; void* p2; int dry;
    __device__ __forceinline__ void operator()(const f32x4 (&acc)[2][2][4][2], const pg8::Unit& u, int a, int b, int c, int d) const {
        if (dry) return;
        if (kind == 0) { EpiInproj e{(unsigned char*)p1}; e(acc, u, a, b, c, d); }
        else if (kind == 1) { EpiMerge e{(const unsigned char*)p0, (float*)p1, (bf16_t*)p2, mode}; e(acc, u, a, b, c, d); }
        else if (kind == 2) { EpiResid e{(const float*)p0, (float*)p1, (const float*)p2}; e(acc, u, a, b, c, d); }
        else { EpiRelu2 e{(bf16_t*)p1}; e(acc, u, a, b, c, d); }
    }
};
template <class Epi>
__device__ __forceinline__ void run_gemm(unsigned char* lds, const bf16_t* A, int lda, const bf16_t* Bt, int N, int K, const Epi& E) {
    pg8::Gemm g{A, Bt, T, N, K, lda}; pg8::StaticOrder S; S.init(T, N, (int)gridDim.x, (int)blockIdx.x);
    pg8::gemm_phase<Epi, pg8::StaticOrder, true, true>((PG8_LAS unsigned char*)lds, g, S, E);
}

__device__ __forceinline__ void phase_pre(const Params& p, unsigned char* lds, const int tid) {
    float* cs = (float*)lds; float* red = cs + 4096;
    const float* c = PIN(1); const float* ada_w = PIN(2); const float* ada_b = PIN(3);
    float* mod = (float*)(p.ws + O_MOD);
    for (int i = tid; i < 4096; i += 512) { const float v = c[i]; cs[i] = v / (1.f + expf(-v)); }
    __syncthreads();
    { float* rot = (float*)(p.ws + O_ROT);
      for (int e = blockIdx.x * 512 + tid; e < 4096 * 8; e += gridDim.x * 512) { const int pos = e >> 3, j = e & 7;
          const float inv_freq = powf(500000.0f, -(float)j * 0.125f); const float ang = (float)pos * inv_freq;
          rot[pos * 16 + j] = cosf(ang); rot[pos * 16 + 8 + j] = sinf(ang); } }
    const int jj = tid & 63, ks = tid >> 6;
    for (int it = blockIdx.x; it < DEPTH * 96; it += gridDim.x) {
        const int l = it / 96, jb = it % 96;
        const float* w = ada_w + (size_t)l * 1024 * 6144 + jb * 64 + jj;
        float a0 = 0.f, a1 = 0.f, a2 = 0.f, a3 = 0.f;
#pragma unroll 8
        for (int k = ks * 128; k < ks * 128 + 128; ++k) { const float wv = w[(size_t)k * 6144]; a0 += cs[k] * wv; a1 += cs[1024 + k] * wv; a2 += cs[2048 + k] * wv; a3 += cs[3072 + k] * wv; }
        red[(ks * 64 + jj) * 4 + 0] = a0; red[(ks * 64 + jj) * 4 + 1] = a1; red[(ks * 64 + jj) * 4 + 2] = a2; red[(ks * 64 + jj) * 4 + 3] = a3;
        __syncthreads();
        if (tid < 256) { const int b = tid >> 6, j2 = tid & 63; float s = 0.f;
#pragma unroll
            for (int q = 0; q < 8; ++q) s += red[(q * 64 + j2) * 4 + b];
            const int cc = jb * 64 + j2; mod[((size_t)l * 4 + b) * 6144 + cc] = s + ada_b[l * 6144 + cc]; }
        __syncthreads();
    }
}

__device__ __forceinline__ int inproj_src_col(int n) {
    if (n < 2560) return n;
    if (n < 6144) return n + 8;
    if (n < 10240) return n + 20;
    if (n < 10248) return 2560 + (n - 10240);
    if (n < 10260) return 6152 + (n - 10248);
    return -1;
}
__device__ __forceinline__ void transpose_item(const float* W, int K, int Nsrc, bf16_t* WT, float* scr, int k0, int n0, int lane, bool remap) {
    const int nd = n0 + (lane & 31); const int sc = remap ? inproj_src_col(nd) : nd;
#pragma unroll
    for (int i = 0; i < 32; ++i) { const int kk = 2 * i + (lane >> 5); scr[kk * 33 + (lane & 31)] = (sc >= 0) ? W[(size_t)(k0 + kk) * Nsrc + sc] : 0.f; }
    LDS_WAIT();
    const int c = lane & 7;
#pragma unroll
    for (int j = 0; j < 4; ++j) { const int n = (lane >> 3) + 8 * j; const float* s = scr + (8 * c) * 33 + n;
        u32x4 o; o.x = cvtpk(s[0 * 33], s[1 * 33]); o.y = cvtpk(s[2 * 33], s[3 * 33]); o.z = cvtpk(s[4 * 33], s[5 * 33]); o.w = cvtpk(s[6 * 33], s[7 * 33]);
        *(u32x4*)(WT + (size_t)(n0 + n) * K + k0 + 8 * c) = o; }
    LDS_WAIT();
}
__device__ __forceinline__ void convert_weights(const Params& p, int l, unsigned char* lds, int gw, int NGW, int wid, int lane) {
    float* scr = (float*)(lds + wid * 16384);
    unsigned char* ws = p.ws;
    constexpr int I_IN = 16 * (NPROJ / 32), I_BR = 8 * 32, I_D = 12 * 32, I_O = 16 * 32, I_1 = 16 * 128, I_2 = 64 * 32;
    constexpr int TOT = I_IN + 3 * I_BR + I_D + I_O + I_1 + I_2;
    for (int it = gw; it < TOT; it += NGW) {
        int r = it; const float* W; bf16_t* WT; int K, Nsrc, Nd; bool remap = false;
        if (r < I_IN) { W = PIN(5) + (size_t)l * 1024 * IN_COLS; WT = (bf16_t*)(ws + O_WIN); K = 1024; Nsrc = IN_COLS; Nd = NPROJ; remap = true; }
        else if ((r -= I_IN) < I_BR) { W = PIN(17) + (size_t)l * 512 * 1024; WT = (bf16_t*)(ws + O_WA); K = 512; Nsrc = 1024; Nd = 1024; }
        else if ((r -= I_BR) < I_BR) { W = PIN(18) + (size_t)l * 512 * 1024; WT = (bf16_t*)(ws + O_WB); K = 512; Nsrc = 1024; Nd = 1024; }
        else if ((r -= I_BR) < I_BR) { W = PIN(19) + (size_t)l * 512 * 1024; WT = (bf16_t*)(ws + O_WC); K = 512; Nsrc = 1024; Nd = 1024; }
        else if ((r -= I_BR) < I_D) { W = PIN(20) + (size_t)l * 768 * 1024; WT = (bf16_t*)(ws + O_WD); K = 768; Nsrc = 1024; Nd = 1024; }
        else if ((r -= I_D) < I_O) { W = PIN(21) + (size_t)l * 1024 * 1024; WT = (bf16_t*)(ws + O_WO); K = 1024; Nsrc = 1024; Nd = 1024; }
        else if ((r -= I_O) < I_1) { W = PIN(23) + (size_t)l * 1024 * 4096; WT = (bf16_t*)(ws + O_W1); K = 1024; Nsrc = 4096; Nd = 4096; }
        else { r -= I_1; W = PIN(24) + (size_t)l * 4096 * 1024; WT = (bf16_t*)(ws + O_W2); K = 4096; Nsrc = 1024; Nd = 1024; }
        const int nblk = Nd / 32, kb = r / nblk, nb = r % nblk;
        transpose_item(W, K, Nsrc, WT, scr, 64 * kb, 32 * nb, lane, remap);
    }
    const float* gws = PIN(8) + (size_t)l * 8 * 128 * 128; bf16_t* gd = (bf16_t*)(ws + O_GWS);
    for (int e = gw * 64 + lane; e < 8 * 128 * 128; e += NGW * 64) { const int s = e & 127, t = (e >> 7) & 127; const float v = (s <= t) ? gws[e] : 0.f; gd[e] = (bf16_t)(cvtpk(v, 0.f) & 0xffffu); }
}
__device__ __forceinline__ void norm_mod_rows(const float* x, const float* w, const float* sh, const float* sc, bf16_t* out, int gw, int NGW, int lane) {
    for (int row = gw; row < T; row += NGW) {
        const int b = row >> 12; const f32x4* xr = (const f32x4*)(x + (size_t)row * 1024) + lane;
        f32x4 v[4]; float ss = 0.f;
#pragma unroll
        for (int j = 0; j < 4; ++j) { v[j] = xr[64 * j]; ss += (v[j][0] * v[j][0] + v[j][1] * v[j][1]) + (v[j][2] * v[j][2] + v[j][3] * v[j][3]); }
        const float rstd = rsqrtf(wave_sum(ss) * (1.f / 1024.f) + NORM_EPS);
#pragma unroll
        for (int j = 0; j < 4; ++j) { const int col = 4 * (64 * j + lane);
            const f32x4 wv = *(const f32x4*)(w + col), sv = *(const f32x4*)(sc + (size_t)b * 6144 + col), hv = *(const f32x4*)(sh + (size_t)b * 6144 + col);
            const f32x4 o = (v[j] * rstd * wv) * (sv + 1.f) + hv;
            u32x2 pk; pk.x = cvtpk(o[0], o[1]); pk.y = cvtpk(o[2], o[3]); *(u32x2*)(out + (size_t)row * 1024 + col) = pk; }
    }
}
__device__ __forceinline__ void final_norm_rows(const float* x, const float* w, float* out, int gw, int NGW, int lane) {
    for (int row = gw; row < T; row += NGW) {
        const f32x4* xr = (const f32x4*)(x + (size_t)row * 1024) + lane;
        f32x4 v[4]; float ss = 0.f;
#pragma unroll
        for (int j = 0; j < 4; ++j) { v[j] = xr[64 * j]; ss += (v[j][0] * v[j][0] + v[j][1] * v[j][1]) + (v[j][2] * v[j][2] + v[j][3] * v[j][3]); }
        const float rstd = rsqrtf(wave_sum(ss) * (1.f / 1024.f) + NORM_EPS);
#pragma unroll
        for (int j = 0; j < 4; ++j) { const int col = 4 * (64 * j + lane); const f32x4 wv = *(const f32x4*)(w + col);
            *(f32x4*)(out + (size_t)row * 1024 + col) = v[j] * rstd * wv; }
    }
}

__device__ __forceinline__ void gmlp_item(const Params& p, int l, unsigned char* lds, int item, int wid, int lane) {
    const int half = item & 1, ch = (item >> 1) & 31, b = item >> 6;
    const int fr = lane & 15, fq = lane >> 4;
    bf16_t* UV = (bf16_t*)(p.ws + O_UV); const bf16_t* GWS = (const bf16_t*)(p.ws + O_GWS);
    const float* lnw = PIN(6) + l * 512; const float* lnb = PIN(7) + l * 512;
    bf16_t* vnT = (bf16_t*)lds;
    const size_t row0 = (size_t)b * SEQ + ch * 128;
#pragma unroll 8
    for (int r = 0; r < 16; ++r) {
        const int s = wid * 16 + r;
        const bf16x8 raw = *(const bf16x8*)(UV + (row0 + s) * 1024 + 512 + 8 * lane);
        float x[8]; float sum = 0.f;
#pragma unroll
        for (int j = 0; j < 8; ++j) { x[j] = bf2f(raw[j]); sum += x[j]; }
        const float mean = wave_sum(sum) * (1.f / 512.f); float sq = 0.f;
#pragma unroll
        for (int j = 0; j < 8; ++j) { x[j] -= mean; sq += x[j] * x[j]; }
        const float rstd = rsqrtf(wave_sum(sq) * (1.f / 512.f) + NORM_EPS);
        if ((lane >> 5) == half) { const int c0 = (lane & 31) * 8;
#pragma unroll
            for (int j = 0; j < 8; ++j) { const int cc = half * 256 + c0 + j; const float o = x[j] * rstd * lnw[cc] + lnb[cc]; vnT[(c0 + j) * 136 + s] = (bf16_t)(cvtpk(o, 0.f) & 0xffffu); } }
    }
    __syncthreads();
    const int t0 = wid * 16; const int nks = (t0 + 15) / 32 + 1;
#pragma unroll 1
    for (int g4 = 0; g4 < 4; ++g4) {
        const int grp = half * 4 + g4;
        f32x4 acc[4];
#pragma unroll
        for (int ct = 0; ct < 4; ++ct) acc[ct] = (f32x4){0.f, 0.f, 0.f, 0.f};
        for (int ks = 0; ks < nks; ++ks) {
            const bf16x8 bw = *(const bf16x8*)(GWS + ((size_t)grp * 128 + t0 + fr) * 128 + ks * 32 + 8 * fq);
#pragma unroll
            for (int ct = 0; ct < 4; ++ct) { const bf16x8 av = *(const bf16x8*)(vnT + (g4 * 64 + ct * 16 + fr) * 136 + ks * 32 + 8 * fq); acc[ct] = mfma16(av, bw, acc[ct]); }
        }
        const float bsv = (PIN(9) + (size_t)l * 8 * 128 + grp * 128)[t0 + fr];
#pragma unroll
        for (int ct = 0; ct < 4; ++ct) { bf16_t* up = UV + (row0 + t0 + fr) * 1024 + grp * 64 + ct * 16 + 4 * fq;
            const u32x2 uw = *(const u32x2*)up; u32x2 o;
            o.x = cvtpk(bflo(uw.x) * (acc[ct][0] + bsv), bfhi(uw.x) * (acc[ct][1] + bsv)); o.y = cvtpk(bflo(uw.y) * (acc[ct][2] + bsv), bfhi(uw.y) * (acc[ct][3] + bsv));
            *(u32x2*)up = o; }
    }
    __syncthreads();
}
__device__ __forceinline__ void rotary_item(const Params& p, unsigned char* lds, int item, int tid, bool dry = false) {
    const int h = item & 7, nb = (item >> 3) & 15, b = item >> 7;
    float* sums = (float*)lds;
    if (tid < 64) sums[tid] = 0.f;
    __syncthreads();
    bf16_t* MQ = (bf16_t*)(p.ws + O_MQKV);
    const int half = (tid >> 5) & 1, tt = (tid >> 6) * 32 + (tid & 31); const int pos = nb * 256 + tt; const size_t row = (size_t)b * SEQ + pos;
    bf16_t* kp = MQ + row * 1536 + 512 + h * 64 + half * 32;
    float kv[32];
#pragma unroll
    for (int q = 0; q < 4; ++q) { const bf16x8 raw = *(const bf16x8*)(kp + 8 * q);
#pragma unroll
        for (int j = 0; j < 8; ++j) kv[8 * q + j] = bf2f(raw[j]); }
    if (half == 0 && !dry) {
        bf16_t* qp = MQ + row * 1536 + h * 64;
        float qv[16];
        { const bf16x8 r0 = *(const bf16x8*)qp, r1 = *(const bf16x8*)(qp + 8);
#pragma unroll
          for (int j = 0; j < 8; ++j) { qv[j] = bf2f(r0[j]); qv[8 + j] = bf2f(r1[j]); } }
        const float* rt = (const float*)(p.ws + O_ROT) + pos * 16;
        const f32x4 c0 = *(const f32x4*)rt, c1 = *(const f32x4*)(rt + 4), s0 = *(const f32x4*)(rt + 8), s1 = *(const f32x4*)(rt + 12);
#pragma unroll
        for (int j = 0; j < 8; ++j) {
            const float cs = (j < 4) ? c0[j & 3] : c1[j & 3], sn = (j < 4) ? s0[j & 3] : s1[j & 3];
            const float k1 = kv[j], k2 = kv[8 + j]; kv[j] = k1 * cs - k2 * sn; kv[8 + j] = k2 * cs + k1 * sn;
            const float q1 = qv[j], q2 = qv[8 + j]; qv[j] = q1 * cs - q2 * sn; qv[8 + j] = q2 * cs + q1 * sn;
        }
        *(bf16x8*)kp = pack8(kv[0], kv[1], kv[2], kv[3], kv[4], kv[5], kv[6], kv[7]);
        *(bf16x8*)(kp + 8) = pack8(kv[8], kv[9], kv[10], kv[11], kv[12], kv[13], kv[14], kv[15]);
        *(bf16x8*)qp = pack8(qv[0], qv[1], qv[2], qv[3], qv[4], qv[5], qv[6], qv[7]);
        *(bf16x8*)(qp + 8) = pack8(qv[8], qv[9], qv[10], qv[11], qv[12], qv[13], qv[14], qv[15]);
    }
#pragma unroll
    for (int d = 0; d < 32; ++d) {
        float v = row16_sum(kv[d]); v += __shfl_xor(v, 16);
        if ((tid & 31) == 0) atomicAdd(&sums[half * 32 + d], v);
    }
    __syncthreads();
    if (tid < 64) ((float*)(p.ws + O_KMEAN))[(((size_t)b * 8 + h) * 16 + nb) * 64 + tid] = sums[tid] * (1.f / 256.f);
    __syncthreads();
}
__device__ __forceinline__ void vt_item(const Params& p, unsigned char* lds, int item, int tid) {
    const int tb = item & 31, h = (item >> 5) & 7, b = (item >> 8) & 3, which = item >> 10;
    const bf16_t* src = (const bf16_t*)(p.ws + (which ? O_MQKV : O_FQKV)) + ((size_t)b * SEQ + tb * 128) * 1536 + 1024 + h * 64;
    bf16_t* dst = (bf16_t*)(p.ws + (which ? O_VTM : O_VTF)) + ((size_t)(b * 8 + h) * 64) * 4096 + tb * 128;
    bf16_t* tl = (bf16_t*)lds;
    { const int tok = tid >> 2, dq = tid & 3;
      const bf16x8 r0 = *(const bf16x8*)(src + (size_t)tok * 1536 + dq * 16), r1 = *(const bf16x8*)(src + (size_t)tok * 1536 + dq * 16 + 8);
#pragma unroll
      for (int j = 0; j < 8; ++j) { tl[(dq * 16 + j) * 136 + tok] = (bf16_t)r0[j]; tl[(dq * 16 + 8 + j) * 136 + tok] = (bf16_t)r1[j]; } }
    __syncthreads();
    { const int d = tid >> 3, c = tid & 7;
      const bf16x8 a = *(const bf16x8*)(tl + d * 136 + c * 16), bq = *(const bf16x8*)(tl + d * 136 + c * 16 + 8);
      *(bf16x8*)(dst + (size_t)d * 4096 + c * 16) = a; *(bf16x8*)(dst + (size_t)d * 4096 + c * 16 + 8) = bq; }
    __syncthreads();
}
__device__ __forceinline__ void conv_item(const Params& p, int l, int item, int tid) {
    const int cb = item % 20, sp = (item / 20) & 15, b = item / 320;
    const int c8 = tid & 7, tq = tid >> 3; const int gc = cb * 64 + 8 * c8;
    const int t0 = sp * 256 + tq * 4;
    const bf16_t* xp = (const bf16_t*)(p.ws + O_XBC) + ((size_t)b * SEQ) * 1280 + gc;
    float v[7][8];
#pragma unroll
    for (int r = 0; r < 7; ++r) { const int t = t0 - 3 + r;
        if (t >= 0) { const bf16x8 raw = *(const bf16x8*)(xp + (size_t)t * 1280);
#pragma unroll
            for (int j = 0; j < 8; ++j) v[r][j] = bf2f(raw[j]); }
        else {
#pragma unroll
            for (int j = 0; j < 8; ++j) v[r][j] = 0.f; } }
    const float* cw = PIN(11) + (size_t)l * 4 * 1280 + gc; const float* cbp = PIN(12) + l * 1280 + gc;
    float w[4][8], bias[8];
#pragma unroll
    for (int kk = 0; kk < 4; ++kk) { const f32x4 a = *(const f32x4*)(cw + kk * 1280), bq = *(const f32x4*)(cw + kk * 1280 + 4);
#pragma unroll
        for (int j = 0; j < 4; ++j) { w[kk][j] = a[j]; w[kk][4 + j] = bq[j]; } }
    { const f32x4 a = *(const f32x4*)cbp, bq = *(const f32x4*)(cbp + 4);
#pragma unroll
      for (int j = 0; j < 4; ++j) { bias[j] = a[j]; bias[4 + j] = bq[j]; } }
    float o[4][8];
#pragma unroll
    for (int tt = 0; tt < 4; ++tt)
#pragma unroll
        for (int j = 0; j < 8; ++j) { const float x = bias[j] + w[0][j] * v[tt][j] + w[1][j] * v[tt + 1][j] + w[2][j] * v[tt + 2][j] + w[3][j] * v[tt + 3][j]; o[tt][j] = x / (1.f + __expf(-x)); }
    const size_t tok0 = (size_t)b * SEQ + t0;
    if (cb < 12) {
        bf16_t* d = (bf16_t*)(p.ws + O_XT) + ((size_t)(b * 12 + cb) * 64 + 8 * c8) * 4096 + t0;
#pragma unroll
        for (int j = 0; j < 8; ++j) { u32x2 q; q.x = cvtpk(o[0][j], o[1][j]); q.y = cvtpk(o[2][j], o[3][j]); *(u32x2*)(d + (size_t)j * 4096) = q; }
    } else {
        bf16_t* BC = (bf16_t*)(p.ws + O_BC); const int bc = gc - 768;
#pragma unroll
        for (int tt = 0; tt < 4; ++tt) *(bf16x8*)(BC + (tok0 + tt) * 512 + bc) = pack8(o[tt][0], o[tt][1], o[tt][2], o[tt][3], o[tt][4], o[tt][5], o[tt][6], o[tt][7]);
        if (cb < 16) { bf16_t* d = (bf16_t*)(p.ws + O_BT) + ((size_t)b * 256 + bc) * 4096 + t0;
#pragma unroll
            for (int j = 0; j < 8; ++j) { u32x2 q; q.x = cvtpk(o[0][j], o[1][j]); q.y = cvtpk(o[2][j], o[3][j]); *(u32x2*)(d + (size_t)j * 4096) = q; } }
    }
}
__device__ __forceinline__ void acum_item(const Params& p, int l, int item, int lane) {
    const int ch = item & 31, h = (item >> 5) % 12, b = item / 384;
    const float* sm = (const float*)(p.ws + O_SMALL); const float a = -expf(PIN(14)[l * 12 + h]);
    const size_t tok = (size_t)b * SEQ + ch * 128 + 2 * lane;
    const float dtb = PIN(13)[l * 12 + h];
    const f32x2 raw = *(const f32x2*)(sm + (size_t)(8 + h) * T + tok); const float d0 = softplusf_(raw[0] + dtb), d1 = softplusf_(raw[1] + dtb);
    { f32x2 dd = {d0, d1}; *(f32x2*)((float*)(p.ws + O_DT) + ((size_t)(b * 12 + h)) * 4096 + ch * 128 + 2 * lane) = dd; }
    const float v0 = d0 * a, v1 = d1 * a;
    float sc = v0 + v1;
#pragma unroll
    for (int o = 1; o < 64; o <<= 1) { const float t = __shfl_up(sc, o); if (lane >= o) sc += t; }
    const float ex = sc - (v0 + v1);
    f32x2 r = {ex + v0, ex + v0 + v1};
    *(f32x2*)((float*)(p.ws + O_ACUM) + ((size_t)(b * 12 + h)) * 4096 + ch * 128 + 2 * lane) = r;
}
__device__ __forceinline__ void foxcum_item(const Params& p, int l, int item, int lane) {
    const int h = item & 7, b = item >> 3; const float fb = PIN(10)[l * 8 + h];
    const float* sm = (const float*)(p.ws + O_SMALL) + (size_t)h * T + (size_t)b * SEQ + lane * 64;
    float* cum = (float*)(p.ws + O_CUMF) + (size_t)(b * 8 + h) * 4096 + lane * 64;
    float v[64];
#pragma unroll
    for (int i = 0; i < 64; i += 4) { const f32x4 q = *(const f32x4*)(sm + i); v[i] = q[0]; v[i + 1] = q[1]; v[i + 2] = q[2]; v[i + 3] = q[3]; }
    float run = 0.f;
#pragma unroll
    for (int i = 0; i < 64; ++i) { const float x = v[i] + fb; run += fminf(x, 0.f) - __logf(1.f + __expf(-fabsf(x))); v[i] = run; }
    float sc = run;
#pragma unroll
    for (int o = 1; o < 64; o <<= 1) { const float t = __shfl_up(sc, o); if (lane >= o) sc += t; }
    const float ex = sc - run;
#pragma unroll
    for (int i = 0; i < 64; i += 4) { f32x4 w = {v[i] + ex, v[i + 1] + ex, v[i + 2] + ex, v[i + 3] + ex}; *(f32x4*)(cum + i) = w; }
}

template <bool MOBA, int VPITCH>
__device__ __forceinline__ void attn_tile64(const bf16_t* KL, const bf16_t* VL, const float* CL, int k0, bool diag, int kb,
                                            const bf16x8 (&qf)[2][2], const float (&cq)[2], const unsigned (&sel)[2], int qpos0, int fr, int fq,
                                            f32x4 (&lacc)[2], f32x4 (&o)[4][2]) {
    bf16x8 kf[4][2], vf[2][4]; f32x4 nck[4];
#pragma unroll
    for (int jk = 0; jk < 4; ++jk) { kf[jk][0] = *(const bf16x8*)(KL + (16 * jk + fr) * 72 + 8 * fq); kf[jk][1] = *(const bf16x8*)(KL + (16 * jk + fr) * 72 + 32 + 8 * fq); }
#pragma unroll
    for (int jk = 0; jk < 4; ++jk) nck[jk] = MOBA ? (f32x4){0.f, 0.f, 0.f, 0.f} : *(const f32x4*)(CL + 16 * jk + 4 * fq);
#pragma unroll
    for (int dt = 0; dt < 4; ++dt) { const bf16_t* vp = VL + (4 * fq + (fr >> 2)) * VPITCH + dt * 16 + 4 * (fr & 3); vf[0][dt] = cat4(lds_tr(vp), lds_tr(vp + 16 * VPITCH)); }
    __builtin_amdgcn_sched_barrier(0);
    f32x4 s[4][2];
    __builtin_amdgcn_s_setprio(1);
#pragma unroll
    for (int jk = 0; jk < 4; ++jk)
#pragma unroll
        for (int jq = 0; jq < 2; ++jq) { f32x4 z = {0.f, 0.f, 0.f, 0.f}; z = mfma16(kf[jk][0], qf[jq][0], z); s[jk][jq] = mfma16(kf[jk][1], qf[jq][1], z); }
    __builtin_amdgcn_s_setprio(0);
    __builtin_amdgcn_sched_barrier(0);
#pragma unroll
    for (int dt = 0; dt < 4; ++dt) { const bf16_t* vp = VL + (32 + 4 * fq + (fr >> 2)) * VPITCH + dt * 16 + 4 * (fr & 3); vf[1][dt] = cat4(lds_tr(vp), lds_tr(vp + 16 * VPITCH)); }
    __builtin_amdgcn_sched_barrier(0);
    constexpr float C2 = 0.125f * LOG2E;
#pragma unroll
    for (int jk = 0; jk < 4; ++jk)
#pragma unroll
        for (int jq = 0; jq < 2; ++jq)
#pragma unroll
            for (int i = 0; i < 4; ++i) s[jk][jq][i] = MOBA ? s[jk][jq][i] * C2 : fmaf(s[jk][jq][i], C2, nck[jk][i] + cq[jq]);
    if (diag) {
#pragma unroll
        for (int jk = 0; jk < 4; ++jk)
#pragma unroll
            for (int jq = 0; jq < 2; ++jq)
#pragma unroll
                for (int i = 0; i < 4; ++i) if (k0 + 16 * jk + 4 * fq + i > qpos0 + 16 * jq + fr) s[jk][jq][i] = -INFINITY;
    }
    if (MOBA && kb >= 0) {
#pragma unroll
        for (int jq = 0; jq < 2; ++jq) if (!((sel[jq] >> kb) & 1u)) {
#pragma unroll
            for (int jk = 0; jk < 4; ++jk) s[jk][jq] = (f32x4){-INFINITY, -INFINITY, -INFINITY, -INFINITY}; }
    }
    bf16x8 pb[2][2];
#pragma unroll
    for (int jq = 0; jq < 2; ++jq) {
#pragma unroll
        for (int jk = 0; jk < 4; ++jk)
#pragma unroll
            for (int i = 0; i < 4; ++i) s[jk][jq][i] = ex2(fminf(s[jk][jq][i], 100.f));
        pb[jq][0] = pack8(s[0][jq][0], s[0][jq][1], s[0][jq][2], s[0][jq][3], s[1][jq][0], s[1][jq][1], s[1][jq][2], s[1][jq][3]);
        pb[jq][1] = pack8(s[2][jq][0], s[2][jq][1], s[2][jq][2], s[2][jq][3], s[3][jq][0], s[3][jq][1], s[3][jq][2], s[3][jq][3]);
    }
    const u32x4 onesw = {0x3f803f80u, 0x3f803f80u, 0x3f803f80u, 0x3f803f80u}; const bf16x8 ones = __builtin_bit_cast(bf16x8, onesw);
    __builtin_amdgcn_s_setprio(1);
#pragma unroll
    for (int hh = 0; hh < 2; ++hh) {
#pragma unroll
        for (int jq = 0; jq < 2; ++jq) lacc[jq] = mfma16(ones, pb[jq][hh], lacc[jq]);
#pragma unroll
        for (int dt = 0; dt < 4; ++dt)
#pragma unroll
            for (int jq = 0; jq < 2; ++jq) o[dt][jq] = mfma16(vf[hh][dt], pb[jq][hh], o[dt][jq]);
    }
    __builtin_amdgcn_s_setprio(0);
}
__device__ __forceinline__ unsigned moba_select(const bf16_t* qp, const float* km, int own) {
    const bf16x8 r0 = *(const bf16x8*)qp, r1 = *(const bf16x8*)(qp + 8);
    float qd[16];
#pragma unroll
    for (int j = 0; j < 8; ++j) { qd[j] = bf2f(r0[j]); qd[8 + j] = bf2f(r1[j]); }
    float gate[15];
#pragma unroll
    for (int n = 0; n < 15; ++n) {
        float a = -INFINITY;
        if (n < own) { a = 0.f;
#pragma unroll
            for (int d = 0; d < 16; d += 4) { const f32x4 kk = *(const f32x4*)(km + n * 64 + d); a += qd[d] * kk[0] + qd[d + 1] * kk[1] + qd[d + 2] * kk[2] + qd[d + 3] * kk[3]; }
            a += __shfl_xor(a, 16); a += __shfl_xor(a, 32); }
        gate[n] = a;
    }
    unsigned msk = 0u;
#pragma unroll
    for (int pass = 0; pass < 3; ++pass) { float best = -INFINITY; int bi = -1;
#pragma unroll
        for (int n = 0; n < 15; ++n) { const float v = ((msk >> n) & 1u) ? -INFINITY : gate[n]; if (v > best) { best = v; bi = n; } }
        if (bi >= 0) msk |= 1u << bi; }
    return msk;
}
template <bool MOBA>
__device__ __forceinline__ void attn_block_item(const Params& p, unsigned char* lds, int b, int h, int qb, int tid_in, int wid, int lane_in) {
    int tid = tid_in, lane = lane_in; asm volatile("" : "+v"(tid), "+v"(lane));
    const int fr = lane & 15, fq = lane >> 4; const int q0 = qb * 256 + wid * 32;
    bf16_t* qkv = (bf16_t*)(p.ws + (MOBA ? O_MQKV : O_FQKV)) + ((size_t)b * SEQ) * 1536 + h * 64;
    const bf16_t* kbase = qkv + 512; const bf16_t* vtbase = (const bf16_t*)(p.ws + (MOBA ? O_VTM : O_VTF)) + ((size_t)(b * 8 + h) * 64) * 4096;
    const float* cum = (const float*)(p.ws + O_CUMF) + (size_t)(b * 8 + h) * 4096;
    bf16x8 qf[2][2];
#pragma unroll
    for (int jq = 0; jq < 2; ++jq)
#pragma unroll
        for (int ks = 0; ks < 2; ++ks) qf[jq][ks] = *(const bf16x8*)(qkv + (size_t)(q0 + 16 * jq + fr) * 1536 + ks * 32 + 8 * fq);
    float cq[2] = {0.f, 0.f}; unsigned sel[2] = {0u, 0u}; unsigned umask = 0u;
    const int own = qb;
    if (!MOBA) { cq[0] = cum[q0 + fr] * LOG2E; cq[1] = cum[q0 + 16 + fr] * LOG2E; }
    if (MOBA && own > 0) {
        const float* km = (const float*)(p.ws + O_KMEAN) + ((size_t)(b * 8 + h) * 16) * 64 + 16 * fq;
        sel[0] = moba_select(qkv + (size_t)(q0 + fr) * 1536 + 16 * fq, km, own);
        __builtin_amdgcn_sched_barrier(0);
        sel[1] = moba_select(qkv + (size_t)(q0 + 16 + fr) * 1536 + 16 * fq, km, own);
        __builtin_amdgcn_sched_barrier(0);
        umask = sel[0] | sel[1];
#pragma unroll
        for (int o2 = 1; o2 < 16; o2 <<= 1) umask |= __shfl_xor(umask, o2);
        umask = __builtin_amdgcn_readfirstlane(umask);
    }
    f32x4 lacc[2] = {(f32x4){0.f, 0.f, 0.f, 0.f}, (f32x4){0.f, 0.f, 0.f, 0.f}}; f32x4 o[4][2];
#pragma unroll
    for (int dt = 0; dt < 4; ++dt) { o[dt][0] = (f32x4){0.f, 0.f, 0.f, 0.f}; o[dt][1] = (f32x4){0.f, 0.f, 0.f, 0.f}; }
    const int NT = 2 * (qb + 1);
    constexpr int VP = 80;
    bf16_t* KLb = (bf16_t*)lds; bf16_t* VLb = KLb + 2 * 128 * 72;
    float* CLb = (float*)(VLb + 2 * 128 * VP);
    const int lr = tid >> 3, lc = (tid & 7) * 8;
    #define STEP_KT(i) (MOBA ? (((i) < 2) ? 2 * qb + (i) : (i) - 2) : (i))
    bf16x8 kreg0, kreg1, vreg0, vreg1; f32x4 creg = {0.f, 0.f, 0.f, 0.f};
    #define LOAD_STEP(kk0) do { kreg0 = *(const bf16x8*)(kbase + (size_t)((kk0) + lr) * 1536 + lc); kreg1 = *(const bf16x8*)(kbase + (size_t)((kk0) + 64 + lr) * 1536 + lc); \
        vreg0 = *(const bf16x8*)(kbase + 512 + (size_t)((kk0) + lr) * 1536 + lc); vreg1 = *(const bf16x8*)(kbase + 512 + (size_t)((kk0) + 64 + lr) * 1536 + lc); \
        if (!MOBA && tid < 32) creg = *(const f32x4*)(cum + (kk0) + 4 * tid) * (-LOG2E); } while (0)
    #define STORE_STEP(bb) do { *(bf16x8*)(KLb + (bb) * 128 * 72 + lr * 72 + lc) = kreg0; *(bf16x8*)(KLb + (bb) * 128 * 72 + (lr + 64) * 72 + lc) = kreg1; \
        *(bf16x8*)(VLb + (bb) * 128 * VP + lr * VP + lc) = vreg0; *(bf16x8*)(VLb + (bb) * 128 * VP + (lr + 64) * VP + lc) = vreg1; \
        if (!MOBA && tid < 32) *(f32x4*)(CLb + (bb) * 128 + 4 * tid) = creg; } while (0)
    int i_start = 0;
    if (!MOBA) {
        const float cq0 = cum[qb * 256];
        const float ce = (lane < NT) ? cum[lane * 128 + 127] : 0.f;
        const bool need = (lane < NT) && ((cq0 - ce) * LOG2E >= -64.f);
        const unsigned long long bal = __ballot(need);
        i_start = __builtin_amdgcn_readfirstlane(bal ? (int)__ffsll((long long)bal) - 1 : NT - 1);
    }
    LOAD_STEP(STEP_KT(i_start) * 128); STORE_STEP(0);
    __syncthreads();
#pragma unroll 1
    for (int i = i_start; i < NT; ++i) {
        const int k0 = STEP_KT(i) * 128; const int buf = (i - i_start) & 1;
        if (i + 1 < NT) LOAD_STEP(STEP_KT(i + 1) * 128);
        const bf16_t* KL = KLb + buf * 128 * 72; const bf16_t* VL = VLb + buf * 128 * VP; const float* CL = CLb + buf * 128;
        const int kb = k0 >> 8;
        const bool live = !MOBA || kb == own || ((umask >> kb) & 1u);
        if (live) {
#pragma unroll
            for (int hh = 0; hh < 2; ++hh) { const int k0h = k0 + 64 * hh;
                if (k0h <= q0 + 31) attn_tile64<MOBA, VP>(KL + hh * 64 * 72, VL + hh * 64 * VP, CL + hh * 64, k0h, k0h + 63 > q0, (MOBA && kb < own) ? kb : -1, qf, cq, sel, q0, fr, fq, lacc, o); }
        }
        if (i + 1 < NT) STORE_STEP(buf ^ 1);
        __syncthreads();
    }
    #undef STEP_KT
    #undef LOAD_STEP
    #undef STORE_STEP
#pragma unroll
    for (int jq = 0; jq < 2; ++jq) {
        const float inv = 1.f / lacc[jq][0];
        bf16_t* op = qkv + (size_t)(q0 + 16 * jq + fr) * 1536 + 4 * fq;
#pragma unroll
        for (int dt = 0; dt < 4; ++dt) { const f32x4 v = o[dt][jq] * inv; u32x2 w; w.x = cvtpk(v[0], v[1]); w.y = cvtpk(v[2], v[3]); *(u32x2*)(op + dt * 16) = w; }
    }
}
__device__ __forceinline__ void ssd_states_item(const Params& p, int item, int lane) {
    const int h = item % 12, c = (item / 12) & 31, b = item / 384; const int grp = h / 6;
    const int fr = lane & 15, fq = lane >> 4;
    const float* ac = (const float*)(p.ws + O_ACUM) + (size_t)(b * 12 + h) * 4096 + c * 128;
    const float* dtp = (const float*)(p.ws + O_DT) + (size_t)(b * 12 + h) * 4096 + c * 128;
    const bf16_t* XT = (const bf16_t*)(p.ws + O_XT) + ((size_t)(b * 12 + h) * 64) * 4096 + c * 128;
    const bf16_t* BT = (const bf16_t*)(p.ws + O_BT) + ((size_t)(b * 2 + grp) * 128) * 4096 + c * 128;
    float* ST = (float*)(p.ws + O_ST) + ((size_t)((b * 32 + c) * 12 + h)) * 8192;
    const float total = ac[127];
#pragma unroll 1
    for (int q2 = 0; q2 < 4; ++q2) {
        f32x4 acc[4][2];
#pragma unroll
        for (int pt = 0; pt < 4; ++pt) { acc[pt][0] = (f32x4){0.f, 0.f, 0.f, 0.f}; acc[pt][1] = (f32x4){0.f, 0.f, 0.f, 0.f}; }
#pragma unroll 1
        for (int ks = 0; ks < 4; ++ks) {
            const int s0 = ks * 32 + 8 * fq;
            const f32x4 a0 = *(const f32x4*)(ac + s0), a1 = *(const f32x4*)(ac + s0 + 4);
            const f32x4 d0 = *(const f32x4*)(dtp + s0), d1 = *(const f32x4*)(dtp + s0 + 4);
            float w8[8];
#pragma unroll
            for (int j = 0; j < 4; ++j) { w8[j] = __expf(total - a0[j]) * d0[j]; w8[4 + j] = __expf(total - a1[j]) * d1[j]; }
            const bf16x8 b0 = *(const bf16x8*)(BT + (size_t)((q2 * 2 + 0) * 16 + fr) * 4096 + s0), b1 = *(const bf16x8*)(BT + (size_t)((q2 * 2 + 1) * 16 + fr) * 4096 + s0);
#pragma unroll
            for (int pt = 0; pt < 4; ++pt) { const bf16x8 xa = *(const bf16x8*)(XT + (size_t)(pt * 16 + fr) * 4096 + s0);
                const bf16x8 af = pack8(bf2f(xa[0]) * w8[0], bf2f(xa[1]) * w8[1], bf2f(xa[2]) * w8[2], bf2f(xa[3]) * w8[3], bf2f(xa[4]) * w8[4], bf2f(xa[5]) * w8[5], bf2f(xa[6]) * w8[6], bf2f(xa[7]) * w8[7]);
                acc[pt][0] = mfma16(b0, af, acc[pt][0]); acc[pt][1] = mfma16(b1, af, acc[pt][1]); }
        }
#pragma unroll
        for (int pt = 0; pt < 4; ++pt)
#pragma unroll
            for (int nt = 0; nt < 2; ++nt) *(f32x4*)(ST + (size_t)(pt * 16 + fr) * 128 + (q2 * 2 + nt) * 16 + 4 * fq) = acc[pt][nt];
    }
}
__device__ __forceinline__ void ssd_scan(const Params& p, int gtid, int gthreads) {
    const float* ST = (const float*)(p.ws + O_ST); bf16_t* PV = (bf16_t*)(p.ws + O_PREV); const float* ACUM = (const float*)(p.ws + O_ACUM);
    for (int e4 = gtid; e4 < NB * 12 * 2048; e4 += gthreads) {
        const int pn = (e4 & 2047) * 4, h = (e4 >> 11) % 12, b = e4 / (12 * 2048);
        const float* ac = ACUM + (size_t)(b * 12 + h) * 4096 + 127;
        const size_t base = ((size_t)(b * 32) * 12 + h) * 8192 + pn;
        f32x4 hs = {0.f, 0.f, 0.f, 0.f};
#pragma unroll 8
        for (int c = 0; c < 32; ++c) { const f32x4 st = *(const f32x4*)(ST + base + (size_t)c * 12 * 8192); const float dc = __expf(ac[c * 128]);
            u32x2 q; q.x = cvtpk(hs[0], hs[1]); q.y = cvtpk(hs[2], hs[3]); *(u32x2*)(PV + base + (size_t)c * 12 * 8192) = q;
            hs = hs * dc + st; }
    }
}
__device__ __forceinline__ void ssd_out_item(const Params& p, int l, int item, int wid, int lane, bool dry = false) {
    const int grp = item & 1, c = (item >> 1) & 31, b = item >> 6;
    const int fr = lane & 15, fq = lane >> 4; const int w = wid; const int tl = 16 * w + fr;
    const size_t row0 = (size_t)b * SEQ + c * 128; const size_t row = row0 + tl;
    const bf16_t* BC = (const bf16_t*)(p.ws + O_BC);
    bf16_t* Z = (bf16_t*)(p.ws + O_Z);
    bf16x8 cf[4];
#pragma unroll
    for (int ks = 0; ks < 4; ++ks) cf[ks] = *(const bf16x8*)(BC + row * 512 + 256 + grp * 128 + ks * 32 + 8 * fq);
    f32x4 cbt[8];
#pragma unroll
    for (int js = 0; js < 8; ++js) { cbt[js] = (f32x4){0.f, 0.f, 0.f, 0.f};
        if (js <= w) {
#pragma unroll
            for (int ks = 0; ks < 4; ++ks) { const bf16x8 a = *(const bf16x8*)(BC + (row0 + js * 16 + fr) * 512 + grp * 128 + ks * 32 + 8 * fq); cbt[js] = mfma16(a, cf[ks], cbt[js]); } } }
    float ssq = 0.f;
#pragma unroll 1
    for (int r = 0; r < 6; ++r) {
        const int h = grp * 6 + r;
        const float* ac = (const float*)(p.ws + O_ACUM) + (size_t)(b * 12 + h) * 4096 + c * 128;
        const float* dtp = (const float*)(p.ws + O_DT) + (size_t)(b * 12 + h) * 4096 + c * 128;
        const float acl = ac[tl]; const float eacl = __expf(acl); const float Dh = PIN(15)[l * 12 + h];
        const bf16_t* PV = (const bf16_t*)(p.ws + O_PREV) + ((size_t)((b * 32 + c) * 12 + h)) * 8192;
        const bf16_t* XT = (const bf16_t*)(p.ws + O_XT) + ((size_t)(b * 12 + h) * 64) * 4096 + c * 128;
        f32x4 yt[4];
#pragma unroll
        for (int pt = 0; pt < 4; ++pt) yt[pt] = (f32x4){0.f, 0.f, 0.f, 0.f};
#pragma unroll
        for (int ks = 0; ks < 4; ++ks)
#pragma unroll
            for (int pt = 0; pt < 4; ++pt) { const bf16x8 a = *(const bf16x8*)(PV + (size_t)(pt * 16 + fr) * 128 + ks * 32 + 8 * fq); yt[pt] = mfma16(a, cf[ks], yt[pt]); }
#pragma unroll
        for (int pt = 0; pt < 4; ++pt) yt[pt] = yt[pt] * eacl;
#pragma unroll
        for (int jp = 0; jp < 4; ++jp) {
            if (2 * jp <= w) {
                const int sA = 32 * jp + 4 * fq, sB = sA + 16;
                const f32x4 a0 = *(const f32x4*)(ac + sA), a1 = *(const f32x4*)(ac + sB), dv0 = *(const f32x4*)(dtp + sA), dv1 = *(const f32x4*)(dtp + sB);
                float mv[8];
#pragma unroll
                for (int j = 0; j < 4; ++j) {
                    const int s = sA + j; const float d0 = dv0[j];
                    float v = (s <= tl) ? cbt[2 * jp][j] * __expf(acl - a0[j]) * d0 : 0.f; if (s == tl) v += Dh; mv[j] = v;
                    const int s2 = sB + j; const float d1 = dv1[j];
                    float v2 = (s2 <= tl) ? cbt[2 * jp + 1][j] * __expf(acl - a1[j]) * d1 : 0.f; if (s2 == tl) v2 += Dh; mv[4 + j] = v2;
                }
                const bf16x8 mb = pack8(mv[0], mv[1], mv[2], mv[3], mv[4], mv[5], mv[6], mv[7]);
#pragma unroll
                for (int pt = 0; pt < 4; ++pt) { const bf16_t* xp = XT + (size_t)(pt * 16 + fr) * 4096 + sA; yt[pt] = mfma16(ld2x8(xp, xp + 16), mb, yt[pt]); }
            }
        }
#pragma unroll
        for (int pt = 0; pt < 4; ++pt) { bf16_t* zp = Z + row * 768 + h * 64 + pt * 16 + 4 * fq; const u32x2 zw = *(const u32x2*)zp;
            const float y0 = yt[pt][0] * bflo(zw.x), y1 = yt[pt][1] * bfhi(zw.x), y2 = yt[pt][2] * bflo(zw.y), y3 = yt[pt][3] * bfhi(zw.y);
            ssq += (y0 * y0 + y1 * y1) + (y2 * y2 + y3 * y3);
            u32x2 o; o.x = cvtpk(y0, y1); o.y = cvtpk(y2, y3); if (!dry) *(u32x2*)zp = o; }
    }
    ssq += __shfl_xor(ssq, 16); ssq += __shfl_xor(ssq, 32);
    if (dry) return;
    const float rstd = rsqrtf(ssq * (1.f / 384.f) + NORM_EPS);
    VM_WAIT();
    const float* nw = PIN(16) + l * 768 + grp * 384;
    bf16_t* zp0 = Z + row * 768 + grp * 384 + 4 * fq;
#pragma unroll 4
    for (int q = 0; q < 24; ++q) { bf16_t* zp = zp0 + q * 16; const u32x2 zw = *(const u32x2*)zp; const f32x4 nv = *(const f32x4*)(nw + q * 16 + 4 * fq);
        u32x2 o; o.x = cvtpk(bflo(zw.x) * rstd * nv[0], bfhi(zw.x) * rstd * nv[1]); o.y = cvtpk(bflo(zw.y) * rstd * nv[2], bfhi(zw.y) * rstd * nv[3]); *(u32x2*)zp = o; }
}

__device__ __forceinline__ void small_cols_item(const bf16_t* Hh, const bf16_t* Wt, float* sm, int item, int lane) {
    const int fr = lane & 15, fq = lane >> 4; const size_t row0 = (size_t)item * 16;
    const bf16_t* ap = Hh + (row0 + fr) * 1024 + 8 * fq; const bf16_t* b0p = Wt + (size_t)fr * 1024 + 8 * fq; const bf16_t* b1p = b0p + 16 * 1024;
    f32x4 acc0[2] = {(f32x4){0.f, 0.f, 0.f, 0.f}, (f32x4){0.f, 0.f, 0.f, 0.f}}, acc1[2] = {(f32x4){0.f, 0.f, 0.f, 0.f}, (f32x4){0.f, 0.f, 0.f, 0.f}};
#pragma unroll 8
    for (int ks = 0; ks < 32; ++ks) {
        const bf16x8 a = *(const bf16x8*)(ap + ks * 32), w0 = *(const bf16x8*)(b0p + ks * 32), w1 = *(const bf16x8*)(b1p + ks * 32);
        acc0[ks & 1] = mfma16(a, w0, acc0[ks & 1]); acc1[ks & 1] = mfma16(a, w1, acc1[ks & 1]);
    }
    const f32x4 r0 = acc0[0] + acc0[1], r1 = acc1[0] + acc1[1];
    *(f32x4*)(sm + (size_t)fr * T + row0 + 4 * fq) = r0; *(f32x4*)(sm + (size_t)(16 + fr) * T + row0 + 4 * fq) = r1;
}
#define LAS __attribute__((address_space(3)))
#define XB_TMO      128
#define XB_XCNT(j)  (256  + 64 * (j))
#define XB_XSUB(j)  (1280 + 64 * (j))
#define XB_XGEN(j)  (2304 + 64 * (j))
#define XB_TOP      3328
#define XB_TOPGEN   3392
#define XCD_BAR_WORDS 3456
#define XB_SPIN_CAP (1u << 18)

__device__ __forceinline__ unsigned xb_ld(unsigned* p)              { return __hip_atomic_load(p, __ATOMIC_RELAXED, __HIP_MEMORY_SCOPE_AGENT); }
__device__ __forceinline__ unsigned xb_add(unsigned* p, unsigned v) { return __hip_atomic_fetch_add(p, v, __ATOMIC_RELAXED, __HIP_MEMORY_SCOPE_AGENT); }
__device__ __forceinline__ unsigned xb_xcc_id() { return (unsigned)__builtin_amdgcn_s_getreg((3 << 11) | 20) & 0xFu; }
#define XB_SPIN(cond, bar) do { unsigned _sp = 0; while (cond) { __builtin_amdgcn_s_sleep(1); \
    if ((++_sp & 255u) == 0u) { if (xb_ld(&(bar)[XB_TMO])) break; if (_sp > XB_SPIN_CAP) { atomicAdd(&(bar)[XB_TMO], 1u); break; } } } } while (0)

struct XcdBarrier {
    unsigned* bar; unsigned x;
    volatile LAS unsigned* st;
};

__device__ __forceinline__ XcdBarrier xcd_barrier_post(unsigned* bar, volatile LAS unsigned* st) {
    XcdBarrier b; b.bar = bar; b.x = xb_xcc_id(); b.st = st;
    if (threadIdx.x == 0) (void)xb_add(&bar[XB_XCNT(b.x)], 1u);
    return b;
}
__device__ __forceinline__ void xcd_barrier_complete(unsigned* bar, unsigned x, unsigned& nloc, unsigned& nx) {
    const unsigned G = gridDim.x * gridDim.y * gridDim.z;
    unsigned sum, cnt, mine, sp = 0u;
    for (;;) {
        sum = 0u; cnt = 0u; mine = 0u;
#pragma unroll
        for (unsigned j = 0; j < 16; ++j) { const unsigned c = xb_ld(&bar[XB_XCNT(j)]); sum += c; cnt += (c > 0u) ? 1u : 0u; mine = (j == x) ? c : mine; }
        if (sum == G) break;
        __builtin_amdgcn_s_sleep(1);
        if ((++sp & 255u) == 0u) { if (xb_ld(&bar[XB_TMO])) break; if (sp > XB_SPIN_CAP) { atomicAdd(&bar[XB_TMO], 1u); break; } }
    }
    nloc = mine > 0u ? mine : 1u; nx = cnt > 0u ? cnt : 1u;
}

__device__ __forceinline__ void xcd_barrier(const XcdBarrier& b) {
    asm volatile("s_waitcnt vmcnt(0)" ::: "memory");
    __syncthreads();
    if (threadIdx.x == 0) {
        unsigned* bar = b.bar;
        __builtin_amdgcn_s_waitcnt(0);
        unsigned nloc = b.st[0], nx = b.st[1];
        if (nloc == 0u) { xcd_barrier_complete(bar, b.x, nloc, nx); b.st[0] = nloc; b.st[1] = nx; }
        const unsigned old = xb_add(&bar[XB_XSUB(b.x)], 1u);
        const unsigned gen = old / nloc;
        if (old + 1u == (gen + 1u) * nloc) {
            __builtin_amdgcn_fence(__ATOMIC_RELEASE, "agent");
            asm volatile("s_waitcnt vmcnt(0)" ::: "memory");
            const unsigned og = xb_add(&bar[XB_TOP], 1u);
            const unsigned tg = og / nx;
            if (og + 1u == (tg + 1u) * nx) xb_add(&bar[XB_TOPGEN], 1u);
            else XB_SPIN(xb_ld(&bar[XB_TOPGEN]) == tg, bar);
            __builtin_amdgcn_fence(__ATOMIC_ACQUIRE, "agent");
            xb_add(&bar[XB_XGEN(b.x)], 1u);
            asm volatile("s_waitcnt vmcnt(0)" ::: "memory");
        } else {
            XB_SPIN(xb_ld(&bar[XB_XGEN(b.x)]) == gen, bar);
            __builtin_amdgcn_fence(__ATOMIC_ACQUIRE, "agent");
            asm volatile("s_waitcnt vmcnt(0)" ::: "memory");
        }
    }
    __syncthreads();
}

constexpr int PH_PER_LAYER = 11, N_PHASES = 1 + DEPTH * PH_PER_LAYER + 1;
template <int EN_MASK, bool EN_GEMM>
__device__ __forceinline__ void fwd_body(const Params& p) {
    extern __shared__ __attribute__((aligned(16))) unsigned char lds[];
    cg::grid_group grid = cg::this_grid();
    const int G = gridDim.x, NGW = G * 8;
    unsigned char* ws = p.ws;
    volatile LAS unsigned* MISC = (volatile LAS unsigned*)((LAS unsigned char*)lds + 132096);
    if (threadIdx.x < 2) MISC[threadIdx.x] = 0u;
    __syncthreads();
    XcdBarrier xbar = xcd_barrier_post((unsigned*)(ws + O_CTL), MISC);
    float* mod = (float*)(ws + O_MOD); float* X = (float*)(ws + O_X); bf16_t* H = (bf16_t*)(ws + O_H);
    for (int ph = p.ph_lo; ph < p.ph_hi; ++ph) {
        int tid = threadIdx.x; asm volatile("" : "+v"(tid));
        const int lane = tid & 63, wid = __builtin_amdgcn_readfirstlane(tid >> 6); const int gw = blockIdx.x * 8 + wid;
        if (ph == 0) { if constexpr (EN_MASK != 0) phase_pre(p, lds, tid); }
        else if (ph == N_PHASES - 1) { if constexpr (EN_MASK != 0) final_norm_rows(X, PIN(25), p.out, gw, NGW, lane); }
        else {
            const int l = (ph - 1) / PH_PER_LAYER, k = (ph - 1) % PH_PER_LAYER;
            const float* modl = mod + (size_t)l * 4 * 6144;
            const float* xin = (l == 0) ? PIN(0) : X;
            if (k == 1 || k == 6 || k == 7 || k == 9 || k == 10) { if constexpr (EN_GEMM) {
                const int nsub = (k == 6) ? 4 : 1;
#pragma unroll 1
                for (int br = 0; br < nsub; ++br) {
                    EpiU E{}; const bf16_t* A; const bf16_t* Bt; int lda, N, K;
                    if (k == 1) { E.kind = 0; E.p1 = ws; A = H; lda = 1024; Bt = (const bf16_t*)(ws + O_WIN); N = NPROJ - 256; K = 1024; }
                    else if (k == 6) {
                        const size_t aoffs = (br == 0) ? O_UV : (br == 1) ? O_FQKV : (br == 2) ? O_MQKV : O_Z;
                        const size_t woffs = (br == 0) ? O_WA : (br == 1) ? O_WB : (br == 2) ? O_WC : O_WD;
                        E.kind = 1; E.p0 = (const unsigned char*)(ws + O_GATE) + br * 1024; E.p1 = (float*)(ws + O_MF32); E.p2 = H; E.mode = (br == 0) ? 0 : (br == 3) ? 2 : 1;
                        A = (const bf16_t*)(ws + aoffs); lda = (br == 0) ? 1024 : (br == 3) ? 768 : 1536; Bt = (const bf16_t*)(ws + woffs); N = 1024; K = (br == 3) ? 768 : 512; }
                    else if (k == 7) { E.kind = 2; E.p0 = xin; E.p1 = X; E.p2 = (void*)(modl + 2048); A = H; lda = 1024; Bt = (const bf16_t*)(ws + O_WO); N = 1024; K = 1024; }
                    else if (k == 9) { E.kind = 3; E.p1 = (bf16_t*)(ws + O_HID); A = H; lda = 1024; Bt = (const bf16_t*)(ws + O_W1); N = 4096; K = 1024; }
                    else { E.kind = 2; E.p0 = X; E.p1 = X; E.p2 = (void*)(modl + 5120); A = (const bf16_t*)(ws + O_HID); lda = 4096; Bt = (const bf16_t*)(ws + O_W2); N = 1024; K = 4096; }
#ifdef PROBE_DUP_GEMM
                    E.dry = (p.ph_lo == 0); run_gemm(lds, A, lda, Bt, N, K, E); E.dry = 0;
#endif
#ifndef STAGGER_TICKS
#define STAGGER_TICKS 0
#endif
                    if (STAGGER_TICKS > 0 && (k == 1 || k == 9)) {
                        const unsigned long long t0 = __builtin_amdgcn_s_memrealtime(); const unsigned long long dl = (unsigned long long)(((blockIdx.x >> 3) & 3) * STAGGER_TICKS);
                        while (__builtin_amdgcn_s_memrealtime() - t0 < dl) __builtin_amdgcn_s_sleep(16);
                    }
                    run_gemm(lds, A, lda, Bt, N, K, E);
                }
                if (k == 1) for (int it = gw; it < 1024; it += NGW) small_cols_item((const bf16_t*)H, (const bf16_t*)(ws + O_WIN) + (size_t)10240 * 1024, (float*)(ws + O_SMALL), it, lane);
            } } else switch (k) {
            case 0: if constexpr ((EN_MASK >> 0) & 1) {
#ifdef PROBE_A
                convert_weights(p, l, lds, gw, NGW, wid, lane); norm_mod_rows(xin, PIN(4) + l * 1024, modl + 0, modl + 1024, H, gw, NGW, lane);
#endif
                convert_weights(p, l, lds, gw, NGW, wid, lane);
                norm_mod_rows(xin, PIN(4) + l * 1024, modl + 0, modl + 1024, H, gw, NGW, lane);
            } break;
            case 2: if constexpr ((EN_MASK >> 2) & 1) {
#ifdef PROBE_C
                { const bool dry = (p.ph_lo == 0);
                for (int it = blockIdx.x; it < 1024; it += G) gmlp_item(p, l, lds, it, wid, lane, dry);
                for (int it = blockIdx.x; it < 512; it += G) rotary_item(p, lds, it, tid, dry);
                for (int it = blockIdx.x; it < 1280; it += G) conv_item(p, l, it, tid);
                for (int it = gw; it < 1536; it += NGW) acum_item(p, l, it, lane);
                for (int it = NGW - 1 - gw; it < 32; it += NGW) foxcum_item(p, l, it, lane); }
#endif
                for (int it = blockIdx.x; it < 256; it += G) gmlp_item(p, l, lds, it, wid, lane);
                for (int it = blockIdx.x; it < 512; it += G) rotary_item(p, lds, it, tid);
                for (int it = blockIdx.x; it < 1280; it += G) conv_item(p, l, it, tid);
                for (int it = gw; it < 1536; it += NGW) acum_item(p, l, it, lane);
                for (int it = NGW - 1 - gw; it < 32; it += NGW) foxcum_item(p, l, it, lane);
            } break;
            case 3: if constexpr ((EN_MASK >> 3) & 1) {
#ifndef EN3
#define EN3 7
#endif
                { unsigned* qctr = (unsigned*)(ws + O_CTL) + 3584 + 64 * l;
                  volatile unsigned* slot = (volatile unsigned*)(lds + 131584);
                  for (;;) {
                      if (tid == 0) *slot = atomicAdd(qctr, 1u);
                      __syncthreads();
                      const unsigned it = (unsigned)__builtin_amdgcn_readfirstlane((int)*slot);
                      __syncthreads();
                      if (it >= 1024u) break;
                      const int qb = 15 - (int)(it >> 6), sub = (int)(it & 63u), bh = sub & 31;
                      if (sub < 32) attn_block_item<false>(p, lds, bh >> 3, bh & 7, qb, tid, wid, lane);
                      else attn_block_item<true>(p, lds, bh >> 3, bh & 7, qb, tid, wid, lane);
                  } }
                if constexpr (EN3 & 4) for (int i = NGW - 1 - gw; i < 1536; i += NGW) ssd_states_item(p, i, lane);
            } break;
            case 4: if constexpr ((EN_MASK >> 4) & 1) {
#ifdef PROBE_EF
                ssd_scan(p, blockIdx.x * 512 + tid, G * 512);
#endif
                ssd_scan(p, blockIdx.x * 512 + tid, G * 512); } break;
            case 5: if constexpr ((EN_MASK >> 5) & 1) {
#ifdef PROBE_EF
                for (int it = blockIdx.x; it < 256; it += G) ssd_out_item(p, l, it, wid, lane, p.ph_lo == 0);
#endif
                for (int it = blockIdx.x; it < 256; it += G) ssd_out_item(p, l, it, wid, lane); } break;
            case 8: if constexpr ((EN_MASK >> 8) & 1) { norm_mod_rows(X, PIN(22) + l * 1024, modl + 3072, modl + 4096, H, gw, NGW, lane); } break;
            }
        }
        if (ph + 1 < p.ph_hi) { if (ph == 0) grid.sync(); else xcd_barrier(xbar); }
#ifdef PROBE_SYNC
        if (ph + 1 < p.ph_hi) { xcd_barrier(xbar); xcd_barrier(xbar); }
#endif
    }
}

#ifndef N_LAUNCH_MODE
#define N_LAUNCH_MODE 1
#endif
#if N_LAUNCH_MODE == 1
__global__ void __launch_bounds__(512, 2) fwd_all(Params p) { fwd_body<0x7ff, true>(p); }
#define KERNEL_FOR_ATTR fwd_all
#else
__global__ void __launch_bounds__(512, 2) fwd_gemm(Params p) { fwd_body<0, true>(p); }
__global__ void __launch_bounds__(512, 2) fwd_misc(Params p) { fwd_body<0x7ff, false>(p); }
#endif
extern "C" void kernel_launch(void* const* d_in, const int* in_sizes, int n_in, void* d_out, int out_size, void* d_ws, size_t ws_size, hipStream_t stream) {
    static int grid = 0;
    if (grid == 0) {
        if (n_in != 26 || out_size != T * DM || ws_size < WS_END) { fprintf(stderr, "kernel_launch: unexpected shapes (n_in %d out %d ws %zu need %zu)\n", n_in, out_size, ws_size, (size_t)WS_END); grid = -1; return; }
        int dev = 0, cus = 0;
        (void)hipGetDevice(&dev); (void)hipDeviceGetAttribute(&cus, hipDeviceAttributeMultiprocessorCount, dev);
#if N_LAUNCH_MODE == 1
        if (hipFuncSetAttribute((const void*)fwd_all, hipFuncAttributeMaxDynamicSharedMemorySize, LDS_BYTES) != hipSuccess) { fprintf(stderr, "kernel_launch: hipFuncSetAttribute failed\n"); grid = -1; return; }
#else
        if (hipFuncSetAttribute((const void*)fwd_gemm, hipFuncAttributeMaxDynamicSharedMemorySize, LDS_BYTES) != hipSuccess || hipFuncSetAttribute((const void*)fwd_misc, hipFuncAttributeMaxDynamicSharedMemorySize, LDS_BYTES) != hipSuccess) { fprintf(stderr, "kernel_launch: hipFuncSetAttribute failed\n"); grid = -1; return; }
#endif
        (void)hipGetLastError();
        grid = cus > 0 ? cus : 256;
    }
    if (grid < 0) return;
    if (hipMemsetAsync((char*)d_ws + O_CTL, 0, 16384, stream) != hipSuccess) { fprintf(stderr, "kernel_launch: memset failed\n"); return; }
    Params p{};
    for (int i = 0; i < 26; ++i) p.in[i] = (const float*)d_in[i];
    p.out = (float*)d_out; p.ws = (unsigned char*)d_ws;
#if N_LAUNCH_MODE == 1
    p.ph_lo = 0; p.ph_hi = N_PHASES;
    void* args[] = {&p};
    hipError_t e = hipLaunchCooperativeKernel((const void*)fwd_all, dim3(grid), dim3(512), args, LDS_BYTES, stream);
    if (e != hipSuccess) fprintf(stderr, "kernel_launch: cooperative launch failed: %s (grid %d)\n", hipGetErrorString(e), grid);
#else
    for (int ph = 0; ph < N_PHASES; ++ph) { p.ph_lo = ph; p.ph_hi = ph + 1;
        const int k = (ph >= 1 && ph < N_PHASES - 1) ? (ph - 1) % PH_PER_LAYER : -1;
        if (k == 1 || k == 6 || k == 7 || k == 9 || k == 10) hipLaunchKernelGGL(fwd_gemm, dim3(grid), dim3(512), LDS_BYTES, stream, p);
        else hipLaunchKernelGGL(fwd_misc, dim3(grid), dim3(512), LDS_BYTES, stream, p); }
#endif
}
```

```cpp
#include <hip/hip_runtime.h>
#include <hip/hip_cooperative_groups.h>
#include <cstdio>
#include <cstdint>
#include <cmath>
namespace cg = cooperative_groups;
namespace pg8 {
#define PG8_LAS __attribute__((address_space(3)))
typedef unsigned short bf16_t;
typedef short bf16x8 __attribute__((ext_vector_type(8)));
typedef float f32x4 __attribute__((ext_vector_type(4)));
typedef unsigned u32x4 __attribute__((ext_vector_type(4)));
constexpr int BM = 256, BK = 64, HALF = 128, HTB = HALF * BK * 2  , STAGE_BYTES = 8 * HTB, NXCD = 8, WGM = 8;

__host__ __device__ __forceinline__ int lds_byte(int r, int c) { const int st = (r >> 4) * 2 + (c >> 5), rr = r & 15, cc = c & 31, ob = rr * 64 + cc * 2; return st * 1024 + (ob ^ (((ob >> 9) & 1) << 5)); }
__host__ __device__ __forceinline__ void stage_rc(int b, int& R, int& C) { const int st = b / 1024, sb = b % 1024, swz = sb ^ (((sb >> 9) & 1) << 5); R = (st >> 1) * 16 + swz / 64; C = (st & 1) * 32 + (swz % 64) / 2; }
__host__ __device__ __forceinline__ int perm32(int rho) { const int n = rho >> 4, i = rho & 15; return 8 * (i >> 2) + 4 * n + (i & 3); }

struct Unit { int pm, pn; };
struct Gemm { const bf16_t* A; const bf16_t* Bt; int M, N, K, lda; };

struct StaticOrder {
    int nM, nN, nwg, G, c;
    __host__ __device__ void init(int M, int N, int G_, int c_) { nM = M / BM; nN = N / BM; nwg = nM * nN; G = G_; c = c_; }
    __host__ __device__ bool next(int i, Unit& u) const {
        const long L = (long)i * G + c; if (L >= nwg) return false;
        int wgid = (int)L; { const int q = nwg / NXCD, r = nwg % NXCD, xcd = wgid % NXCD, off = wgid / NXCD; wgid = (xcd < r ? xcd * (q + 1) : r * (q + 1) + (xcd - r) * q) + off; }
        const int nig = WGM * nN, gid = wgid / nig, fm = gid * WGM, gsz = (nM - fm) < WGM ? (nM - fm) : WGM;
        u.pm = fm + ((wgid % nig) % gsz); u.pn = (wgid % nig) / gsz; return true;
    }
    __device__ __forceinline__ void a_ready(const Unit&) const {}
    __device__ __forceinline__ void done(const Unit&) const {}
};


template <class Epi, class Sched, bool ALIGN_EPI = false, bool SP2 = false>
__device__ __forceinline__ void gemm_phase(PG8_LAS unsigned char* lds, const Gemm g, const Sched& S, const Epi& E) {
    int tid_l = threadIdx.x; asm volatile("" : "+v"(tid_l));
    const int tid = tid_l, wid = __builtin_amdgcn_readfirstlane(tid >> 6), lane = tid & 63, wr = wid >> 2, wc = wid & 3, fr = lane & 15, fq = lane >> 4;
    const int K = g.K, nt = K / BK;
    unsigned voffA[2], voffB[2];
#pragma unroll
    for (int i = 0; i < 2; ++i) { int R, C; stage_rc(tid * 16 + i * 8192, R, C); const int Rb = Epi::PERM ? ((R & ~31) + perm32(R & 31)) : R;
        voffA[i] = (unsigned)(R * g.lda + C) * 2u; voffB[i] = (unsigned)(Rb * K + C) * 2u; }
    const size_t kstep = (size_t)(BK * 2);
    const size_t hstepB = (size_t)HALF * K * 2, hstepA = (size_t)HALF * g.lda * 2;
    const size_t tstepB = 2 * hstepB, tstepA = 2 * hstepA;
    const unsigned ldsw = (unsigned)wid * 1024u;
    const int aoff = lds_byte(wr * 64 + fr, fq * 8), boff = lds_byte(wc * 32 + fr, fq * 8);
#define PG8_SA(b, h) (((b) * 2 + (h)) * HTB)
#define PG8_SB(b, h) ((4 + (b) * 2 + (h)) * HTB)
#define PG8_STAGE(bufoff, gbase, voff) do { _Pragma("unroll") for (int _i = 0; _i < 2; ++_i) \
        __builtin_amdgcn_global_load_lds((const unsigned*)((const char*)(gbase) + (voff)[_i]), (PG8_LAS unsigned*)(lds + (bufoff) + ldsw + _i * 8192), 16, 0, 0); } while (0)
#define PG8_LDA(dst, b, h) do { _Pragma("unroll") for (int m = 0; m < 4; ++m) _Pragma("unroll") for (int k = 0; k < 2; ++k) dst[m][k] = *(const PG8_LAS bf16x8*)(lds + PG8_SA(b, h) + aoff + m * 2048 + k * 1024); } while (0)
#define PG8_LDB(dst, b, h) do { _Pragma("unroll") for (int n = 0; n < 2; ++n) _Pragma("unroll") for (int k = 0; k < 2; ++k) dst[n][k] = *(const PG8_LAS bf16x8*)(lds + PG8_SB(b, h) + boff + n * 2048 + k * 1024); } while (0)
#define PG8_MMA(ai, bj, At, Bt) do { __builtin_amdgcn_s_setprio(1); _Pragma("unroll") for (int m = 0; m < 4; ++m) _Pragma("unroll") for (int n = 0; n < 2; ++n) _Pragma("unroll") for (int k = 0; k < 2; ++k) \
        acc[ai][bj][m][n] = __builtin_amdgcn_mfma_f32_16x16x32_bf16(Bt[n][k], At[m][k], acc[ai][bj][m][n], 0, 0, 0); __builtin_amdgcn_s_setprio(0); } while (0)
#define PG8_WAIT_V(n) asm volatile("s_waitcnt vmcnt(" #n ")" ::: "memory")
#define PG8_WAIT_L(n) asm volatile("s_waitcnt lgkmcnt(" #n ")" ::: "memory")
#define PG8_BAR __builtin_amdgcn_s_barrier()
#define PG8_SCHED __builtin_amdgcn_sched_barrier(0)
    Unit cur, nxt; int ui = 0;
    if (!S.next(0, cur)) return;
    f32x4 acc[2][2][4][2];
#pragma unroll
    for (int a = 0; a < 2; ++a)
#pragma unroll
        for (int b = 0; b < 2; ++b)
#pragma unroll
            for (int m = 0; m < 4; ++m)
#pragma unroll
                for (int n = 0; n < 2; ++n) acc[a][b][m][n] = (f32x4){0.f, 0.f, 0.f, 0.f};
    bf16x8 At[4][2], B0[2][2], B1[2][2];
    const char* cA = (const char*)g.A + (size_t)cur.pm * tstepA; const char* cB = (const char*)g.Bt + (size_t)cur.pn * tstepB;
    S.a_ready(cur);
    if constexpr (SP2) {
        PG8_STAGE(PG8_SB(0, 0), cB, voffB); PG8_STAGE(PG8_SB(0, 1), cB + hstepB, voffB); PG8_STAGE(PG8_SA(0, 0), cA, voffA); PG8_STAGE(PG8_SA(0, 1), cA + hstepA, voffA);
        if (wr == 1) PG8_BAR;
        PG8_WAIT_V(2); PG8_BAR;
        PG8_STAGE(PG8_SB(1, 0), cB + kstep, voffB); PG8_STAGE(PG8_SA(1, 0), cA + kstep, voffA); PG8_STAGE(PG8_SB(1, 1), cB + hstepB + kstep, voffB);
        PG8_WAIT_V(6); PG8_BAR;
    } else {
        PG8_STAGE(PG8_SB(0, 0), cB, voffB); PG8_STAGE(PG8_SA(0, 0), cA, voffA); PG8_STAGE(PG8_SB(0, 1), cB + hstepB, voffB); PG8_STAGE(PG8_SA(0, 1), cA + hstepA, voffA);
        if (wr == 1) PG8_BAR;
        PG8_WAIT_V(4); PG8_BAR;
        PG8_STAGE(PG8_SB(1, 0), cB + kstep, voffB); PG8_STAGE(PG8_SA(1, 0), cA + kstep, voffA); PG8_STAGE(PG8_SB(1, 1), cB + hstepB + kstep, voffB);
        PG8_WAIT_V(6); PG8_BAR;
    }
    for (;;) {
        const bool has_next = S.next(ui + 1, nxt);
        const char* nA = has_next ? (const char*)g.A + (size_t)nxt.pm * tstepA : cA; const char* nB = has_next ? (const char*)g.Bt + (size_t)nxt.pn * tstepB : cB;
        for (int t = 0; t < nt; t += 2) {
            const bool last = (t == nt - 2);
            const char* a1 = cA + (size_t)(t + 1) * kstep;
            const char* a2 = last ? nA : cA + (size_t)(t + 2) * kstep; const char* b2 = last ? nB : cB + (size_t)(t + 2) * kstep;
            const char* a3 = a2 + kstep; const char* b3 = b2 + kstep;
            if (last && has_next) S.a_ready(nxt);
            if constexpr (SP2) {
            PG8_LDB(B0, 0, 0); PG8_LDB(B1, 0, 1); PG8_SCHED; PG8_LDA(At, 0, 0); PG8_STAGE(PG8_SA(1, 1), a1 + hstepA, voffA);
            PG8_WAIT_V(8); PG8_WAIT_L(0); PG8_BAR; PG8_MMA(0, 0, At, B0); PG8_MMA(0, 1, At, B1); PG8_BAR; PG8_SCHED;
            PG8_LDA(At, 0, 1); PG8_STAGE(PG8_SB(0, 0), b2, voffB); PG8_STAGE(PG8_SB(0, 1), b2 + hstepB, voffB); PG8_STAGE(PG8_SA(0, 0), a2, voffA);
            PG8_WAIT_V(8); PG8_WAIT_L(0); PG8_BAR; PG8_MMA(1, 0, At, B0); PG8_MMA(1, 1, At, B1); PG8_BAR; PG8_SCHED;
            PG8_LDB(B0, 1, 0); PG8_LDB(B1, 1, 1); PG8_SCHED; PG8_LDA(At, 1, 0); PG8_STAGE(PG8_SA(0, 1), a2 + hstepA, voffA);
            PG8_WAIT_V(8); PG8_WAIT_L(0); PG8_BAR; PG8_MMA(0, 0, At, B0); PG8_MMA(0, 1, At, B1); PG8_BAR; PG8_SCHED;
            PG8_LDA(At, 1, 1); PG8_STAGE(PG8_SB(1, 0), b3, voffB); PG8_STAGE(PG8_SB(1, 1), b3 + hstepB, voffB); PG8_STAGE(PG8_SA(1, 0), a3, voffA);
            PG8_WAIT_V(8); PG8_WAIT_L(0); PG8_BAR; PG8_MMA(1, 0, At, B0); PG8_MMA(1, 1, At, B1); PG8_BAR; PG8_SCHED;
            } else {
            PG8_LDB(B0, 0, 0); PG8_SCHED; PG8_LDA(At, 0, 0); PG8_STAGE(PG8_SA(1, 1), a1 + hstepA, voffA);
            PG8_WAIT_L(8); PG8_BAR; PG8_WAIT_L(0); PG8_MMA(0, 0, At, B0); PG8_BAR; PG8_SCHED;
            PG8_LDB(B1, 0, 1); PG8_STAGE(PG8_SB(0, 0), b2, voffB);
            PG8_BAR; PG8_WAIT_L(0); PG8_MMA(0, 1, At, B1); PG8_BAR;
            PG8_LDA(At, 0, 1); PG8_STAGE(PG8_SA(0, 0), a2, voffA);
            PG8_BAR; PG8_WAIT_L(0); PG8_MMA(1, 0, At, B0); PG8_BAR; PG8_SCHED;
            PG8_STAGE(PG8_SB(0, 1), b2 + hstepB, voffB);
            PG8_WAIT_V(6); PG8_BAR; PG8_MMA(1, 1, At, B1); PG8_BAR;
            PG8_LDB(B0, 1, 0); PG8_SCHED; PG8_LDA(At, 1, 0); PG8_STAGE(PG8_SA(0, 1), a2 + hstepA, voffA);
            PG8_WAIT_L(8); PG8_BAR; PG8_WAIT_L(0); PG8_MMA(0, 0, At, B0); PG8_BAR; PG8_SCHED;
            PG8_LDB(B1, 1, 1); PG8_STAGE(PG8_SB(1, 0), b3, voffB);
            PG8_BAR; PG8_WAIT_L(0); PG8_MMA(0, 1, At, B1); PG8_BAR;
            PG8_LDA(At, 1, 1); PG8_STAGE(PG8_SA(1, 0), a3, voffA);
            PG8_BAR; PG8_WAIT_L(0); PG8_MMA(1, 0, At, B0); PG8_BAR; PG8_SCHED;
            PG8_STAGE(PG8_SB(1, 1), b3 + hstepB, voffB);
            PG8_WAIT_V(6); PG8_BAR; PG8_MMA(1, 1, At, B1); PG8_BAR;
            }
        }
        if constexpr (ALIGN_EPI) { if (wr == 0) PG8_BAR; }
        if constexpr (!Epi::AFTER_DRAIN) { E(acc, cur, wr, wc, fr, fq); S.done(cur); }
        if (!has_next) break;
#pragma unroll
        for (int a = 0; a < 2; ++a)
#pragma unroll
            for (int b = 0; b < 2; ++b)
#pragma unroll
                for (int m = 0; m < 4; ++m)
#pragma unroll
                    for (int n = 0; n < 2; ++n) acc[a][b][m][n] = (f32x4){0.f, 0.f, 0.f, 0.f};
        cur = nxt; cA = nA; cB = nB; ++ui;
        if constexpr (ALIGN_EPI) { if (wr == 1) PG8_BAR; }
    }
    PG8_WAIT_V(0);
    if constexpr (!ALIGN_EPI) { if (wr == 0) PG8_BAR; }
    PG8_BAR;
    if constexpr (Epi::AFTER_DRAIN) { E.fused(acc, cur, wr, wc, fr, fq, lds, wid, lane); S.done(cur); }
#undef PG8_SA
#undef PG8_SB
#undef PG8_STAGE
#undef PG8_LDA
#undef PG8_LDB
#undef PG8_MMA
#undef PG8_WAIT_V
#undef PG8_WAIT_L
#undef PG8_BAR
#undef PG8_SCHED
}
}

constexpr int NB = 4, SEQ = 4096, T = NB * SEQ, DM = 1024, DEPTH = 4;
constexpr int NPROJ = 10496;
constexpr int IN_COLS = 10260;
constexpr float NORM_EPS = 1e-6f;
constexpr float LOG2E = 1.4426950408889634f;

typedef unsigned short bf16_t;
typedef short bf16x8 __attribute__((ext_vector_type(8)));
typedef float f32x4 __attribute__((ext_vector_type(4)));
typedef float f32x2 __attribute__((ext_vector_type(2)));
typedef unsigned u32x4 __attribute__((ext_vector_type(4)));
typedef unsigned u32x2 __attribute__((ext_vector_type(2)));
typedef __bf16 bf16x2_t __attribute__((ext_vector_type(2)));

constexpr size_t MiB = 1u << 20;
constexpr size_t O_MOD = 0, O_X = 1 * MiB, O_H = 65 * MiB, O_UV = 97 * MiB, O_FQKV = 129 * MiB, O_MQKV = 177 * MiB, O_Z = 225 * MiB,
                 O_XBC = 249 * MiB, O_GATE = 289 * MiB, O_SMALL = 417 * MiB, O_VTF = 419 * MiB, O_VTM = 435 * MiB, O_XT = 451 * MiB,
                 O_BC = 475 * MiB, O_BT = 491 * MiB, O_ST = 499 * MiB, O_CUMF = 547 * MiB, O_ACUM = 548 * MiB, O_KMEAN = 549 * MiB,
                 O_WIN = 550 * MiB, O_WA = 571 * MiB, O_WB = 572 * MiB, O_WC = 573 * MiB, O_WD = 574 * MiB, O_WO = 576 * MiB,
                 O_W1 = 578 * MiB, O_W2 = 586 * MiB, O_GWS = 594 * MiB, WS_END = 595 * MiB;
constexpr size_t O_ROT = O_GWS + 512 * 1024;
constexpr size_t O_DT = O_KMEAN + 256 * 1024;
constexpr size_t O_CTL = 512 * 1024;
constexpr size_t O_PREV = O_XBC;
constexpr size_t O_HID = O_GATE;
constexpr size_t O_MF32 = O_VTF;
constexpr int LDS_BYTES = 147456;

struct Params { const float* in[26]; float* out; unsigned char* ws; int ph_lo, ph_hi; };

__device__ __forceinline__ int opq(int i) { asm volatile("" : "+s"(i)); return i; }
#define PIN(i) (p.in[opq(i)])
__device__ __forceinline__ unsigned cvtpk(float lo, float hi) { f32x2 v = {lo, hi}; bf16x2_t b = __builtin_convertvector(v, bf16x2_t); return __builtin_bit_cast(unsigned, b); }
__device__ __forceinline__ float bf2f(short h) { return __uint_as_float(((unsigned)(unsigned short)h) << 16); }
__device__ __forceinline__ float bflo(unsigned w) { return __uint_as_float(w << 16); }
__device__ __forceinline__ float bfhi(unsigned w) { return __uint_as_float(w & 0xffff0000u); }
__device__ __forceinline__ bf16x8 pack8(float a0, float a1, float a2, float a3, float a4, float a5, float a6, float a7) {
    u32x4 w = {cvtpk(a0, a1), cvtpk(a2, a3), cvtpk(a4, a5), cvtpk(a6, a7)}; return __builtin_bit_cast(bf16x8, w); }
__device__ __forceinline__ bf16x8 ld2x8(const bf16_t* p0, const bf16_t* p1) { const u32x2 a = *(const u32x2*)p0, b = *(const u32x2*)p1; u32x4 w = {a.x, a.y, b.x, b.y}; return __builtin_bit_cast(bf16x8, w); }
typedef short s16x4_t __attribute__((ext_vector_type(4)));
__device__ __forceinline__ s16x4_t lds_tr(const bf16_t* p) { return __builtin_bit_cast(s16x4_t, __builtin_amdgcn_ds_read_tr16_b64_v4i16((__attribute__((address_space(3))) s16x4_t*)p)); }
__device__ __forceinline__ bf16x8 cat4(s16x4_t a, s16x4_t b) { return (bf16x8){a[0], a[1], a[2], a[3], b[0], b[1], b[2], b[3]}; }
__device__ __forceinline__ f32x4 mfma16(bf16x8 a, bf16x8 b, f32x4 c) { return __builtin_amdgcn_mfma_f32_16x16x32_bf16(a, b, c, 0, 0, 0); }
__device__ __forceinline__ float dpp_add(float v, const int ctrl_sel) {
    const int iv = __builtin_bit_cast(int, v); int m;
    if (ctrl_sel == 0) m = __builtin_amdgcn_update_dpp(0, iv, 0xB1, 0xF, 0xF, true);
    else if (ctrl_sel == 1) m = __builtin_amdgcn_update_dpp(0, iv, 0x4E, 0xF, 0xF, true);
    else if (ctrl_sel == 2) m = __builtin_amdgcn_update_dpp(0, iv, 0x141, 0xF, 0xF, true);
    else m = __builtin_amdgcn_update_dpp(0, iv, 0x140, 0xF, 0xF, true);
    return v + __builtin_bit_cast(float, m); }
__device__ __forceinline__ float row16_sum(float v) { v = dpp_add(v, 0); v = dpp_add(v, 1); v = dpp_add(v, 2); v = dpp_add(v, 3); return v; }
__device__ __forceinline__ float wave_sum(float v) { v = row16_sum(v); v += __shfl_xor(v, 16); v += __shfl_xor(v, 32); return v; }
__device__ __forceinline__ float ex2(float x) { return __builtin_amdgcn_exp2f(x); }
__device__ __forceinline__ float sigmoidf_(float x) { return 1.f / (1.f + __expf(-x)); }
__device__ __forceinline__ float softplusf_(float x) { return fmaxf(x, 0.f) + log1pf(expf(-fabsf(x))); }
#define LDS_WAIT() asm volatile("s_waitcnt lgkmcnt(0)" ::: "memory")
#define VM_WAIT() asm volatile("s_waitcnt vmcnt(0)" ::: "memory")

#define EPI_LANE_SETUP() int t_ = threadIdx.x; asm volatile("" : "+v"(t_)); const int fr = t_ & 15, fq = (t_ >> 4) & 3; const int wv_ = __builtin_amdgcn_readfirstlane(t_ >> 6); const int wr = wv_ >> 2, wc = wv_ & 3
__device__ __forceinline__ unsigned pk4u8(float a, float b, float c, float d) {
    const unsigned ua = (unsigned)(a * 255.f + 0.5f), ub = (unsigned)(b * 255.f + 0.5f), uc = (unsigned)(c * 255.f + 0.5f), ud = (unsigned)(d * 255.f + 0.5f);
    return ua | (ub << 8) | (uc << 16) | (ud << 24); }
__device__ __forceinline__ float u8f(unsigned w, int i) { return (float)((w >> (8 * i)) & 255u); }
__device__ __forceinline__ float act_unified(float x, int act) {
    const float uu = 1.5957691216057308f * (x + 0.044715f * x * x * x);
    const float arg = (act == 1) ? uu : (act == 0) ? INFINITY : x;
    const float num = (act == 3) ? 1.f : x;
    return num * __builtin_amdgcn_rcpf(1.f + ex2(-LOG2E * arg));
}
struct EpiInproj {
    static constexpr bool PERM = true, AFTER_DRAIN = false;
    unsigned char* ws;
    __device__ __forceinline__ void operator()(const f32x4 (&acc)[2][2][4][2], const pg8::Unit& u, int, int, int, int) const {
        EPI_LANE_SETUP();
        const int pn = u.pn; const int row0 = u.pm * 256 + wr * 64 + fr;
        if (pn == 40) {
            if (wc == 0) {
                float* sm = (float*)(ws + O_SMALL);
#pragma unroll
                for (int ai = 0; ai < 2; ++ai)
#pragma unroll
                    for (int m = 0; m < 4; ++m) { float* rp = sm + (size_t)(row0 + ai * 128 + m * 16) * 32 + 8 * fq;
                        *(f32x4*)rp = acc[ai][0][m][0]; *(f32x4*)(rp + 4) = acc[ai][0][m][1]; }
            }
            return;
        }
        bf16_t* base; int pitch, ct, act;
        if (pn < 4) { base = (bf16_t*)(ws + O_UV); pitch = 1024; ct = pn; act = 1; }
        else if (pn < 10) { base = (bf16_t*)(ws + O_FQKV); pitch = 1536; ct = pn - 4; act = 0; }
        else if (pn < 16) { base = (bf16_t*)(ws + O_MQKV); pitch = 1536; ct = pn - 10; act = 0; }
        else if (pn < 19) { base = (bf16_t*)(ws + O_Z); pitch = 768; ct = pn - 16; act = 2; }
        else if (pn < 24) { base = (bf16_t*)(ws + O_XBC); pitch = 1280; ct = pn - 19; act = 0; }
        else { base = (bf16_t*)(ws + O_GATE); pitch = 4096; ct = pn - 24; act = 3; }
        const int col0 = ct * 256 + wc * 32 + 8 * fq;
#pragma unroll
        for (int ai = 0; ai < 2; ++ai)
#pragma unroll
            for (int m = 0; m < 4; ++m) { bf16_t* rowp = base + (size_t)(row0 + ai * 128 + m * 16) * pitch + col0;
#pragma unroll
                for (int bj = 0; bj < 2; ++bj) { f32x4 v0 = acc[ai][bj][m][0], v1 = acc[ai][bj][m][1];
#pragma unroll
                    for (int j = 0; j < 4; ++j) if (act != 0) { v0[j] = act_unified(v0[j], act); v1[j] = act_unified(v1[j], act); }
                    if (act == 3) {
                        unsigned char* gp = (unsigned char*)(ws + O_GATE) + (size_t)(row0 + ai * 128 + m * 16) * 4096 + col0 + bj * 128;
                        u32x2 q; q.x = pk4u8(v0[0], v0[1], v0[2], v0[3]); q.y = pk4u8(v1[0], v1[1], v1[2], v1[3]);
                        __builtin_nontemporal_store(q, (u32x2*)gp);
                    } else {
                        u32x4 w; w.x = cvtpk(v0[0], v0[1]); w.y = cvtpk(v0[2], v0[3]); w.z = cvtpk(v1[0], v1[1]); w.w = cvtpk(v1[2], v1[3]);
                        __builtin_nontemporal_store(w, (u32x4*)(rowp + bj * 128)); } }
                asm volatile("" ::: "memory"); }
    }
};
struct EpiMerge {
    static constexpr bool PERM = true, AFTER_DRAIN = false;
    const unsigned char* gate; float* mf; bf16_t* outb; int mode;
    __device__ __forceinline__ void operator()(const f32x4 (&acc)[2][2][4][2], const pg8::Unit& u, int, int, int, int) const {
        EPI_LANE_SETUP();
        const int row0 = u.pm * 256 + wr * 64 + fr, col0 = u.pn * 256 + wc * 32 + 8 * fq;
#pragma unroll
        for (int ai = 0; ai < 2; ++ai)
#pragma unroll
            for (int m = 0; m < 4; ++m) { const size_t row = (size_t)(row0 + ai * 128 + m * 16);
#pragma unroll
                for (int bj = 0; bj < 2; ++bj) { const int col = col0 + bj * 128;
                    const u32x2 gw = *(const u32x2*)(gate + row * 4096 + col);
                    f32x4 v0 = acc[ai][bj][m][0] * (1.f / 255.f), v1 = acc[ai][bj][m][1] * (1.f / 255.f);
                    v0[0] *= u8f(gw.x, 0); v0[1] *= u8f(gw.x, 1); v0[2] *= u8f(gw.x, 2); v0[3] *= u8f(gw.x, 3); v1[0] *= u8f(gw.y, 0); v1[1] *= u8f(gw.y, 1); v1[2] *= u8f(gw.y, 2); v1[3] *= u8f(gw.y, 3);
                    bf16_t* op = outb + row * 1024 + col;
                    if (mode != 0) { const u32x4 pw = *(const u32x4*)op;
                        v0[0] += bflo(pw.x); v0[1] += bfhi(pw.x); v0[2] += bflo(pw.y); v0[3] += bfhi(pw.y); v1[0] += bflo(pw.z); v1[1] += bfhi(pw.z); v1[2] += bflo(pw.w); v1[3] += bfhi(pw.w); }
                    u32x4 w; w.x = cvtpk(v0[0], v0[1]); w.y = cvtpk(v0[2], v0[3]); w.z = cvtpk(v1[0], v1[1]); w.w = cvtpk(v1[2], v1[3]);
                    *(u32x4*)op = w; }
                asm volatile("" ::: "memory"); }
    }
};
struct EpiResid {
    static constexpr bool PERM = true, AFTER_DRAIN = false;
    const float* xin; float* xout; const float* gmod;
    __device__ __forceinline__ void operator()(const f32x4 (&acc)[2][2][4][2], const pg8::Unit& u, int, int, int, int) const {
        EPI_LANE_SETUP();
        const int row0 = u.pm * 256 + wr * 64 + fr, col0 = u.pn * 256 + wc * 32 + 8 * fq; const int b = u.pm >> 4;
        const float* gp = gmod + (size_t)b * 6144 + col0;
#pragma unroll
        for (int ai = 0; ai < 2; ++ai)
#pragma unroll
            for (int m = 0; m < 4; ++m) { const size_t off = (size_t)(row0 + ai * 128 + m * 16) * 1024 + col0;
#pragma unroll
                for (int bj = 0; bj < 2; ++bj) { const int co = bj * 128; const f32x4 g0 = *(const f32x4*)(gp + co), g1 = *(const f32x4*)(gp + co + 4);
                    *(f32x4*)(xout + off + co) = *(const f32x4*)(xin + off + co) + g0 * acc[ai][bj][m][0];
                    *(f32x4*)(xout + off + co + 4) = *(const f32x4*)(xin + off + co + 4) + g1 * acc[ai][bj][m][1]; }
                asm volatile("" ::: "memory"); }
    }
};
struct EpiRelu2 {
    static constexpr bool PERM = true, AFTER_DRAIN = false;
    bf16_t* out;
    __device__ __forceinline__ void operator()(const f32x4 (&acc)[2][2][4][2], const pg8::Unit& u, int, int, int, int) const {
        EPI_LANE_SETUP();
        const int row0 = u.pm * 256 + wr * 64 + fr, col0 = u.pn * 256 + wc * 32 + 8 * fq;
#pragma unroll
        for (int ai = 0; ai < 2; ++ai)
#pragma unroll
            for (int m = 0; m < 4; ++m) { bf16_t* rowp = out + (size_t)(row0 + ai * 128 + m * 16) * 4096 + col0;
#pragma unroll
                for (int bj = 0; bj < 2; ++bj) { f32x4 v0 = acc[ai][bj][m][0], v1 = acc[ai][bj][m][1];
#pragma unroll
                    for (int j = 0; j < 4; ++j) { const float r0 = fmaxf(v0[j], 0.f), r1 = fmaxf(v1[j], 0.f); v0[j] = r0 * r0; v1[j] = r1 * r1; }
                    u32x4 w; w.x = cvtpk(v0[0], v0[1]); w.y = cvtpk(v0[2], v0[3]); w.z = cvtpk(v1[0], v1[1]); w.w = cvtpk(v1[2], v1[3]);
                    __builtin_nontemporal_store(w, (u32x4*)(rowp + bj * 128)); }
                asm volatile("" ::: "memory"); }
    }
};
struct EpiU {
    static constexpr bool PERM = true, AFTER_DRAIN = false;
    int kind, mode; const void* p0; void* p1; void* p2; int dry;
    __device__ __forceinline__ void operator()(const f32x4 (&acc)[2][2][4][2], const pg8::Unit& u, int a, int b, int c, int d) const {
        if (dry) return;
        if (kind == 0) { EpiInproj e{(unsigned char*)p1}; e(acc, u, a, b, c, d); }
        else if (kind == 1) { EpiMerge e{(const unsigned char*)p0, (float*)p1, (bf16_t*)p2, mode}; e(acc, u, a, b, c, d); }
        else if (kind == 2) { EpiResid e{(const float*)p0, (float*)p1, (const float*)p2}; e(acc, u, a, b, c, d); }
        else { EpiRelu2 e{(bf16_t*)p1}; e(acc, u, a, b, c, d); }
    }
};
template <class Epi>
__device__ __forceinline__ void run_gemm(unsigned char* lds, const bf16_t* A, int lda, const bf16_t* Bt, int N, int K, const Epi& E) {
    pg8::Gemm g{A, Bt, T, N, K, lda}; pg8::StaticOrder S; S.init(T, N, (int)gridDim.x, (int)blockIdx.x);
    pg8::gemm_phase<Epi, pg8::StaticOrder, true, true>((PG8_LAS unsigned char*)lds, g, S, E);
}

__device__ __forceinline__ void phase_pre(const Params& p, unsigned char* lds, const int tid) {
    float* cs = (float*)lds; float* red = cs + 4096;
    const float* c = PIN(1); const float* ada_w = PIN(2); const float* ada_b = PIN(3);
    float* mod = (float*)(p.ws + O_MOD);
    for (int i = tid; i < 4096; i += 512) { const float v = c[i]; cs[i] = v / (1.f + expf(-v)); }
    __syncthreads();
    { float* rot = (float*)(p.ws + O_ROT);
      for (int e = blockIdx.x * 512 + tid; e < 4096 * 8; e += gridDim.x * 512) { const int pos = e >> 3, j = e & 7;
          const float inv_freq = powf(500000.0f, -(float)j * 0.125f); const float ang = (float)pos * inv_freq;
          rot[pos * 16 + j] = cosf(ang); rot[pos * 16 + 8 + j] = sinf(ang); } }
    const int jj = tid & 63, ks = tid >> 6;
    for (int it = blockIdx.x; it < DEPTH * 96; it += gridDim.x) {
        const int l = it / 96, jb = it % 96;
        const float* w = ada_w + (size_t)l * 1024 * 6144 + jb * 64 + jj;
        float a0 = 0.f, a1 = 0.f, a2 = 0.f, a3 = 0.f;
#pragma unroll 8
        for (int k = ks * 128; k < ks * 128 + 128; ++k) { const float wv = w[(size_t)k * 6144]; a0 += cs[k] * wv; a1 += cs[1024 + k] * wv; a2 += cs[2048 + k] * wv; a3 += cs[3072 + k] * wv; }
        red[(ks * 64 + jj) * 4 + 0] = a0; red[(ks * 64 + jj) * 4 + 1] = a1; red[(ks * 64 + jj) * 4 + 2] = a2; red[(ks * 64 + jj) * 4 + 3] = a3;
        __syncthreads();
        if (tid < 256) { const int b = tid >> 6, j2 = tid & 63; float s = 0.f;
#pragma unroll
            for (int q = 0; q < 8; ++q) s += red[(q * 64 + j2) * 4 + b];
            const int cc = jb * 64 + j2; mod[((size_t)l * 4 + b) * 6144 + cc] = s + ada_b[l * 6144 + cc]; }
        __syncthreads();
    }
}

__device__ __forceinline__ int inproj_src_col(int n) {
    if (n < 2560) return n;
    if (n < 6144) return n + 8;
    if (n < 10240) return n + 20;
    if (n < 10248) return 2560 + (n - 10240);
    if (n < 10260) return 6152 + (n - 10248);
    return -1;
}
__device__ __forceinline__ void transpose_item(const float* W, int K, int Nsrc, bf16_t* WT, float* scr, int k0, int n0, int lane, bool remap) {
    const int nd = n0 + (lane & 31); const int sc = remap ? inproj_src_col(nd) : nd;
#pragma unroll
    for (int i = 0; i < 32; ++i) { const int kk = 2 * i + (lane >> 5); scr[kk * 33 + (lane & 31)] = (sc >= 0) ? W[(size_t)(k0 + kk) * Nsrc + sc] : 0.f; }
    LDS_WAIT();
    const int c = lane & 7;
#pragma unroll
    for (int j = 0; j < 4; ++j) { const int n = (lane >> 3) + 8 * j; const float* s = scr + (8 * c) * 33 + n;
        u32x4 o; o.x = cvtpk(s[0 * 33], s[1 * 33]); o.y = cvtpk(s[2 * 33], s[3 * 33]); o.z = cvtpk(s[4 * 33], s[5 * 33]); o.w = cvtpk(s[6 * 33], s[7 * 33]);
        *(u32x4*)(WT + (size_t)(n0 + n) * K + k0 + 8 * c) = o; }
    LDS_WAIT();
}
__device__ __forceinline__ void convert_weights(const Params& p, int l, unsigned char* lds, int gw, int NGW, int wid, int lane) {
    float* scr = (float*)(lds + wid * 16384);
    unsigned char* ws = p.ws;
    constexpr int I_IN = 16 * (NPROJ / 32), I_BR = 8 * 32, I_D = 12 * 32, I_O = 16 * 32, I_1 = 16 * 128, I_2 = 64 * 32;
    constexpr int TOT = I_IN + 3 * I_BR + I_D + I_O + I_1 + I_2;
    for (int it = gw; it < TOT; it += NGW) {
        int r = it; const float* W; bf16_t* WT; int K, Nsrc, Nd; bool remap = false;
        if (r < I_IN) { W = PIN(5) + (size_t)l * 1024 * IN_COLS; WT = (bf16_t*)(ws + O_WIN); K = 1024; Nsrc = IN_COLS; Nd = NPROJ; remap = true; }
        else if ((r -= I_IN) < I_BR) { W = PIN(17) + (size_t)l * 512 * 1024; WT = (bf16_t*)(ws + O_WA); K = 512; Nsrc = 1024; Nd = 1024; }
        else if ((r -= I_BR) < I_BR) { W = PIN(18) + (size_t)l * 512 * 1024; WT = (bf16_t*)(ws + O_WB); K = 512; Nsrc = 1024; Nd = 1024; }
        else if ((r -= I_BR) < I_BR) { W = PIN(19) + (size_t)l * 512 * 1024; WT = (bf16_t*)(ws + O_WC); K = 512; Nsrc = 1024; Nd = 1024; }
        else if ((r -= I_BR) < I_D) { W = PIN(20) + (size_t)l * 768 * 1024; WT = (bf16_t*)(ws + O_WD); K = 768; Nsrc = 1024; Nd = 1024; }
        else if ((r -= I_D) < I_O) { W = PIN(21) + (size_t)l * 1024 * 1024; WT = (bf16_t*)(ws + O_WO); K = 1024; Nsrc = 1024; Nd = 1024; }
        else if ((r -= I_O) < I_1) { W = PIN(23) + (size_t)l * 1024 * 4096; WT = (bf16_t*)(ws + O_W1); K = 1024; Nsrc = 4096; Nd = 4096; }
        else { r -= I_1; W = PIN(24) + (size_t)l * 4096 * 1024; WT = (bf16_t*)(ws + O_W2); K = 4096; Nsrc = 1024; Nd = 1024; }
        const int nblk = Nd / 32, kb = r / nblk, nb = r % nblk;
        transpose_item(W, K, Nsrc, WT, scr, 64 * kb, 32 * nb, lane, remap);
    }
    const float* gws = PIN(8) + (size_t)l * 8 * 128 * 128; bf16_t* gd = (bf16_t*)(ws + O_GWS);
    for (int e = gw * 64 + lane; e < 8 * 128 * 128; e += NGW * 64) { const int s = e & 127, t = (e >> 7) & 127; const float v = (s <= t) ? gws[e] : 0.f; gd[e] = (bf16_t)(cvtpk(v, 0.f) & 0xffffu); }
}
__device__ __forceinline__ void norm_mod_rows(const float* x, const float* w, const float* sh, const float* sc, bf16_t* out, int gw, int NGW, int lane) {
    const int per = T / NGW;
    const int rbeg = gw * per; const int b = rbeg >> 12;
    f32x4 ws[4], hv[4];
#pragma unroll
    for (int j = 0; j < 4; ++j) { const int col = 4 * (64 * j + lane);
        ws[j] = *(const f32x4*)(w + col) * (*(const f32x4*)(sc + (size_t)b * 6144 + col) + 1.f); hv[j] = *(const f32x4*)(sh + (size_t)b * 6144 + col); }
#pragma unroll 2
    for (int r = 0; r < per; ++r) {
        const int row = rbeg + r; const f32x4* xr = (const f32x4*)(x + (size_t)row * 1024) + lane;
        f32x4 v[4]; float ss = 0.f;
#pragma unroll
        for (int j = 0; j < 4; ++j) { v[j] = xr[64 * j]; ss += (v[j][0] * v[j][0] + v[j][1] * v[j][1]) + (v[j][2] * v[j][2] + v[j][3] * v[j][3]); }
        const float rstd = rsqrtf(wave_sum(ss) * (1.f / 1024.f) + NORM_EPS);
#pragma unroll
        for (int j = 0; j < 4; ++j) { const int col = 4 * (64 * j + lane);
            const f32x4 o = (v[j] * rstd) * ws[j] + hv[j];
            u32x2 pk; pk.x = cvtpk(o[0], o[1]); pk.y = cvtpk(o[2], o[3]); *(u32x2*)(out + (size_t)row * 1024 + col) = pk; }
    }
}
__device__ __forceinline__ void final_norm_rows(const float* x, const float* w, float* out, int gw, int NGW, int lane) {
    for (int row = gw; row < T; row += NGW) {
        const f32x4* xr = (const f32x4*)(x + (size_t)row * 1024) + lane;
        f32x4 v[4]; float ss = 0.f;
#pragma unroll
        for (int j = 0; j < 4; ++j) { v[j] = xr[64 * j]; ss += (v[j][0] * v[j][0] + v[j][1] * v[j][1]) + (v[j][2] * v[j][2] + v[j][3] * v[j][3]); }
        const float rstd = rsqrtf(wave_sum(ss) * (1.f / 1024.f) + NORM_EPS);
#pragma unroll
        for (int j = 0; j < 4; ++j) { const int col = 4 * (64 * j + lane); const f32x4 wv = *(const f32x4*)(w + col);
            *(f32x4*)(out + (size_t)row * 1024 + col) = v[j] * rstd * wv; }
    }
}

__device__ __forceinline__ void gmlp_item(const Params& p, int l, unsigned char* lds, int item, int wid, int lane) {
    const int half = item & 1, ch = (item >> 1) & 31, b = item >> 6;
    const int fr = lane & 15, fq = lane >> 4;
    bf16_t* UV = (bf16_t*)(p.ws + O_UV); const bf16_t* GWS = (const bf16_t*)(p.ws + O_GWS);
    const float* lnw = PIN(6) + l * 512; const float* lnb = PIN(7) + l * 512;
    bf16_t* vnT = (bf16_t*)lds;
    const size_t row0 = (size_t)b * SEQ + ch * 128;
#pragma unroll 8
    for (int r = 0; r < 16; ++r) {
        const int s = wid * 16 + r;
        const bf16x8 raw = *(const bf16x8*)(UV + (row0 + s) * 1024 + 512 + 8 * lane);
        float x[8]; float sum = 0.f;
#pragma unroll
        for (int j = 0; j < 8; ++j) { x[j] = bf2f(raw[j]); sum += x[j]; }
        const float mean = wave_sum(sum) * (1.f / 512.f); float sq = 0.f;
#pragma unroll
        for (int j = 0; j < 8; ++j) { x[j] -= mean; sq += x[j] * x[j]; }
        const float rstd = rsqrtf(wave_sum(sq) * (1.f / 512.f) + NORM_EPS);
        if ((lane >> 5) == half) { const int c0 = (lane & 31) * 8;
#pragma unroll
            for (int j = 0; j < 8; ++j) { const int cc = half * 256 + c0 + j; const float o = x[j] * rstd * lnw[cc] + lnb[cc]; vnT[(c0 + j) * 136 + s] = (bf16_t)(cvtpk(o, 0.f) & 0xffffu); } }
    }
    __syncthreads();
    const int t0 = wid * 16; const int nks = (t0 + 15) / 32 + 1;
#pragma unroll 1
    for (int g4 = 0; g4 < 4; ++g4) {
        const int grp = half * 4 + g4;
        f32x4 acc[4];
#pragma unroll
        for (int ct = 0; ct < 4; ++ct) acc[ct] = (f32x4){0.f, 0.f, 0.f, 0.f};
        for (int ks = 0; ks < nks; ++ks) {
            const bf16x8 bw = *(const bf16x8*)(GWS + ((size_t)grp * 128 + t0 + fr) * 128 + ks * 32 + 8 * fq);
#pragma unroll
            for (int ct = 0; ct < 4; ++ct) { const bf16x8 av = *(const bf16x8*)(vnT + (g4 * 64 + ct * 16 + fr) * 136 + ks * 32 + 8 * fq); acc[ct] = mfma16(av, bw, acc[ct]); }
        }
        const float bsv = (PIN(9) + (size_t)l * 8 * 128 + grp * 128)[t0 + fr];
#pragma unroll
        for (int ct = 0; ct < 4; ++ct) { bf16_t* up = UV + (row0 + t0 + fr) * 1024 + grp * 64 + ct * 16 + 4 * fq;
            const u32x2 uw = *(const u32x2*)up; u32x2 o;
            o.x = cvtpk(bflo(uw.x) * (acc[ct][0] + bsv), bfhi(uw.x) * (acc[ct][1] + bsv)); o.y = cvtpk(bflo(uw.y) * (acc[ct][2] + bsv), bfhi(uw.y) * (acc[ct][3] + bsv));
            *(u32x2*)up = o; }
    }
    __syncthreads();
}
__device__ __forceinline__ void rotary_item(const Params& p, unsigned char* lds, int item, int tid, bool dry = false) {
    const int h = item & 7, nb = (item >> 3) & 15, b = item >> 7;
    float* sums = (float*)lds;
    if (tid < 64) sums[tid] = 0.f;
    __syncthreads();
    bf16_t* MQ = (bf16_t*)(p.ws + O_MQKV);
    const int half = (tid >> 5) & 1, tt = (tid >> 6) * 32 + (tid & 31); const int pos = nb * 256 + tt; const size_t row = (size_t)b * SEQ + pos;
    bf16_t* kp = MQ + row * 1536 + 512 + h * 64 + half * 32;
    float kv[32];
#pragma unroll
    for (int q = 0; q < 4; ++q) { const bf16x8 raw = *(const bf16x8*)(kp + 8 * q);
#pragma unroll
        for (int j = 0; j < 8; ++j) kv[8 * q + j] = bf2f(raw[j]); }
    if (half == 0 && !dry) {
        bf16_t* qp = MQ + row * 1536 + h * 64;
        float qv[16];
        { const bf16x8 r0 = *(const bf16x8*)qp, r1 = *(const bf16x8*)(qp + 8);
#pragma unroll
          for (int j = 0; j < 8; ++j) { qv[j] = bf2f(r0[j]); qv[8 + j] = bf2f(r1[j]); } }
        const float* rt = (const float*)(p.ws + O_ROT) + pos * 16;
        const f32x4 c0 = *(const f32x4*)rt, c1 = *(const f32x4*)(rt + 4), s0 = *(const f32x4*)(rt + 8), s1 = *(const f32x4*)(rt + 12);
#pragma unroll
        for (int j = 0; j < 8; ++j) {
            const float cs = (j < 4) ? c0[j & 3] : c1[j & 3], sn = (j < 4) ? s0[j & 3] : s1[j & 3];
            const float k1 = kv[j], k2 = kv[8 + j]; kv[j] = k1 * cs - k2 * sn; kv[8 + j] = k2 * cs + k1 * sn;
            const float q1 = qv[j], q2 = qv[8 + j]; qv[j] = q1 * cs - q2 * sn; qv[8 + j] = q2 * cs + q1 * sn;
        }
        *(bf16x8*)kp = pack8(kv[0], kv[1], kv[2], kv[3], kv[4], kv[5], kv[6], kv[7]);
        *(bf16x8*)(kp + 8) = pack8(kv[8], kv[9], kv[10], kv[11], kv[12], kv[13], kv[14], kv[15]);
        *(bf16x8*)qp = pack8(qv[0], qv[1], qv[2], qv[3], qv[4], qv[5], qv[6], qv[7]);
        *(bf16x8*)(qp + 8) = pack8(qv[8], qv[9], qv[10], qv[11], qv[12], qv[13], qv[14], qv[15]);
    }
#pragma unroll
    for (int d = 0; d < 32; ++d) {
        float v = row16_sum(kv[d]); v += __shfl_xor(v, 16);
        if ((tid & 31) == 0) atomicAdd(&sums[half * 32 + d], v);
    }
    __syncthreads();
    if (tid < 64) ((float*)(p.ws + O_KMEAN))[(((size_t)b * 8 + h) * 16 + nb) * 64 + tid] = sums[tid] * (1.f / 256.f);
    __syncthreads();
}
__device__ __forceinline__ void vt_item(const Params& p, unsigned char* lds, int item, int tid) {
    const int tb = item & 31, h = (item >> 5) & 7, b = (item >> 8) & 3, which = item >> 10;
    const bf16_t* src = (const bf16_t*)(p.ws + (which ? O_MQKV : O_FQKV)) + ((size_t)b * SEQ + tb * 128) * 1536 + 1024 + h * 64;
    bf16_t* dst = (bf16_t*)(p.ws + (which ? O_VTM : O_VTF)) + ((size_t)(b * 8 + h) * 64) * 4096 + tb * 128;
    bf16_t* tl = (bf16_t*)lds;
    { const int tok = tid >> 2, dq = tid & 3;
      const bf16x8 r0 = *(const bf16x8*)(src + (size_t)tok * 1536 + dq * 16), r1 = *(const bf16x8*)(src + (size_t)tok * 1536 + dq * 16 + 8);
#pragma unroll
      for (int j = 0; j < 8; ++j) { tl[(dq * 16 + j) * 136 + tok] = (bf16_t)r0[j]; tl[(dq * 16 + 8 + j) * 136 + tok] = (bf16_t)r1[j]; } }
    __syncthreads();
    { const int d = tid >> 3, c = tid & 7;
      const bf16x8 a = *(const bf16x8*)(tl + d * 136 + c * 16), bq = *(const bf16x8*)(tl + d * 136 + c * 16 + 8);
      *(bf16x8*)(dst + (size_t)d * 4096 + c * 16) = a; *(bf16x8*)(dst + (size_t)d * 4096 + c * 16 + 8) = bq; }
    __syncthreads();
}
__device__ __forceinline__ void conv_item(const Params& p, int l, int item, int tid) {
    const int cb = item % 20, sp = (item / 20) & 15, b = item / 320;
    const int c8 = tid & 7, tq = tid >> 3; const int gc = cb * 64 + 8 * c8;
    const int t0 = sp * 256 + tq * 4;
    const bf16_t* xp = (const bf16_t*)(p.ws + O_XBC) + ((size_t)b * SEQ) * 1280 + gc;
    float v[7][8];
#pragma unroll
    for (int r = 0; r < 7; ++r) { const int t = t0 - 3 + r;
        if (t >= 0) { const bf16x8 raw = *(const bf16x8*)(xp + (size_t)t * 1280);
#pragma unroll
            for (int j = 0; j < 8; ++j) v[r][j] = bf2f(raw[j]); }
        else {
#pragma unroll
            for (int j = 0; j < 8; ++j) v[r][j] = 0.f; } }
    const float* cw = PIN(11) + (size_t)l * 4 * 1280 + gc; const float* cbp = PIN(12) + l * 1280 + gc;
    float w[4][8], bias[8];
#pragma unroll
    for (int kk = 0; kk < 4; ++kk) { const f32x4 a = *(const f32x4*)(cw + kk * 1280), bq = *(const f32x4*)(cw + kk * 1280 + 4);
#pragma unroll
        for (int j = 0; j < 4; ++j) { w[kk][j] = a[j]; w[kk][4 + j] = bq[j]; } }
    { const f32x4 a = *(const f32x4*)cbp, bq = *(const f32x4*)(cbp + 4);
#pragma unroll
      for (int j = 0; j < 4; ++j) { bias[j] = a[j]; bias[4 + j] = bq[j]; } }
    float o[4][8];
#pragma unroll
    for (int tt = 0; tt < 4; ++tt)
#pragma unroll
        for (int j = 0; j < 8; ++j) { const float x = bias[j] + w[0][j] * v[tt][j] + w[1][j] * v[tt + 1][j] + w[2][j] * v[tt + 2][j] + w[3][j] * v[tt + 3][j]; o[tt][j] = x / (1.f + __expf(-x)); }
    const size_t tok0 = (size_t)b * SEQ + t0;
    if (cb < 12) {
        bf16_t* d = (bf16_t*)(p.ws + O_XT) + ((size_t)(b * 12 + cb) * 64 + 8 * c8) * 4096 + t0;
#pragma unroll
        for (int j = 0; j < 8; ++j) { u32x2 q; q.x = cvtpk(o[0][j], o[1][j]); q.y = cvtpk(o[2][j], o[3][j]); *(u32x2*)(d + (size_t)j * 4096) = q; }
    } else {
        bf16_t* BC = (bf16_t*)(p.ws + O_BC); const int bc = gc - 768;
#pragma unroll
        for (int tt = 0; tt < 4; ++tt) *(bf16x8*)(BC + (tok0 + tt) * 512 + bc) = pack8(o[tt][0], o[tt][1], o[tt][2], o[tt][3], o[tt][4], o[tt][5], o[tt][6], o[tt][7]);
        if (cb < 16) { bf16_t* d = (bf16_t*)(p.ws + O_BT) + ((size_t)b * 256 + bc) * 4096 + t0;
#pragma unroll
            for (int j = 0; j < 8; ++j) { u32x2 q; q.x = cvtpk(o[0][j], o[1][j]); q.y = cvtpk(o[2][j], o[3][j]); *(u32x2*)(d + (size_t)j * 4096) = q; } }
    }
}
__device__ __forceinline__ void acum_item(const Params& p, int l, int item, int lane) {
    const int ch = item & 31, h = (item >> 5) % 12, b = item / 384;
    const float* sm = (const float*)(p.ws + O_SMALL); const float a = -expf(PIN(14)[l * 12 + h]);
    const size_t tok = (size_t)b * SEQ + ch * 128 + 2 * lane;
    const float dtb = PIN(13)[l * 12 + h];
    const f32x2 raw = *(const f32x2*)(sm + (size_t)(8 + h) * T + tok); const float d0 = softplusf_(raw[0] + dtb), d1 = softplusf_(raw[1] + dtb);
    { f32x2 dd = {d0, d1}; *(f32x2*)((float*)(p.ws + O_DT) + ((size_t)(b * 12 + h)) * 4096 + ch * 128 + 2 * lane) = dd; }
    const float v0 = d0 * a, v1 = d1 * a;
    float sc = v0 + v1;
#pragma unroll
    for (int o = 1; o < 64; o <<= 1) { const float t = __shfl_up(sc, o); if (lane >= o) sc += t; }
    const float ex = sc - (v0 + v1);
    f32x2 r = {ex + v0, ex + v0 + v1};
    *(f32x2*)((float*)(p.ws + O_ACUM) + ((size_t)(b * 12 + h)) * 4096 + ch * 128 + 2 * lane) = r;
}
__device__ __forceinline__ void foxcum_item(const Params& p, int l, int item, int lane) {
    const int h = item & 7, b = item >> 3; const float fb = PIN(10)[l * 8 + h];
    const float* sm = (const float*)(p.ws + O_SMALL) + (size_t)h * T + (size_t)b * SEQ + lane * 64;
    float* cum = (float*)(p.ws + O_CUMF) + (size_t)(b * 8 + h) * 4096 + lane * 64;
    float v[64];
#pragma unroll
    for (int i = 0; i < 64; i += 4) { const f32x4 q = *(const f32x4*)(sm + i); v[i] = q[0]; v[i + 1] = q[1]; v[i + 2] = q[2]; v[i + 3] = q[3]; }
    float run = 0.f;
#pragma unroll
    for (int i = 0; i < 64; ++i) { const float x = v[i] + fb; run += fminf(x, 0.f) - __logf(1.f + __expf(-fabsf(x))); v[i] = run; }
    float sc = run;
#pragma unroll
    for (int o = 1; o < 64; o <<= 1) { const float t = __shfl_up(sc, o); if (lane >= o) sc += t; }
    const float ex = sc - run;
#pragma unroll
    for (int i = 0; i < 64; i += 4) { f32x4 w = {v[i] + ex, v[i + 1] + ex, v[i + 2] + ex, v[i + 3] + ex}; *(f32x4*)(cum + i) = w; }
}

template <bool MOBA, int VPITCH>
__device__ __forceinline__ void attn_tile64(const bf16_t* KL, const bf16_t* VL, const float* CL, int k0, bool diag, int kb,
                                            const bf16x8 (&qf)[2][2], const float (&cq)[2], const unsigned (&sel)[2], int qpos0, int fr, int fq,
                                            f32x4 (&lacc)[2], f32x4 (&o)[4][2]) {
    bf16x8 kf[4][2], vf[2][4]; f32x4 nck[4];
#pragma unroll
    for (int jk = 0; jk < 4; ++jk) { kf[jk][0] = *(const bf16x8*)(KL + (16 * jk + fr) * 72 + 8 * fq); kf[jk][1] = *(const bf16x8*)(KL + (16 * jk + fr) * 72 + 32 + 8 * fq); }
#pragma unroll
    for (int jk = 0; jk < 4; ++jk) nck[jk] = MOBA ? (f32x4){0.f, 0.f, 0.f, 0.f} : *(const f32x4*)(CL + 16 * jk + 4 * fq);
#pragma unroll
    for (int dt = 0; dt < 4; ++dt) { const bf16_t* vp = VL + (4 * fq + (fr >> 2)) * VPITCH + dt * 16 + 4 * (fr & 3); vf[0][dt] = cat4(lds_tr(vp), lds_tr(vp + 16 * VPITCH)); }
    __builtin_amdgcn_sched_barrier(0);
    f32x4 s[4][2];
    __builtin_amdgcn_s_setprio(1);
#pragma unroll
    for (int jk = 0; jk < 4; ++jk)
#pragma unroll
        for (int jq = 0; jq < 2; ++jq) { f32x4 z = {0.f, 0.f, 0.f, 0.f}; z = mfma16(kf[jk][0], qf[jq][0], z); s[jk][jq] = mfma16(kf[jk][1], qf[jq][1], z); }
    __builtin_amdgcn_s_setprio(0);
    __builtin_amdgcn_sched_barrier(0);
#pragma unroll
    for (int dt = 0; dt < 4; ++dt) { const bf16_t* vp = VL + (32 + 4 * fq + (fr >> 2)) * VPITCH + dt * 16 + 4 * (fr & 3); vf[1][dt] = cat4(lds_tr(vp), lds_tr(vp + 16 * VPITCH)); }
    __builtin_amdgcn_sched_barrier(0);
    constexpr float C2 = 0.125f * LOG2E;
#pragma unroll
    for (int jk = 0; jk < 4; ++jk)
#pragma unroll
        for (int jq = 0; jq < 2; ++jq)
#pragma unroll
            for (int i = 0; i < 4; ++i) s[jk][jq][i] = MOBA ? s[jk][jq][i] * C2 : fmaf(s[jk][jq][i], C2, nck[jk][i] + cq[jq]);
    if (diag) {
#pragma unroll
        for (int jk = 0; jk < 4; ++jk)
#pragma unroll
            for (int jq = 0; jq < 2; ++jq)
#pragma unroll
                for (int i = 0; i < 4; ++i) if (k0 + 16 * jk + 4 * fq + i > qpos0 + 16 * jq + fr) s[jk][jq][i] = -INFINITY;
    }
    if (MOBA && kb >= 0) {
#pragma unroll
        for (int jq = 0; jq < 2; ++jq) if (!((sel[jq] >> kb) & 1u)) {
#pragma unroll
            for (int jk = 0; jk < 4; ++jk) s[jk][jq] = (f32x4){-INFINITY, -INFINITY, -INFINITY, -INFINITY}; }
    }
    bf16x8 pb[2][2];
#pragma unroll
    for (int jq = 0; jq < 2; ++jq) {
#pragma unroll
        for (int jk = 0; jk < 4; ++jk)
#pragma unroll
            for (int i = 0; i < 4; ++i) s[jk][jq][i] = ex2(fminf(s[jk][jq][i], 100.f));
        pb[jq][0] = pack8(s[0][jq][0], s[0][jq][1], s[0][jq][2], s[0][jq][3], s[1][jq][0], s[1][jq][1], s[1][jq][2], s[1][jq][3]);
        pb[jq][1] = pack8(s[2][jq][0], s[2][jq][1], s[2][jq][2], s[2][jq][3], s[3][jq][0], s[3][jq][1], s[3][jq][2], s[3][jq][3]);
    }
    const u32x4 onesw = {0x3f803f80u, 0x3f803f80u, 0x3f803f80u, 0x3f803f80u}; const bf16x8 ones = __builtin_bit_cast(bf16x8, onesw);
    __builtin_amdgcn_s_setprio(1);
#pragma unroll
    for (int hh = 0; hh < 2; ++hh) {
#pragma unroll
        for (int jq = 0; jq < 2; ++jq) lacc[jq] = mfma16(ones, pb[jq][hh], lacc[jq]);
#pragma unroll
        for (int dt = 0; dt < 4; ++dt)
#pragma unroll
            for (int jq = 0; jq < 2; ++jq) o[dt][jq] = mfma16(vf[hh][dt], pb[jq][hh], o[dt][jq]);
    }
    __builtin_amdgcn_s_setprio(0);
}
__device__ __forceinline__ unsigned moba_select(const bf16_t* qp, const float* km, int own) {
    const bf16x8 r0 = *(const bf16x8*)qp, r1 = *(const bf16x8*)(qp + 8);
    float qd[16];
#pragma unroll
    for (int j = 0; j < 8; ++j) { qd[j] = bf2f(r0[j]); qd[8 + j] = bf2f(r1[j]); }
    float gate[15];
#pragma unroll
    for (int n = 0; n < 15; ++n) {
        float a = -INFINITY;
        if (n < own) { a = 0.f;
#pragma unroll
            for (int d = 0; d < 16; d += 4) { const f32x4 kk = *(const f32x4*)(km + n * 64 + d); a += qd[d] * kk[0] + qd[d + 1] * kk[1] + qd[d + 2] * kk[2] + qd[d + 3] * kk[3]; }
            a += __shfl_xor(a, 16); a += __shfl_xor(a, 32); }
        gate[n] = a;
    }
    unsigned msk = 0u;
#pragma unroll
    for (int pass = 0; pass < 3; ++pass) { float best = -INFINITY; int bi = -1;
#pragma unroll
        for (int n = 0; n < 15; ++n) { const float v = ((msk >> n) & 1u) ? -INFINITY : gate[n]; if (v > best) { best = v; bi = n; } }
        if (bi >= 0) msk |= 1u << bi; }
    return msk;
}
template <bool MOBA>
__device__ __forceinline__ void attn_block_item(const Params& p, unsigned char* lds, int b, int h, int qb, int tid_in, int wid, int lane_in) {
    int tid = tid_in, lane = lane_in; asm volatile("" : "+v"(tid), "+v"(lane));
    const int fr = lane & 15, fq = lane >> 4; const int q0 = qb * 256 + wid * 32;
    bf16_t* qkv = (bf16_t*)(p.ws + (MOBA ? O_MQKV : O_FQKV)) + ((size_t)b * SEQ) * 1536 + h * 64;
    const bf16_t* kbase = qkv + 512; const bf16_t* vtbase = (const bf16_t*)(p.ws + (MOBA ? O_VTM : O_VTF)) + ((size_t)(b * 8 + h) * 64) * 4096;
    const float* cum = (const float*)(p.ws + O_CUMF) + (size_t)(b * 8 + h) * 4096;
    bf16x8 qf[2][2];
#pragma unroll
    for (int jq = 0; jq < 2; ++jq)
#pragma unroll
        for (int ks = 0; ks < 2; ++ks) qf[jq][ks] = *(const bf16x8*)(qkv + (size_t)(q0 + 16 * jq + fr) * 1536 + ks * 32 + 8 * fq);
    float cq[2] = {0.f, 0.f}; unsigned sel[2] = {0u, 0u}; unsigned umask = 0u;
    const int own = qb;
    if (!MOBA) { cq[0] = cum[q0 + fr] * LOG2E; cq[1] = cum[q0 + 16 + fr] * LOG2E; }
    if (MOBA && own > 0) {
        const float* km = (const float*)(p.ws + O_KMEAN) + ((size_t)(b * 8 + h) * 16) * 64 + 16 * fq;
        sel[0] = moba_select(qkv + (size_t)(q0 + fr) * 1536 + 16 * fq, km, own);
        __builtin_amdgcn_sched_barrier(0);
        sel[1] = moba_select(qkv + (size_t)(q0 + 16 + fr) * 1536 + 16 * fq, km, own);
        __builtin_amdgcn_sched_barrier(0);
        umask = sel[0] | sel[1];
#pragma unroll
        for (int o2 = 1; o2 < 16; o2 <<= 1) umask |= __shfl_xor(umask, o2);
        umask = __builtin_amdgcn_readfirstlane(umask);
    }
    f32x4 lacc[2] = {(f32x4){0.f, 0.f, 0.f, 0.f}, (f32x4){0.f, 0.f, 0.f, 0.f}}; f32x4 o[4][2];
#pragma unroll
    for (int dt = 0; dt < 4; ++dt) { o[dt][0] = (f32x4){0.f, 0.f, 0.f, 0.f}; o[dt][1] = (f32x4){0.f, 0.f, 0.f, 0.f}; }
    const int NT = 2 * (qb + 1);
    constexpr int VP = 80;
    bf16_t* KLb = (bf16_t*)lds; bf16_t* VLb = KLb + 2 * 128 * 72;
    float* CLb = (float*)(VLb + 2 * 128 * VP);
    const int lr = tid >> 3, lc = (tid & 7) * 8;
    #define STEP_KT(i) (MOBA ? (((i) < 2) ? 2 * qb + (i) : (i) - 2) : (i))
    bf16x8 kreg0, kreg1, vreg0, vreg1; f32x4 creg = {0.f, 0.f, 0.f, 0.f};
    #define LOAD_STEP(kk0) do { kreg0 = *(const bf16x8*)(kbase + (size_t)((kk0) + lr) * 1536 + lc); kreg1 = *(const bf16x8*)(kbase + (size_t)((kk0) + 64 + lr) * 1536 + lc); \
        vreg0 = *(const bf16x8*)(kbase + 512 + (size_t)((kk0) + lr) * 1536 + lc); vreg1 = *(const bf16x8*)(kbase + 512 + (size_t)((kk0) + 64 + lr) * 1536 + lc); \
        if (!MOBA && tid < 32) creg = *(const f32x4*)(cum + (kk0) + 4 * tid) * (-LOG2E); } while (0)
    #define STORE_STEP(bb) do { *(bf16x8*)(KLb + (bb) * 128 * 72 + lr * 72 + lc) = kreg0; *(bf16x8*)(KLb + (bb) * 128 * 72 + (lr + 64) * 72 + lc) = kreg1; \
        *(bf16x8*)(VLb + (bb) * 128 * VP + lr * VP + lc) = vreg0; *(bf16x8*)(VLb + (bb) * 128 * VP + (lr + 64) * VP + lc) = vreg1; \
        if (!MOBA && tid < 32) *(f32x4*)(CLb + (bb) * 128 + 4 * tid) = creg; } while (0)
    int i_start = 0;
    if (!MOBA) {
        const float cq0 = cum[qb * 256];
        const float ce = (lane < NT) ? cum[lane * 128 + 127] : 0.f;
        const bool need = (lane < NT) && ((cq0 - ce) * LOG2E >= -64.f);
        const unsigned long long bal = __ballot(need);
        i_start = __builtin_amdgcn_readfirstlane(bal ? (int)__ffsll((long long)bal) - 1 : NT - 1);
    }
    LOAD_STEP(STEP_KT(i_start) * 128); STORE_STEP(0);
    __syncthreads();
#pragma unroll 1
    for (int i = i_start; i < NT; ++i) {
        const int k0 = STEP_KT(i) * 128; const int buf = (i - i_start) & 1;
        if (i + 1 < NT) LOAD_STEP(STEP_KT(i + 1) * 128);
        const bf16_t* KL = KLb + buf * 128 * 72; const bf16_t* VL = VLb + buf * 128 * VP; const float* CL = CLb + buf * 128;
        const int kb = k0 >> 8;
        const bool live = !MOBA || kb == own || ((umask >> kb) & 1u);
        if (live) {
#pragma unroll
            for (int hh = 0; hh < 2; ++hh) { const int k0h = k0 + 64 * hh;
                if (k0h <= q0 + 31) attn_tile64<MOBA, VP>(KL + hh * 64 * 72, VL + hh * 64 * VP, CL + hh * 64, k0h, k0h + 63 > q0, (MOBA && kb < own) ? kb : -1, qf, cq, sel, q0, fr, fq, lacc, o); }
        }
        if (i + 1 < NT) STORE_STEP(buf ^ 1);
        __syncthreads();
    }
    #undef STEP_KT
    #undef LOAD_STEP
    #undef STORE_STEP
#pragma unroll
    for (int jq = 0; jq < 2; ++jq) {
        const float inv = 1.f / lacc[jq][0];
        bf16_t* op = qkv + (size_t)(q0 + 16 * jq + fr) * 1536 + 4 * fq;
#pragma unroll
        for (int dt = 0; dt < 4; ++dt) { const f32x4 v = o[dt][jq] * inv; u32x2 w; w.x = cvtpk(v[0], v[1]); w.y = cvtpk(v[2], v[3]); *(u32x2*)(op + dt * 16) = w; }
    }
}
__device__ __forceinline__ void ssd_states_item(const Params& p, int item, int lane) {
    const int h = item % 12, c = (item / 12) & 31, b = item / 384; const int grp = h / 6;
    const int fr = lane & 15, fq = lane >> 4;
    const float* ac = (const float*)(p.ws + O_ACUM) + (size_t)(b * 12 + h) * 4096 + c * 128;
    const float* dtp = (const float*)(p.ws + O_DT) + (size_t)(b * 12 + h) * 4096 + c * 128;
    const bf16_t* XT = (const bf16_t*)(p.ws + O_XT) + ((size_t)(b * 12 + h) * 64) * 4096 + c * 128;
    const bf16_t* BT = (const bf16_t*)(p.ws + O_BT) + ((size_t)(b * 2 + grp) * 128) * 4096 + c * 128;
    float* ST = (float*)(p.ws + O_ST) + ((size_t)((b * 32 + c) * 12 + h)) * 8192;
    const float total = ac[127];
#pragma unroll 1
    for (int q2 = 0; q2 < 4; ++q2) {
        f32x4 acc[4][2];
#pragma unroll
        for (int pt = 0; pt < 4; ++pt) { acc[pt][0] = (f32x4){0.f, 0.f, 0.f, 0.f}; acc[pt][1] = (f32x4){0.f, 0.f, 0.f, 0.f}; }
#pragma unroll 1
        for (int ks = 0; ks < 4; ++ks) {
            const int s0 = ks * 32 + 8 * fq;
            const f32x4 a0 = *(const f32x4*)(ac + s0), a1 = *(const f32x4*)(ac + s0 + 4);
            const f32x4 d0 = *(const f32x4*)(dtp + s0), d1 = *(const f32x4*)(dtp + s0 + 4);
            float w8[8];
#pragma unroll
            for (int j = 0; j < 4; ++j) { w8[j] = __expf(total - a0[j]) * d0[j]; w8[4 + j] = __expf(total - a1[j]) * d1[j]; }
            const bf16x8 b0 = *(const bf16x8*)(BT + (size_t)((q2 * 2 + 0) * 16 + fr) * 4096 + s0), b1 = *(const bf16x8*)(BT + (size_t)((q2 * 2 + 1) * 16 + fr) * 4096 + s0);
#pragma unroll
            for (int pt = 0; pt < 4; ++pt) { const bf16x8 xa = *(const bf16x8*)(XT + (size_t)(pt * 16 + fr) * 4096 + s0);
                const bf16x8 af = pack8(bf2f(xa[0]) * w8[0], bf2f(xa[1]) * w8[1], bf2f(xa[2]) * w8[2], bf2f(xa[3]) * w8[3], bf2f(xa[4]) * w8[4], bf2f(xa[5]) * w8[5], bf2f(xa[6]) * w8[6], bf2f(xa[7]) * w8[7]);
                acc[pt][0] = mfma16(b0, af, acc[pt][0]); acc[pt][1] = mfma16(b1, af, acc[pt][1]); }
        }
#pragma unroll
        for (int pt = 0; pt < 4; ++pt)
#pragma unroll
            for (int nt = 0; nt < 2; ++nt) *(f32x4*)(ST + (size_t)(pt * 16 + fr) * 128 + (q2 * 2 + nt) * 16 + 4 * fq) = acc[pt][nt];
    }
}
__device__ __forceinline__ void ssd_scan(const Params& p, int gtid, int gthreads) {
    const float* ST = (const float*)(p.ws + O_ST); bf16_t* PV = (bf16_t*)(p.ws + O_PREV); const float* ACUM = (const float*)(p.ws + O_ACUM);
    for (int e4 = gtid; e4 < NB * 12 * 2048; e4 += gthreads) {
        const int pn = (e4 & 2047) * 4, h = (e4 >> 11) % 12, b = e4 / (12 * 2048);
        const float* ac = ACUM + (size_t)(b * 12 + h) * 4096 + 127;
        const size_t base = ((size_t)(b * 32) * 12 + h) * 8192 + pn;
        f32x4 hs = {0.f, 0.f, 0.f, 0.f};
#pragma unroll 8
        for (int c = 0; c < 32; ++c) { const f32x4 st = *(const f32x4*)(ST + base + (size_t)c * 12 * 8192); const float dc = __expf(ac[c * 128]);
            u32x2 q; q.x = cvtpk(hs[0], hs[1]); q.y = cvtpk(hs[2], hs[3]); *(u32x2*)(PV + base + (size_t)c * 12 * 8192) = q;
            hs = hs * dc + st; }
    }
}
__device__ __forceinline__ void ssd_out_item(const Params& p, int l, int item, int wid, int lane, bool dry = false) {
    const int grp = item & 1, c = (item >> 1) & 31, b = item >> 6;
    const int fr = lane & 15, fq = lane >> 4; const int w = wid; const int tl = 16 * w + fr;
    const size_t row0 = (size_t)b * SEQ + c * 128; const size_t row = row0 + tl;
    const bf16_t* BC = (const bf16_t*)(p.ws + O_BC);
    bf16_t* Z = (bf16_t*)(p.ws + O_Z);
    bf16x8 cf[4];
#pragma unroll
    for (int ks = 0; ks < 4; ++ks) cf[ks] = *(const bf16x8*)(BC + row * 512 + 256 + grp * 128 + ks * 32 + 8 * fq);
    f32x4 cbt[8];
#pragma unroll
    for (int js = 0; js < 8; ++js) { cbt[js] = (f32x4){0.f, 0.f, 0.f, 0.f};
        if (js <= w) {
#pragma unroll
            for (int ks = 0; ks < 4; ++ks) { const bf16x8 a = *(const bf16x8*)(BC + (row0 + js * 16 + fr) * 512 + grp * 128 + ks * 32 + 8 * fq); cbt[js] = mfma16(a, cf[ks], cbt[js]); } } }
    float ssq = 0.f;
#pragma unroll 1
    for (int r = 0; r < 6; ++r) {
        const int h = grp * 6 + r;
        const float* ac = (const float*)(p.ws + O_ACUM) + (size_t)(b * 12 + h) * 4096 + c * 128;
        const float* dtp = (const float*)(p.ws + O_DT) + (size_t)(b * 12 + h) * 4096 + c * 128;
        const float acl = ac[tl]; const float eacl = __expf(acl); const float Dh = PIN(15)[l * 12 + h];
        const bf16_t* PV = (const bf16_t*)(p.ws + O_PREV) + ((size_t)((b * 32 + c) * 12 + h)) * 8192;
        const bf16_t* XT = (const bf16_t*)(p.ws + O_XT) + ((size_t)(b * 12 + h) * 64) * 4096 + c * 128;
        f32x4 yt[4];
#pragma unroll
        for (int pt = 0; pt < 4; ++pt) yt[pt] = (f32x4){0.f, 0.f, 0.f, 0.f};
#pragma unroll
        for (int ks = 0; ks < 4; ++ks)
#pragma unroll
            for (int pt = 0; pt < 4; ++pt) { const bf16x8 a = *(const bf16x8*)(PV + (size_t)(pt * 16 + fr) * 128 + ks * 32 + 8 * fq); yt[pt] = mfma16(a, cf[ks], yt[pt]); }
#pragma unroll
        for (int pt = 0; pt < 4; ++pt) yt[pt] = yt[pt] * eacl;
#pragma unroll
        for (int jp = 0; jp < 4; ++jp) {
            if (2 * jp <= w) {
                const int sA = 32 * jp + 4 * fq, sB = sA + 16;
                const f32x4 a0 = *(const f32x4*)(ac + sA), a1 = *(const f32x4*)(ac + sB), dv0 = *(const f32x4*)(dtp + sA), dv1 = *(const f32x4*)(dtp + sB);
                float mv[8];
#pragma unroll
                for (int j = 0; j < 4; ++j) {
                    const int s = sA + j; const float d0 = dv0[j];
                    float v = (s <= tl) ? cbt[2 * jp][j] * __expf(acl - a0[j]) * d0 : 0.f; if (s == tl) v += Dh; mv[j] = v;
                    const int s2 = sB + j; const float d1 = dv1[j];
                    float v2 = (s2 <= tl) ? cbt[2 * jp + 1][j] * __expf(acl - a1[j]) * d1 : 0.f; if (s2 == tl) v2 += Dh; mv[4 + j] = v2;
                }
                const bf16x8 mb = pack8(mv[0], mv[1], mv[2], mv[3], mv[4], mv[5], mv[6], mv[7]);
#pragma unroll
                for (int pt = 0; pt < 4; ++pt) { const bf16_t* xp = XT + (size_t)(pt * 16 + fr) * 4096 + sA; yt[pt] = mfma16(ld2x8(xp, xp + 16), mb, yt[pt]); }
            }
        }
#pragma unroll
        for (int pt = 0; pt < 4; ++pt) { bf16_t* zp = Z + row * 768 + h * 64 + pt * 16 + 4 * fq; const u32x2 zw = *(const u32x2*)zp;
            const float y0 = yt[pt][0] * bflo(zw.x), y1 = yt[pt][1] * bfhi(zw.x), y2 = yt[pt][2] * bflo(zw.y), y3 = yt[pt][3] * bfhi(zw.y);
            ssq += (y0 * y0 + y1 * y1) + (y2 * y2 + y3 * y3);
            u32x2 o; o.x = cvtpk(y0, y1); o.y = cvtpk(y2, y3); if (!dry) *(u32x2*)zp = o; }
    }
    ssq += __shfl_xor(ssq, 16); ssq += __shfl_xor(ssq, 32);
    if (dry) return;
    const float rstd = rsqrtf(ssq * (1.f / 384.f) + NORM_EPS);
    VM_WAIT();
    const float* nw = PIN(16) + l * 768 + grp * 384;
    bf16_t* zp0 = Z + row * 768 + grp * 384 + 4 * fq;
#pragma unroll 4
    for (int q = 0; q < 24; ++q) { bf16_t* zp = zp0 + q * 16; const u32x2 zw = *(const u32x2*)zp; const f32x4 nv = *(const f32x4*)(nw + q * 16 + 4 * fq);
        u32x2 o; o.x = cvtpk(bflo(zw.x) * rstd * nv[0], bfhi(zw.x) * rstd * nv[1]); o.y = cvtpk(bflo(zw.y) * rstd * nv[2], bfhi(zw.y) * rstd * nv[3]); *(u32x2*)zp = o; }
}

__device__ __forceinline__ void small_cols_item(const bf16_t* Hh, const bf16_t* Wt, float* sm, int item, int lane) {
    const int fr = lane & 15, fq = lane >> 4; const size_t row0 = (size_t)item * 16;
    const bf16_t* ap = Hh + (row0 + fr) * 1024 + 8 * fq; const bf16_t* b0p = Wt + (size_t)fr * 1024 + 8 * fq; const bf16_t* b1p = b0p + 16 * 1024;
    f32x4 acc0[2] = {(f32x4){0.f, 0.f, 0.f, 0.f}, (f32x4){0.f, 0.f, 0.f, 0.f}}, acc1[2] = {(f32x4){0.f, 0.f, 0.f, 0.f}, (f32x4){0.f, 0.f, 0.f, 0.f}};
#pragma unroll 8
    for (int ks = 0; ks < 32; ++ks) {
        const bf16x8 a = *(const bf16x8*)(ap + ks * 32), w0 = *(const bf16x8*)(b0p + ks * 32), w1 = *(const bf16x8*)(b1p + ks * 32);
        acc0[ks & 1] = mfma16(a, w0, acc0[ks & 1]); acc1[ks & 1] = mfma16(a, w1, acc1[ks & 1]);
    }
    const f32x4 r0 = acc0[0] + acc0[1], r1 = acc1[0] + acc1[1];
    *(f32x4*)(sm + (size_t)fr * T + row0 + 4 * fq) = r0; *(f32x4*)(sm + (size_t)(16 + fr) * T + row0 + 4 * fq) = r1;
}
#define LAS __attribute__((address_space(3)))
#define XB_TMO      128
#define XB_XCNT(j)  (256  + 64 * (j))
#define XB_XSUB(j)  (1280 + 64 * (j))
#define XB_XGEN(j)  (2304 + 64 * (j))
#define XB_TOP      3328
#define XB_TOPGEN   3392
#define XCD_BAR_WORDS 3456
#define XB_SPIN_CAP (1u << 18)

__device__ __forceinline__ unsigned xb_ld(unsigned* p)              { return __hip_atomic_load(p, __ATOMIC_RELAXED, __HIP_MEMORY_SCOPE_AGENT); }
__device__ __forceinline__ unsigned xb_add(unsigned* p, unsigned v) { return __hip_atomic_fetch_add(p, v, __ATOMIC_RELAXED, __HIP_MEMORY_SCOPE_AGENT); }
__device__ __forceinline__ unsigned xb_xcc_id() { return (unsigned)__builtin_amdgcn_s_getreg((3 << 11) | 20) & 0xFu; }
#define XB_SPIN(cond, bar) do { unsigned _sp = 0; while (cond) { __builtin_amdgcn_s_sleep(1); \
    if ((++_sp & 255u) == 0u) { if (xb_ld(&(bar)[XB_TMO])) break; if (_sp > XB_SPIN_CAP) { atomicAdd(&(bar)[XB_TMO], 1u); break; } } } } while (0)

struct XcdBarrier {
    unsigned* bar; unsigned x;
    volatile LAS unsigned* st;
};

__device__ __forceinline__ XcdBarrier xcd_barrier_post(unsigned* bar, volatile LAS unsigned* st) {
    XcdBarrier b; b.bar = bar; b.x = xb_xcc_id(); b.st = st;
    if (threadIdx.x == 0) (void)xb_add(&bar[XB_XCNT(b.x)], 1u);
    return b;
}
__device__ __forceinline__ void xcd_barrier_complete(unsigned* bar, unsigned x, unsigned& nloc, unsigned& nx) {
    const unsigned G = gridDim.x * gridDim.y * gridDim.z;
    unsigned sum, cnt, mine, sp = 0u;
    for (;;) {
        sum = 0u; cnt = 0u; mine = 0u;
#pragma unroll
        for (unsigned j = 0; j < 16; ++j) { const unsigned c = xb_ld(&bar[XB_XCNT(j)]); sum += c; cnt += (c > 0u) ? 1u : 0u; mine = (j == x) ? c : mine; }
        if (sum == G) break;
        __builtin_amdgcn_s_sleep(1);
        if ((++sp & 255u) == 0u) { if (xb_ld(&bar[XB_TMO])) break; if (sp > XB_SPIN_CAP) { atomicAdd(&bar[XB_TMO], 1u); break; } }
    }
    nloc = mine > 0u ? mine : 1u; nx = cnt > 0u ? cnt : 1u;
}

__device__ __forceinline__ void xcd_barrier(const XcdBarrier& b) {
    asm volatile("s_waitcnt vmcnt(0)" ::: "memory");
    __syncthreads();
    if (threadIdx.x == 0) {
        unsigned* bar = b.bar;
        __builtin_amdgcn_s_waitcnt(0);
        unsigned nloc = b.st[0], nx = b.st[1];
        if (nloc == 0u) { xcd_barrier_complete(bar, b.x, nloc, nx); b.st[0] = nloc; b.st[1] = nx; }
        const unsigned old = xb_add(&bar[XB_XSUB(b.x)], 1u);
        const unsigned gen = old / nloc;
        if (old + 1u == (gen + 1u) * nloc) {
            __builtin_amdgcn_fence(__ATOMIC_RELEASE, "agent");
            asm volatile("s_waitcnt vmcnt(0)" ::: "memory");
            const unsigned og = xb_add(&bar[XB_TOP], 1u);
            const unsigned tg = og / nx;
            if (og + 1u == (tg + 1u) * nx) xb_add(&bar[XB_TOPGEN], 1u);
            else XB_SPIN(xb_ld(&bar[XB_TOPGEN]) == tg, bar);
            __builtin_amdgcn_fence(__ATOMIC_ACQUIRE, "agent");
            xb_add(&bar[XB_XGEN(b.x)], 1u);
            asm volatile("s_waitcnt vmcnt(0)" ::: "memory");
        } else {
            XB_SPIN(xb_ld(&bar[XB_XGEN(b.x)]) == gen, bar);
            __builtin_amdgcn_fence(__ATOMIC_ACQUIRE, "agent");
            asm volatile("s_waitcnt vmcnt(0)" ::: "memory");
        }
    }
    __syncthreads();
}

constexpr int PH_PER_LAYER = 11, N_PHASES = 1 + DEPTH * PH_PER_LAYER + 1;
template <int EN_MASK, bool EN_GEMM>
__device__ __forceinline__ void fwd_body(const Params& p) {
    extern __shared__ __attribute__((aligned(16))) unsigned char lds[];
    cg::grid_group grid = cg::this_grid();
    const int G = gridDim.x, NGW = G * 8;
    unsigned char* ws = p.ws;
    volatile LAS unsigned* MISC = (volatile LAS unsigned*)((LAS unsigned char*)lds + 132096);
    if (threadIdx.x < 2) MISC[threadIdx.x] = 0u;
    __syncthreads();
    XcdBarrier xbar = xcd_barrier_post((unsigned*)(ws + O_CTL), MISC);
    float* mod = (float*)(ws + O_MOD); float* X = (float*)(ws + O_X); bf16_t* H = (bf16_t*)(ws + O_H);
    for (int ph = p.ph_lo; ph < p.ph_hi; ++ph) {
        int tid = threadIdx.x; asm volatile("" : "+v"(tid));
        const int lane = tid & 63, wid = __builtin_amdgcn_readfirstlane(tid >> 6); const int gw = blockIdx.x * 8 + wid;
        if (ph == 0) { if constexpr (EN_MASK != 0) phase_pre(p, lds, tid); }
        else if (ph == N_PHASES - 1) { if constexpr (EN_MASK != 0) final_norm_rows(X, PIN(25), p.out, gw, NGW, lane); }
        else {
            const int l = (ph - 1) / PH_PER_LAYER, k = (ph - 1) % PH_PER_LAYER;
            const float* modl = mod + (size_t)l * 4 * 6144;
            const float* xin = (l == 0) ? PIN(0) : X;
            if (k == 1 || k == 6 || k == 7 || k == 9 || k == 10) { if constexpr (EN_GEMM) {
                const int nsub = (k == 6) ? 4 : 1;
#pragma unroll 1
                for (int br = 0; br < nsub; ++br) {
                    EpiU E{}; const bf16_t* A; const bf16_t* Bt; int lda, N, K;
                    if (k == 1) { E.kind = 0; E.p1 = ws; A = H; lda = 1024; Bt = (const bf16_t*)(ws + O_WIN); N = NPROJ - 256; K = 1024; }
                    else if (k == 6) {
                        const size_t aoffs = (br == 0) ? O_UV : (br == 1) ? O_FQKV : (br == 2) ? O_MQKV : O_Z;
                        const size_t woffs = (br == 0) ? O_WA : (br == 1) ? O_WB : (br == 2) ? O_WC : O_WD;
                        E.kind = 1; E.p0 = (const unsigned char*)(ws + O_GATE) + br * 1024; E.p1 = (float*)(ws + O_MF32); E.p2 = H; E.mode = (br == 0) ? 0 : (br == 3) ? 2 : 1;
                        A = (const bf16_t*)(ws + aoffs); lda = (br == 0) ? 1024 : (br == 3) ? 768 : 1536; Bt = (const bf16_t*)(ws + woffs); N = 1024; K = (br == 3) ? 768 : 512; }
                    else if (k == 7) { E.kind = 2; E.p0 = xin; E.p1 = X; E.p2 = (void*)(modl + 2048); A = H; lda = 1024; Bt = (const bf16_t*)(ws + O_WO); N = 1024; K = 1024; }
                    else if (k == 9) { E.kind = 3; E.p1 = (bf16_t*)(ws + O_HID); A = H; lda = 1024; Bt = (const bf16_t*)(ws + O_W1); N = 4096; K = 1024; }
                    else { E.kind = 2; E.p0 = X; E.p1 = X; E.p2 = (void*)(modl + 5120); A = (const bf16_t*)(ws + O_HID); lda = 4096; Bt = (const bf16_t*)(ws + O_W2); N = 1024; K = 4096; }
#ifdef PROBE_DUP_GEMM
                    E.dry = (p.ph_lo == 0); run_gemm(lds, A, lda, Bt, N, K, E); E.dry = 0;
#endif
#ifndef STAGGER_TICKS
#define STAGGER_TICKS 0
#endif
                    if (STAGGER_TICKS > 0 && (k == 1 || k == 9)) {
                        const unsigned long long t0 = __builtin_amdgcn_s_memrealtime(); const unsigned long long dl = (unsigned long long)(((blockIdx.x >> 3) & 3) * STAGGER_TICKS);
                        while (__builtin_amdgcn_s_memrealtime() - t0 < dl) __builtin_amdgcn_s_sleep(16);
                    }
                    run_gemm(lds, A, lda, Bt, N, K, E);
                }
                if (k == 1) for (int it = gw; it < 1024; it += NGW) small_cols_item((const bf16_t*)H, (const bf16_t*)(ws + O_WIN) + (size_t)10240 * 1024, (float*)(ws + O_SMALL), it, lane);
            } } else switch (k) {
            case 0: if constexpr ((EN_MASK >> 0) & 1) {
#ifdef PROBE_A
                convert_weights(p, l, lds, gw, NGW, wid, lane); norm_mod_rows(xin, PIN(4) + l * 1024, modl + 0, modl + 1024, H, gw, NGW, lane);
#endif
                convert_weights(p, l, lds, gw, NGW, wid, lane);
                norm_mod_rows(xin, PIN(4) + l * 1024, modl + 0, modl + 1024, H, gw, NGW, lane);
            } break;
            case 2: if constexpr ((EN_MASK >> 2) & 1) {
#ifdef PROBE_C
                { const bool dry = (p.ph_lo == 0);
                for (int it = blockIdx.x; it < 1024; it += G) gmlp_item(p, l, lds, it, wid, lane, dry);
                for (int it = blockIdx.x; it < 512; it += G) rotary_item(p, lds, it, tid, dry);
                for (int it = blockIdx.x; it < 1280; it += G) conv_item(p, l, it, tid);
                for (int it = gw; it < 1536; it += NGW) acum_item(p, l, it, lane);
                for (int it = NGW - 1 - gw; it < 32; it += NGW) foxcum_item(p, l, it, lane); }
#endif
                for (int it = blockIdx.x; it < 256; it += G) gmlp_item(p, l, lds, it, wid, lane);
                for (int it = blockIdx.x; it < 512; it += G) rotary_item(p, lds, it, tid);
                for (int it = blockIdx.x; it < 1280; it += G) conv_item(p, l, it, tid);
                for (int it = gw; it < 1536; it += NGW) acum_item(p, l, it, lane);
                for (int it = NGW - 1 - gw; it < 32; it += NGW) foxcum_item(p, l, it, lane);
            } break;
            case 3: if constexpr ((EN_MASK >> 3) & 1) {
#ifndef EN3
#define EN3 7
#endif
                { unsigned* qctr = (unsigned*)(ws + O_CTL) + 3584 + 64 * l;
                  volatile unsigned* slot = (volatile unsigned*)(lds + 131584);
                  for (;;) {
                      if (tid == 0) *slot = atomicAdd(qctr, 1u);
                      __syncthreads();
                      const unsigned it = (unsigned)__builtin_amdgcn_readfirstlane((int)*slot);
                      __syncthreads();
                      if (it >= 1024u) break;
                      const int qb = 15 - (int)(it >> 6), sub = (int)(it & 63u), bh = sub & 31;
                      if (sub < 32) attn_block_item<false>(p, lds, bh >> 3, bh & 7, qb, tid, wid, lane);
                      else attn_block_item<true>(p, lds, bh >> 3, bh & 7, qb, tid, wid, lane);
                  } }
                if constexpr (EN3 & 4) for (int i = NGW - 1 - gw; i < 1536; i += NGW) ssd_states_item(p, i, lane);
            } break;
            case 4: if constexpr ((EN_MASK >> 4) & 1) {
#ifdef PROBE_EF
                ssd_scan(p, blockIdx.x * 512 + tid, G * 512);
#endif
                ssd_scan(p, blockIdx.x * 512 + tid, G * 512); } break;
            case 5: if constexpr ((EN_MASK >> 5) & 1) {
#ifdef PROBE_EF
                for (int it = blockIdx.x; it < 256; it += G) ssd_out_item(p, l, it, wid, lane, p.ph_lo == 0);
#endif
                for (int it = blockIdx.x; it < 256; it += G) ssd_out_item(p, l, it, wid, lane); } break;
            case 8: if constexpr ((EN_MASK >> 8) & 1) { norm_mod_rows(X, PIN(22) + l * 1024, modl + 3072, modl + 4096, H, gw, NGW, lane); } break;
            }
        }
        if (ph + 1 < p.ph_hi) { if (ph == 0) grid.sync(); else xcd_barrier(xbar); }
#ifdef PROBE_SYNC
        if (ph + 1 < p.ph_hi) { xcd_barrier(xbar); xcd_barrier(xbar); }
#endif
    }
}

#ifndef N_LAUNCH_MODE
#define N_LAUNCH_MODE 1
#endif
#if N_LAUNCH_MODE == 1
__global__ void __launch_bounds__(512, 2) fwd_all(Params p) { fwd_body<0x7ff, true>(p); }
#define KERNEL_FOR_ATTR fwd_all
#else
__global__ void __launch_bounds__(512, 2) fwd_gemm(Params p) { fwd_body<0, true>(p); }
__global__ void __launch_bounds__(512, 2) fwd_misc(Params p) { fwd_body<0x7ff, false>(p); }
#endif
extern "C" void kernel_launch(void* const* d_in, const int* in_sizes, int n_in, void* d_out, int out_size, void* d_ws, size_t ws_size, hipStream_t stream) {
    static int grid = 0;
    if (grid == 0) {
        if (n_in != 26 || out_size != T * DM || ws_size < WS_END) { fprintf(stderr, "kernel_launch: unexpected shapes (n_in %d out %d ws %zu need %zu)\n", n_in, out_size, ws_size, (size_t)WS_END); grid = -1; return; }
        int dev = 0, cus = 0;
        (void)hipGetDevice(&dev); (void)hipDeviceGetAttribute(&cus, hipDeviceAttributeMultiprocessorCount, dev);
#if N_LAUNCH_MODE == 1
        if (hipFuncSetAttribute((const void*)fwd_all, hipFuncAttributeMaxDynamicSharedMemorySize, LDS_BYTES) != hipSuccess) { fprintf(stderr, "kernel_launch: hipFuncSetAttribute failed\n"); grid = -1; return; }
#else
        if (hipFuncSetAttribute((const void*)fwd_gemm, hipFuncAttributeMaxDynamicSharedMemorySize, LDS_BYTES) != hipSuccess || hipFuncSetAttribute((const void*)fwd_misc, hipFuncAttributeMaxDynamicSharedMemorySize, LDS_BYTES) != hipSuccess) { fprintf(stderr, "kernel_launch: hipFuncSetAttribute failed\n"); grid = -1; return; }
#endif
        (void)hipGetLastError();
        grid = cus > 0 ? cus : 256;
    }
    if (grid < 0) return;
    if (hipMemsetAsync((char*)d_ws + O_CTL, 0, 16384, stream) != hipSuccess) { fprintf(stderr, "kernel_launch: memset failed\n"); return; }
    Params p{};
    for (int i = 0; i < 26; ++i) p.in[i] = (const float*)d_in[i];
    p.out = (float*)d_out; p.ws = (unsigned char*)d_ws;
#if N_LAUNCH_MODE == 1
    p.ph_lo = 0; p.ph_hi = N_PHASES;
    void* args[] = {&p};
    hipError_t e = hipLaunchCooperativeKernel((const void*)fwd_all, dim3(grid), dim3(512), args, LDS_BYTES, stream);
    if (e != hipSuccess) fprintf(stderr, "kernel_launch: cooperative launch failed: %s (grid %d)\n", hipGetErrorString(e), grid);
#else
    for (int ph = 0; ph < N_PHASES; ++ph) { p.ph_lo = ph; p.ph_hi = ph + 1;
        const int k = (ph >= 1 && ph < N_PHASES - 1) ? (ph - 1) % PH_PER_LAYER : -1;
        if (k == 1 || k == 6 || k == 7 || k == 9 || k == 10) hipLaunchKernelGGL(fwd_gemm, dim3(grid), dim3(512), LDS_BYTES, stream, p);
        else hipLaunchKernelGGL(fwd_misc, dim3(grid), dim3(512), LDS_BYTES, stream, p); }
#endif
}
```

```cpp
#include <hip/hip_runtime.h>
#include <hip/hip_cooperative_groups.h>
#include <cstdio>
#include <cstdint>
#include <cmath>
namespace cg = cooperative_groups;
namespace pg8 {
#define PG8_LAS __attribute__((address_space(3)))
typedef unsigned short bf16_t;
typedef short bf16x8 __attribute__((ext_vector_type(8)));
typedef float f32x4 __attribute__((ext_vector_type(4)));
typedef unsigned u32x4 __attribute__((ext_vector_type(4)));
constexpr int BM = 256, BK = 64, HALF = 128, HTB = HALF * BK * 2  , STAGE_BYTES = 8 * HTB, NXCD = 8, WGM = 8;

__host__ __device__ __forceinline__ int lds_byte(int r, int c) { const int st = (r >> 4) * 2 + (c >> 5), rr = r & 15, cc = c & 31, ob = rr * 64 + cc * 2; return st * 1024 + (ob ^ (((ob >> 9) & 1) << 5)); }
__host__ __device__ __forceinline__ void stage_rc(int b, int& R, int& C) { const int st = b / 1024, sb = b % 1024, swz = sb ^ (((sb >> 9) & 1) << 5); R = (st >> 1) * 16 + swz / 64; C = (st & 1) * 32 + (swz % 64) / 2; }
__host__ __device__ __forceinline__ int perm32(int rho) { const int n = rho >> 4, i = rho & 15; return 8 * (i >> 2) + 4 * n + (i & 3); }

struct Unit { int pm, pn; };
struct Gemm { const bf16_t* A; const bf16_t* Bt; int M, N, K, lda; };

struct StaticOrder {
    int nM, nN, nwg, G, c;
    __host__ __device__ void init(int M, int N, int G_, int c_) { nM = M / BM; nN = N / BM; nwg = nM * nN; G = G_; c = c_; }
    __host__ __device__ bool next(int i, Unit& u) const {
        const long L = (long)i * G + c; if (L >= nwg) return false;
        int wgid = (int)L; { const int q = nwg / NXCD, r = nwg % NXCD, xcd = wgid % NXCD, off = wgid / NXCD; wgid = (xcd < r ? xcd * (q + 1) : r * (q + 1) + (xcd - r) * q) + off; }
        const int nig = WGM * nN, gid = wgid / nig, fm = gid * WGM, gsz = (nM - fm) < WGM ? (nM - fm) : WGM;
        u.pm = fm + ((wgid % nig) % gsz); u.pn = (wgid % nig) / gsz; return true;
    }
    __device__ __forceinline__ void a_ready(const Unit&) const {}
    __device__ __forceinline__ void done(const Unit&) const {}
};


template <class Epi, class Sched, bool ALIGN_EPI = false, bool SP2 = false>
__device__ __forceinline__ void gemm_phase(PG8_LAS unsigned char* lds, const Gemm g, const Sched& S, const Epi& E) {
    int tid_l = threadIdx.x; asm volatile("" : "+v"(tid_l));
    const int tid = tid_l, wid = __builtin_amdgcn_readfirstlane(tid >> 6), lane = tid & 63, wr = wid >> 2, wc = wid & 3, fr = lane & 15, fq = lane >> 4;
    const int K = g.K, nt = K / BK;
    unsigned voffA[2], voffB[2];
#pragma unroll
    for (int i = 0; i < 2; ++i) { int R, C; stage_rc(tid * 16 + i * 8192, R, C); const int Rb = Epi::PERM ? ((R & ~31) + perm32(R & 31)) : R;
        voffA[i] = (unsigned)(R * g.lda + C) * 2u; voffB[i] = (unsigned)(Rb * K + C) * 2u; }
    const size_t kstep = (size_t)(BK * 2);
    const size_t hstepB = (size_t)HALF * K * 2, hstepA = (size_t)HALF * g.lda * 2;
    const size_t tstepB = 2 * hstepB, tstepA = 2 * hstepA;
    const unsigned ldsw = (unsigned)wid * 1024u;
    const int aoff = lds_byte(wr * 64 + fr, fq * 8), boff = lds_byte(wc * 32 + fr, fq * 8);
#define PG8_SA(b, h) (((b) * 2 + (h)) * HTB)
#define PG8_SB(b, h) ((4 + (b) * 2 + (h)) * HTB)
#define PG8_STAGE(bufoff, gbase, voff) do { _Pragma("unroll") for (int _i = 0; _i < 2; ++_i) \
        __builtin_amdgcn_global_load_lds((const unsigned*)((const char*)(gbase) + (voff)[_i]), (PG8_LAS unsigned*)(lds + (bufoff) + ldsw + _i * 8192), 16, 0, 0); } while (0)
#define PG8_LDA(dst, b, h) do { _Pragma("unroll") for (int m = 0; m < 4; ++m) _Pragma("unroll") for (int k = 0; k < 2; ++k) dst[m][k] = *(const PG8_LAS bf16x8*)(lds + PG8_SA(b, h) + aoff + m * 2048 + k * 1024); } while (0)
#define PG8_LDB(dst, b, h) do { _Pragma("unroll") for (int n = 0; n < 2; ++n) _Pragma("unroll") for (int k = 0; k < 2; ++k) dst[n][k] = *(const PG8_LAS bf16x8*)(lds + PG8_SB(b, h) + boff + n * 2048 + k * 1024); } while (0)
#define PG8_MMA(ai, bj, At, Bt) do { __builtin_amdgcn_s_setprio(1); _Pragma("unroll") for (int m = 0; m < 4; ++m) _Pragma("unroll") for (int n = 0; n < 2; ++n) _Pragma("unroll") for (int k = 0; k < 2; ++k) \
        acc[ai][bj][m][n] = __builtin_amdgcn_mfma_f32_16x16x32_bf16(Bt[n][k], At[m][k], acc[ai][bj][m][n], 0, 0, 0); __builtin_amdgcn_s_setprio(0); } while (0)
#define PG8_WAIT_V(n) asm volatile("s_waitcnt vmcnt(" #n ")" ::: "memory")
#define PG8_WAIT_L(n) asm volatile("s_waitcnt lgkmcnt(" #n ")" ::: "memory")
#define PG8_BAR __builtin_amdgcn_s_barrier()
#define PG8_SCHED __builtin_amdgcn_sched_barrier(0)
    Unit cur, nxt; int ui = 0;
    if (!S.next(0, cur)) return;
    f32x4 acc[2][2][4][2];
#pragma unroll
    for (int a = 0; a < 2; ++a)
#pragma unroll
        for (int b = 0; b < 2; ++b)
#pragma unroll
            for (int m = 0; m < 4; ++m)
#pragma unroll
                for (int n = 0; n < 2; ++n) acc[a][b][m][n] = (f32x4){0.f, 0.f, 0.f, 0.f};
    bf16x8 At[4][2], B0[2][2], B1[2][2];
    const char* cA = (const char*)g.A + (size_t)cur.pm * tstepA; const char* cB = (const char*)g.Bt + (size_t)cur.pn * tstepB;
    S.a_ready(cur);
    if constexpr (SP2) {
        PG8_STAGE(PG8_SB(0, 0), cB, voffB); PG8_STAGE(PG8_SB(0, 1), cB + hstepB, voffB); PG8_STAGE(PG8_SA(0, 0), cA, voffA); PG8_STAGE(PG8_SA(0, 1), cA + hstepA, voffA);
        if (wr == 1) PG8_BAR;
        PG8_WAIT_V(2); PG8_BAR;
        PG8_STAGE(PG8_SB(1, 0), cB + kstep, voffB); PG8_STAGE(PG8_SA(1, 0), cA + kstep, voffA); PG8_STAGE(PG8_SB(1, 1), cB + hstepB + kstep, voffB);
        PG8_WAIT_V(6); PG8_BAR;
    } else {
        PG8_STAGE(PG8_SB(0, 0), cB, voffB); PG8_STAGE(PG8_SA(0, 0), cA, voffA); PG8_STAGE(PG8_SB(0, 1), cB + hstepB, voffB); PG8_STAGE(PG8_SA(0, 1), cA + hstepA, voffA);
        if (wr == 1) PG8_BAR;
        PG8_WAIT_V(4); PG8_BAR;
        PG8_STAGE(PG8_SB(1, 0), cB + kstep, voffB); PG8_STAGE(PG8_SA(1, 0), cA + kstep, voffA); PG8_STAGE(PG8_SB(1, 1), cB + hstepB + kstep, voffB);
        PG8_WAIT_V(6); PG8_BAR;
    }
    for (;;) {
        const bool has_next = S.next(ui + 1, nxt);
        const char* nA = has_next ? (const char*)g.A + (size_t)nxt.pm * tstepA : cA; const char* nB = has_next ? (const char*)g.Bt + (size_t)nxt.pn * tstepB : cB;
        for (int t = 0; t < nt; t += 2) {
            const bool last = (t == nt - 2);
            const char* a1 = cA + (size_t)(t + 1) * kstep;
            const char* a2 = last ? nA : cA + (size_t)(t + 2) * kstep; const char* b2 = last ? nB : cB + (size_t)(t + 2) * kstep;
            const char* a3 = a2 + kstep; const char* b3 = b2 + kstep;
            if (last && has_next) S.a_ready(nxt);
            if constexpr (SP2) {
            PG8_LDB(B0, 0, 0); PG8_LDB(B1, 0, 1); PG8_SCHED; PG8_LDA(At, 0, 0); PG8_STAGE(PG8_SA(1, 1), a1 + hstepA, voffA);
            PG8_WAIT_V(8); PG8_WAIT_L(0); PG8_BAR; PG8_MMA(0, 0, At, B0); PG8_MMA(0, 1, At, B1); PG8_BAR; PG8_SCHED;
            PG8_LDA(At, 0, 1); PG8_STAGE(PG8_SB(0, 0), b2, voffB); PG8_STAGE(PG8_SB(0, 1), b2 + hstepB, voffB); PG8_STAGE(PG8_SA(0, 0), a2, voffA);
            PG8_WAIT_V(8); PG8_WAIT_L(0); PG8_BAR; PG8_MMA(1, 0, At, B0); PG8_MMA(1, 1, At, B1); PG8_BAR; PG8_SCHED;
            PG8_LDB(B0, 1, 0); PG8_LDB(B1, 1, 1); PG8_SCHED; PG8_LDA(At, 1, 0); PG8_STAGE(PG8_SA(0, 1), a2 + hstepA, voffA);
            PG8_WAIT_V(8); PG8_WAIT_L(0); PG8_BAR; PG8_MMA(0, 0, At, B0); PG8_MMA(0, 1, At, B1); PG8_BAR; PG8_SCHED;
            PG8_LDA(At, 1, 1); PG8_STAGE(PG8_SB(1, 0), b3, voffB); PG8_STAGE(PG8_SB(1, 1), b3 + hstepB, voffB); PG8_STAGE(PG8_SA(1, 0), a3, voffA);
            PG8_WAIT_V(8); PG8_WAIT_L(0); PG8_BAR; PG8_MMA(1, 0, At, B0); PG8_MMA(1, 1, At, B1); PG8_BAR; PG8_SCHED;
            } else {
            PG8_LDB(B0, 0, 0); PG8_SCHED; PG8_LDA(At, 0, 0); PG8_STAGE(PG8_SA(1, 1), a1 + hstepA, voffA);
            PG8_WAIT_L(8); PG8_BAR; PG8_WAIT_L(0); PG8_MMA(0, 0, At, B0); PG8_BAR; PG8_SCHED;
            PG8_LDB(B1, 0, 1); PG8_STAGE(PG8_SB(0, 0), b2, voffB);
            PG8_BAR; PG8_WAIT_L(0); PG8_MMA(0, 1, At, B1); PG8_BAR;
            PG8_LDA(At, 0, 1); PG8_STAGE(PG8_SA(0, 0), a2, voffA);
            PG8_BAR; PG8_WAIT_L(0); PG8_MMA(1, 0, At, B0); PG8_BAR; PG8_SCHED;
            PG8_STAGE(PG8_SB(0, 1), b2 + hstepB, voffB);
            PG8_WAIT_V(6); PG8_BAR; PG8_MMA(1, 1, At, B1); PG8_BAR;
            PG8_LDB(B0, 1, 0); PG8_SCHED; PG8_LDA(At, 1, 0); PG8_STAGE(PG8_SA(0, 1), a2 + hstepA, voffA);
            PG8_WAIT_L(8); PG8_BAR; PG8_WAIT_L(0); PG8_MMA(0, 0, At, B0); PG8_BAR; PG8_SCHED;
            PG8_LDB(B1, 1, 1); PG8_STAGE(PG8_SB(1, 0), b3, voffB);
            PG8_BAR; PG8_WAIT_L(0); PG8_MMA(0, 1, At, B1); PG8_BAR;
            PG8_LDA(At, 1, 1); PG8_STAGE(PG8_SA(1, 0), a3, voffA);
            PG8_BAR; PG8_WAIT_L(0); PG8_MMA(1, 0, At, B0); PG8_BAR; PG8_SCHED;
            PG8_STAGE(PG8_SB(1, 1), b3 + hstepB, voffB);
            PG8_WAIT_V(6); PG8_BAR; PG8_MMA(1, 1, At, B1); PG8_BAR;
            }
        }
        if constexpr (ALIGN_EPI) { if (wr == 0) PG8_BAR; }
        if constexpr (!Epi::AFTER_DRAIN) { E(acc, cur, wr, wc, fr, fq); S.done(cur); }
        if (!has_next) break;
#pragma unroll
        for (int a = 0; a < 2; ++a)
#pragma unroll
            for (int b = 0; b < 2; ++b)
#pragma unroll
                for (int m = 0; m < 4; ++m)
#pragma unroll
                    for (int n = 0; n < 2; ++n) acc[a][b][m][n] = (f32x4){0.f, 0.f, 0.f, 0.f};
        cur = nxt; cA = nA; cB = nB; ++ui;
        if constexpr (ALIGN_EPI) { if (wr == 1) PG8_BAR; }
    }
    PG8_WAIT_V(0);
    if constexpr (!ALIGN_EPI) { if (wr == 0) PG8_BAR; }
    PG8_BAR;
    if constexpr (Epi::AFTER_DRAIN) { E.fused(acc, cur, wr, wc, fr, fq, lds, wid, lane); S.done(cur); }
#undef PG8_SA
#undef PG8_SB
#undef PG8_STAGE
#undef PG8_LDA
#undef PG8_LDB
#undef PG8_MMA
#undef PG8_WAIT_V
#undef PG8_WAIT_L
#undef PG8_BAR
#undef PG8_SCHED
}
}

constexpr int NB = 4, SEQ = 4096, T = NB * SEQ, DM = 1024, DEPTH = 4;
constexpr int NPROJ = 10496;
constexpr int IN_COLS = 10260;
constexpr float NORM_EPS = 1e-6f;
constexpr float LOG2E = 1.4426950408889634f;

typedef unsigned short bf16_t;
typedef short bf16x8 __attribute__((ext_vector_type(8)));
typedef float f32x4 __attribute__((ext_vector_type(4)));
typedef float f32x2 __attribute__((ext_vector_type(2)));
typedef unsigned u32x4 __attribute__((ext_vector_type(4)));
typedef unsigned u32x2 __attribute__((ext_vector_type(2)));
typedef __bf16 bf16x2_t __attribute__((ext_vector_type(2)));

constexpr size_t MiB = 1u << 20;
constexpr size_t O_MOD = 0, O_X = 1 * MiB, O_H = 65 * MiB, O_UV = 97 * MiB, O_FQKV = 129 * MiB, O_MQKV = 177 * MiB, O_Z = 225 * MiB,
                 O_XBC = 249 * MiB, O_GATE = 289 * MiB, O_SMALL = 417 * MiB, O_VTF = 419 * MiB, O_VTM = 435 * MiB, O_XT = 451 * MiB,
                 O_BC = 475 * MiB, O_BT = 491 * MiB, O_ST = 499 * MiB, O_CUMF = 547 * MiB, O_ACUM = 548 * MiB, O_KMEAN = 549 * MiB,
                 O_WIN = 550 * MiB, O_WA = 571 * MiB, O_WB = 572 * MiB, O_WC = 573 * MiB, O_WD = 574 * MiB, O_WO = 576 * MiB,
                 O_W1 = 578 * MiB, O_W2 = 586 * MiB, O_GWS = 594 * MiB, WS_END = 595 * MiB;
constexpr size_t O_ROT = O_GWS + 512 * 1024;
constexpr size_t O_DT = O_KMEAN + 256 * 1024;
constexpr size_t O_CTL = 512 * 1024;
constexpr size_t O_PREV = O_XBC;
constexpr size_t O_HID = O_GATE;
constexpr size_t O_MF32 = O_VTF;
constexpr int LDS_BYTES = 147456;

struct Params { const float* in[26]; float* out; unsigned char* ws; int ph_lo, ph_hi; };

__device__ __forceinline__ int opq(int i) { asm volatile("" : "+s"(i)); return i; }
#define PIN(i) (p.in[opq(i)])
__device__ __forceinline__ unsigned cvtpk(float lo, float hi) { f32x2 v = {lo, hi}; bf16x2_t b = __builtin_convertvector(v, bf16x2_t); return __builtin_bit_cast(unsigned, b); }
__device__ __forceinline__ float bf2f(short h) { return __uint_as_float(((unsigned)(unsigned short)h) << 16); }
__device__ __forceinline__ float bflo(unsigned w) { return __uint_as_float(w << 16); }
__device__ __forceinline__ float bfhi(unsigned w) { return __uint_as_float(w & 0xffff0000u); }
__device__ __forceinline__ bf16x8 pack8(float a0, float a1, float a2, float a3, float a4, float a5, float a6, float a7) {
    u32x4 w = {cvtpk(a0, a1), cvtpk(a2, a3), cvtpk(a4, a5), cvtpk(a6, a7)}; return __builtin_bit_cast(bf16x8, w); }
__device__ __forceinline__ bf16x8 ld2x8(const bf16_t* p0, const bf16_t* p1) { const u32x2 a = *(const u32x2*)p0, b = *(const u32x2*)p1; u32x4 w = {a.x, a.y, b.x, b.y}; return __builtin_bit_cast(bf16x8, w); }
typedef short s16x4_t __attribute__((ext_vector_type(4)));
__device__ __forceinline__ s16x4_t lds_tr(const bf16_t* p) { return __builtin_bit_cast(s16x4_t, __builtin_amdgcn_ds_read_tr16_b64_v4i16((__attribute__((address_space(3))) s16x4_t*)p)); }
__device__ __forceinline__ bf16x8 cat4(s16x4_t a, s16x4_t b) { return (bf16x8){a[0], a[1], a[2], a[3], b[0], b[1], b[2], b[3]}; }
__device__ __forceinline__ f32x4 mfma16(bf16x8 a, bf16x8 b, f32x4 c) { return __builtin_amdgcn_mfma_f32_16x16x32_bf16(a, b, c, 0, 0, 0); }
__device__ __forceinline__ float dpp_add(float v, const int ctrl_sel) {
    const int iv = __builtin_bit_cast(int, v); int m;
    if (ctrl_sel == 0) m = __builtin_amdgcn_update_dpp(0, iv, 0xB1, 0xF, 0xF, true);
    else if (ctrl_sel == 1) m = __builtin_amdgcn_update_dpp(0, iv, 0x4E, 0xF, 0xF, true);
    else if (ctrl_sel == 2) m = __builtin_amdgcn_update_dpp(0, iv, 0x141, 0xF, 0xF, true);
    else m = __builtin_amdgcn_update_dpp(0, iv, 0x140, 0xF, 0xF, true);
    return v + __builtin_bit_cast(float, m); }
__device__ __forceinline__ float row16_sum(float v) { v = dpp_add(v, 0); v = dpp_add(v, 1); v = dpp_add(v, 2); v = dpp_add(v, 3); return v; }
__device__ __forceinline__ float wave_sum(float v) { v = row16_sum(v); v += __shfl_xor(v, 16); v += __shfl_xor(v, 32); return v; }
__device__ __forceinline__ float ex2(float x) { return __builtin_amdgcn_exp2f(x); }
__device__ __forceinline__ float sigmoidf_(float x) { return 1.f / (1.f + __expf(-x)); }
__device__ __forceinline__ float softplusf_(float x) { return fmaxf(x, 0.f) + log1pf(expf(-fabsf(x))); }
#define LDS_WAIT() asm volatile("s_waitcnt lgkmcnt(0)" ::: "memory")
#define VM_WAIT() asm volatile("s_waitcnt vmcnt(0)" ::: "memory")

#define EPI_LANE_SETUP() int t_ = threadIdx.x; asm volatile("" : "+v"(t_)); const int fr = t_ & 15, fq = (t_ >> 4) & 3; const int wv_ = __builtin_amdgcn_readfirstlane(t_ >> 6); const int wr = wv_ >> 2, wc = wv_ & 3
__device__ __forceinline__ unsigned pk4u8(float a, float b, float c, float d) {
    const unsigned ua = (unsigned)(a * 255.f + 0.5f), ub = (unsigned)(b * 255.f + 0.5f), uc = (unsigned)(c * 255.f + 0.5f), ud = (unsigned)(d * 255.f + 0.5f);
    return ua | (ub << 8) | (uc << 16) | (ud << 24); }
__device__ __forceinline__ float u8f(unsigned w, int i) { return (float)((w >> (8 * i)) & 255u); }
__device__ __forceinline__ float act_unified(float x, int act) {
    const float uu = 1.5957691216057308f * (x + 0.044715f * x * x * x);
    const float arg = (act == 1) ? uu : (act == 0) ? INFINITY : x;
    const float num = (act == 3) ? 1.f : x;
    return num * __builtin_amdgcn_rcpf(1.f + ex2(-LOG2E * arg));
}
struct EpiInproj {
    static constexpr bool PERM = true, AFTER_DRAIN = false;
    unsigned char* ws;
    __device__ __forceinline__ void operator()(const f32x4 (&acc)[2][2][4][2], const pg8::Unit& u, int, int, int, int) const {
        EPI_LANE_SETUP();
        const int pn = u.pn; const int row0 = u.pm * 256 + wr * 64 + fr;
        if (pn == 40) {
            if (wc == 0) {
                float* sm = (float*)(ws + O_SMALL);
#pragma unroll
                for (int ai = 0; ai < 2; ++ai)
#pragma unroll
                    for (int m = 0; m < 4; ++m) { float* rp = sm + (size_t)(row0 + ai * 128 + m * 16) * 32 + 8 * fq;
                        *(f32x4*)rp = acc[ai][0][m][0]; *(f32x4*)(rp + 4) = acc[ai][0][m][1]; }
            }
            return;
        }
        bf16_t* base; int pitch, ct, act;
        if (pn < 4) { base = (bf16_t*)(ws + O_UV); pitch = 1024; ct = pn; act = 1; }
        else if (pn < 10) { base = (bf16_t*)(ws + O_FQKV); pitch = 1536; ct = pn - 4; act = 0; }
        else if (pn < 16) { base = (bf16_t*)(ws + O_MQKV); pitch = 1536; ct = pn - 10; act = 0; }
        else if (pn < 19) { base = (bf16_t*)(ws + O_Z); pitch = 768; ct = pn - 16; act = 2; }
        else if (pn < 24) { base = (bf16_t*)(ws + O_XBC); pitch = 1280; ct = pn - 19; act = 0; }
        else { base = (bf16_t*)(ws + O_GATE); pitch = 4096; ct = pn - 24; act = 3; }
        const int col0 = ct * 256 + wc * 32 + 8 * fq;
#pragma unroll
        for (int ai = 0; ai < 2; ++ai)
#pragma unroll
            for (int m = 0; m < 4; ++m) { bf16_t* rowp = base + (size_t)(row0 + ai * 128 + m * 16) * pitch + col0;
#pragma unroll
                for (int bj = 0; bj < 2; ++bj) { f32x4 v0 = acc[ai][bj][m][0], v1 = acc[ai][bj][m][1];
#pragma unroll
                    for (int j = 0; j < 4; ++j) if (act != 0) { v0[j] = act_unified(v0[j], act); v1[j] = act_unified(v1[j], act); }
                    if (act == 3) {
                        unsigned char* gp = (unsigned char*)(ws + O_GATE) + (size_t)(row0 + ai * 128 + m * 16) * 4096 + col0 + bj * 128;
                        u32x2 q; q.x = pk4u8(v0[0], v0[1], v0[2], v0[3]); q.y = pk4u8(v1[0], v1[1], v1[2], v1[3]);
                        __builtin_nontemporal_store(q, (u32x2*)gp);
                    } else {
                        u32x4 w; w.x = cvtpk(v0[0], v0[1]); w.y = cvtpk(v0[2], v0[3]); w.z = cvtpk(v1[0], v1[1]); w.w = cvtpk(v1[2], v1[3]);
                        __builtin_nontemporal_store(w, (u32x4*)(rowp + bj * 128)); } }
                asm volatile("" ::: "memory"); }
    }
};
struct EpiMerge {
    static constexpr bool PERM = true, AFTER_DRAIN = false;
    const unsigned char* gate; float* mf; bf16_t* outb; int mode;
    __device__ __forceinline__ void operator()(const f32x4 (&acc)[2][2][4][2], const pg8::Unit& u, int, int, int, int) const {
        EPI_LANE_SETUP();
        const int row0 = u.pm * 256 + wr * 64 + fr, col0 = u.pn * 256 + wc * 32 + 8 * fq;
#pragma unroll
        for (int ai = 0; ai < 2; ++ai) {
#pragma unroll
            for (int m = 0; m < 4; ++m) { const size_t row = (size_t)(row0 + ai * 128 + m * 16);
#pragma unroll
                for (int bj = 0; bj < 2; ++bj) { const int col = col0 + bj * 128;
                    const u32x2 gw = *(const u32x2*)(gate + row * 4096 + col);
                    f32x4 v0 = acc[ai][bj][m][0] * (1.f / 255.f), v1 = acc[ai][bj][m][1] * (1.f / 255.f);
                    v0[0] *= u8f(gw.x, 0); v0[1] *= u8f(gw.x, 1); v0[2] *= u8f(gw.x, 2); v0[3] *= u8f(gw.x, 3); v1[0] *= u8f(gw.y, 0); v1[1] *= u8f(gw.y, 1); v1[2] *= u8f(gw.y, 2); v1[3] *= u8f(gw.y, 3);
                    bf16_t* op = outb + row * 1024 + col;
                    if (mode != 0) { const u32x4 pw = *(const u32x4*)op;
                        v0[0] += bflo(pw.x); v0[1] += bfhi(pw.x); v0[2] += bflo(pw.y); v0[3] += bfhi(pw.y); v1[0] += bflo(pw.z); v1[1] += bfhi(pw.z); v1[2] += bflo(pw.w); v1[3] += bfhi(pw.w); }
                    u32x4 w; w.x = cvtpk(v0[0], v0[1]); w.y = cvtpk(v0[2], v0[3]); w.z = cvtpk(v1[0], v1[1]); w.w = cvtpk(v1[2], v1[3]);
                    *(u32x4*)op = w; } }
            asm volatile("" ::: "memory"); }
    }
};
struct EpiResid {
    static constexpr bool PERM = true, AFTER_DRAIN = false;
    const float* xin; float* xout; const float* gmod;
    __device__ __forceinline__ void operator()(const f32x4 (&acc)[2][2][4][2], const pg8::Unit& u, int, int, int, int) const {
        EPI_LANE_SETUP();
        const int row0 = u.pm * 256 + wr * 64 + fr, col0 = u.pn * 256 + wc * 32 + 8 * fq; const int b = u.pm >> 4;
        const float* gp = gmod + (size_t)b * 6144 + col0;
        const f32x4 g00 = *(const f32x4*)gp, g01 = *(const f32x4*)(gp + 4), g10 = *(const f32x4*)(gp + 128), g11 = *(const f32x4*)(gp + 132);
#pragma unroll
        for (int ai = 0; ai < 2; ++ai) {
#pragma unroll
            for (int m = 0; m < 4; ++m) { const size_t off = (size_t)(row0 + ai * 128 + m * 16) * 1024 + col0;
                *(f32x4*)(xout + off) = *(const f32x4*)(xin + off) + g00 * acc[ai][0][m][0];
                *(f32x4*)(xout + off + 4) = *(const f32x4*)(xin + off + 4) + g01 * acc[ai][0][m][1];
                *(f32x4*)(xout + off + 128) = *(const f32x4*)(xin + off + 128) + g10 * acc[ai][1][m][0];
                *(f32x4*)(xout + off + 132) = *(const f32x4*)(xin + off + 132) + g11 * acc[ai][1][m][1]; }
            asm volatile("" ::: "memory"); }
    }
};
struct EpiRelu2 {
    static constexpr bool PERM = true, AFTER_DRAIN = false;
    bf16_t* out;
    __device__ __forceinline__ void operator()(const f32x4 (&acc)[2][2][4][2], const pg8::Unit& u, int, int, int, int) const {
        EPI_LANE_SETUP();
        const int row0 = u.pm * 256 + wr * 64 + fr, col0 = u.pn * 256 + wc * 32 + 8 * fq;
#pragma unroll
        for (int ai = 0; ai < 2; ++ai)
#pragma unroll
            for (int m = 0; m < 4; ++m) { bf16_t* rowp = out + (size_t)(row0 + ai * 128 + m * 16) * 4096 + col0;
#pragma unroll
                for (int bj = 0; bj < 2; ++bj) { f32x4 v0 = acc[ai][bj][m][0], v1 = acc[ai][bj][m][1];
#pragma unroll
                    for (int j = 0; j < 4; ++j) { const float r0 = fmaxf(v0[j], 0.f), r1 = fmaxf(v1[j], 0.f); v0[j] = r0 * r0; v1[j] = r1 * r1; }
                    u32x4 w; w.x = cvtpk(v0[0], v0[1]); w.y = cvtpk(v0[2], v0[3]); w.z = cvtpk(v1[0], v1[1]); w.w = cvtpk(v1[2], v1[3]);
                    __builtin_nontemporal_store(w, (u32x4*)(rowp + bj * 128)); }
                asm volatile("" ::: "memory"); }
    }
};
struct EpiU {
    static constexpr bool PERM = true, AFTER_DRAIN = false;
    int kind, mode; const void* p0; void* p1; void* p2; int dry;
    __device__ __forceinline__ void operator()(const f32x4 (&acc)[2][2][4][2], const pg8::Unit& u, int a, int b, int c, int d) const {
        if (dry) return;
        if (kind == 0) { EpiInproj e{(unsigned char*)p1}; e(acc, u, a, b, c, d); }
        else if (kind == 1) { EpiMerge e{(const unsigned char*)p0, (float*)p1, (bf16_t*)p2, mode}; e(acc, u, a, b, c, d); }
        else if (kind == 2) { EpiResid e{(const float*)p0, (float*)p1, (const float*)p2}; e(acc, u, a, b, c, d); }
        else { EpiRelu2 e{(bf16_t*)p1}; e(acc, u, a, b, c, d); }
    }
};
template <class Epi>
__device__ __forceinline__ void run_gemm(unsigned char* lds, const bf16_t* A, int lda, const bf16_t* Bt, int N, int K, const Epi& E) {
    pg8::Gemm g{A, Bt, T, N, K, lda}; pg8::StaticOrder S; S.init(T, N, (int)gridDim.x, (int)blockIdx.x);
    pg8::gemm_phase<Epi, pg8::StaticOrder, true, true>((PG8_LAS unsigned char*)lds, g, S, E);
}

__device__ __forceinline__ void phase_pre(const Params& p, unsigned char* lds, const int tid) {
    float* cs = (float*)lds; float* red = cs + 4096;
    const float* c = PIN(1); const float* ada_w = PIN(2); const float* ada_b = PIN(3);
    float* mod = (float*)(p.ws + O_MOD);
    for (int i = tid; i < 4096; i += 512) { const float v = c[i]; cs[i] = v / (1.f + expf(-v)); }
    __syncthreads();
    { float* rot = (float*)(p.ws + O_ROT);
      for (int e = blockIdx.x * 512 + tid; e < 4096 * 8; e += gridDim.x * 512) { const int pos = e >> 3, j = e & 7;
          const float inv_freq = powf(500000.0f, -(float)j * 0.125f); const float ang = (float)pos * inv_freq;
          rot[pos * 16 + j] = cosf(ang); rot[pos * 16 + 8 + j] = sinf(ang); } }
    const int jj = tid & 63, ks = tid >> 6;
    for (int it = blockIdx.x; it < DEPTH * 96; it += gridDim.x) {
        const int l = it / 96, jb = it % 96;
        const float* w = ada_w + (size_t)l * 1024 * 6144 + jb * 64 + jj;
        float a0 = 0.f, a1 = 0.f, a2 = 0.f, a3 = 0.f;
#pragma unroll 8
        for (int k = ks * 128; k < ks * 128 + 128; ++k) { const float wv = w[(size_t)k * 6144]; a0 += cs[k] * wv; a1 += cs[1024 + k] * wv; a2 += cs[2048 + k] * wv; a3 += cs[3072 + k] * wv; }
        red[(ks * 64 + jj) * 4 + 0] = a0; red[(ks * 64 + jj) * 4 + 1] = a1; red[(ks * 64 + jj) * 4 + 2] = a2; red[(ks * 64 + jj) * 4 + 3] = a3;
        __syncthreads();
        if (tid < 256) { const int b = tid >> 6, j2 = tid & 63; float s = 0.f;
#pragma unroll
            for (int q = 0; q < 8; ++q) s += red[(q * 64 + j2) * 4 + b];
            const int cc = jb * 64 + j2; mod[((size_t)l * 4 + b) * 6144 + cc] = s + ada_b[l * 6144 + cc]; }
        __syncthreads();
    }
}

__device__ __forceinline__ int inproj_src_col(int n) {
    if (n < 2560) return n;
    if (n < 6144) return n + 8;
    if (n < 10240) return n + 20;
    if (n < 10248) return 2560 + (n - 10240);
    if (n < 10260) return 6152 + (n - 10248);
    return -1;
}
__device__ __forceinline__ void transpose_item(const float* W, int K, int Nsrc, bf16_t* WT, float* scr, int k0, int n0, int lane, bool remap) {
    const int nd = n0 + (lane & 31); const int sc = remap ? inproj_src_col(nd) : nd;
#pragma unroll
    for (int i = 0; i < 32; ++i) { const int kk = 2 * i + (lane >> 5); scr[kk * 33 + (lane & 31)] = (sc >= 0) ? W[(size_t)(k0 + kk) * Nsrc + sc] : 0.f; }
    LDS_WAIT();
    const int c = lane & 7;
#pragma unroll
    for (int j = 0; j < 4; ++j) { const int n = (lane >> 3) + 8 * j; const float* s = scr + (8 * c) * 33 + n;
        u32x4 o; o.x = cvtpk(s[0 * 33], s[1 * 33]); o.y = cvtpk(s[2 * 33], s[3 * 33]); o.z = cvtpk(s[4 * 33], s[5 * 33]); o.w = cvtpk(s[6 * 33], s[7 * 33]);
        *(u32x4*)(WT + (size_t)(n0 + n) * K + k0 + 8 * c) = o; }
    LDS_WAIT();
}
__device__ __forceinline__ void convert_weights(const Params& p, int l, unsigned char* lds, int gw, int NGW, int wid, int lane) {
    float* scr = (float*)(lds + wid * 16384);
    unsigned char* ws = p.ws;
    constexpr int I_IN = 16 * (NPROJ / 32), I_BR = 8 * 32, I_D = 12 * 32, I_O = 16 * 32, I_1 = 16 * 128, I_2 = 64 * 32;
    constexpr int TOT = I_IN + 3 * I_BR + I_D + I_O + I_1 + I_2;
    for (int it = gw; it < TOT; it += NGW) {
        int r = it; const float* W; bf16_t* WT; int K, Nsrc, Nd; bool remap = false;
        if (r < I_IN) { W = PIN(5) + (size_t)l * 1024 * IN_COLS; WT = (bf16_t*)(ws + O_WIN); K = 1024; Nsrc = IN_COLS; Nd = NPROJ; remap = true; }
        else if ((r -= I_IN) < I_BR) { W = PIN(17) + (size_t)l * 512 * 1024; WT = (bf16_t*)(ws + O_WA); K = 512; Nsrc = 1024; Nd = 1024; }
        else if ((r -= I_BR) < I_BR) { W = PIN(18) + (size_t)l * 512 * 1024; WT = (bf16_t*)(ws + O_WB); K = 512; Nsrc = 1024; Nd = 1024; }
        else if ((r -= I_BR) < I_BR) { W = PIN(19) + (size_t)l * 512 * 1024; WT = (bf16_t*)(ws + O_WC); K = 512; Nsrc = 1024; Nd = 1024; }
        else if ((r -= I_BR) < I_D) { W = PIN(20) + (size_t)l * 768 * 1024; WT = (bf16_t*)(ws + O_WD); K = 768; Nsrc = 1024; Nd = 1024; }
        else if ((r -= I_D) < I_O) { W = PIN(21) + (size_t)l * 1024 * 1024; WT = (bf16_t*)(ws + O_WO); K = 1024; Nsrc = 1024; Nd = 1024; }
        else if ((r -= I_O) < I_1) { W = PIN(23) + (size_t)l * 1024 * 4096; WT = (bf16_t*)(ws + O_W1); K = 1024; Nsrc = 4096; Nd = 4096; }
        else { r -= I_1; W = PIN(24) + (size_t)l * 4096 * 1024; WT = (bf16_t*)(ws + O_W2); K = 4096; Nsrc = 1024; Nd = 1024; }
        const int nblk = Nd / 32, kb = r / nblk, nb = r % nblk;
        transpose_item(W, K, Nsrc, WT, scr, 64 * kb, 32 * nb, lane, remap);
    }
    const float* gws = PIN(8) + (size_t)l * 8 * 128 * 128; bf16_t* gd = (bf16_t*)(ws + O_GWS);
    for (int e = gw * 64 + lane; e < 8 * 128 * 128; e += NGW * 64) { const int s = e & 127, t = (e >> 7) & 127; const float v = (s <= t) ? gws[e] : 0.f; gd[e] = (bf16_t)(cvtpk(v, 0.f) & 0xffffu); }
}
__device__ __forceinline__ void norm_mod_rows(const float* x, const float* w, const float* sh, const float* sc, bf16_t* out, int gw, int NGW, int lane) {
    const int per = T / NGW;
    const int rbeg = gw * per; const int b = rbeg >> 12;
    f32x4 ws[4], hv[4];
#pragma unroll
    for (int j = 0; j < 4; ++j) { const int col = 4 * (64 * j + lane);
        ws[j] = *(const f32x4*)(w + col) * (*(const f32x4*)(sc + (size_t)b * 6144 + col) + 1.f); hv[j] = *(const f32x4*)(sh + (size_t)b * 6144 + col); }
#pragma unroll 2
    for (int r = 0; r < per; ++r) {
        const int row = rbeg + r; const f32x4* xr = (const f32x4*)(x + (size_t)row * 1024) + lane;
        f32x4 v[4]; float ss = 0.f;
#pragma unroll
        for (int j = 0; j < 4; ++j) { v[j] = xr[64 * j]; ss += (v[j][0] * v[j][0] + v[j][1] * v[j][1]) + (v[j][2] * v[j][2] + v[j][3] * v[j][3]); }
        const float rstd = rsqrtf(wave_sum(ss) * (1.f / 1024.f) + NORM_EPS);
#pragma unroll
        for (int j = 0; j < 4; ++j) { const int col = 4 * (64 * j + lane);
            const f32x4 o = (v[j] * rstd) * ws[j] + hv[j];
            u32x2 pk; pk.x = cvtpk(o[0], o[1]); pk.y = cvtpk(o[2], o[3]); *(u32x2*)(out + (size_t)row * 1024 + col) = pk; }
    }
}
__device__ __forceinline__ void final_norm_rows(const float* x, const float* w, float* out, int gw, int NGW, int lane) {
    for (int row = gw; row < T; row += NGW) {
        const f32x4* xr = (const f32x4*)(x + (size_t)row * 1024) + lane;
        f32x4 v[4]; float ss = 0.f;
#pragma unroll
        for (int j = 0; j < 4; ++j) { v[j] = xr[64 * j]; ss += (v[j][0] * v[j][0] + v[j][1] * v[j][1]) + (v[j][2] * v[j][2] + v[j][3] * v[j][3]); }
        const float rstd = rsqrtf(wave_sum(ss) * (1.f / 1024.f) + NORM_EPS);
#pragma unroll
        for (int j = 0; j < 4; ++j) { const int col = 4 * (64 * j + lane); const f32x4 wv = *(const f32x4*)(w + col);
            *(f32x4*)(out + (size_t)row * 1024 + col) = v[j] * rstd * wv; }
    }
}

__device__ __forceinline__ void gmlp_item(const Params& p, int l, unsigned char* lds, int item, int wid, int lane) {
    const int half = item & 1, ch = (item >> 1) & 31, b = item >> 6;
    const int fr = lane & 15, fq = lane >> 4;
    bf16_t* UV = (bf16_t*)(p.ws + O_UV); const bf16_t* GWS = (const bf16_t*)(p.ws + O_GWS);
    const float* lnw = PIN(6) + l * 512; const float* lnb = PIN(7) + l * 512;
    bf16_t* vnT = (bf16_t*)lds;
    const size_t row0 = (size_t)b * SEQ + ch * 128;
#pragma unroll 8
    for (int r = 0; r < 16; ++r) {
        const int s = wid * 16 + r;
        const bf16x8 raw = *(const bf16x8*)(UV + (row0 + s) * 1024 + 512 + 8 * lane);
        float x[8]; float sum = 0.f;
#pragma unroll
        for (int j = 0; j < 8; ++j) { x[j] = bf2f(raw[j]); sum += x[j]; }
        const float mean = wave_sum(sum) * (1.f / 512.f); float sq = 0.f;
#pragma unroll
        for (int j = 0; j < 8; ++j) { x[j] -= mean; sq += x[j] * x[j]; }
        const float rstd = rsqrtf(wave_sum(sq) * (1.f / 512.f) + NORM_EPS);
        if ((lane >> 5) == half) { const int c0 = (lane & 31) * 8;
#pragma unroll
            for (int j = 0; j < 8; ++j) { const int cc = half * 256 + c0 + j; const float o = x[j] * rstd * lnw[cc] + lnb[cc]; vnT[(c0 + j) * 136 + s] = (bf16_t)(cvtpk(o, 0.f) & 0xffffu); } }
    }
    __syncthreads();
    const int t0 = wid * 16; const int nks = (t0 + 15) / 32 + 1;
#pragma unroll 1
    for (int g4 = 0; g4 < 4; ++g4) {
        const int grp = half * 4 + g4;
        f32x4 acc[4];
#pragma unroll
        for (int ct = 0; ct < 4; ++ct) acc[ct] = (f32x4){0.f, 0.f, 0.f, 0.f};
        for (int ks = 0; ks < nks; ++ks) {
            const bf16x8 bw = *(const bf16x8*)(GWS + ((size_t)grp * 128 + t0 + fr) * 128 + ks * 32 + 8 * fq);
#pragma unroll
            for (int ct = 0; ct < 4; ++ct) { const bf16x8 av = *(const bf16x8*)(vnT + (g4 * 64 + ct * 16 + fr) * 136 + ks * 32 + 8 * fq); acc[ct] = mfma16(av, bw, acc[ct]); }
        }
        const float bsv = (PIN(9) + (size_t)l * 8 * 128 + grp * 128)[t0 + fr];
#pragma unroll
        for (int ct = 0; ct < 4; ++ct) { bf16_t* up = UV + (row0 + t0 + fr) * 1024 + grp * 64 + ct * 16 + 4 * fq;
            const u32x2 uw = *(const u32x2*)up; u32x2 o;
            o.x = cvtpk(bflo(uw.x) * (acc[ct][0] + bsv), bfhi(uw.x) * (acc[ct][1] + bsv)); o.y = cvtpk(bflo(uw.y) * (acc[ct][2] + bsv), bfhi(uw.y) * (acc[ct][3] + bsv));
            *(u32x2*)up = o; }
    }
    __syncthreads();
}
__device__ __forceinline__ void rotary_item(const Params& p, unsigned char* lds, int item, int tid, bool dry = false) {
    const int h = item & 7, nb = (item >> 3) & 15, b = item >> 7;
    float* sums = (float*)lds;
    if (tid < 64) sums[tid] = 0.f;
    __syncthreads();
    bf16_t* MQ = (bf16_t*)(p.ws + O_MQKV);
    const int half = (tid >> 5) & 1, tt = (tid >> 6) * 32 + (tid & 31); const int pos = nb * 256 + tt; const size_t row = (size_t)b * SEQ + pos;
    bf16_t* kp = MQ + row * 1536 + 512 + h * 64 + half * 32;
    float kv[32];
#pragma unroll
    for (int q = 0; q < 4; ++q) { const bf16x8 raw = *(const bf16x8*)(kp + 8 * q);
#pragma unroll
        for (int j = 0; j < 8; ++j) kv[8 * q + j] = bf2f(raw[j]); }
    if (half == 0 && !dry) {
        bf16_t* qp = MQ + row * 1536 + h * 64;
        float qv[16];
        { const bf16x8 r0 = *(const bf16x8*)qp, r1 = *(const bf16x8*)(qp + 8);
#pragma unroll
          for (int j = 0; j < 8; ++j) { qv[j] = bf2f(r0[j]); qv[8 + j] = bf2f(r1[j]); } }
        const float* rt = (const float*)(p.ws + O_ROT) + pos * 16;
        const f32x4 c0 = *(const f32x4*)rt, c1 = *(const f32x4*)(rt + 4), s0 = *(const f32x4*)(rt + 8), s1 = *(const f32x4*)(rt + 12);
#pragma unroll
        for (int j = 0; j < 8; ++j) {
            const float cs = (j < 4) ? c0[j & 3] : c1[j & 3], sn = (j < 4) ? s0[j & 3] : s1[j & 3];
            const float k1 = kv[j], k2 = kv[8 + j]; kv[j] = k1 * cs - k2 * sn; kv[8 + j] = k2 * cs + k1 * sn;
            const float q1 = qv[j], q2 = qv[8 + j]; qv[j] = q1 * cs - q2 * sn; qv[8 + j] = q2 * cs + q1 * sn;
        }
        *(bf16x8*)kp = pack8(kv[0], kv[1], kv[2], kv[3], kv[4], kv[5], kv[6], kv[7]);
        *(bf16x8*)(kp + 8) = pack8(kv[8], kv[9], kv[10], kv[11], kv[12], kv[13], kv[14], kv[15]);
        *(bf16x8*)qp = pack8(qv[0], qv[1], qv[2], qv[3], qv[4], qv[5], qv[6], qv[7]);
        *(bf16x8*)(qp + 8) = pack8(qv[8], qv[9], qv[10], qv[11], qv[12], qv[13], qv[14], qv[15]);
    }
#pragma unroll
    for (int d = 0; d < 32; ++d) {
        float v = row16_sum(kv[d]); v += __shfl_xor(v, 16);
        if ((tid & 31) == 0) atomicAdd(&sums[half * 32 + d], v);
    }
    __syncthreads();
    if (tid < 64) ((float*)(p.ws + O_KMEAN))[(((size_t)b * 8 + h) * 16 + nb) * 64 + tid] = sums[tid] * (1.f / 256.f);
    __syncthreads();
}
__device__ __forceinline__ void vt_item(const Params& p, unsigned char* lds, int item, int tid) {
    const int tb = item & 31, h = (item >> 5) & 7, b = (item >> 8) & 3, which = item >> 10;
    const bf16_t* src = (const bf16_t*)(p.ws + (which ? O_MQKV : O_FQKV)) + ((size_t)b * SEQ + tb * 128) * 1536 + 1024 + h * 64;
    bf16_t* dst = (bf16_t*)(p.ws + (which ? O_VTM : O_VTF)) + ((size_t)(b * 8 + h) * 64) * 4096 + tb * 128;
    bf16_t* tl = (bf16_t*)lds;
    { const int tok = tid >> 2, dq = tid & 3;
      const bf16x8 r0 = *(const bf16x8*)(src + (size_t)tok * 1536 + dq * 16), r1 = *(const bf16x8*)(src + (size_t)tok * 1536 + dq * 16 + 8);
#pragma unroll
      for (int j = 0; j < 8; ++j) { tl[(dq * 16 + j) * 136 + tok] = (bf16_t)r0[j]; tl[(dq * 16 + 8 + j) * 136 + tok] = (bf16_t)r1[j]; } }
    __syncthreads();
    { const int d = tid >> 3, c = tid & 7;
      const bf16x8 a = *(const bf16x8*)(tl + d * 136 + c * 16), bq = *(const bf16x8*)(tl + d * 136 + c * 16 + 8);
      *(bf16x8*)(dst + (size_t)d * 4096 + c * 16) = a; *(bf16x8*)(dst + (size_t)d * 4096 + c * 16 + 8) = bq; }
    __syncthreads();
}
__device__ __forceinline__ void conv_item(const Params& p, int l, int item, int tid) {
    const int cb = item % 20, sp = (item / 20) & 15, b = item / 320;
    const int c8 = tid & 7, tq = tid >> 3; const int gc = cb * 64 + 8 * c8;
    const int t0 = sp * 256 + tq * 4;
    const bf16_t* xp = (const bf16_t*)(p.ws + O_XBC) + ((size_t)b * SEQ) * 1280 + gc;
    float v[7][8];
#pragma unroll
    for (int r = 0; r < 7; ++r) { const int t = t0 - 3 + r;
        if (t >= 0) { const bf16x8 raw = *(const bf16x8*)(xp + (size_t)t * 1280);
#pragma unroll
            for (int j = 0; j < 8; ++j) v[r][j] = bf2f(raw[j]); }
        else {
#pragma unroll
            for (int j = 0; j < 8; ++j) v[r][j] = 0.f; } }
    const float* cw = PIN(11) + (size_t)l * 4 * 1280 + gc; const float* cbp = PIN(12) + l * 1280 + gc;
    float w[4][8], bias[8];
#pragma unroll
    for (int kk = 0; kk < 4; ++kk) { const f32x4 a = *(const f32x4*)(cw + kk * 1280), bq = *(const f32x4*)(cw + kk * 1280 + 4);
#pragma unroll
        for (int j = 0; j < 4; ++j) { w[kk][j] = a[j]; w[kk][4 + j] = bq[j]; } }
    { const f32x4 a = *(const f32x4*)cbp, bq = *(const f32x4*)(cbp + 4);
#pragma unroll
      for (int j = 0; j < 4; ++j) { bias[j] = a[j]; bias[4 + j] = bq[j]; } }
    float o[4][8];
#pragma unroll
    for (int tt = 0; tt < 4; ++tt)
#pragma unroll
        for (int j = 0; j < 8; ++j) { const float x = bias[j] + w[0][j] * v[tt][j] + w[1][j] * v[tt + 1][j] + w[2][j] * v[tt + 2][j] + w[3][j] * v[tt + 3][j]; o[tt][j] = x / (1.f + __expf(-x)); }
    const size_t tok0 = (size_t)b * SEQ + t0;
    if (cb < 12) {
        bf16_t* d = (bf16_t*)(p.ws + O_XT) + ((size_t)(b * 12 + cb) * 64 + 8 * c8) * 4096 + t0;
#pragma unroll
        for (int j = 0; j < 8; ++j) { u32x2 q; q.x = cvtpk(o[0][j], o[1][j]); q.y = cvtpk(o[2][j], o[3][j]); *(u32x2*)(d + (size_t)j * 4096) = q; }
    } else {
        bf16_t* BC = (bf16_t*)(p.ws + O_BC); const int bc = gc - 768;
#pragma unroll
        for (int tt = 0; tt < 4; ++tt) *(bf16x8*)(BC + (tok0 + tt) * 512 + bc) = pack8(o[tt][0], o[tt][1], o[tt][2], o[tt][3], o[tt][4], o[tt][5], o[tt][6], o[tt][7]);
        if (cb < 16) { bf16_t* d = (bf16_t*)(p.ws + O_BT) + ((size_t)b * 256 + bc) * 4096 + t0;
#pragma unroll
            for (int j = 0; j < 8; ++j) { u32x2 q; q.x = cvtpk(o[0][j], o[1][j]); q.y = cvtpk(o[2][j], o[3][j]); *(u32x2*)(d + (size_t)j * 4096) = q; } }
    }
}
__device__ __forceinline__ void acum_item(const Params& p, int l, int item, int lane) {
    const int ch = item & 31, h = (item >> 5) % 12, b = item / 384;
    const float* sm = (const float*)(p.ws + O_SMALL); const float a = -expf(PIN(14)[l * 12 + h]);
    const size_t tok = (size_t)b * SEQ + ch * 128 + 2 * lane;
    const float dtb = PIN(13)[l * 12 + h];
    const f32x2 raw = *(const f32x2*)(sm + (size_t)(8 + h) * T + tok); const float d0 = softplusf_(raw[0] + dtb), d1 = softplusf_(raw[1] + dtb);
    { f32x2 dd = {d0, d1}; *(f32x2*)((float*)(p.ws + O_DT) + ((size_t)(b * 12 + h)) * 4096 + ch * 128 + 2 * lane) = dd; }
    const float v0 = d0 * a, v1 = d1 * a;
    float sc = v0 + v1;
#pragma unroll
    for (int o = 1; o < 64; o <<= 1) { const float t = __shfl_up(sc, o); if (lane >= o) sc += t; }
    const float ex = sc - (v0 + v1);
    f32x2 r = {ex + v0, ex + v0 + v1};
    *(f32x2*)((float*)(p.ws + O_ACUM) + ((size_t)(b * 12 + h)) * 4096 + ch * 128 + 2 * lane) = r;
}
__device__ __forceinline__ void foxcum_item(const Params& p, int l, int item, int lane) {
    const int h = item & 7, b = item >> 3; const float fb = PIN(10)[l * 8 + h];
    const float* sm = (const float*)(p.ws + O_SMALL) + (size_t)h * T + (size_t)b * SEQ + lane * 64;
    float* cum = (float*)(p.ws + O_CUMF) + (size_t)(b * 8 + h) * 4096 + lane * 64;
    float v[64];
#pragma unroll
    for (int i = 0; i < 64; i += 4) { const f32x4 q = *(const f32x4*)(sm + i); v[i] = q[0]; v[i + 1] = q[1]; v[i + 2] = q[2]; v[i + 3] = q[3]; }
    float run = 0.f;
#pragma unroll
    for (int i = 0; i < 64; ++i) { const float x = v[i] + fb; run += fminf(x, 0.f) - __logf(1.f + __expf(-fabsf(x))); v[i] = run; }
    float sc = run;
#pragma unroll
    for (int o = 1; o < 64; o <<= 1) { const float t = __shfl_up(sc, o); if (lane >= o) sc += t; }
    const float ex = sc - run;
#pragma unroll
    for (int i = 0; i < 64; i += 4) { f32x4 w = {v[i] + ex, v[i + 1] + ex, v[i + 2] + ex, v[i + 3] + ex}; *(f32x4*)(cum + i) = w; }
}

template <bool MOBA, int VPITCH>
__device__ __forceinline__ void attn_tile64(const bf16_t* KL, const bf16_t* VL, const float* CL, int k0, bool diag, int kb,
                                            const bf16x8 (&qf)[2][2], const float (&cq)[2], const unsigned (&sel)[2], int qpos0, int fr, int fq,
                                            f32x4 (&lacc)[2], f32x4 (&o)[4][2]) {
    bf16x8 kf[4][2], vf[2][4]; f32x4 nck[4];
#pragma unroll
    for (int jk = 0; jk < 4; ++jk) { kf[jk][0] = *(const bf16x8*)(KL + (16 * jk + fr) * 72 + 8 * fq); kf[jk][1] = *(const bf16x8*)(KL + (16 * jk + fr) * 72 + 32 + 8 * fq); }
#pragma unroll
    for (int jk = 0; jk < 4; ++jk) nck[jk] = MOBA ? (f32x4){0.f, 0.f, 0.f, 0.f} : *(const f32x4*)(CL + 16 * jk + 4 * fq);
#pragma unroll
    for (int dt = 0; dt < 4; ++dt) { const bf16_t* vp = VL + (4 * fq + (fr >> 2)) * VPITCH + dt * 16 + 4 * (fr & 3); vf[0][dt] = cat4(lds_tr(vp), lds_tr(vp + 16 * VPITCH)); }
    __builtin_amdgcn_sched_barrier(0);
    f32x4 s[4][2];
    __builtin_amdgcn_s_setprio(1);
#pragma unroll
    for (int jk = 0; jk < 4; ++jk)
#pragma unroll
        for (int jq = 0; jq < 2; ++jq) { f32x4 z = {0.f, 0.f, 0.f, 0.f}; z = mfma16(kf[jk][0], qf[jq][0], z); s[jk][jq] = mfma16(kf[jk][1], qf[jq][1], z); }
    __builtin_amdgcn_s_setprio(0);
    __builtin_amdgcn_sched_barrier(0);
#pragma unroll
    for (int dt = 0; dt < 4; ++dt) { const bf16_t* vp = VL + (32 + 4 * fq + (fr >> 2)) * VPITCH + dt * 16 + 4 * (fr & 3); vf[1][dt] = cat4(lds_tr(vp), lds_tr(vp + 16 * VPITCH)); }
    __builtin_amdgcn_sched_barrier(0);
    constexpr float C2 = 0.125f * LOG2E;
#pragma unroll
    for (int jk = 0; jk < 4; ++jk)
#pragma unroll
        for (int jq = 0; jq < 2; ++jq)
#pragma unroll
            for (int i = 0; i < 4; ++i) s[jk][jq][i] = MOBA ? s[jk][jq][i] * C2 : fmaf(s[jk][jq][i], C2, nck[jk][i] + cq[jq]);
    if (diag) {
#pragma unroll
        for (int jk = 0; jk < 4; ++jk)
#pragma unroll
            for (int jq = 0; jq < 2; ++jq)
#pragma unroll
                for (int i = 0; i < 4; ++i) if (k0 + 16 * jk + 4 * fq + i > qpos0 + 16 * jq + fr) s[jk][jq][i] = -INFINITY;
    }
    if (MOBA && kb >= 0) {
#pragma unroll
        for (int jq = 0; jq < 2; ++jq) if (!((sel[jq] >> kb) & 1u)) {
#pragma unroll
            for (int jk = 0; jk < 4; ++jk) s[jk][jq] = (f32x4){-INFINITY, -INFINITY, -INFINITY, -INFINITY}; }
    }
    bf16x8 pb[2][2];
#pragma unroll
    for (int jq = 0; jq < 2; ++jq) {
#pragma unroll
        for (int jk = 0; jk < 4; ++jk)
#pragma unroll
            for (int i = 0; i < 4; ++i) s[jk][jq][i] = ex2(fminf(s[jk][jq][i], 100.f));
        pb[jq][0] = pack8(s[0][jq][0], s[0][jq][1], s[0][jq][2], s[0][jq][3], s[1][jq][0], s[1][jq][1], s[1][jq][2], s[1][jq][3]);
        pb[jq][1] = pack8(s[2][jq][0], s[2][jq][1], s[2][jq][2], s[2][jq][3], s[3][jq][0], s[3][jq][1], s[3][jq][2], s[3][jq][3]);
    }
    const u32x4 onesw = {0x3f803f80u, 0x3f803f80u, 0x3f803f80u, 0x3f803f80u}; const bf16x8 ones = __builtin_bit_cast(bf16x8, onesw);
    __builtin_amdgcn_s_setprio(1);
#pragma unroll
    for (int hh = 0; hh < 2; ++hh) {
#pragma unroll
        for (int jq = 0; jq < 2; ++jq) lacc[jq] = mfma16(ones, pb[jq][hh], lacc[jq]);
#pragma unroll
        for (int dt = 0; dt < 4; ++dt)
#pragma unroll
            for (int jq = 0; jq < 2; ++jq) o[dt][jq] = mfma16(vf[hh][dt], pb[jq][hh], o[dt][jq]);
    }
    __builtin_amdgcn_s_setprio(0);
}
__device__ __forceinline__ unsigned moba_select(const bf16_t* qp, const float* km, int own) {
    const bf16x8 r0 = *(const bf16x8*)qp, r1 = *(const bf16x8*)(qp + 8);
    float qd[16];
#pragma unroll
    for (int j = 0; j < 8; ++j) { qd[j] = bf2f(r0[j]); qd[8 + j] = bf2f(r1[j]); }
    float gate[15];
#pragma unroll
    for (int n = 0; n < 15; ++n) {
        float a = -INFINITY;
        if (n < own) { a = 0.f;
#pragma unroll
            for (int d = 0; d < 16; d += 4) { const f32x4 kk = *(const f32x4*)(km + n * 64 + d); a += qd[d] * kk[0] + qd[d + 1] * kk[1] + qd[d + 2] * kk[2] + qd[d + 3] * kk[3]; }
            a += __shfl_xor(a, 16); a += __shfl_xor(a, 32); }
        gate[n] = a;
    }
    unsigned msk = 0u;
#pragma unroll
    for (int pass = 0; pass < 3; ++pass) { float best = -INFINITY; int bi = -1;
#pragma unroll
        for (int n = 0; n < 15; ++n) { const float v = ((msk >> n) & 1u) ? -INFINITY : gate[n]; if (v > best) { best = v; bi = n; } }
        if (bi >= 0) msk |= 1u << bi; }
    return msk;
}
template <bool MOBA>
__device__ __forceinline__ void attn_block_item(const Params& p, unsigned char* lds, int b, int h, int qb, int tid_in, int wid, int lane_in) {
    int tid = tid_in, lane = lane_in; asm volatile("" : "+v"(tid), "+v"(lane));
    const int fr = lane & 15, fq = lane >> 4; const int q0 = qb * 256 + wid * 32;
    bf16_t* qkv = (bf16_t*)(p.ws + (MOBA ? O_MQKV : O_FQKV)) + ((size_t)b * SEQ) * 1536 + h * 64;
    const bf16_t* kbase = qkv + 512; const bf16_t* vtbase = (const bf16_t*)(p.ws + (MOBA ? O_VTM : O_VTF)) + ((size_t)(b * 8 + h) * 64) * 4096;
    const float* cum = (const float*)(p.ws + O_CUMF) + (size_t)(b * 8 + h) * 4096;
    bf16x8 qf[2][2];
#pragma unroll
    for (int jq = 0; jq < 2; ++jq)
#pragma unroll
        for (int ks = 0; ks < 2; ++ks) qf[jq][ks] = *(const bf16x8*)(qkv + (size_t)(q0 + 16 * jq + fr) * 1536 + ks * 32 + 8 * fq);
    float cq[2] = {0.f, 0.f}; unsigned sel[2] = {0u, 0u}; unsigned umask = 0u;
    const int own = qb;
    if (!MOBA) { cq[0] = cum[q0 + fr] * LOG2E; cq[1] = cum[q0 + 16 + fr] * LOG2E; }
    if (MOBA && own > 0) {
        const float* km = (const float*)(p.ws + O_KMEAN) + ((size_t)(b * 8 + h) * 16) * 64 + 16 * fq;
        sel[0] = moba_select(qkv + (size_t)(q0 + fr) * 1536 + 16 * fq, km, own);
        __builtin_amdgcn_sched_barrier(0);
        sel[1] = moba_select(qkv + (size_t)(q0 + 16 + fr) * 1536 + 16 * fq, km, own);
        __builtin_amdgcn_sched_barrier(0);
        umask = sel[0] | sel[1];
#pragma unroll
        for (int o2 = 1; o2 < 16; o2 <<= 1) umask |= __shfl_xor(umask, o2);
        umask = __builtin_amdgcn_readfirstlane(umask);
    }
    f32x4 lacc[2] = {(f32x4){0.f, 0.f, 0.f, 0.f}, (f32x4){0.f, 0.f, 0.f, 0.f}}; f32x4 o[4][2];
#pragma unroll
    for (int dt = 0; dt < 4; ++dt) { o[dt][0] = (f32x4){0.f, 0.f, 0.f, 0.f}; o[dt][1] = (f32x4){0.f, 0.f, 0.f, 0.f}; }
    const int NT = 2 * (qb + 1);
    constexpr int VP = 80;
    bf16_t* KLb = (bf16_t*)lds; bf16_t* VLb = KLb + 2 * 128 * 72;
    float* CLb = (float*)(VLb + 2 * 128 * VP);
    const int lr = tid >> 3, lc = (tid & 7) * 8;
    #define STEP_KT(i) (MOBA ? (((i) < 2) ? 2 * qb + (i) : (i) - 2) : (i))
    bf16x8 kreg0, kreg1, vreg0, vreg1; f32x4 creg = {0.f, 0.f, 0.f, 0.f};
    #define LOAD_STEP(kk0) do { kreg0 = *(const bf16x8*)(kbase + (size_t)((kk0) + lr) * 1536 + lc); kreg1 = *(const bf16x8*)(kbase + (size_t)((kk0) + 64 + lr) * 1536 + lc); \
        vreg0 = *(const bf16x8*)(kbase + 512 + (size_t)((kk0) + lr) * 1536 + lc); vreg1 = *(const bf16x8*)(kbase + 512 + (size_t)((kk0) + 64 + lr) * 1536 + lc); \
        if (!MOBA && tid < 32) creg = *(const f32x4*)(cum + (kk0) + 4 * tid) * (-LOG2E); } while (0)
    #define STORE_STEP(bb) do { *(bf16x8*)(KLb + (bb) * 128 * 72 + lr * 72 + lc) = kreg0; *(bf16x8*)(KLb + (bb) * 128 * 72 + (lr + 64) * 72 + lc) = kreg1; \
        *(bf16x8*)(VLb + (bb) * 128 * VP + lr * VP + lc) = vreg0; *(bf16x8*)(VLb + (bb) * 128 * VP + (lr + 64) * VP + lc) = vreg1; \
        if (!MOBA && tid < 32) *(f32x4*)(CLb + (bb) * 128 + 4 * tid) = creg; } while (0)
    int i_start = 0;
    if (!MOBA) {
        const float cq0 = cum[qb * 256];
        const float ce = (lane < NT) ? cum[lane * 128 + 127] : 0.f;
        const bool need = (lane < NT) && ((cq0 - ce) * LOG2E >= -64.f);
        const unsigned long long bal = __ballot(need);
        i_start = __builtin_amdgcn_readfirstlane(bal ? (int)__ffsll((long long)bal) - 1 : NT - 1);
    }
    LOAD_STEP(STEP_KT(i_start) * 128); STORE_STEP(0);
    __syncthreads();
#pragma unroll 1
    for (int i = i_start; i < NT; ++i) {
        const int k0 = STEP_KT(i) * 128; const int buf = (i - i_start) & 1;
        if (i + 1 < NT) LOAD_STEP(STEP_KT(i + 1) * 128);
        const bf16_t* KL = KLb + buf * 128 * 72; const bf16_t* VL = VLb + buf * 128 * VP; const float* CL = CLb + buf * 128;
        const int kb = k0 >> 8;
        const bool live = !MOBA || kb == own || ((umask >> kb) & 1u);
        if (live) {
#pragma unroll
            for (int hh = 0; hh < 2; ++hh) { const int k0h = k0 + 64 * hh;
                if (k0h <= q0 + 31) attn_tile64<MOBA, VP>(KL + hh * 64 * 72, VL + hh * 64 * VP, CL + hh * 64, k0h, k0h + 63 > q0, (MOBA && kb < own) ? kb : -1, qf, cq, sel, q0, fr, fq, lacc, o); }
        }
        if (i + 1 < NT) STORE_STEP(buf ^ 1);
        __syncthreads();
    }
    #undef STEP_KT
    #undef LOAD_STEP
    #undef STORE_STEP
#pragma unroll
    for (int jq = 0; jq < 2; ++jq) {
        const float inv = 1.f / lacc[jq][0];
        bf16_t* op = qkv + (size_t)(q0 + 16 * jq + fr) * 1536 + 4 * fq;
#pragma unroll
        for (int dt = 0; dt < 4; ++dt) { const f32x4 v = o[dt][jq] * inv; u32x2 w; w.x = cvtpk(v[0], v[1]); w.y = cvtpk(v[2], v[3]); *(u32x2*)(op + dt * 16) = w; }
    }
}
__device__ __forceinline__ void ssd_states_item(const Params& p, int item, int lane) {
    const int h = item % 12, c = (item / 12) & 31, b = item / 384; const int grp = h / 6;
    const int fr = lane & 15, fq = lane >> 4;
    const float* ac = (const float*)(p.ws + O_ACUM) + (size_t)(b * 12 + h) * 4096 + c * 128;
    const float* dtp = (const float*)(p.ws + O_DT) + (size_t)(b * 12 + h) * 4096 + c * 128;
    const bf16_t* XT = (const bf16_t*)(p.ws + O_XT) + ((size_t)(b * 12 + h) * 64) * 4096 + c * 128;
    const bf16_t* BT = (const bf16_t*)(p.ws + O_BT) + ((size_t)(b * 2 + grp) * 128) * 4096 + c * 128;
    float* ST = (float*)(p.ws + O_ST) + ((size_t)((b * 32 + c) * 12 + h)) * 8192;
    const float total = ac[127];
#pragma unroll 1
    for (int q2 = 0; q2 < 4; ++q2) {
        f32x4 acc[4][2];
#pragma unroll
        for (int pt = 0; pt < 4; ++pt) { acc[pt][0] = (f32x4){0.f, 0.f, 0.f, 0.f}; acc[pt][1] = (f32x4){0.f, 0.f, 0.f, 0.f}; }
#pragma unroll 1
        for (int ks = 0; ks < 4; ++ks) {
            const int s0 = ks * 32 + 8 * fq;
            const f32x4 a0 = *(const f32x4*)(ac + s0), a1 = *(const f32x4*)(ac + s0 + 4);
            const f32x4 d0 = *(const f32x4*)(dtp + s0), d1 = *(const f32x4*)(dtp + s0 + 4);
            float w8[8];
#pragma unroll
            for (int j = 0; j < 4; ++j) { w8[j] = __expf(total - a0[j]) * d0[j]; w8[4 + j] = __expf(total - a1[j]) * d1[j]; }
            const bf16x8 b0 = *(const bf16x8*)(BT + (size_t)((q2 * 2 + 0) * 16 + fr) * 4096 + s0), b1 = *(const bf16x8*)(BT + (size_t)((q2 * 2 + 1) * 16 + fr) * 4096 + s0);
#pragma unroll
            for (int pt = 0; pt < 4; ++pt) { const bf16x8 xa = *(const bf16x8*)(XT + (size_t)(pt * 16 + fr) * 4096 + s0);
                const bf16x8 af = pack8(bf2f(xa[0]) * w8[0], bf2f(xa[1]) * w8[1], bf2f(xa[2]) * w8[2], bf2f(xa[3]) * w8[3], bf2f(xa[4]) * w8[4], bf2f(xa[5]) * w8[5], bf2f(xa[6]) * w8[6], bf2f(xa[7]) * w8[7]);
                acc[pt][0] = mfma16(b0, af, acc[pt][0]); acc[pt][1] = mfma16(b1, af, acc[pt][1]); }
        }
#pragma unroll
        for (int pt = 0; pt < 4; ++pt)
#pragma unroll
            for (int nt = 0; nt < 2; ++nt) *(f32x4*)(ST + (size_t)(pt * 16 + fr) * 128 + (q2 * 2 + nt) * 16 + 4 * fq) = acc[pt][nt];
    }
}
__device__ __forceinline__ void ssd_scan(const Params& p, int gtid, int gthreads) {
    const float* ST = (const float*)(p.ws + O_ST); bf16_t* PV = (bf16_t*)(p.ws + O_PREV); const float* ACUM = (const float*)(p.ws + O_ACUM);
    for (int e4 = gtid; e4 < NB * 12 * 2048; e4 += gthreads) {
        const int pn = (e4 & 2047) * 4, h = (e4 >> 11) % 12, b = e4 / (12 * 2048);
        const float* ac = ACUM + (size_t)(b * 12 + h) * 4096 + 127;
        const size_t base = ((size_t)(b * 32) * 12 + h) * 8192 + pn;
        f32x4 hs = {0.f, 0.f, 0.f, 0.f};
#pragma unroll 8
        for (int c = 0; c < 32; ++c) { const f32x4 st = *(const f32x4*)(ST + base + (size_t)c * 12 * 8192); const float dc = __expf(ac[c * 128]);
            u32x2 q; q.x = cvtpk(hs[0], hs[1]); q.y = cvtpk(hs[2], hs[3]); *(u32x2*)(PV + base + (size_t)c * 12 * 8192) = q;
            hs = hs * dc + st; }
    }
}
__device__ __forceinline__ void ssd_out_item(const Params& p, int l, int item, int wid, int lane, bool dry = false) {
    const int grp = item & 1, c = (item >> 1) & 31, b = item >> 6;
    const int fr = lane & 15, fq = lane >> 4; const int w = wid; const int tl = 16 * w + fr;
    const size_t row0 = (size_t)b * SEQ + c * 128; const size_t row = row0 + tl;
    const bf16_t* BC = (const bf16_t*)(p.ws + O_BC);
    bf16_t* Z = (bf16_t*)(p.ws + O_Z);
    bf16x8 cf[4];
#pragma unroll
    for (int ks = 0; ks < 4; ++ks) cf[ks] = *(const bf16x8*)(BC + row * 512 + 256 + grp * 128 + ks * 32 + 8 * fq);
    f32x4 cbt[8];
#pragma unroll
    for (int js = 0; js < 8; ++js) { cbt[js] = (f32x4){0.f, 0.f, 0.f, 0.f};
        if (js <= w) {
#pragma unroll
            for (int ks = 0; ks < 4; ++ks) { const bf16x8 a = *(const bf16x8*)(BC + (row0 + js * 16 + fr) * 512 + grp * 128 + ks * 32 + 8 * fq); cbt[js] = mfma16(a, cf[ks], cbt[js]); } } }
    float ssq = 0.f;
#pragma unroll 1
    for (int r = 0; r < 6; ++r) {
        const int h = grp * 6 + r;
        const float* ac = (const float*)(p.ws + O_ACUM) + (size_t)(b * 12 + h) * 4096 + c * 128;
        const float* dtp = (const float*)(p.ws + O_DT) + (size_t)(b * 12 + h) * 4096 + c * 128;
        const float acl = ac[tl]; const float eacl = __expf(acl); const float Dh = PIN(15)[l * 12 + h];
        const bf16_t* PV = (const bf16_t*)(p.ws + O_PREV) + ((size_t)((b * 32 + c) * 12 + h)) * 8192;
        const bf16_t* XT = (const bf16_t*)(p.ws + O_XT) + ((size_t)(b * 12 + h) * 64) * 4096 + c * 128;
        f32x4 yt[4];
#pragma unroll
        for (int pt = 0; pt < 4; ++pt) yt[pt] = (f32x4){0.f, 0.f, 0.f, 0.f};
#pragma unroll
        for (int ks = 0; ks < 4; ++ks)
#pragma unroll
            for (int pt = 0; pt < 4; ++pt) { const bf16x8 a = *(const bf16x8*)(PV + (size_t)(pt * 16 + fr) * 128 + ks * 32 + 8 * fq); yt[pt] = mfma16(a, cf[ks], yt[pt]); }
#pragma unroll
        for (int pt = 0; pt < 4; ++pt) yt[pt] = yt[pt] * eacl;
#pragma unroll
        for (int jp = 0; jp < 4; ++jp) {
            if (2 * jp <= w) {
                const int sA = 32 * jp + 4 * fq, sB = sA + 16;
                const f32x4 a0 = *(const f32x4*)(ac + sA), a1 = *(const f32x4*)(ac + sB), dv0 = *(const f32x4*)(dtp + sA), dv1 = *(const f32x4*)(dtp + sB);
                float mv[8];
#pragma unroll
                for (int j = 0; j < 4; ++j) {
                    const int s = sA + j; const float d0 = dv0[j];
                    float v = (s <= tl) ? cbt[2 * jp][j] * __expf(acl - a0[j]) * d0 : 0.f; if (s == tl) v += Dh; mv[j] = v;
                    const int s2 = sB + j; const float d1 = dv1[j];
                    float v2 = (s2 <= tl) ? cbt[2 * jp + 1][j] * __expf(acl - a1[j]) * d1 : 0.f; if (s2 == tl) v2 += Dh; mv[4 + j] = v2;
                }
                const bf16x8 mb = pack8(mv[0], mv[1], mv[2], mv[3], mv[4], mv[5], mv[6], mv[7]);
#pragma unroll
                for (int pt = 0; pt < 4; ++pt) { const bf16_t* xp = XT + (size_t)(pt * 16 + fr) * 4096 + sA; yt[pt] = mfma16(ld2x8(xp, xp + 16), mb, yt[pt]); }
            }
        }
#pragma unroll
        for (int pt = 0; pt < 4; ++pt) { bf16_t* zp = Z + row * 768 + h * 64 + pt * 16 + 4 * fq; const u32x2 zw = *(const u32x2*)zp;
            const float y0 = yt[pt][0] * bflo(zw.x), y1 = yt[pt][1] * bfhi(zw.x), y2 = yt[pt][2] * bflo(zw.y), y3 = yt[pt][3] * bfhi(zw.y);
            ssq += (y0 * y0 + y1 * y1) + (y2 * y2 + y3 * y3);
            u32x2 o; o.x = cvtpk(y0, y1); o.y = cvtpk(y2, y3); if (!dry) *(u32x2*)zp = o; }
    }
    ssq += __shfl_xor(ssq, 16); ssq += __shfl_xor(ssq, 32);
    if (dry) return;
    const float rstd = rsqrtf(ssq * (1.f / 384.f) + NORM_EPS);
    VM_WAIT();
    const float* nw = PIN(16) + l * 768 + grp * 384;
    bf16_t* zp0 = Z + row * 768 + grp * 384 + 4 * fq;
#pragma unroll 4
    for (int q = 0; q < 24; ++q) { bf16_t* zp = zp0 + q * 16; const u32x2 zw = *(const u32x2*)zp; const f32x4 nv = *(const f32x4*)(nw + q * 16 + 4 * fq);
        u32x2 o; o.x = cvtpk(bflo(zw.x) * rstd * nv[0], bfhi(zw.x) * rstd * nv[1]); o.y = cvtpk(bflo(zw.y) * rstd * nv[2], bfhi(zw.y) * rstd * nv[3]); *(u32x2*)zp = o; }
}

__device__ __forceinline__ void small_cols_item(const bf16_t* Hh, const bf16_t* Wt, float* sm, int item, int lane) {
    const int fr = lane & 15, fq = lane >> 4; const size_t row0 = (size_t)item * 16;
    const bf16_t* ap = Hh + (row0 + fr) * 1024 + 8 * fq; const bf16_t* b0p = Wt + (size_t)fr * 1024 + 8 * fq; const bf16_t* b1p = b0p + 16 * 1024;
    f32x4 acc0[2] = {(f32x4){0.f, 0.f, 0.f, 0.f}, (f32x4){0.f, 0.f, 0.f, 0.f}}, acc1[2] = {(f32x4){0.f, 0.f, 0.f, 0.f}, (f32x4){0.f, 0.f, 0.f, 0.f}};
#pragma unroll 8
    for (int ks = 0; ks < 32; ++ks) {
        const bf16x8 a = *(const bf16x8*)(ap + ks * 32), w0 = *(const bf16x8*)(b0p + ks * 32), w1 = *(const bf16x8*)(b1p + ks * 32);
        acc0[ks & 1] = mfma16(a, w0, acc0[ks & 1]); acc1[ks & 1] = mfma16(a, w1, acc1[ks & 1]);
    }
    const f32x4 r0 = acc0[0] + acc0[1], r1 = acc1[0] + acc1[1];
    *(f32x4*)(sm + (size_t)fr * T + row0 + 4 * fq) = r0; *(f32x4*)(sm + (size_t)(16 + fr) * T + row0 + 4 * fq) = r1;
}
#define LAS __attribute__((address_space(3)))
#define XB_TMO      128
#define XB_XCNT(j)  (256  + 64 * (j))
#define XB_XSUB(j)  (1280 + 64 * (j))
#define XB_XGEN(j)  (2304 + 64 * (j))
#define XB_TOP      3328
#define XB_TOPGEN   3392
#define XCD_BAR_WORDS 3456
#define XB_SPIN_CAP (1u << 18)

__device__ __forceinline__ unsigned xb_ld(unsigned* p)              { return __hip_atomic_load(p, __ATOMIC_RELAXED, __HIP_MEMORY_SCOPE_AGENT); }
__device__ __forceinline__ unsigned xb_add(unsigned* p, unsigned v) { return __hip_atomic_fetch_add(p, v, __ATOMIC_RELAXED, __HIP_MEMORY_SCOPE_AGENT); }
__device__ __forceinline__ unsigned xb_xcc_id() { return (unsigned)__builtin_amdgcn_s_getreg((3 << 11) | 20) & 0xFu; }
#define XB_SPIN(cond, bar) do { unsigned _sp = 0; while (cond) { __builtin_amdgcn_s_sleep(1); \
    if ((++_sp & 255u) == 0u) { if (xb_ld(&(bar)[XB_TMO])) break; if (_sp > XB_SPIN_CAP) { atomicAdd(&(bar)[XB_TMO], 1u); break; } } } } while (0)

struct XcdBarrier {
    unsigned* bar; unsigned x;
    volatile LAS unsigned* st;
};

__device__ __forceinline__ XcdBarrier xcd_barrier_post(unsigned* bar, volatile LAS unsigned* st) {
    XcdBarrier b; b.bar = bar; b.x = xb_xcc_id(); b.st = st;
    if (threadIdx.x == 0) (void)xb_add(&bar[XB_XCNT(b.x)], 1u);
    return b;
}
__device__ __forceinline__ void xcd_barrier_complete(unsigned* bar, unsigned x, unsigned& nloc, unsigned& nx) {
    const unsigned G = gridDim.x * gridDim.y * gridDim.z;
    unsigned sum, cnt, mine, sp = 0u;
    for (;;) {
        sum = 0u; cnt = 0u; mine = 0u;
#pragma unroll
        for (unsigned j = 0; j < 16; ++j) { const unsigned c = xb_ld(&bar[XB_XCNT(j)]); sum += c; cnt += (c > 0u) ? 1u : 0u; mine = (j == x) ? c : mine; }
        if (sum == G) break;
        __builtin_amdgcn_s_sleep(1);
        if ((++sp & 255u) == 0u) { if (xb_ld(&bar[XB_TMO])) break; if (sp > XB_SPIN_CAP) { atomicAdd(&bar[XB_TMO], 1u); break; } }
    }
    nloc = mine > 0u ? mine : 1u; nx = cnt > 0u ? cnt : 1u;
}

__device__ __forceinline__ void xcd_barrier(const XcdBarrier& b) {
    asm volatile("s_waitcnt vmcnt(0)" ::: "memory");
    __syncthreads();
    if (threadIdx.x == 0) {
        unsigned* bar = b.bar;
        __builtin_amdgcn_s_waitcnt(0);
        unsigned nloc = b.st[0], nx = b.st[1];
        if (nloc == 0u) { xcd_barrier_complete(bar, b.x, nloc, nx); b.st[0] = nloc; b.st[1] = nx; }
        const unsigned old = xb_add(&bar[XB_XSUB(b.x)], 1u);
        const unsigned gen = old / nloc;
        if (old + 1u == (gen + 1u) * nloc) {
            __builtin_amdgcn_fence(__ATOMIC_RELEASE, "agent");
            asm volatile("s_waitcnt vmcnt(0)" ::: "memory");
            const unsigned og = xb_add(&bar[XB_TOP], 1u);
            const unsigned tg = og / nx;
            if (og + 1u == (tg + 1u) * nx) xb_add(&bar[XB_TOPGEN], 1u);
            else XB_SPIN(xb_ld(&bar[XB_TOPGEN]) == tg, bar);
            __builtin_amdgcn_fence(__ATOMIC_ACQUIRE, "agent");
            xb_add(&bar[XB_XGEN(b.x)], 1u);
            asm volatile("s_waitcnt vmcnt(0)" ::: "memory");
        } else {
            XB_SPIN(xb_ld(&bar[XB_XGEN(b.x)]) == gen, bar);
            __builtin_amdgcn_fence(__ATOMIC_ACQUIRE, "agent");
            asm volatile("s_waitcnt vmcnt(0)" ::: "memory");
        }
    }
    __syncthreads();
}

constexpr int PH_PER_LAYER = 11, N_PHASES = 1 + DEPTH * PH_PER_LAYER + 1;
template <int EN_MASK, bool EN_GEMM>
__device__ __forceinline__ void fwd_body(const Params& p) {
    extern __shared__ __attribute__((aligned(16))) unsigned char lds[];
    cg::grid_group grid = cg::this_grid();
    const int G = gridDim.x, NGW = G * 8;
    unsigned char* ws = p.ws;
    volatile LAS unsigned* MISC = (volatile LAS unsigned*)((LAS unsigned char*)lds + 132096);
    if (threadIdx.x < 2) MISC[threadIdx.x] = 0u;
    __syncthreads();
    XcdBarrier xbar = xcd_barrier_post((unsigned*)(ws + O_CTL), MISC);
    float* mod = (float*)(ws + O_MOD); float* X = (float*)(ws + O_X); bf16_t* H = (bf16_t*)(ws + O_H);
    for (int ph = p.ph_lo; ph < p.ph_hi; ++ph) {
        int tid = threadIdx.x; asm volatile("" : "+v"(tid));
        const int lane = tid & 63, wid = __builtin_amdgcn_readfirstlane(tid >> 6); const int gw = blockIdx.x * 8 + wid;
        if (ph == 0) { if constexpr (EN_MASK != 0) phase_pre(p, lds, tid); }
        else if (ph == N_PHASES - 1) { if constexpr (EN_MASK != 0) final_norm_rows(X, PIN(25), p.out, gw, NGW, lane); }
        else {
            const int l = (ph - 1) / PH_PER_LAYER, k = (ph - 1) % PH_PER_LAYER;
            const float* modl = mod + (size_t)l * 4 * 6144;
            const float* xin = (l == 0) ? PIN(0) : X;
            if (k == 1 || k == 6 || k == 7 || k == 9 || k == 10) { if constexpr (EN_GEMM) {
                const int nsub = (k == 6) ? 4 : 1;
#pragma unroll 1
                for (int br = 0; br < nsub; ++br) {
                    EpiU E{}; const bf16_t* A; const bf16_t* Bt; int lda, N, K;
                    if (k == 1) { E.kind = 0; E.p1 = ws; A = H; lda = 1024; Bt = (const bf16_t*)(ws + O_WIN); N = NPROJ - 256; K = 1024; }
                    else if (k == 6) {
                        const size_t aoffs = (br == 0) ? O_UV : (br == 1) ? O_FQKV : (br == 2) ? O_MQKV : O_Z;
                        const size_t woffs = (br == 0) ? O_WA : (br == 1) ? O_WB : (br == 2) ? O_WC : O_WD;
                        E.kind = 1; E.p0 = (const unsigned char*)(ws + O_GATE) + br * 1024; E.p1 = (float*)(ws + O_MF32); E.p2 = H; E.mode = (br == 0) ? 0 : (br == 3) ? 2 : 1;
                        A = (const bf16_t*)(ws + aoffs); lda = (br == 0) ? 1024 : (br == 3) ? 768 : 1536; Bt = (const bf16_t*)(ws + woffs); N = 1024; K = (br == 3) ? 768 : 512; }
                    else if (k == 7) { E.kind = 2; E.p0 = xin; E.p1 = X; E.p2 = (void*)(modl + 2048); A = H; lda = 1024; Bt = (const bf16_t*)(ws + O_WO); N = 1024; K = 1024; }
                    else if (k == 9) { E.kind = 3; E.p1 = (bf16_t*)(ws + O_HID); A = H; lda = 1024; Bt = (const bf16_t*)(ws + O_W1); N = 4096; K = 1024; }
                    else { E.kind = 2; E.p0 = X; E.p1 = X; E.p2 = (void*)(modl + 5120); A = (const bf16_t*)(ws + O_HID); lda = 4096; Bt = (const bf16_t*)(ws + O_W2); N = 1024; K = 4096; }
#ifdef PROBE_DUP_GEMM
                    E.dry = (p.ph_lo == 0); run_gemm(lds, A, lda, Bt, N, K, E); E.dry = 0;
#endif
#ifndef STAGGER_TICKS
#define STAGGER_TICKS 0
#endif
                    if (STAGGER_TICKS > 0 && (k == 1 || k == 9)) {
                        const unsigned long long t0 = __builtin_amdgcn_s_memrealtime(); const unsigned long long dl = (unsigned long long)(((blockIdx.x >> 3) & 3) * STAGGER_TICKS);
                        while (__builtin_amdgcn_s_memrealtime() - t0 < dl) __builtin_amdgcn_s_sleep(16);
                    }
                    run_gemm(lds, A, lda, Bt, N, K, E);
                }
                if (k == 1) for (int it = gw; it < 1024; it += NGW) small_cols_item((const bf16_t*)H, (const bf16_t*)(ws + O_WIN) + (size_t)10240 * 1024, (float*)(ws + O_SMALL), it, lane);
            } } else switch (k) {
            case 0: if constexpr ((EN_MASK >> 0) & 1) {
#ifdef PROBE_A
                convert_weights(p, l, lds, gw, NGW, wid, lane); norm_mod_rows(xin, PIN(4) + l * 1024, modl + 0, modl + 1024, H, gw, NGW, lane);
#endif
                convert_weights(p, l, lds, gw, NGW, wid, lane);
                norm_mod_rows(xin, PIN(4) + l * 1024, modl + 0, modl + 1024, H, gw, NGW, lane);
            } break;
            case 2: if constexpr ((EN_MASK >> 2) & 1) {
#ifdef PROBE_C
                { const bool dry = (p.ph_lo == 0);
                for (int it = blockIdx.x; it < 1024; it += G) gmlp_item(p, l, lds, it, wid, lane, dry);
                for (int it = blockIdx.x; it < 512; it += G) rotary_item(p, lds, it, tid, dry);
                for (int it = blockIdx.x; it < 1280; it += G) conv_item(p, l, it, tid);
                for (int it = gw; it < 1536; it += NGW) acum_item(p, l, it, lane);
                for (int it = NGW - 1 - gw; it < 32; it += NGW) foxcum_item(p, l, it, lane); }
#endif
                for (int it = blockIdx.x; it < 256; it += G) gmlp_item(p, l, lds, it, wid, lane);
                for (int it = blockIdx.x; it < 512; it += G) rotary_item(p, lds, it, tid);
                for (int it = blockIdx.x; it < 1280; it += G) conv_item(p, l, it, tid);
                for (int it = gw; it < 1536; it += NGW) acum_item(p, l, it, lane);
                for (int it = NGW - 1 - gw; it < 32; it += NGW) foxcum_item(p, l, it, lane);
            } break;
            case 3: if constexpr ((EN_MASK >> 3) & 1) {
#ifndef EN3
#define EN3 7
#endif
                { unsigned* qctr = (unsigned*)(ws + O_CTL) + 3584 + 64 * l;
                  volatile unsigned* slot = (volatile unsigned*)(lds + 131584);
                  for (;;) {
                      if (tid == 0) *slot = atomicAdd(qctr, 1u);
                      __syncthreads();
                      const unsigned it = (unsigned)__builtin_amdgcn_readfirstlane((int)*slot);
                      __syncthreads();
                      if (it >= 1024u) break;
                      const int qb = 15 - (int)(it >> 6), sub = (int)(it & 63u), bh = sub & 31;
                      if (sub < 32) attn_block_item<false>(p, lds, bh >> 3, bh & 7, qb, tid, wid, lane);
                      else attn_block_item<true>(p, lds, bh >> 3, bh & 7, qb, tid, wid, lane);
                  } }
                if constexpr (EN3 & 4) for (int i = NGW - 1 - gw; i < 1536; i += NGW) ssd_states_item(p, i, lane);
            } break;
            case 4: if constexpr ((EN_MASK >> 4) & 1) {
#ifdef PROBE_EF
                ssd_scan(p, blockIdx.x * 512 + tid, G * 512);
#endif
                ssd_scan(p, blockIdx.x * 512 + tid, G * 512); } break;
            case 5: if constexpr ((EN_MASK >> 5) & 1) {
#ifdef PROBE_EF
                for (int it = blockIdx.x; it < 256; it += G) ssd_out_item(p, l, it, wid, lane, p.ph_lo == 0);
#endif
                for (int it = blockIdx.x; it < 256; it += G) ssd_out_item(p, l, it, wid, lane); } break;
            case 8: if constexpr ((EN_MASK >> 8) & 1) { norm_mod_rows(X, PIN(22) + l * 1024, modl + 3072, modl + 4096, H, gw, NGW, lane); } break;
            }
        }
        if (ph + 1 < p.ph_hi) { if (ph == 0) grid.sync(); else xcd_barrier(xbar); }
#ifdef PROBE_SYNC
        if (ph + 1 < p.ph_hi) { xcd_barrier(xbar); xcd_barrier(xbar); }
#endif
    }
}

#ifndef N_LAUNCH_MODE
#define N_LAUNCH_MODE 1
#endif
#if N_LAUNCH_MODE == 1
__global__ void __launch_bounds__(512, 2) fwd_all(Params p) { fwd_body<0x7ff, true>(p); }
#define KERNEL_FOR_ATTR fwd_all
#else
__global__ void __launch_bounds__(512, 2) fwd_gemm(Params p) { fwd_body<0, true>(p); }
__global__ void __launch_bounds__(512, 2) fwd_misc(Params p) { fwd_body<0x7ff, false>(p); }
#endif
extern "C" void kernel_launch(void* const* d_in, const int* in_sizes, int n_in, void* d_out, int out_size, void* d_ws, size_t ws_size, hipStream_t stream) {
    static int grid = 0;
    if (grid == 0) {
        if (n_in != 26 || out_size != T * DM || ws_size < WS_END) { fprintf(stderr, "kernel_launch: unexpected shapes (n_in %d out %d ws %zu need %zu)\n", n_in, out_size, ws_size, (size_t)WS_END); grid = -1; return; }
        int dev = 0, cus = 0;
        (void)hipGetDevice(&dev); (void)hipDeviceGetAttribute(&cus, hipDeviceAttributeMultiprocessorCount, dev);
#if N_LAUNCH_MODE == 1
        if (hipFuncSetAttribute((const void*)fwd_all, hipFuncAttributeMaxDynamicSharedMemorySize, LDS_BYTES) != hipSuccess) { fprintf(stderr, "kernel_launch: hipFuncSetAttribute failed\n"); grid = -1; return; }
#else
        if (hipFuncSetAttribute((const void*)fwd_gemm, hipFuncAttributeMaxDynamicSharedMemorySize, LDS_BYTES) != hipSuccess || hipFuncSetAttribute((const void*)fwd_misc, hipFuncAttributeMaxDynamicSharedMemorySize, LDS_BYTES) != hipSuccess) { fprintf(stderr, "kernel_launch: hipFuncSetAttribute failed\n"); grid = -1; return; }
#endif
        (void)hipGetLastError();
        grid = cus > 0 ? cus : 256;
    }
    if (grid < 0) return;
    if (hipMemsetAsync((char*)d_ws + O_CTL, 0, 16384, stream) != hipSuccess) { fprintf(stderr, "kernel_launch: memset failed\n"); return; }
    Params p{};
    for (int i = 0; i < 26; ++i) p.in[i] = (const float*)d_in[i];
    p.out = (float*)d_out; p.ws = (unsigned char*)d_ws;
#if N_LAUNCH_MODE == 1
    p.ph_lo = 0; p.ph_hi = N_PHASES;
    void* args[] = {&p};
    hipError_t e = hipLaunchCooperativeKernel((const void*)fwd_all, dim3(grid), dim3(512), args, LDS_BYTES, stream);
    if (e != hipSuccess) fprintf(stderr, "kernel_launch: cooperative launch failed: %s (grid %d)\n", hipGetErrorString(e), grid);
#else
    for (int ph = 0; ph < N_PHASES; ++ph) { p.ph_lo = ph; p.ph_hi = ph + 1;
        const int k = (ph >= 1 && ph < N_PHASES - 1) ? (ph - 1) % PH_PER_LAYER : -1;
        if (k == 1 || k == 6 || k == 7 || k == 9 || k == 10) hipLaunchKernelGGL(fwd_gemm, dim3(grid), dim3(512), LDS_BYTES, stream, p);
        else hipLaunchKernelGGL(fwd_misc, dim3(grid), dim3(512), LDS_BYTES, stream, p); }
#endif
}
```

```cpp
#include <hip/hip_runtime.h>
#include <hip/hip_cooperative_groups.h>
#include <cstdio>
#include <cstdint>
#include <cmath>
namespace cg = cooperative_groups;
namespace pg8 {
#define PG8_LAS __attribute__((address_space(3)))
typedef unsigned short bf16_t;
typedef short bf16x8 __attribute__((ext_vector_type(8)));
typedef float f32x4 __attribute__((ext_vector_type(4)));
typedef unsigned u32x4 __attribute__((ext_vector_type(4)));
constexpr int BM = 256, BK = 64, HALF = 128, HTB = HALF * BK * 2  , STAGE_BYTES = 8 * HTB, NXCD = 8, WGM = 8;

__host__ __device__ __forceinline__ int lds_byte(int r, int c) { const int st = (r >> 4) * 2 + (c >> 5), rr = r & 15, cc = c & 31, ob = rr * 64 + cc * 2; return st * 1024 + (ob ^ (((ob >> 9) & 1) << 5)); }
__host__ __device__ __forceinline__ void stage_rc(int b, int& R, int& C) { const int st = b / 1024, sb = b % 1024, swz = sb ^ (((sb >> 9) & 1) << 5); R = (st >> 1) * 16 + swz / 64; C = (st & 1) * 32 + (swz % 64) / 2; }
__host__ __device__ __forceinline__ int perm32(int rho) { const int n = rho >> 4, i = rho & 15; return 8 * (i >> 2) + 4 * n + (i & 3); }

struct Unit { int pm, pn; };
struct Gemm { const bf16_t* A; const bf16_t* Bt; int M, N, K, lda; };

struct StaticOrder {
    int nM, nN, nwg, G, c;
    __host__ __device__ void init(int M, int N, int G_, int c_) { nM = M / BM; nN = N / BM; nwg = nM * nN; G = G_; c = c_; }
    __host__ __device__ bool next(int i, Unit& u) const {
        const long L = (long)i * G + c; if (L >= nwg) return false;
        int wgid = (int)L; { const int q = nwg / NXCD, r = nwg % NXCD, xcd = wgid % NXCD, off = wgid / NXCD; wgid = (xcd < r ? xcd * (q + 1) : r * (q + 1) + (xcd - r) * q) + off; }
        const int nig = WGM * nN, gid = wgid / nig, fm = gid * WGM, gsz = (nM - fm) < WGM ? (nM - fm) : WGM;
        u.pm = fm + ((wgid % nig) % gsz); u.pn = (wgid % nig) / gsz; return true;
    }
    __device__ __forceinline__ void a_ready(const Unit&) const {}
    __device__ __forceinline__ void done(const Unit&) const {}
};


template <class Epi, class Sched, bool ALIGN_EPI = false, bool SP2 = false>
__device__ __forceinline__ void gemm_phase(PG8_LAS unsigned char* lds, const Gemm g, const Sched& S, const Epi& E) {
    int tid_l = threadIdx.x; asm volatile("" : "+v"(tid_l));
    const int tid = tid_l, wid = __builtin_amdgcn_readfirstlane(tid >> 6), lane = tid & 63, wr = wid >> 2, wc = wid & 3, fr = lane & 15, fq = lane >> 4;
    const int K = g.K, nt = K / BK;
    unsigned voffA[2], voffB[2];
#pragma unroll
    for (int i = 0; i < 2; ++i) { int R, C; stage_rc(tid * 16 + i * 8192, R, C); const int Rb = Epi::PERM ? ((R & ~31) + perm32(R & 31)) : R;
        voffA[i] = (unsigned)(R * g.lda + C) * 2u; voffB[i] = (unsigned)(Rb * K + C) * 2u; }
    const size_t kstep = (size_t)(BK * 2);
    const size_t hstepB = (size_t)HALF * K * 2, hstepA = (size_t)HALF * g.lda * 2;
    const size_t tstepB = 2 * hstepB, tstepA = 2 * hstepA;
    const unsigned ldsw = (unsigned)wid * 1024u;
    const int aoff = lds_byte(wr * 64 + fr, fq * 8), boff = lds_byte(wc * 32 + fr, fq * 8);
#define PG8_SA(b, h) (((b) * 2 + (h)) * HTB)
#define PG8_SB(b, h) ((4 + (b) * 2 + (h)) * HTB)
#define PG8_STAGE(bufoff, gbase, voff) do { _Pragma("unroll") for (int _i = 0; _i < 2; ++_i) \
        __builtin_amdgcn_global_load_lds((const unsigned*)((const char*)(gbase) + (voff)[_i]), (PG8_LAS unsigned*)(lds + (bufoff) + ldsw + _i * 8192), 16, 0, 0); } while (0)
#define PG8_LDA(dst, b, h) do { _Pragma("unroll") for (int m = 0; m < 4; ++m) _Pragma("unroll") for (int k = 0; k < 2; ++k) dst[m][k] = *(const PG8_LAS bf16x8*)(lds + PG8_SA(b, h) + aoff + m * 2048 + k * 1024); } while (0)
#define PG8_LDB(dst, b, h) do { _Pragma("unroll") for (int n = 0; n < 2; ++n) _Pragma("unroll") for (int k = 0; k < 2; ++k) dst[n][k] = *(const PG8_LAS bf16x8*)(lds + PG8_SB(b, h) + boff + n * 2048 + k * 1024); } while (0)
#define PG8_MMA(ai, bj, At, Bt) do { __builtin_amdgcn_s_setprio(1); _Pragma("unroll") for (int m = 0; m < 4; ++m) _Pragma("unroll") for (int n = 0; n < 2; ++n) _Pragma("unroll") for (int k = 0; k < 2; ++k) \
        acc[ai][bj][m][n] = __builtin_amdgcn_mfma_f32_16x16x32_bf16(Bt[n][k], At[m][k], acc[ai][bj][m][n], 0, 0, 0); __builtin_amdgcn_s_setprio(0); } while (0)
#define PG8_WAIT_V(n) asm volatile("s_waitcnt vmcnt(" #n ")" ::: "memory")
#define PG8_WAIT_L(n) asm volatile("s_waitcnt lgkmcnt(" #n ")" ::: "memory")
#define PG8_BAR __builtin_amdgcn_s_barrier()
#define PG8_SCHED __builtin_amdgcn_sched_barrier(0)
    Unit cur, nxt; int ui = 0;
    if (!S.next(0, cur)) return;
    f32x4 acc[2][2][4][2];
#pragma unroll
    for (int a = 0; a < 2; ++a)
#pragma unroll
        for (int b = 0; b < 2; ++b)
#pragma unroll
            for (int m = 0; m < 4; ++m)
#pragma unroll
                for (int n = 0; n < 2; ++n) acc[a][b][m][n] = (f32x4){0.f, 0.f, 0.f, 0.f};
    bf16x8 At[4][2], B0[2][2], B1[2][2];
    const char* cA = (const char*)g.A + (size_t)cur.pm * tstepA; const char* cB = (const char*)g.Bt + (size_t)cur.pn * tstepB;
    S.a_ready(cur);
    if constexpr (SP2) {
        PG8_STAGE(PG8_SB(0, 0), cB, voffB); PG8_STAGE(PG8_SB(0, 1), cB + hstepB, voffB); PG8_STAGE(PG8_SA(0, 0), cA, voffA); PG8_STAGE(PG8_SA(0, 1), cA + hstepA, voffA);
        if (wr == 1) PG8_BAR;
        PG8_WAIT_V(2); PG8_BAR;
        PG8_STAGE(PG8_SB(1, 0), cB + kstep, voffB); PG8_STAGE(PG8_SA(1, 0), cA + kstep, voffA); PG8_STAGE(PG8_SB(1, 1), cB + hstepB + kstep, voffB);
        PG8_WAIT_V(6); PG8_BAR;
    } else {
        PG8_STAGE(PG8_SB(0, 0), cB, voffB); PG8_STAGE(PG8_SA(0, 0), cA, voffA); PG8_STAGE(PG8_SB(0, 1), cB + hstepB, voffB); PG8_STAGE(PG8_SA(0, 1), cA + hstepA, voffA);
        if (wr == 1) PG8_BAR;
        PG8_WAIT_V(4); PG8_BAR;
        PG8_STAGE(PG8_SB(1, 0), cB + kstep, voffB); PG8_STAGE(PG8_SA(1, 0), cA + kstep, voffA); PG8_STAGE(PG8_SB(1, 1), cB + hstepB + kstep, voffB);
        PG8_WAIT_V(6); PG8_BAR;
    }
    for (;;) {
        const bool has_next = S.next(ui + 1, nxt);
        const char* nA = has_next ? (const char*)g.A + (size_t)nxt.pm * tstepA : cA; const char* nB = has_next ? (const char*)g.Bt + (size_t)nxt.pn * tstepB : cB;
        for (int t = 0; t < nt; t += 2) {
            const bool last = (t == nt - 2);
            const char* a1 = cA + (size_t)(t + 1) * kstep;
            const char* a2 = last ? nA : cA + (size_t)(t + 2) * kstep; const char* b2 = last ? nB : cB + (size_t)(t + 2) * kstep;
            const char* a3 = a2 + kstep; const char* b3 = b2 + kstep;
            if (last && has_next) S.a_ready(nxt);
            if constexpr (SP2) {
            PG8_LDB(B0, 0, 0); PG8_LDB(B1, 0, 1); PG8_SCHED; PG8_LDA(At, 0, 0); PG8_STAGE(PG8_SA(1, 1), a1 + hstepA, voffA);
            PG8_WAIT_V(8); PG8_WAIT_L(0); PG8_BAR; PG8_MMA(0, 0, At, B0); PG8_MMA(0, 1, At, B1); PG8_BAR; PG8_SCHED;
            PG8_LDA(At, 0, 1); PG8_STAGE(PG8_SB(0, 0), b2, voffB); PG8_STAGE(PG8_SB(0, 1), b2 + hstepB, voffB); PG8_STAGE(PG8_SA(0, 0), a2, voffA);
            PG8_WAIT_V(8); PG8_WAIT_L(0); PG8_BAR; PG8_MMA(1, 0, At, B0); PG8_MMA(1, 1, At, B1); PG8_BAR; PG8_SCHED;
            PG8_LDB(B0, 1, 0); PG8_LDB(B1, 1, 1); PG8_SCHED; PG8_LDA(At, 1, 0); PG8_STAGE(PG8_SA(0, 1), a2 + hstepA, voffA);
            PG8_WAIT_V(8); PG8_WAIT_L(0); PG8_BAR; PG8_MMA(0, 0, At, B0); PG8_MMA(0, 1, At, B1); PG8_BAR; PG8_SCHED;
            PG8_LDA(At, 1, 1); PG8_STAGE(PG8_SB(1, 0), b3, voffB); PG8_STAGE(PG8_SB(1, 1), b3 + hstepB, voffB); PG8_STAGE(PG8_SA(1, 0), a3, voffA);
            PG8_WAIT_V(8); PG8_WAIT_L(0); PG8_BAR; PG8_MMA(1, 0, At, B0); PG8_MMA(1, 1, At, B1); PG8_BAR; PG8_SCHED;
            } else {
            PG8_LDB(B0, 0, 0); PG8_SCHED; PG8_LDA(At, 0, 0); PG8_STAGE(PG8_SA(1, 1), a1 + hstepA, voffA);
            PG8_WAIT_L(8); PG8_BAR; PG8_WAIT_L(0); PG8_MMA(0, 0, At, B0); PG8_BAR; PG8_SCHED;
            PG8_LDB(B1, 0, 1); PG8_STAGE(PG8_SB(0, 0), b2, voffB);
            PG8_BAR; PG8_WAIT_L(0); PG8_MMA(0, 1, At, B1); PG8_BAR;
            PG8_LDA(At, 0, 1); PG8_STAGE(PG8_SA(0, 0), a2, voffA);
            PG8_BAR; PG8_WAIT_L(0); PG8_MMA(1, 0, At, B0); PG8_BAR; PG8_SCHED;
            PG8_STAGE(PG8_SB(0, 1), b2 + hstepB, voffB);
            PG8_WAIT_V(6); PG8_BAR; PG8_MMA(1, 1, At, B1); PG8_BAR;
            PG8_LDB(B0, 1, 0); PG8_SCHED; PG8_LDA(At, 1, 0); PG8_STAGE(PG8_SA(0, 1), a2 + hstepA, voffA);
            PG8_WAIT_L(8); PG8_BAR; PG8_WAIT_L(0); PG8_MMA(0, 0, At, B0); PG8_BAR; PG8_SCHED;
            PG8_LDB(B1, 1, 1); PG8_STAGE(PG8_SB(1, 0), b3, voffB);
            PG8_BAR; PG8_WAIT_L(0); PG8_MMA(0, 1, At, B1); PG8_BAR;
            PG8_LDA(At, 1, 1); PG8_STAGE(PG8_SA(1, 0), a3, voffA);
            PG8_BAR; PG8_WAIT_L(0); PG8_MMA(1, 0, At, B0); PG8_BAR; PG8_SCHED;
            PG8_STAGE(PG8_SB(1, 1), b3 + hstepB, voffB);
            PG8_WAIT_V(6); PG8_BAR; PG8_MMA(1, 1, At, B1); PG8_BAR;
            }
        }
        if constexpr (ALIGN_EPI) { if (wr == 0) PG8_BAR; }
        if constexpr (!Epi::AFTER_DRAIN) { E(acc, cur, wr, wc, fr, fq); S.done(cur); }
        if (!has_next) break;
#pragma unroll
        for (int a = 0; a < 2; ++a)
#pragma unroll
            for (int b = 0; b < 2; ++b)
#pragma unroll
                for (int m = 0; m < 4; ++m)
#pragma unroll
                    for (int n = 0; n < 2; ++n) acc[a][b][m][n] = (f32x4){0.f, 0.f, 0.f, 0.f};
        cur = nxt; cA = nA; cB = nB; ++ui;
        if constexpr (ALIGN_EPI) { if (wr == 1) PG8_BAR; }
    }
    PG8_WAIT_V(0);
    if constexpr (!ALIGN_EPI) { if (wr == 0) PG8_BAR; }
    PG8_BAR;
    if constexpr (Epi::AFTER_DRAIN) { E.fused(acc, cur, wr, wc, fr, fq, lds, wid, lane); S.done(cur); }
#undef PG8_SA
#undef PG8_SB
#undef PG8_STAGE
#undef PG8_LDA
#undef PG8_LDB
#undef PG8_MMA
#undef PG8_WAIT_V
#undef PG8_WAIT_L
#undef PG8_BAR
#undef PG8_SCHED
}
}

constexpr int NB = 4, SEQ = 4096, T = NB * SEQ, DM = 1024, DEPTH = 4;
constexpr int NPROJ = 10496;
constexpr int IN_COLS = 10260;
constexpr float NORM_EPS = 1e-6f;
constexpr float LOG2E = 1.4426950408889634f;

typedef unsigned short bf16_t;
typedef short bf16x8 __attribute__((ext_vector_type(8)));
typedef float f32x4 __attribute__((ext_vector_type(4)));
typedef float f32x2 __attribute__((ext_vector_type(2)));
typedef unsigned u32x4 __attribute__((ext_vector_type(4)));
typedef unsigned u32x2 __attribute__((ext_vector_type(2)));
typedef __bf16 bf16x2_t __attribute__((ext_vector_type(2)));

constexpr size_t MiB = 1u << 20;
constexpr size_t O_MOD = 0, O_X = 1 * MiB, O_H = 65 * MiB, O_UV = 97 * MiB, O_FQKV = 129 * MiB, O_MQKV = 177 * MiB, O_Z = 225 * MiB,
                 O_XBC = 249 * MiB, O_GATE = 289 * MiB, O_SMALL = 417 * MiB, O_VTF = 419 * MiB, O_VTM = 435 * MiB, O_XT = 451 * MiB,
                 O_BC = 475 * MiB, O_BT = 491 * MiB, O_ST = 499 * MiB, O_CUMF = 547 * MiB, O_ACUM = 548 * MiB, O_KMEAN = 549 * MiB,
                 O_WIN = 550 * MiB, O_WA = 571 * MiB, O_WB = 572 * MiB, O_WC = 573 * MiB, O_WD = 574 * MiB, O_WO = 576 * MiB,
                 O_W1 = 578 * MiB, O_W2 = 586 * MiB, O_GWS = 594 * MiB, WS_END = 595 * MiB;
constexpr size_t O_ROT = O_GWS + 512 * 1024;
constexpr size_t O_DT = O_KMEAN + 256 * 1024;
constexpr size_t O_CTL = 512 * 1024;
constexpr size_t O_PREV = O_XBC;
constexpr size_t O_HID = O_GATE;
constexpr size_t O_MF32 = O_VTF;
constexpr int LDS_BYTES = 147456;

struct Params { const float* in[26]; float* out; unsigned char* ws; int ph_lo, ph_hi; };

__device__ __forceinline__ int opq(int i) { asm volatile("" : "+s"(i)); return i; }
#define PIN(i) (p.in[opq(i)])
__device__ __forceinline__ unsigned cvtpk(float lo, float hi) { f32x2 v = {lo, hi}; bf16x2_t b = __builtin_convertvector(v, bf16x2_t); return __builtin_bit_cast(unsigned, b); }
__device__ __forceinline__ float bf2f(short h) { return __uint_as_float(((unsigned)(unsigned short)h) << 16); }
__device__ __forceinline__ float bflo(unsigned w) { return __uint_as_float(w << 16); }
__device__ __forceinline__ float bfhi(unsigned w) { return __uint_as_float(w & 0xffff0000u); }
__device__ __forceinline__ bf16x8 pack8(float a0, float a1, float a2, float a3, float a4, float a5, float a6, float a7) {
    u32x4 w = {cvtpk(a0, a1), cvtpk(a2, a3), cvtpk(a4, a5), cvtpk(a6, a7)}; return __builtin_bit_cast(bf16x8, w); }
__device__ __forceinline__ bf16x8 ld2x8(const bf16_t* p0, const bf16_t* p1) { const u32x2 a = *(const u32x2*)p0, b = *(const u32x2*)p1; u32x4 w = {a.x, a.y, b.x, b.y}; return __builtin_bit_cast(bf16x8, w); }
typedef short s16x4_t __attribute__((ext_vector_type(4)));
__device__ __forceinline__ s16x4_t lds_tr(const bf16_t* p) { return __builtin_bit_cast(s16x4_t, __builtin_amdgcn_ds_read_tr16_b64_v4i16((__attribute__((address_space(3))) s16x4_t*)p)); }
__device__ __forceinline__ bf16x8 cat4(s16x4_t a, s16x4_t b) { return (bf16x8){a[0], a[1], a[2], a[3], b[0], b[1], b[2], b[3]}; }
__device__ __forceinline__ f32x4 mfma16(bf16x8 a, bf16x8 b, f32x4 c) { return __builtin_amdgcn_mfma_f32_16x16x32_bf16(a, b, c, 0, 0, 0); }
__device__ __forceinline__ float dpp_add(float v, const int ctrl_sel) {
    const int iv = __builtin_bit_cast(int, v); int m;
    if (ctrl_sel == 0) m = __builtin_amdgcn_update_dpp(0, iv, 0xB1, 0xF, 0xF, true);
    else if (ctrl_sel == 1) m = __builtin_amdgcn_update_dpp(0, iv, 0x4E, 0xF, 0xF, true);
    else if (ctrl_sel == 2) m = __builtin_amdgcn_update_dpp(0, iv, 0x141, 0xF, 0xF, true);
    else m = __builtin_amdgcn_update_dpp(0, iv, 0x140, 0xF, 0xF, true);
    return v + __builtin_bit_cast(float, m); }
__device__ __forceinline__ float row16_sum(float v) { v = dpp_add(v, 0); v = dpp_add(v, 1); v = dpp_add(v, 2); v = dpp_add(v, 3); return v; }
__device__ __forceinline__ float wave_sum(float v) { v = row16_sum(v); v += __shfl_xor(v, 16); v += __shfl_xor(v, 32); return v; }
__device__ __forceinline__ float ex2(float x) { return __builtin_amdgcn_exp2f(x); }
__device__ __forceinline__ float sigmoidf_(float x) { return 1.f / (1.f + __expf(-x)); }
__device__ __forceinline__ float softplusf_(float x) { return fmaxf(x, 0.f) + log1pf(expf(-fabsf(x))); }
#define LDS_WAIT() asm volatile("s_waitcnt lgkmcnt(0)" ::: "memory")
#define VM_WAIT() asm volatile("s_waitcnt vmcnt(0)" ::: "memory")

#define EPI_LANE_SETUP() int t_ = threadIdx.x; asm volatile("" : "+v"(t_)); const int fr = t_ & 15, fq = (t_ >> 4) & 3; const int wv_ = __builtin_amdgcn_readfirstlane(t_ >> 6); const int wr = wv_ >> 2, wc = wv_ & 3
__device__ __forceinline__ unsigned pk4u8(float a, float b, float c, float d) {
    const unsigned ua = (unsigned)(a * 255.f + 0.5f), ub = (unsigned)(b * 255.f + 0.5f), uc = (unsigned)(c * 255.f + 0.5f), ud = (unsigned)(d * 255.f + 0.5f);
    return ua | (ub << 8) | (uc << 16) | (ud << 24); }
__device__ __forceinline__ float u8f(unsigned w, int i) { return (float)((w >> (8 * i)) & 255u); }
__device__ __forceinline__ float act_unified(float x, int act) {
    const float uu = 1.5957691216057308f * (x + 0.044715f * x * x * x);
    const float arg = (act == 1) ? uu : (act == 0) ? INFINITY : x;
    const float num = (act == 3) ? 1.f : x;
    return num * __builtin_amdgcn_rcpf(1.f + ex2(-LOG2E * arg));
}
struct EpiInproj {
    static constexpr bool PERM = true, AFTER_DRAIN = false;
    unsigned char* ws;
    __device__ __forceinline__ void operator()(const f32x4 (&acc)[2][2][4][2], const pg8::Unit& u, int, int, int, int) const {
        EPI_LANE_SETUP();
        const int pn = u.pn; const int row0 = u.pm * 256 + wr * 64 + fr;
        if (pn == 40) {
            if (wc == 0) {
                float* sm = (float*)(ws + O_SMALL);
#pragma unroll
                for (int ai = 0; ai < 2; ++ai)
#pragma unroll
                    for (int m = 0; m < 4; ++m) { float* rp = sm + (size_t)(row0 + ai * 128 + m * 16) * 32 + 8 * fq;
                        *(f32x4*)rp = acc[ai][0][m][0]; *(f32x4*)(rp + 4) = acc[ai][0][m][1]; }
            }
            return;
        }
        bf16_t* base; int pitch, ct, act;
        if (pn < 4) { base = (bf16_t*)(ws + O_UV); pitch = 1024; ct = pn; act = 1; }
        else if (pn < 10) { base = (bf16_t*)(ws + O_FQKV); pitch = 1536; ct = pn - 4; act = 0; }
        else if (pn < 16) { base = (bf16_t*)(ws + O_MQKV); pitch = 1536; ct = pn - 10; act = 0; }
        else if (pn < 19) { base = (bf16_t*)(ws + O_Z); pitch = 768; ct = pn - 16; act = 2; }
        else if (pn < 24) { base = (bf16_t*)(ws + O_XBC); pitch = 1280; ct = pn - 19; act = 0; }
        else { base = (bf16_t*)(ws + O_GATE); pitch = 4096; ct = pn - 24; act = 3; }
        const int col0 = ct * 256 + wc * 32 + 8 * fq;
#pragma unroll
        for (int ai = 0; ai < 2; ++ai)
#pragma unroll
            for (int m = 0; m < 4; ++m) { bf16_t* rowp = base + (size_t)(row0 + ai * 128 + m * 16) * pitch + col0;
#pragma unroll
                for (int bj = 0; bj < 2; ++bj) { f32x4 v0 = acc[ai][bj][m][0], v1 = acc[ai][bj][m][1];
#pragma unroll
                    for (int j = 0; j < 4; ++j) if (act != 0) { v0[j] = act_unified(v0[j], act); v1[j] = act_unified(v1[j], act); }
                    if (act == 3) {
                        unsigned char* gp = (unsigned char*)(ws + O_GATE) + (size_t)(row0 + ai * 128 + m * 16) * 4096 + col0 + bj * 128;
                        u32x2 q; q.x = pk4u8(v0[0], v0[1], v0[2], v0[3]); q.y = pk4u8(v1[0], v1[1], v1[2], v1[3]);
                        __builtin_nontemporal_store(q, (u32x2*)gp);
                    } else {
                        u32x4 w; w.x = cvtpk(v0[0], v0[1]); w.y = cvtpk(v0[2], v0[3]); w.z = cvtpk(v1[0], v1[1]); w.w = cvtpk(v1[2], v1[3]);
                        __builtin_nontemporal_store(w, (u32x4*)(rowp + bj * 128)); } }
                asm volatile("" ::: "memory"); }
    }
};
struct EpiMerge {
    static constexpr bool PERM = true, AFTER_DRAIN = false;
    const unsigned char* gate; float* mf; bf16_t* outb; int mode;
    __device__ __forceinline__ void operator()(const f32x4 (&acc)[2][2][4][2], const pg8::Unit& u, int, int, int, int) const {
        EPI_LANE_SETUP();
        const int row0 = u.pm * 256 + wr * 64 + fr, col0 = u.pn * 256 + wc * 32 + 8 * fq;
#pragma unroll
        for (int ai = 0; ai < 2; ++ai) {
#pragma unroll
            for (int m = 0; m < 4; ++m) { const size_t row = (size_t)(row0 + ai * 128 + m * 16);
#pragma unroll
                for (int bj = 0; bj < 2; ++bj) { const int col = col0 + bj * 128;
                    const u32x2 gw = *(const u32x2*)(gate + row * 4096 + col);
                    f32x4 v0 = acc[ai][bj][m][0] * (1.f / 255.f), v1 = acc[ai][bj][m][1] * (1.f / 255.f);
                    v0[0] *= u8f(gw.x, 0); v0[1] *= u8f(gw.x, 1); v0[2] *= u8f(gw.x, 2); v0[3] *= u8f(gw.x, 3); v1[0] *= u8f(gw.y, 0); v1[1] *= u8f(gw.y, 1); v1[2] *= u8f(gw.y, 2); v1[3] *= u8f(gw.y, 3);
                    bf16_t* op = outb + row * 1024 + col;
                    if (mode != 0) { const u32x4 pw = *(const u32x4*)op;
                        v0[0] += bflo(pw.x); v0[1] += bfhi(pw.x); v0[2] += bflo(pw.y); v0[3] += bfhi(pw.y); v1[0] += bflo(pw.z); v1[1] += bfhi(pw.z); v1[2] += bflo(pw.w); v1[3] += bfhi(pw.w); }
                    u32x4 w; w.x = cvtpk(v0[0], v0[1]); w.y = cvtpk(v0[2], v0[3]); w.z = cvtpk(v1[0], v1[1]); w.w = cvtpk(v1[2], v1[3]);
                    *(u32x4*)op = w; } }
            asm volatile("" ::: "memory"); }
    }
};
struct EpiResid {
    static constexpr bool PERM = true, AFTER_DRAIN = false;
    const float* xin; float* xout; const float* gmod;
    __device__ __forceinline__ void operator()(const f32x4 (&acc)[2][2][4][2], const pg8::Unit& u, int, int, int, int) const {
        EPI_LANE_SETUP();
        const int row0 = u.pm * 256 + wr * 64 + fr, col0 = u.pn * 256 + wc * 32 + 8 * fq; const int b = u.pm >> 4;
        const float* gp = gmod + (size_t)b * 6144 + col0;
        const f32x4 g00 = *(const f32x4*)gp, g01 = *(const f32x4*)(gp + 4), g10 = *(const f32x4*)(gp + 128), g11 = *(const f32x4*)(gp + 132);
#pragma unroll
        for (int ai = 0; ai < 2; ++ai) {
#pragma unroll
            for (int m = 0; m < 4; ++m) { const size_t off = (size_t)(row0 + ai * 128 + m * 16) * 1024 + col0;
                *(f32x4*)(xout + off) = *(const f32x4*)(xin + off) + g00 * acc[ai][0][m][0];
                *(f32x4*)(xout + off + 4) = *(const f32x4*)(xin + off + 4) + g01 * acc[ai][0][m][1];
                *(f32x4*)(xout + off + 128) = *(const f32x4*)(xin + off + 128) + g10 * acc[ai][1][m][0];
                *(f32x4*)(xout + off + 132) = *(const f32x4*)(xin + off + 132) + g11 * acc[ai][1][m][1]; }
            asm volatile("" ::: "memory"); }
    }
};
struct EpiRelu2 {
    static constexpr bool PERM = true, AFTER_DRAIN = false;
    bf16_t* out;
    __device__ __forceinline__ void operator()(const f32x4 (&acc)[2][2][4][2], const pg8::Unit& u, int, int, int, int) const {
        EPI_LANE_SETUP();
        const int row0 = u.pm * 256 + wr * 64 + fr, col0 = u.pn * 256 + wc * 32 + 8 * fq;
#pragma unroll
        for (int ai = 0; ai < 2; ++ai)
#pragma unroll
            for (int m = 0; m < 4; ++m) { bf16_t* rowp = out + (size_t)(row0 + ai * 128 + m * 16) * 4096 + col0;
#pragma unroll
                for (int bj = 0; bj < 2; ++bj) { f32x4 v0 = acc[ai][bj][m][0], v1 = acc[ai][bj][m][1];
#pragma unroll
                    for (int j = 0; j < 4; ++j) { const float r0 = fmaxf(v0[j], 0.f), r1 = fmaxf(v1[j], 0.f); v0[j] = r0 * r0; v1[j] = r1 * r1; }
                    u32x4 w; w.x = cvtpk(v0[0], v0[1]); w.y = cvtpk(v0[2], v0[3]); w.z = cvtpk(v1[0], v1[1]); w.w = cvtpk(v1[2], v1[3]);
                    __builtin_nontemporal_store(w, (u32x4*)(rowp + bj * 128)); }
                asm volatile("" ::: "memory"); }
    }
};
struct EpiU {
    static constexpr bool PERM = true, AFTER_DRAIN = false;
    int kind, mode; const void* p0; void* p1; void* p2; int dry;
    __device__ __forceinline__ void operator()(const f32x4 (&acc)[2][2][4][2], const pg8::Unit& u, int a, int b, int c, int d) const {
        if (dry) return;
        if (kind == 0) { EpiInproj e{(unsigned char*)p1}; e(acc, u, a, b, c, d); }
        else if (kind == 1) { EpiMerge e{(const unsigned char*)p0, (float*)p1, (bf16_t*)p2, mode}; e(acc, u, a, b, c, d); }
        else if (kind == 2) { EpiResid e{(const float*)p0, (float*)p1, (const float*)p2}; e(acc, u, a, b, c, d); }
        else { EpiRelu2 e{(bf16_t*)p1}; e(acc, u, a, b, c, d); }
    }
};
template <class Epi>
__device__ __forceinline__ void run_gemm(unsigned char* lds, const bf16_t* A, int lda, const bf16_t* Bt, int N, int K, const Epi& E) {
    pg8::Gemm g{A, Bt, T, N, K, lda}; pg8::StaticOrder S; S.init(T, N, (int)gridDim.x, (int)blockIdx.x);
    pg8::gemm_phase<Epi, pg8::StaticOrder, true, true>((PG8_LAS unsigned char*)lds, g, S, E);
}

__device__ __forceinline__ void phase_pre(const Params& p, unsigned char* lds, const int tid) {
    float* cs = (float*)lds; float* red = cs + 4096;
    const float* c = PIN(1); const float* ada_w = PIN(2); const float* ada_b = PIN(3);
    float* mod = (float*)(p.ws + O_MOD);
    for (int i = tid; i < 4096; i += 512) { const float v = c[i]; cs[i] = v / (1.f + expf(-v)); }
    __syncthreads();
    { float* rot = (float*)(p.ws + O_ROT);
      for (int e = blockIdx.x * 512 + tid; e < 4096 * 8; e += gridDim.x * 512) { const int pos = e >> 3, j = e & 7;
          const float inv_freq = powf(500000.0f, -(float)j * 0.125f); const float ang = (float)pos * inv_freq;
          rot[pos * 16 + j] = cosf(ang); rot[pos * 16 + 8 + j] = sinf(ang); } }
    const int jj = tid & 63, ks = tid >> 6;
    for (int it = blockIdx.x; it < DEPTH * 96; it += gridDim.x) {
        const int l = it / 96, jb = it % 96;
        const float* w = ada_w + (size_t)l * 1024 * 6144 + jb * 64 + jj;
        float a0 = 0.f, a1 = 0.f, a2 = 0.f, a3 = 0.f;
#pragma unroll 8
        for (int k = ks * 128; k < ks * 128 + 128; ++k) { const float wv = w[(size_t)k * 6144]; a0 += cs[k] * wv; a1 += cs[1024 + k] * wv; a2 += cs[2048 + k] * wv; a3 += cs[3072 + k] * wv; }
        red[(ks * 64 + jj) * 4 + 0] = a0; red[(ks * 64 + jj) * 4 + 1] = a1; red[(ks * 64 + jj) * 4 + 2] = a2; red[(ks * 64 + jj) * 4 + 3] = a3;
        __syncthreads();
        if (tid < 256) { const int b = tid >> 6, j2 = tid & 63; float s = 0.f;
#pragma unroll
            for (int q = 0; q < 8; ++q) s += red[(q * 64 + j2) * 4 + b];
            const int cc = jb * 64 + j2; mod[((size_t)l * 4 + b) * 6144 + cc] = s + ada_b[l * 6144 + cc]; }
        __syncthreads();
    }
}

__device__ __forceinline__ int inproj_src_col(int n) {
    if (n < 2560) return n;
    if (n < 6144) return n + 8;
    if (n < 10240) return n + 20;
    if (n < 10248) return 2560 + (n - 10240);
    if (n < 10260) return 6152 + (n - 10248);
    return -1;
}
__device__ __forceinline__ void transpose_item(const float* W, int K, int Nsrc, bf16_t* WT, float* scr, int k0, int n0, int lane, bool remap) {
    const int nd = n0 + (lane & 31); const int sc = remap ? inproj_src_col(nd) : nd;
#pragma unroll
    for (int i = 0; i < 32; ++i) { const int kk = 2 * i + (lane >> 5); scr[kk * 33 + (lane & 31)] = (sc >= 0) ? W[(size_t)(k0 + kk) * Nsrc + sc] : 0.f; }
    LDS_WAIT();
    const int c = lane & 7;
#pragma unroll
    for (int j = 0; j < 4; ++j) { const int n = (lane >> 3) + 8 * j; const float* s = scr + (8 * c) * 33 + n;
        u32x4 o; o.x = cvtpk(s[0 * 33], s[1 * 33]); o.y = cvtpk(s[2 * 33], s[3 * 33]); o.z = cvtpk(s[4 * 33], s[5 * 33]); o.w = cvtpk(s[6 * 33], s[7 * 33]);
        *(u32x4*)(WT + (size_t)(n0 + n) * K + k0 + 8 * c) = o; }
    LDS_WAIT();
}
__device__ __forceinline__ void convert_weights(const Params& p, int l, unsigned char* lds, int gw, int NGW, int wid, int lane) {
    float* scr = (float*)(lds + wid * 16384);
    unsigned char* ws = p.ws;
    constexpr int I_IN = 16 * (NPROJ / 32), I_BR = 8 * 32, I_D = 12 * 32, I_O = 16 * 32, I_1 = 16 * 128, I_2 = 64 * 32;
    constexpr int TOT = I_IN + 3 * I_BR + I_D + I_O + I_1 + I_2;
    for (int it = gw; it < TOT; it += NGW) {
        int r = it; const float* W; bf16_t* WT; int K, Nsrc, Nd; bool remap = false;
        if (r < I_IN) { W = PIN(5) + (size_t)l * 1024 * IN_COLS; WT = (bf16_t*)(ws + O_WIN); K = 1024; Nsrc = IN_COLS; Nd = NPROJ; remap = true; }
        else if ((r -= I_IN) < I_BR) { W = PIN(17) + (size_t)l * 512 * 1024; WT = (bf16_t*)(ws + O_WA); K = 512; Nsrc = 1024; Nd = 1024; }
        else if ((r -= I_BR) < I_BR) { W = PIN(18) + (size_t)l * 512 * 1024; WT = (bf16_t*)(ws + O_WB); K = 512; Nsrc = 1024; Nd = 1024; }
        else if ((r -= I_BR) < I_BR) { W = PIN(19) + (size_t)l * 512 * 1024; WT = (bf16_t*)(ws + O_WC); K = 512; Nsrc = 1024; Nd = 1024; }
        else if ((r -= I_BR) < I_D) { W = PIN(20) + (size_t)l * 768 * 1024; WT = (bf16_t*)(ws + O_WD); K = 768; Nsrc = 1024; Nd = 1024; }
        else if ((r -= I_D) < I_O) { W = PIN(21) + (size_t)l * 1024 * 1024; WT = (bf16_t*)(ws + O_WO); K = 1024; Nsrc = 1024; Nd = 1024; }
        else if ((r -= I_O) < I_1) { W = PIN(23) + (size_t)l * 1024 * 4096; WT = (bf16_t*)(ws + O_W1); K = 1024; Nsrc = 4096; Nd = 4096; }
        else { r -= I_1; W = PIN(24) + (size_t)l * 4096 * 1024; WT = (bf16_t*)(ws + O_W2); K = 4096; Nsrc = 1024; Nd = 1024; }
        const int nblk = Nd / 32, kb = r / nblk, nb = r % nblk;
        transpose_item(W, K, Nsrc, WT, scr, 64 * kb, 32 * nb, lane, remap);
    }
    const float* gws = PIN(8) + (size_t)l * 8 * 128 * 128; bf16_t* gd = (bf16_t*)(ws + O_GWS);
    for (int e = gw * 64 + lane; e < 8 * 128 * 128; e += NGW * 64) { const int s = e & 127, t = (e >> 7) & 127; const float v = (s <= t) ? gws[e] : 0.f; gd[e] = (bf16_t)(cvtpk(v, 0.f) & 0xffffu); }
}
__device__ __forceinline__ void norm_mod_rows(const float* x, const float* w, const float* sh, const float* sc, bf16_t* out, int gw, int NGW, int lane) {
    const int per = T / NGW;
    const int rbeg = gw * per; const int b = rbeg >> 12;
    f32x4 ws[4], hv[4];
#pragma unroll
    for (int j = 0; j < 4; ++j) { const int col = 4 * (64 * j + lane);
        ws[j] = *(const f32x4*)(w + col) * (*(const f32x4*)(sc + (size_t)b * 6144 + col) + 1.f); hv[j] = *(const f32x4*)(sh + (size_t)b * 6144 + col); }
#pragma unroll 2
    for (int r = 0; r < per; ++r) {
        const int row = rbeg + r; const f32x4* xr = (const f32x4*)(x + (size_t)row * 1024) + lane;
        f32x4 v[4]; float ss = 0.f;
#pragma unroll
        for (int j = 0; j < 4; ++j) { v[j] = xr[64 * j]; ss += (v[j][0] * v[j][0] + v[j][1] * v[j][1]) + (v[j][2] * v[j][2] + v[j][3] * v[j][3]); }
        const float rstd = rsqrtf(wave_sum(ss) * (1.f / 1024.f) + NORM_EPS);
#pragma unroll
        for (int j = 0; j < 4; ++j) { const int col = 4 * (64 * j + lane);
            const f32x4 o = (v[j] * rstd) * ws[j] + hv[j];
            u32x2 pk; pk.x = cvtpk(o[0], o[1]); pk.y = cvtpk(o[2], o[3]); *(u32x2*)(out + (size_t)row * 1024 + col) = pk; }
    }
}
__device__ __forceinline__ void final_norm_rows(const float* x, const float* w, float* out, int gw, int NGW, int lane) {
    for (int row = gw; row < T; row += NGW) {
        const f32x4* xr = (const f32x4*)(x + (size_t)row * 1024) + lane;
        f32x4 v[4]; float ss = 0.f;
#pragma unroll
        for (int j = 0; j < 4; ++j) { v[j] = xr[64 * j]; ss += (v[j][0] * v[j][0] + v[j][1] * v[j][1]) + (v[j][2] * v[j][2] + v[j][3] * v[j][3]); }
        const float rstd = rsqrtf(wave_sum(ss) * (1.f / 1024.f) + NORM_EPS);
#pragma unroll
        for (int j = 0; j < 4; ++j) { const int col = 4 * (64 * j + lane); const f32x4 wv = *(const f32x4*)(w + col);
            *(f32x4*)(out + (size_t)row * 1024 + col) = v[j] * rstd * wv; }
    }
}

__device__ __forceinline__ void gmlp_item(const Params& p, int l, unsigned char* lds, int item, int wid, int lane) {
    const int half = item & 1, ch = (item >> 1) & 31, b = item >> 6;
    const int fr = lane & 15, fq = lane >> 4;
    bf16_t* UV = (bf16_t*)(p.ws + O_UV); const bf16_t* GWS = (const bf16_t*)(p.ws + O_GWS);
    const float* lnw = PIN(6) + l * 512; const float* lnb = PIN(7) + l * 512;
    bf16_t* vnT = (bf16_t*)lds;
    const size_t row0 = (size_t)b * SEQ + ch * 128;
#pragma unroll 8
    for (int r = 0; r < 16; ++r) {
        const int s = wid * 16 + r;
        const bf16x8 raw = *(const bf16x8*)(UV + (row0 + s) * 1024 + 512 + 8 * lane);
        float x[8]; float sum = 0.f;
#pragma unroll
        for (int j = 0; j < 8; ++j) { x[j] = bf2f(raw[j]); sum += x[j]; }
        const float mean = wave_sum(sum) * (1.f / 512.f); float sq = 0.f;
#pragma unroll
        for (int j = 0; j < 8; ++j) { x[j] -= mean; sq += x[j] * x[j]; }
        const float rstd = rsqrtf(wave_sum(sq) * (1.f / 512.f) + NORM_EPS);
        if ((lane >> 5) == half) { const int c0 = (lane & 31) * 8;
#pragma unroll
            for (int j = 0; j < 8; ++j) { const int cc = half * 256 + c0 + j; const float o = x[j] * rstd * lnw[cc] + lnb[cc]; vnT[(c0 + j) * 136 + s] = (bf16_t)(cvtpk(o, 0.f) & 0xffffu); } }
    }
    __syncthreads();
    const int t0 = wid * 16; const int nks = (t0 + 15) / 32 + 1;
#pragma unroll 1
    for (int g4 = 0; g4 < 4; ++g4) {
        const int grp = half * 4 + g4;
        f32x4 acc[4];
#pragma unroll
        for (int ct = 0; ct < 4; ++ct) acc[ct] = (f32x4){0.f, 0.f, 0.f, 0.f};
        for (int ks = 0; ks < nks; ++ks) {
            const bf16x8 bw = *(const bf16x8*)(GWS + ((size_t)grp * 128 + t0 + fr) * 128 + ks * 32 + 8 * fq);
#pragma unroll
            for (int ct = 0; ct < 4; ++ct) { const bf16x8 av = *(const bf16x8*)(vnT + (g4 * 64 + ct * 16 + fr) * 136 + ks * 32 + 8 * fq); acc[ct] = mfma16(av, bw, acc[ct]); }
        }
        const float bsv = (PIN(9) + (size_t)l * 8 * 128 + grp * 128)[t0 + fr];
#pragma unroll
        for (int ct = 0; ct < 4; ++ct) { bf16_t* up = UV + (row0 + t0 + fr) * 1024 + grp * 64 + ct * 16 + 4 * fq;
            const u32x2 uw = *(const u32x2*)up; u32x2 o;
            o.x = cvtpk(bflo(uw.x) * (acc[ct][0] + bsv), bfhi(uw.x) * (acc[ct][1] + bsv)); o.y = cvtpk(bflo(uw.y) * (acc[ct][2] + bsv), bfhi(uw.y) * (acc[ct][3] + bsv));
            *(u32x2*)up = o; }
    }
    __syncthreads();
}
__device__ __forceinline__ void rotary_item(const Params& p, unsigned char* lds, int item, int tid, bool dry = false) {
    const int h = item & 7, nb = (item >> 3) & 15, b = item >> 7;
    float* sums = (float*)lds;
    if (tid < 64) sums[tid] = 0.f;
    __syncthreads();
    bf16_t* MQ = (bf16_t*)(p.ws + O_MQKV);
    const int half = (tid >> 5) & 1, tt = (tid >> 6) * 32 + (tid & 31); const int pos = nb * 256 + tt; const size_t row = (size_t)b * SEQ + pos;
    bf16_t* kp = MQ + row * 1536 + 512 + h * 64 + half * 32;
    float kv[32];
#pragma unroll
    for (int q = 0; q < 4; ++q) { const bf16x8 raw = *(const bf16x8*)(kp + 8 * q);
#pragma unroll
        for (int j = 0; j < 8; ++j) kv[8 * q + j] = bf2f(raw[j]); }
    if (half == 0 && !dry) {
        bf16_t* qp = MQ + row * 1536 + h * 64;
        float qv[16];
        { const bf16x8 r0 = *(const bf16x8*)qp, r1 = *(const bf16x8*)(qp + 8);
#pragma unroll
          for (int j = 0; j < 8; ++j) { qv[j] = bf2f(r0[j]); qv[8 + j] = bf2f(r1[j]); } }
        const float* rt = (const float*)(p.ws + O_ROT) + pos * 16;
        const f32x4 c0 = *(const f32x4*)rt, c1 = *(const f32x4*)(rt + 4), s0 = *(const f32x4*)(rt + 8), s1 = *(const f32x4*)(rt + 12);
#pragma unroll
        for (int j = 0; j < 8; ++j) {
            const float cs = (j < 4) ? c0[j & 3] : c1[j & 3], sn = (j < 4) ? s0[j & 3] : s1[j & 3];
            const float k1 = kv[j], k2 = kv[8 + j]; kv[j] = k1 * cs - k2 * sn; kv[8 + j] = k2 * cs + k1 * sn;
            const float q1 = qv[j], q2 = qv[8 + j]; qv[j] = q1 * cs - q2 * sn; qv[8 + j] = q2 * cs + q1 * sn;
        }
        *(bf16x8*)kp = pack8(kv[0], kv[1], kv[2], kv[3], kv[4], kv[5], kv[6], kv[7]);
        *(bf16x8*)(kp + 8) = pack8(kv[8], kv[9], kv[10], kv[11], kv[12], kv[13], kv[14], kv[15]);
        *(bf16x8*)qp = pack8(qv[0], qv[1], qv[2], qv[3], qv[4], qv[5], qv[6], qv[7]);
        *(bf16x8*)(qp + 8) = pack8(qv[8], qv[9], qv[10], qv[11], qv[12], qv[13], qv[14], qv[15]);
    }
#pragma unroll
    for (int d = 0; d < 32; ++d) {
        float v = row16_sum(kv[d]); v += __shfl_xor(v, 16);
        if ((tid & 31) == 0) atomicAdd(&sums[half * 32 + d], v);
    }
    __syncthreads();
    if (tid < 64) ((float*)(p.ws + O_KMEAN))[(((size_t)b * 8 + h) * 16 + nb) * 64 + tid] = sums[tid] * (1.f / 256.f);
    __syncthreads();
}
__device__ __forceinline__ void vt_item(const Params& p, unsigned char* lds, int item, int tid) {
    const int tb = item & 31, h = (item >> 5) & 7, b = (item >> 8) & 3, which = item >> 10;
    const bf16_t* src = (const bf16_t*)(p.ws + (which ? O_MQKV : O_FQKV)) + ((size_t)b * SEQ + tb * 128) * 1536 + 1024 + h * 64;
    bf16_t* dst = (bf16_t*)(p.ws + (which ? O_VTM : O_VTF)) + ((size_t)(b * 8 + h) * 64) * 4096 + tb * 128;
    bf16_t* tl = (bf16_t*)lds;
    { const int tok = tid >> 2, dq = tid & 3;
      const bf16x8 r0 = *(const bf16x8*)(src + (size_t)tok * 1536 + dq * 16), r1 = *(const bf16x8*)(src + (size_t)tok * 1536 + dq * 16 + 8);
#pragma unroll
      for (int j = 0; j < 8; ++j) { tl[(dq * 16 + j) * 136 + tok] = (bf16_t)r0[j]; tl[(dq * 16 + 8 + j) * 136 + tok] = (bf16_t)r1[j]; } }
    __syncthreads();
    { const int d = tid >> 3, c = tid & 7;
      const bf16x8 a = *(const bf16x8*)(tl + d * 136 + c * 16), bq = *(const bf16x8*)(tl + d * 136 + c * 16 + 8);
      *(bf16x8*)(dst + (size_t)d * 4096 + c * 16) = a; *(bf16x8*)(dst + (size_t)d * 4096 + c * 16 + 8) = bq; }
    __syncthreads();
}
__device__ __forceinline__ void conv_item(const Params& p, int l, int item, int tid) {
    const int cb = item % 20, sp = (item / 20) & 15, b = item / 320;
    const int c8 = tid & 7, tq = tid >> 3; const int gc = cb * 64 + 8 * c8;
    const int t0 = sp * 256 + tq * 4;
    const bf16_t* xp = (const bf16_t*)(p.ws + O_XBC) + ((size_t)b * SEQ) * 1280 + gc;
    float v[7][8];
#pragma unroll
    for (int r = 0; r < 7; ++r) { const int t = t0 - 3 + r;
        if (t >= 0) { const bf16x8 raw = *(const bf16x8*)(xp + (size_t)t * 1280);
#pragma unroll
            for (int j = 0; j < 8; ++j) v[r][j] = bf2f(raw[j]); }
        else {
#pragma unroll
            for (int j = 0; j < 8; ++j) v[r][j] = 0.f; } }
    const float* cw = PIN(11) + (size_t)l * 4 * 1280 + gc; const float* cbp = PIN(12) + l * 1280 + gc;
    float w[4][8], bias[8];
#pragma unroll
    for (int kk = 0; kk < 4; ++kk) { const f32x4 a = *(const f32x4*)(cw + kk * 1280), bq = *(const f32x4*)(cw + kk * 1280 + 4);
#pragma unroll
        for (int j = 0; j < 4; ++j) { w[kk][j] = a[j]; w[kk][4 + j] = bq[j]; } }
    { const f32x4 a = *(const f32x4*)cbp, bq = *(const f32x4*)(cbp + 4);
#pragma unroll
      for (int j = 0; j < 4; ++j) { bias[j] = a[j]; bias[4 + j] = bq[j]; } }
    float o[4][8];
#pragma unroll
    for (int tt = 0; tt < 4; ++tt)
#pragma unroll
        for (int j = 0; j < 8; ++j) { const float x = bias[j] + w[0][j] * v[tt][j] + w[1][j] * v[tt + 1][j] + w[2][j] * v[tt + 2][j] + w[3][j] * v[tt + 3][j]; o[tt][j] = x / (1.f + __expf(-x)); }
    const size_t tok0 = (size_t)b * SEQ + t0;
    if (cb < 12) {
        bf16_t* d = (bf16_t*)(p.ws + O_XT) + ((size_t)(b * 12 + cb) * 64 + 8 * c8) * 4096 + t0;
#pragma unroll
        for (int j = 0; j < 8; ++j) { u32x2 q; q.x = cvtpk(o[0][j], o[1][j]); q.y = cvtpk(o[2][j], o[3][j]); *(u32x2*)(d + (size_t)j * 4096) = q; }
    } else {
        bf16_t* BC = (bf16_t*)(p.ws + O_BC); const int bc = gc - 768;
#pragma unroll
        for (int tt = 0; tt < 4; ++tt) *(bf16x8*)(BC + (tok0 + tt) * 512 + bc) = pack8(o[tt][0], o[tt][1], o[tt][2], o[tt][3], o[tt][4], o[tt][5], o[tt][6], o[tt][7]);
        if (cb < 16) { bf16_t* d = (bf16_t*)(p.ws + O_BT) + ((size_t)b * 256 + bc) * 4096 + t0;
#pragma unroll
            for (int j = 0; j < 8; ++j) { u32x2 q; q.x = cvtpk(o[0][j], o[1][j]); q.y = cvtpk(o[2][j], o[3][j]); *(u32x2*)(d + (size_t)j * 4096) = q; } }
    }
}
__device__ __forceinline__ void acum_item(const Params& p, int l, int item, int lane) {
    const int ch = item & 31, h = (item >> 5) % 12, b = item / 384;
    const float* sm = (const float*)(p.ws + O_SMALL); const float a = -expf(PIN(14)[l * 12 + h]);
    const size_t tok = (size_t)b * SEQ + ch * 128 + 2 * lane;
    const float dtb = PIN(13)[l * 12 + h];
    const f32x2 raw = *(const f32x2*)(sm + (size_t)(8 + h) * T + tok); const float d0 = softplusf_(raw[0] + dtb), d1 = softplusf_(raw[1] + dtb);
    { f32x2 dd = {d0, d1}; *(f32x2*)((float*)(p.ws + O_DT) + ((size_t)(b * 12 + h)) * 4096 + ch * 128 + 2 * lane) = dd; }
    const float v0 = d0 * a, v1 = d1 * a;
    float sc = v0 + v1;
#pragma unroll
    for (int o = 1; o < 64; o <<= 1) { const float t = __shfl_up(sc, o); if (lane >= o) sc += t; }
    const float ex = sc - (v0 + v1);
    f32x2 r = {ex + v0, ex + v0 + v1};
    *(f32x2*)((float*)(p.ws + O_ACUM) + ((size_t)(b * 12 + h)) * 4096 + ch * 128 + 2 * lane) = r;
}
__device__ __forceinline__ void foxcum_item(const Params& p, int l, int item, int lane) {
    const int h = item & 7, b = item >> 3; const float fb = PIN(10)[l * 8 + h];
    const float* sm = (const float*)(p.ws + O_SMALL) + (size_t)h * T + (size_t)b * SEQ + lane * 64;
    float* cum = (float*)(p.ws + O_CUMF) + (size_t)(b * 8 + h) * 4096 + lane * 64;
    float v[64];
#pragma unroll
    for (int i = 0; i < 64; i += 4) { const f32x4 q = *(const f32x4*)(sm + i); v[i] = q[0]; v[i + 1] = q[1]; v[i + 2] = q[2]; v[i + 3] = q[3]; }
    float run = 0.f;
#pragma unroll
    for (int i = 0; i < 64; ++i) { const float x = v[i] + fb; run += fminf(x, 0.f) - __logf(1.f + __expf(-fabsf(x))); v[i] = run; }
    float sc = run;
#pragma unroll
    for (int o = 1; o < 64; o <<= 1) { const float t = __shfl_up(sc, o); if (lane >= o) sc += t; }
    const float ex = sc - run;
#pragma unroll
    for (int i = 0; i < 64; i += 4) { f32x4 w = {v[i] + ex, v[i + 1] + ex, v[i + 2] + ex, v[i + 3] + ex}; *(f32x4*)(cum + i) = w; }
}

template <bool MOBA, int VPITCH>
__device__ __forceinline__ void attn_tile64(const bf16_t* KL, const bf16_t* VL, const float* CL, int k0, bool diag, int kb,
                                            const bf16x8 (&qf)[2][2], const float (&cq)[2], const unsigned (&sel)[2], int qpos0, int fr, int fq,
                                            f32x4 (&lacc)[2], f32x4 (&o)[4][2]) {
    bf16x8 kf[4][2], vf[2][4]; f32x4 nck[4];
#pragma unroll
    for (int jk = 0; jk < 4; ++jk) { kf[jk][0] = *(const bf16x8*)(KL + (16 * jk + fr) * 72 + 8 * fq); kf[jk][1] = *(const bf16x8*)(KL + (16 * jk + fr) * 72 + 32 + 8 * fq); }
#pragma unroll
    for (int jk = 0; jk < 4; ++jk) nck[jk] = MOBA ? (f32x4){0.f, 0.f, 0.f, 0.f} : *(const f32x4*)(CL + 16 * jk + 4 * fq);
#pragma unroll
    for (int dt = 0; dt < 4; ++dt) { const bf16_t* vp = VL + (4 * fq + (fr >> 2)) * VPITCH + dt * 16 + 4 * (fr & 3); vf[0][dt] = cat4(lds_tr(vp), lds_tr(vp + 16 * VPITCH)); }
    __builtin_amdgcn_sched_barrier(0);
    f32x4 s[4][2];
    __builtin_amdgcn_s_setprio(1);
#pragma unroll
    for (int jk = 0; jk < 4; ++jk)
#pragma unroll
        for (int jq = 0; jq < 2; ++jq) { f32x4 z = {0.f, 0.f, 0.f, 0.f}; z = mfma16(kf[jk][0], qf[jq][0], z); s[jk][jq] = mfma16(kf[jk][1], qf[jq][1], z); }
    __builtin_amdgcn_s_setprio(0);
    __builtin_amdgcn_sched_barrier(0);
#pragma unroll
    for (int dt = 0; dt < 4; ++dt) { const bf16_t* vp = VL + (32 + 4 * fq + (fr >> 2)) * VPITCH + dt * 16 + 4 * (fr & 3); vf[1][dt] = cat4(lds_tr(vp), lds_tr(vp + 16 * VPITCH)); }
    __builtin_amdgcn_sched_barrier(0);
    constexpr float C2 = 0.125f * LOG2E;
#pragma unroll
    for (int jk = 0; jk < 4; ++jk)
#pragma unroll
        for (int jq = 0; jq < 2; ++jq)
#pragma unroll
            for (int i = 0; i < 4; ++i) s[jk][jq][i] = MOBA ? s[jk][jq][i] * C2 : fmaf(s[jk][jq][i], C2, nck[jk][i] + cq[jq]);
    if (diag) {
#pragma unroll
        for (int jk = 0; jk < 4; ++jk)
#pragma unroll
            for (int jq = 0; jq < 2; ++jq)
#pragma unroll
                for (int i = 0; i < 4; ++i) if (k0 + 16 * jk + 4 * fq + i > qpos0 + 16 * jq + fr) s[jk][jq][i] = -INFINITY;
    }
    if (MOBA && kb >= 0) {
#pragma unroll
        for (int jq = 0; jq < 2; ++jq) if (!((sel[jq] >> kb) & 1u)) {
#pragma unroll
            for (int jk = 0; jk < 4; ++jk) s[jk][jq] = (f32x4){-INFINITY, -INFINITY, -INFINITY, -INFINITY}; }
    }
    bf16x8 pb[2][2];
#pragma unroll
    for (int jq = 0; jq < 2; ++jq) {
#pragma unroll
        for (int jk = 0; jk < 4; ++jk)
#pragma unroll
            for (int i = 0; i < 4; ++i) s[jk][jq][i] = ex2(fminf(s[jk][jq][i], 100.f));
        pb[jq][0] = pack8(s[0][jq][0], s[0][jq][1], s[0][jq][2], s[0][jq][3], s[1][jq][0], s[1][jq][1], s[1][jq][2], s[1][jq][3]);
        pb[jq][1] = pack8(s[2][jq][0], s[2][jq][1], s[2][jq][2], s[2][jq][3], s[3][jq][0], s[3][jq][1], s[3][jq][2], s[3][jq][3]);
    }
    const u32x4 onesw = {0x3f803f80u, 0x3f803f80u, 0x3f803f80u, 0x3f803f80u}; const bf16x8 ones = __builtin_bit_cast(bf16x8, onesw);
    __builtin_amdgcn_s_setprio(1);
#pragma unroll
    for (int hh = 0; hh < 2; ++hh) {
#pragma unroll
        for (int jq = 0; jq < 2; ++jq) lacc[jq] = mfma16(ones, pb[jq][hh], lacc[jq]);
#pragma unroll
        for (int dt = 0; dt < 4; ++dt)
#pragma unroll
            for (int jq = 0; jq < 2; ++jq) o[dt][jq] = mfma16(vf[hh][dt], pb[jq][hh], o[dt][jq]);
    }
    __builtin_amdgcn_s_setprio(0);
}
__device__ __forceinline__ unsigned moba_select(const bf16_t* qp, const float* km, int own) {
    const bf16x8 r0 = *(const bf16x8*)qp, r1 = *(const bf16x8*)(qp + 8);
    float qd[16];
#pragma unroll
    for (int j = 0; j < 8; ++j) { qd[j] = bf2f(r0[j]); qd[8 + j] = bf2f(r1[j]); }
    float gate[15];
#pragma unroll
    for (int n = 0; n < 15; ++n) {
        float a = -INFINITY;
        if (n < own) { a = 0.f;
#pragma unroll
            for (int d = 0; d < 16; d += 4) { const f32x4 kk = *(const f32x4*)(km + n * 64 + d); a += qd[d] * kk[0] + qd[d + 1] * kk[1] + qd[d + 2] * kk[2] + qd[d + 3] * kk[3]; }
            a += __shfl_xor(a, 16); a += __shfl_xor(a, 32); }
        gate[n] = a;
    }
    unsigned msk = 0u;
#pragma unroll
    for (int pass = 0; pass < 3; ++pass) { float best = -INFINITY; int bi = -1;
#pragma unroll
        for (int n = 0; n < 15; ++n) { const float v = ((msk >> n) & 1u) ? -INFINITY : gate[n]; if (v > best) { best = v; bi = n; } }
        if (bi >= 0) msk |= 1u << bi; }
    return msk;
}
template <bool MOBA>
__device__ __forceinline__ void attn_block_item(const Params& p, unsigned char* lds, int b, int h, int qb, int tid_in, int wid, int lane_in) {
    int tid = tid_in, lane = lane_in; asm volatile("" : "+v"(tid), "+v"(lane));
    const int fr = lane & 15, fq = lane >> 4; const int q0 = qb * 256 + wid * 32;
    bf16_t* qkv = (bf16_t*)(p.ws + (MOBA ? O_MQKV : O_FQKV)) + ((size_t)b * SEQ) * 1536 + h * 64;
    const bf16_t* kbase = qkv + 512; const bf16_t* vtbase = (const bf16_t*)(p.ws + (MOBA ? O_VTM : O_VTF)) + ((size_t)(b * 8 + h) * 64) * 4096;
    const float* cum = (const float*)(p.ws + O_CUMF) + (size_t)(b * 8 + h) * 4096;
    bf16x8 qf[2][2];
#pragma unroll
    for (int jq = 0; jq < 2; ++jq)
#pragma unroll
        for (int ks = 0; ks < 2; ++ks) qf[jq][ks] = *(const bf16x8*)(qkv + (size_t)(q0 + 16 * jq + fr) * 1536 + ks * 32 + 8 * fq);
    float cq[2] = {0.f, 0.f}; unsigned sel[2] = {0u, 0u}; unsigned umask = 0u;
    const int own = qb;
    if (!MOBA) { cq[0] = cum[q0 + fr] * LOG2E; cq[1] = cum[q0 + 16 + fr] * LOG2E; }
    if (MOBA && own > 0) {
        const float* km = (const float*)(p.ws + O_KMEAN) + ((size_t)(b * 8 + h) * 16) * 64 + 16 * fq;
        sel[0] = moba_select(qkv + (size_t)(q0 + fr) * 1536 + 16 * fq, km, own);
        __builtin_amdgcn_sched_barrier(0);
        sel[1] = moba_select(qkv + (size_t)(q0 + 16 + fr) * 1536 + 16 * fq, km, own);
        __builtin_amdgcn_sched_barrier(0);
        umask = sel[0] | sel[1];
#pragma unroll
        for (int o2 = 1; o2 < 16; o2 <<= 1) umask |= __shfl_xor(umask, o2);
        umask = __builtin_amdgcn_readfirstlane(umask);
    }
    f32x4 lacc[2] = {(f32x4){0.f, 0.f, 0.f, 0.f}, (f32x4){0.f, 0.f, 0.f, 0.f}}; f32x4 o[4][2];
#pragma unroll
    for (int dt = 0; dt < 4; ++dt) { o[dt][0] = (f32x4){0.f, 0.f, 0.f, 0.f}; o[dt][1] = (f32x4){0.f, 0.f, 0.f, 0.f}; }
    const int NT = 2 * (qb + 1);
    constexpr int VP = 80;
    bf16_t* KLb = (bf16_t*)lds; bf16_t* VLb = KLb + 2 * 128 * 72;
    float* CLb = (float*)(VLb + 2 * 128 * VP);
    const int lr = tid >> 3, lc = (tid & 7) * 8;
    #define STEP_KT(i) (MOBA ? (((i) < 2) ? 2 * qb + (i) : (i) - 2) : (i))
    bf16x8 kreg0, kreg1, vreg0, vreg1; f32x4 creg = {0.f, 0.f, 0.f, 0.f};
    #define LOAD_STEP(kk0) do { kreg0 = *(const bf16x8*)(kbase + (size_t)((kk0) + lr) * 1536 + lc); kreg1 = *(const bf16x8*)(kbase + (size_t)((kk0) + 64 + lr) * 1536 + lc); \
        vreg0 = *(const bf16x8*)(kbase + 512 + (size_t)((kk0) + lr) * 1536 + lc); vreg1 = *(const bf16x8*)(kbase + 512 + (size_t)((kk0) + 64 + lr) * 1536 + lc); \
        if (!MOBA && tid < 32) creg = *(const f32x4*)(cum + (kk0) + 4 * tid) * (-LOG2E); } while (0)
    #define STORE_STEP(bb) do { *(bf16x8*)(KLb + (bb) * 128 * 72 + lr * 72 + lc) = kreg0; *(bf16x8*)(KLb + (bb) * 128 * 72 + (lr + 64) * 72 + lc) = kreg1; \
        *(bf16x8*)(VLb + (bb) * 128 * VP + lr * VP + lc) = vreg0; *(bf16x8*)(VLb + (bb) * 128 * VP + (lr + 64) * VP + lc) = vreg1; \
        if (!MOBA && tid < 32) *(f32x4*)(CLb + (bb) * 128 + 4 * tid) = creg; } while (0)
    int i_start = 0;
    if (!MOBA) {
        const float cq0 = cum[qb * 256];
        const float ce = (lane < NT) ? cum[lane * 128 + 127] : 0.f;
        const bool need = (lane < NT) && ((cq0 - ce) * LOG2E >= -64.f);
        const unsigned long long bal = __ballot(need);
        i_start = __builtin_amdgcn_readfirstlane(bal ? (int)__ffsll((long long)bal) - 1 : NT - 1);
    }
    LOAD_STEP(STEP_KT(i_start) * 128); STORE_STEP(0);
    __syncthreads();
#pragma unroll 1
    for (int i = i_start; i < NT; ++i) {
        const int k0 = STEP_KT(i) * 128; const int buf = (i - i_start) & 1;
        if (i + 1 < NT) LOAD_STEP(STEP_KT(i + 1) * 128);
        const bf16_t* KL = KLb + buf * 128 * 72; const bf16_t* VL = VLb + buf * 128 * VP; const float* CL = CLb + buf * 128;
        const int kb = k0 >> 8;
        const bool live = !MOBA || kb == own || ((umask >> kb) & 1u);
        if (live) {
#pragma unroll
            for (int hh = 0; hh < 2; ++hh) { const int k0h = k0 + 64 * hh;
                if (k0h <= q0 + 31) attn_tile64<MOBA, VP>(KL + hh * 64 * 72, VL + hh * 64 * VP, CL + hh * 64, k0h, k0h + 63 > q0, (MOBA && kb < own) ? kb : -1, qf, cq, sel, q0, fr, fq, lacc, o); }
        }
        if (i + 1 < NT) STORE_STEP(buf ^ 1);
        __syncthreads();
    }
    #undef STEP_KT
    #undef LOAD_STEP
    #undef STORE_STEP
#pragma unroll
    for (int jq = 0; jq < 2; ++jq) {
        const float inv = 1.f / lacc[jq][0];
        bf16_t* op = qkv + (size_t)(q0 + 16 * jq + fr) * 1536 + 4 * fq;
#pragma unroll
        for (int dt = 0; dt < 4; ++dt) { const f32x4 v = o[dt][jq] * inv; u32x2 w; w.x = cvtpk(v[0], v[1]); w.y = cvtpk(v[2], v[3]); *(u32x2*)(op + dt * 16) = w; }
    }
}
__device__ __forceinline__ void ssd_states_item(const Params& p, int item, int lane) {
    const int h = item % 12, c = (item / 12) & 31, b = item / 384; const int grp = h / 6;
    const int fr = lane & 15, fq = lane >> 4;
    const float* ac = (const float*)(p.ws + O_ACUM) + (size_t)(b * 12 + h) * 4096 + c * 128;
    const float* dtp = (const float*)(p.ws + O_DT) + (size_t)(b * 12 + h) * 4096 + c * 128;
    const bf16_t* XT = (const bf16_t*)(p.ws + O_XT) + ((size_t)(b * 12 + h) * 64) * 4096 + c * 128;
    const bf16_t* BT = (const bf16_t*)(p.ws + O_BT) + ((size_t)(b * 2 + grp) * 128) * 4096 + c * 128;
    float* ST = (float*)(p.ws + O_ST) + ((size_t)((b * 32 + c) * 12 + h)) * 8192;
    const float total = ac[127];
#pragma unroll 1
    for (int hf = 0; hf < 2; ++hf) {
        f32x4 acc[4][4];
#pragma unroll
        for (int pt = 0; pt < 4; ++pt)
#pragma unroll
            for (int nt = 0; nt < 4; ++nt) acc[pt][nt] = (f32x4){0.f, 0.f, 0.f, 0.f};
#pragma unroll 1
        for (int ks = 0; ks < 4; ++ks) {
            const int s0 = ks * 32 + 8 * fq;
            const f32x4 a0 = *(const f32x4*)(ac + s0), a1 = *(const f32x4*)(ac + s0 + 4);
            const f32x4 d0 = *(const f32x4*)(dtp + s0), d1 = *(const f32x4*)(dtp + s0 + 4);
            bf16x8 bfr[4], xa[4];
#pragma unroll
            for (int nt = 0; nt < 4; ++nt) bfr[nt] = *(const bf16x8*)(BT + (size_t)((hf * 4 + nt) * 16 + fr) * 4096 + s0);
#pragma unroll
            for (int pt = 0; pt < 4; ++pt) xa[pt] = *(const bf16x8*)(XT + (size_t)(pt * 16 + fr) * 4096 + s0);
            float w8[8];
#pragma unroll
            for (int j = 0; j < 4; ++j) { w8[j] = __expf(total - a0[j]) * d0[j]; w8[4 + j] = __expf(total - a1[j]) * d1[j]; }
#pragma unroll
            for (int pt = 0; pt < 4; ++pt) {
                const bf16x8 af = pack8(bf2f(xa[pt][0]) * w8[0], bf2f(xa[pt][1]) * w8[1], bf2f(xa[pt][2]) * w8[2], bf2f(xa[pt][3]) * w8[3], bf2f(xa[pt][4]) * w8[4], bf2f(xa[pt][5]) * w8[5], bf2f(xa[pt][6]) * w8[6], bf2f(xa[pt][7]) * w8[7]);
#pragma unroll
                for (int nt = 0; nt < 4; ++nt) acc[pt][nt] = mfma16(bfr[nt], af, acc[pt][nt]); }
        }
#pragma unroll
        for (int pt = 0; pt < 4; ++pt)
#pragma unroll
            for (int nt = 0; nt < 4; ++nt) *(f32x4*)(ST + (size_t)(pt * 16 + fr) * 128 + (hf * 4 + nt) * 16 + 4 * fq) = acc[pt][nt];
    }
}
__device__ __forceinline__ void ssd_scan(const Params& p, int gtid, int gthreads) {
    const float* ST = (const float*)(p.ws + O_ST); bf16_t* PV = (bf16_t*)(p.ws + O_PREV); const float* ACUM = (const float*)(p.ws + O_ACUM);
    for (int e4 = gtid; e4 < NB * 12 * 2048; e4 += gthreads) {
        const int pn = (e4 & 2047) * 4, h = (e4 >> 11) % 12, b = e4 / (12 * 2048);
        const float* ac = ACUM + (size_t)(b * 12 + h) * 4096 + 127;
        const size_t base = ((size_t)(b * 32) * 12 + h) * 8192 + pn;
        f32x4 hs = {0.f, 0.f, 0.f, 0.f};
#pragma unroll 8
        for (int c = 0; c < 32; ++c) { const f32x4 st = *(const f32x4*)(ST + base + (size_t)c * 12 * 8192); const float dc = __expf(ac[c * 128]);
            u32x2 q; q.x = cvtpk(hs[0], hs[1]); q.y = cvtpk(hs[2], hs[3]); *(u32x2*)(PV + base + (size_t)c * 12 * 8192) = q;
            hs = hs * dc + st; }
    }
}
__device__ __forceinline__ void ssd_out_item(const Params& p, int l, int item, int wid, int lane, bool dry = false) {
    const int grp = item & 1, c = (item >> 1) & 31, b = item >> 6;
    const int fr = lane & 15, fq = lane >> 4; const int w = wid; const int tl = 16 * w + fr;
    const size_t row0 = (size_t)b * SEQ + c * 128; const size_t row = row0 + tl;
    const bf16_t* BC = (const bf16_t*)(p.ws + O_BC);
    bf16_t* Z = (bf16_t*)(p.ws + O_Z);
    bf16x8 cf[4];
#pragma unroll
    for (int ks = 0; ks < 4; ++ks) cf[ks] = *(const bf16x8*)(BC + row * 512 + 256 + grp * 128 + ks * 32 + 8 * fq);
    f32x4 cbt[8];
#pragma unroll
    for (int js = 0; js < 8; ++js) { cbt[js] = (f32x4){0.f, 0.f, 0.f, 0.f};
        if (js <= w) {
#pragma unroll
            for (int ks = 0; ks < 4; ++ks) { const bf16x8 a = *(const bf16x8*)(BC + (row0 + js * 16 + fr) * 512 + grp * 128 + ks * 32 + 8 * fq); cbt[js] = mfma16(a, cf[ks], cbt[js]); } } }
    float ssq = 0.f;
#pragma unroll 1
    for (int r = 0; r < 6; ++r) {
        const int h = grp * 6 + r;
        const float* ac = (const float*)(p.ws + O_ACUM) + (size_t)(b * 12 + h) * 4096 + c * 128;
        const float* dtp = (const float*)(p.ws + O_DT) + (size_t)(b * 12 + h) * 4096 + c * 128;
        const float acl = ac[tl]; const float eacl = __expf(acl); const float Dh = PIN(15)[l * 12 + h];
        const bf16_t* PV = (const bf16_t*)(p.ws + O_PREV) + ((size_t)((b * 32 + c) * 12 + h)) * 8192;
        const bf16_t* XT = (const bf16_t*)(p.ws + O_XT) + ((size_t)(b * 12 + h) * 64) * 4096 + c * 128;
        f32x4 yt[4];
#pragma unroll
        for (int pt = 0; pt < 4; ++pt) yt[pt] = (f32x4){0.f, 0.f, 0.f, 0.f};
#pragma unroll
        for (int ks = 0; ks < 4; ++ks)
#pragma unroll
            for (int pt = 0; pt < 4; ++pt) { const bf16x8 a = *(const bf16x8*)(PV + (size_t)(pt * 16 + fr) * 128 + ks * 32 + 8 * fq); yt[pt] = mfma16(a, cf[ks], yt[pt]); }
#pragma unroll
        for (int pt = 0; pt < 4; ++pt) yt[pt] = yt[pt] * eacl;
#pragma unroll
        for (int jp = 0; jp < 4; ++jp) {
            if (2 * jp <= w) {
                const int sA = 32 * jp + 4 * fq, sB = sA + 16;
                const f32x4 a0 = *(const f32x4*)(ac + sA), a1 = *(const f32x4*)(ac + sB), dv0 = *(const f32x4*)(dtp + sA), dv1 = *(const f32x4*)(dtp + sB);
                float mv[8];
#pragma unroll
                for (int j = 0; j < 4; ++j) {
                    const int s = sA + j; const float d0 = dv0[j];
                    float v = (s <= tl) ? cbt[2 * jp][j] * __expf(acl - a0[j]) * d0 : 0.f; if (s == tl) v += Dh; mv[j] = v;
                    const int s2 = sB + j; const float d1 = dv1[j];
                    float v2 = (s2 <= tl) ? cbt[2 * jp + 1][j] * __expf(acl - a1[j]) * d1 : 0.f; if (s2 == tl) v2 += Dh; mv[4 + j] = v2;
                }
                const bf16x8 mb = pack8(mv[0], mv[1], mv[2], mv[3], mv[4], mv[5], mv[6], mv[7]);
#pragma unroll
                for (int pt = 0; pt < 4; ++pt) { const bf16_t* xp = XT + (size_t)(pt * 16 + fr) * 4096 + sA; yt[pt] = mfma16(ld2x8(xp, xp + 16), mb, yt[pt]); }
            }
        }
#pragma unroll
        for (int pt = 0; pt < 4; ++pt) { bf16_t* zp = Z + row * 768 + h * 64 + pt * 16 + 4 * fq; const u32x2 zw = *(const u32x2*)zp;
            const float y0 = yt[pt][0] * bflo(zw.x), y1 = yt[pt][1] * bfhi(zw.x), y2 = yt[pt][2] * bflo(zw.y), y3 = yt[pt][3] * bfhi(zw.y);
            ssq += (y0 * y0 + y1 * y1) + (y2 * y2 + y3 * y3);
            u32x2 o; o.x = cvtpk(y0, y1); o.y = cvtpk(y2, y3); if (!dry) *(u32x2*)zp = o; }
    }
    ssq += __shfl_xor(ssq, 16); ssq += __shfl_xor(ssq, 32);
    if (dry) return;
    const float rstd = rsqrtf(ssq * (1.f / 384.f) + NORM_EPS);
    VM_WAIT();
    const float* nw = PIN(16) + l * 768 + grp * 384;
    bf16_t* zp0 = Z + row * 768 + grp * 384 + 4 * fq;
#pragma unroll 4
    for (int q = 0; q < 24; ++q) { bf16_t* zp = zp0 + q * 16; const u32x2 zw = *(const u32x2*)zp; const f32x4 nv = *(const f32x4*)(nw + q * 16 + 4 * fq);
        u32x2 o; o.x = cvtpk(bflo(zw.x) * rstd * nv[0], bfhi(zw.x) * rstd * nv[1]); o.y = cvtpk(bflo(zw.y) * rstd * nv[2], bfhi(zw.y) * rstd * nv[3]); *(u32x2*)zp = o; }
}

__device__ __forceinline__ void small_cols_item(const bf16_t* Hh, const bf16_t* Wt, float* sm, int item, int lane) {
    const int fr = lane & 15, fq = lane >> 4; const size_t row0 = (size_t)item * 16;
    const bf16_t* ap = Hh + (row0 + fr) * 1024 + 8 * fq; const bf16_t* b0p = Wt + (size_t)fr * 1024 + 8 * fq; const bf16_t* b1p = b0p + 16 * 1024;
    f32x4 acc0[2] = {(f32x4){0.f, 0.f, 0.f, 0.f}, (f32x4){0.f, 0.f, 0.f, 0.f}}, acc1[2] = {(f32x4){0.f, 0.f, 0.f, 0.f}, (f32x4){0.f, 0.f, 0.f, 0.f}};
#pragma unroll 8
    for (int ks = 0; ks < 32; ++ks) {
        const bf16x8 a = *(const bf16x8*)(ap + ks * 32), w0 = *(const bf16x8*)(b0p + ks * 32), w1 = *(const bf16x8*)(b1p + ks * 32);
        acc0[ks & 1] = mfma16(a, w0, acc0[ks & 1]); acc1[ks & 1] = mfma16(a, w1, acc1[ks & 1]);
    }
    const f32x4 r0 = acc0[0] + acc0[1], r1 = acc1[0] + acc1[1];
    *(f32x4*)(sm + (size_t)fr * T + row0 + 4 * fq) = r0; *(f32x4*)(sm + (size_t)(16 + fr) * T + row0 + 4 * fq) = r1;
}
#define LAS __attribute__((address_space(3)))
#define XB_TMO      128
#define XB_XCNT(j)  (256  + 64 * (j))
#define XB_XSUB(j)  (1280 + 64 * (j))
#define XB_XGEN(j)  (2304 + 64 * (j))
#define XB_TOP      3328
#define XB_TOPGEN   3392
#define XCD_BAR_WORDS 3456
#define XB_SPIN_CAP (1u << 18)

__device__ __forceinline__ unsigned xb_ld(unsigned* p)              { return __hip_atomic_load(p, __ATOMIC_RELAXED, __HIP_MEMORY_SCOPE_AGENT); }
__device__ __forceinline__ unsigned xb_add(unsigned* p, unsigned v) { return __hip_atomic_fetch_add(p, v, __ATOMIC_RELAXED, __HIP_MEMORY_SCOPE_AGENT); }
__device__ __forceinline__ unsigned xb_xcc_id() { return (unsigned)__builtin_amdgcn_s_getreg((3 << 11) | 20) & 0xFu; }
#define XB_SPIN(cond, bar) do { unsigned _sp = 0; while (cond) { __builtin_amdgcn_s_sleep(1); \
    if ((++_sp & 255u) == 0u) { if (xb_ld(&(bar)[XB_TMO])) break; if (_sp > XB_SPIN_CAP) { atomicAdd(&(bar)[XB_TMO], 1u); break; } } } } while (0)

struct XcdBarrier {
    unsigned* bar; unsigned x;
    volatile LAS unsigned* st;
};

__device__ __forceinline__ XcdBarrier xcd_barrier_post(unsigned* bar, volatile LAS unsigned* st) {
    XcdBarrier b; b.bar = bar; b.x = xb_xcc_id(); b.st = st;
    if (threadIdx.x == 0) (void)xb_add(&bar[XB_XCNT(b.x)], 1u);
    return b;
}
__device__ __forceinline__ void xcd_barrier_complete(unsigned* bar, unsigned x, unsigned& nloc, unsigned& nx) {
    const unsigned G = gridDim.x * gridDim.y * gridDim.z;
    unsigned sum, cnt, mine, sp = 0u;
    for (;;) {
        sum = 0u; cnt = 0u; mine = 0u;
#pragma unroll
        for (unsigned j = 0; j < 16; ++j) { const unsigned c = xb_ld(&bar[XB_XCNT(j)]); sum += c; cnt += (c > 0u) ? 1u : 0u; mine = (j == x) ? c : mine; }
        if (sum == G) break;
        __builtin_amdgcn_s_sleep(1);
        if ((++sp & 255u) == 0u) { if (xb_ld(&bar[XB_TMO])) break; if (sp > XB_SPIN_CAP) { atomicAdd(&bar[XB_TMO], 1u); break; } }
    }
    nloc = mine > 0u ? mine : 1u; nx = cnt > 0u ? cnt : 1u;
}

__device__ __forceinline__ void xcd_barrier(const XcdBarrier& b) {
    asm volatile("s_waitcnt vmcnt(0)" ::: "memory");
    __syncthreads();
    if (threadIdx.x == 0) {
        unsigned* bar = b.bar;
        __builtin_amdgcn_s_waitcnt(0);
        unsigned nloc = b.st[0], nx = b.st[1];
        if (nloc == 0u) { xcd_barrier_complete(bar, b.x, nloc, nx); b.st[0] = nloc; b.st[1] = nx; }
        const unsigned old = xb_add(&bar[XB_XSUB(b.x)], 1u);
        const unsigned gen = old / nloc;
        if (old + 1u == (gen + 1u) * nloc) {
            __builtin_amdgcn_fence(__ATOMIC_RELEASE, "agent");
            asm volatile("s_waitcnt vmcnt(0)" ::: "memory");
            const unsigned og = xb_add(&bar[XB_TOP], 1u);
            const unsigned tg = og / nx;
            if (og + 1u == (tg + 1u) * nx) xb_add(&bar[XB_TOPGEN], 1u);
            else XB_SPIN(xb_ld(&bar[XB_TOPGEN]) == tg, bar);
            __builtin_amdgcn_fence(__ATOMIC_ACQUIRE, "agent");
            xb_add(&bar[XB_XGEN(b.x)], 1u);
            asm volatile("s_waitcnt vmcnt(0)" ::: "memory");
        } else {
            XB_SPIN(xb_ld(&bar[XB_XGEN(b.x)]) == gen, bar);
            __builtin_amdgcn_fence(__ATOMIC_ACQUIRE, "agent");
            asm volatile("s_waitcnt vmcnt(0)" ::: "memory");
        }
    }
    __syncthreads();
}

constexpr int PH_PER_LAYER = 11, N_PHASES = 1 + DEPTH * PH_PER_LAYER + 1;
template <int EN_MASK, bool EN_GEMM>
__device__ __forceinline__ void fwd_body(const Params& p) {
    extern __shared__ __attribute__((aligned(16))) unsigned char lds[];
    cg::grid_group grid = cg::this_grid();
    const int G = gridDim.x, NGW = G * 8;
    unsigned char* ws = p.ws;
    volatile LAS unsigned* MISC = (volatile LAS unsigned*)((LAS unsigned char*)lds + 132096);
    if (threadIdx.x < 2) MISC[threadIdx.x] = 0u;
    __syncthreads();
    XcdBarrier xbar = xcd_barrier_post((unsigned*)(ws + O_CTL), MISC);
    float* mod = (float*)(ws + O_MOD); float* X = (float*)(ws + O_X); bf16_t* H = (bf16_t*)(ws + O_H);
    for (int ph = p.ph_lo; ph < p.ph_hi; ++ph) {
        int tid = threadIdx.x; asm volatile("" : "+v"(tid));
        const int lane = tid & 63, wid = __builtin_amdgcn_readfirstlane(tid >> 6); const int gw = blockIdx.x * 8 + wid;
        if (ph == 0) { if constexpr (EN_MASK != 0) phase_pre(p, lds, tid); }
        else if (ph == N_PHASES - 1) { if constexpr (EN_MASK != 0) final_norm_rows(X, PIN(25), p.out, gw, NGW, lane); }
        else {
            const int l = (ph - 1) / PH_PER_LAYER, k = (ph - 1) % PH_PER_LAYER;
            const float* modl = mod + (size_t)l * 4 * 6144;
            const float* xin = (l == 0) ? PIN(0) : X;
            if (k == 1 || k == 6 || k == 7 || k == 9 || k == 10) { if constexpr (EN_GEMM) {
                const int nsub = (k == 6) ? 4 : 1;
#pragma unroll 1
                for (int br = 0; br < nsub; ++br) {
                    EpiU E{}; const bf16_t* A; const bf16_t* Bt; int lda, N, K;
                    if (k == 1) { E.kind = 0; E.p1 = ws; A = H; lda = 1024; Bt = (const bf16_t*)(ws + O_WIN); N = NPROJ - 256; K = 1024; }
                    else if (k == 6) {
                        const size_t aoffs = (br == 0) ? O_UV : (br == 1) ? O_FQKV : (br == 2) ? O_MQKV : O_Z;
                        const size_t woffs = (br == 0) ? O_WA : (br == 1) ? O_WB : (br == 2) ? O_WC : O_WD;
                        E.kind = 1; E.p0 = (const unsigned char*)(ws + O_GATE) + br * 1024; E.p1 = (float*)(ws + O_MF32); E.p2 = H; E.mode = (br == 0) ? 0 : (br == 3) ? 2 : 1;
                        A = (const bf16_t*)(ws + aoffs); lda = (br == 0) ? 1024 : (br == 3) ? 768 : 1536; Bt = (const bf16_t*)(ws + woffs); N = 1024; K = (br == 3) ? 768 : 512; }
                    else if (k == 7) { E.kind = 2; E.p0 = xin; E.p1 = X; E.p2 = (void*)(modl + 2048); A = H; lda = 1024; Bt = (const bf16_t*)(ws + O_WO); N = 1024; K = 1024; }
                    else if (k == 9) { E.kind = 3; E.p1 = (bf16_t*)(ws + O_HID); A = H; lda = 1024; Bt = (const bf16_t*)(ws + O_W1); N = 4096; K = 1024; }
                    else { E.kind = 2; E.p0 = X; E.p1 = X; E.p2 = (void*)(modl + 5120); A = (const bf16_t*)(ws + O_HID); lda = 4096; Bt = (const bf16_t*)(ws + O_W2); N = 1024; K = 4096; }
#ifdef PROBE_DUP_GEMM
                    E.dry = (p.ph_lo == 0); run_gemm(lds, A, lda, Bt, N, K, E); E.dry = 0;
#endif
#ifndef STAGGER_TICKS
#define STAGGER_TICKS 0
#endif
                    if (STAGGER_TICKS > 0 && (k == 1 || k == 9)) {
                        const unsigned long long t0 = __builtin_amdgcn_s_memrealtime(); const unsigned long long dl = (unsigned long long)(((blockIdx.x >> 3) & 3) * STAGGER_TICKS);
                        while (__builtin_amdgcn_s_memrealtime() - t0 < dl) __builtin_amdgcn_s_sleep(16);
                    }
                    run_gemm(lds, A, lda, Bt, N, K, E);
                }
                if (k == 1) for (int it = gw; it < 1024; it += NGW) small_cols_item((const bf16_t*)H, (const bf16_t*)(ws + O_WIN) + (size_t)10240 * 1024, (float*)(ws + O_SMALL), it, lane);
            } } else switch (k) {
            case 0: if constexpr ((EN_MASK >> 0) & 1) {
#ifdef PROBE_A
                convert_weights(p, l, lds, gw, NGW, wid, lane); norm_mod_rows(xin, PIN(4) + l * 1024, modl + 0, modl + 1024, H, gw, NGW, lane);
#endif
                convert_weights(p, l, lds, gw, NGW, wid, lane);
                norm_mod_rows(xin, PIN(4) + l * 1024, modl + 0, modl + 1024, H, gw, NGW, lane);
            } break;
            case 2: if constexpr ((EN_MASK >> 2) & 1) {
#ifdef PROBE_C
                { const bool dry = (p.ph_lo == 0);
                for (int it = blockIdx.x; it < 1024; it += G) gmlp_item(p, l, lds, it, wid, lane, dry);
                for (int it = blockIdx.x; it < 512; it += G) rotary_item(p, lds, it, tid, dry);
                for (int it = blockIdx.x; it < 1280; it += G) conv_item(p, l, it, tid);
                for (int it = gw; it < 1536; it += NGW) acum_item(p, l, it, lane);
                for (int it = NGW - 1 - gw; it < 32; it += NGW) foxcum_item(p, l, it, lane); }
#endif
                for (int it = blockIdx.x; it < 256; it += G) gmlp_item(p, l, lds, it, wid, lane);
                for (int it = blockIdx.x; it < 512; it += G) rotary_item(p, lds, it, tid);
                for (int it = blockIdx.x; it < 1280; it += G) conv_item(p, l, it, tid);
                for (int it = gw; it < 1536; it += NGW) acum_item(p, l, it, lane);
                for (int it = NGW - 1 - gw; it < 32; it += NGW) foxcum_item(p, l, it, lane);
            } break;
            case 3: if constexpr ((EN_MASK >> 3) & 1) {
#ifndef EN3
#define EN3 7
#endif
                { unsigned* qctr = (unsigned*)(ws + O_CTL) + 3584 + 64 * l;
                  volatile unsigned* slot = (volatile unsigned*)(lds + 131584);
                  for (;;) {
                      if (tid == 0) *slot = atomicAdd(qctr, 1u);
                      __syncthreads();
                      const unsigned it = (unsigned)__builtin_amdgcn_readfirstlane((int)*slot);
                      __syncthreads();
                      if (it >= 1024u) break;
                      const int qb = 15 - (int)(it >> 6), sub = (int)(it & 63u), bh = sub & 31;
                      if (sub < 32) attn_block_item<false>(p, lds, bh >> 3, bh & 7, qb, tid, wid, lane);
                      else attn_block_item<true>(p, lds, bh >> 3, bh & 7, qb, tid, wid, lane);
                  } }
                if constexpr (EN3 & 4) for (int i = NGW - 1 - gw; i < 1536; i += NGW) ssd_states_item(p, i, lane);
            } break;
            case 4: if constexpr ((EN_MASK >> 4) & 1) {
#ifdef PROBE_EF
                ssd_scan(p, blockIdx.x * 512 + tid, G * 512);
#endif
                ssd_scan(p, blockIdx.x * 512 + tid, G * 512); } break;
            case 5: if constexpr ((EN_MASK >> 5) & 1) {
#ifdef PROBE_EF
                for (int it = blockIdx.x; it < 256; it += G) ssd_out_item(p, l, it, wid, lane, p.ph_lo == 0);
#endif
                for (int it = blockIdx.x; it < 256; it += G) ssd_out_item(p, l, it, wid, lane); } break;
            case 8: if constexpr ((EN_MASK >> 8) & 1) { norm_mod_rows(X, PIN(22) + l * 1024, modl + 3072, modl + 4096, H, gw, NGW, lane); } break;
            }
        }
        if (ph + 1 < p.ph_hi) { if (ph == 0) grid.sync(); else xcd_barrier(xbar); }
#ifdef PROBE_SYNC
        if (ph + 1 < p.ph_hi) { xcd_barrier(xbar); xcd_barrier(xbar); }
#endif
    }
}

#ifndef N_LAUNCH_MODE
#define N_LAUNCH_MODE 1
#endif
#if N_LAUNCH_MODE == 1
__global__ void __launch_bounds__(512, 2) fwd_all(Params p) { fwd_body<0x7ff, true>(p); }
#define KERNEL_FOR_ATTR fwd_all
#else
__global__ void __launch_bounds__(512, 2) fwd_gemm(Params p) { fwd_body<0, true>(p); }
__global__ void __launch_bounds__(512, 2) fwd_misc(Params p) { fwd_body<0x7ff, false>(p); }
#endif
extern "C" void kernel_launch(void* const* d_in, const int* in_sizes, int n_in, void* d_out, int out_size, void* d_ws, size_t ws_size, hipStream_t stream) {
    static int grid = 0;
    if (grid == 0) {
        if (n_in != 26 || out_size != T * DM || ws_size < WS_END) { fprintf(stderr, "kernel_launch: unexpected shapes (n_in %d out %d ws %zu need %zu)\n", n_in, out_size, ws_size, (size_t)WS_END); grid = -1; return; }
        int dev = 0, cus = 0;
        (void)hipGetDevice(&dev); (void)hipDeviceGetAttribute(&cus, hipDeviceAttributeMultiprocessorCount, dev);
#if N_LAUNCH_MODE == 1
        if (hipFuncSetAttribute((const void*)fwd_all, hipFuncAttributeMaxDynamicSharedMemorySize, LDS_BYTES) != hipSuccess) { fprintf(stderr, "kernel_launch: hipFuncSetAttribute failed\n"); grid = -1; return; }
#else
        if (hipFuncSetAttribute((const void*)fwd_gemm, hipFuncAttributeMaxDynamicSharedMemorySize, LDS_BYTES) != hipSuccess || hipFuncSetAttribute((const void*)fwd_misc, hipFuncAttributeMaxDynamicSharedMemorySize, LDS_BYTES) != hipSuccess) { fprintf(stderr, "kernel_launch: hipFuncSetAttribute failed\n"); grid = -1; return; }
#endif
        (void)hipGetLastError();
        grid = cus > 0 ? cus : 256;
    }
    if (grid < 0) return;
    if (hipMemsetAsync((char*)d_ws + O_CTL, 0, 16384, stream) != hipSuccess) { fprintf(stderr, "kernel_launch: memset failed\n"); return; }
    Params p{};
    for (int i = 0; i < 26; ++i) p.in[i] = (const float*)d_in[i];
    p.out = (float*)d_out; p.ws = (unsigned char*)d_ws;
#if N_LAUNCH_MODE == 1
    p.ph_lo = 0; p.ph_hi = N_PHASES;
    void* args[] = {&p};
    hipError_t e = hipLaunchCooperativeKernel((const void*)fwd_all, dim3(grid), dim3(512), args, LDS_BYTES, stream);
    if (e != hipSuccess) fprintf(stderr, "kernel_launch: cooperative launch failed: %s (grid %d)\n", hipGetErrorString(e), grid);
#else
    for (int ph = 0; ph < N_PHASES; ++ph) { p.ph_lo = ph; p.ph_hi = ph + 1;
        const int k = (ph >= 1 && ph < N_PHASES - 1) ? (ph - 1) % PH_PER_LAYER : -1;
        if (k == 1 || k == 6 || k == 7 || k == 9 || k == 10) hipLaunchKernelGGL(fwd_gemm, dim3(grid), dim3(512), LDS_BYTES, stream, p);
        else hipLaunchKernelGGL(fwd_misc, dim3(grid), dim3(512), LDS_BYTES, stream, p); }
#endif
}
```

```cpp
#include <hip/hip_runtime.h>
#include <hip/hip_cooperative_groups.h>
#include <cstdio>
#include <cstdint>
#include <cmath>
namespace cg = cooperative_groups;
namespace pg8 {
#define PG8_LAS __attribute__((address_space(3)))
typedef unsigned short bf16_t;
typedef short bf16x8 __attribute__((ext_vector_type(8)));
typedef float f32x4 __attribute__((ext_vector_type(4)));
typedef unsigned u32x4 __attribute__((ext_vector_type(4)));
constexpr int BM = 256, BK = 64, HALF = 128, HTB = HALF * BK * 2  , STAGE_BYTES = 8 * HTB, NXCD = 8, WGM = 8;

__host__ __device__ __forceinline__ int lds_byte(int r, int c) { const int st = (r >> 4) * 2 + (c >> 5), rr = r & 15, cc = c & 31, ob = rr * 64 + cc * 2; return st * 1024 + (ob ^ (((ob >> 9) & 1) << 5)); }
__host__ __device__ __forceinline__ void stage_rc(int b, int& R, int& C) { const int st = b / 1024, sb = b % 1024, swz = sb ^ (((sb >> 9) & 1) << 5); R = (st >> 1) * 16 + swz / 64; C = (st & 1) * 32 + (swz % 64) / 2; }
__host__ __device__ __forceinline__ int perm32(int rho) { const int n = rho >> 4, i = rho & 15; return 8 * (i >> 2) + 4 * n + (i & 3); }

struct Unit { int pm, pn; };
struct Gemm { const bf16_t* A; const bf16_t* Bt; int M, N, K, lda; };

struct StaticOrder {
    int nM, nN, nwg, G, c;
    __host__ __device__ void init(int M, int N, int G_, int c_) { nM = M / BM; nN = N / BM; nwg = nM * nN; G = G_; c = c_; }
    __host__ __device__ bool next(int i, Unit& u) const {
        const long L = (long)i * G + c; if (L >= nwg) return false;
        int wgid = (int)L; { const int q = nwg / NXCD, r = nwg % NXCD, xcd = wgid % NXCD, off = wgid / NXCD; wgid = (xcd < r ? xcd * (q + 1) : r * (q + 1) + (xcd - r) * q) + off; }
        const int nig = WGM * nN, gid = wgid / nig, fm = gid * WGM, gsz = (nM - fm) < WGM ? (nM - fm) : WGM;
        u.pm = fm + ((wgid % nig) % gsz); u.pn = (wgid % nig) / gsz; return true;
    }
    __device__ __forceinline__ void a_ready(const Unit&) const {}
    __device__ __forceinline__ void done(const Unit&) const {}
};


template <class Epi, class Sched, bool ALIGN_EPI = false, bool SP2 = false>
__device__ __forceinline__ void gemm_phase(PG8_LAS unsigned char* lds, const Gemm g, const Sched& S, const Epi& E) {
    int tid_l = threadIdx.x; asm volatile("" : "+v"(tid_l));
    const int tid = tid_l, wid = __builtin_amdgcn_readfirstlane(tid >> 6), lane = tid & 63, wr = wid >> 2, wc = wid & 3, fr = lane & 15, fq = lane >> 4;
    const int K = g.K, nt = K / BK;
    unsigned voffA[2], voffB[2];
#pragma unroll
    for (int i = 0; i < 2; ++i) { int R, C; stage_rc(tid * 16 + i * 8192, R, C); const int Rb = Epi::PERM ? ((R & ~31) + perm32(R & 31)) : R;
        voffA[i] = (unsigned)(R * g.lda + C) * 2u; voffB[i] = (unsigned)(Rb * K + C) * 2u; }
    const size_t kstep = (size_t)(BK * 2);
    const size_t hstepB = (size_t)HALF * K * 2, hstepA = (size_t)HALF * g.lda * 2;
    const size_t tstepB = 2 * hstepB, tstepA = 2 * hstepA;
    const unsigned ldsw = (unsigned)wid * 1024u;
    const int aoff = lds_byte(wr * 64 + fr, fq * 8), boff = lds_byte(wc * 32 + fr, fq * 8);
#define PG8_SA(b, h) (((b) * 2 + (h)) * HTB)
#define PG8_SB(b, h) ((4 + (b) * 2 + (h)) * HTB)
#define PG8_STAGE(bufoff, gbase, voff) do { _Pragma("unroll") for (int _i = 0; _i < 2; ++_i) \
        __builtin_amdgcn_global_load_lds((const unsigned*)((const char*)(gbase) + (voff)[_i]), (PG8_LAS unsigned*)(lds + (bufoff) + ldsw + _i * 8192), 16, 0, 0); } while (0)
#define PG8_LDA(dst, b, h) do { _Pragma("unroll") for (int m = 0; m < 4; ++m) _Pragma("unroll") for (int k = 0; k < 2; ++k) dst[m][k] = *(const PG8_LAS bf16x8*)(lds + PG8_SA(b, h) + aoff + m * 2048 + k * 1024); } while (0)
#define PG8_LDB(dst, b, h) do { _Pragma("unroll") for (int n = 0; n < 2; ++n) _Pragma("unroll") for (int k = 0; k < 2; ++k) dst[n][k] = *(const PG8_LAS bf16x8*)(lds + PG8_SB(b, h) + boff + n * 2048 + k * 1024); } while (0)
#define PG8_MMA(ai, bj, At, Bt) do { __builtin_amdgcn_s_setprio(1); _Pragma("unroll") for (int m = 0; m < 4; ++m) _Pragma("unroll") for (int n = 0; n < 2; ++n) _Pragma("unroll") for (int k = 0; k < 2; ++k) \
        acc[ai][bj][m][n] = __builtin_amdgcn_mfma_f32_16x16x32_bf16(Bt[n][k], At[m][k], acc[ai][bj][m][n], 0, 0, 0); __builtin_amdgcn_s_setprio(0); } while (0)
#define PG8_WAIT_V(n) asm volatile("s_waitcnt vmcnt(" #n ")" ::: "memory")
#define PG8_WAIT_L(n) asm volatile("s_waitcnt lgkmcnt(" #n ")" ::: "memory")
#define PG8_BAR __builtin_amdgcn_s_barrier()
#define PG8_SCHED __builtin_amdgcn_sched_barrier(0)
    Unit cur, nxt; int ui = 0;
    if (!S.next(0, cur)) return;
    f32x4 acc[2][2][4][2];
#pragma unroll
    for (int a = 0; a < 2; ++a)
#pragma unroll
        for (int b = 0; b < 2; ++b)
#pragma unroll
            for (int m = 0; m < 4; ++m)
#pragma unroll
                for (int n = 0; n < 2; ++n) acc[a][b][m][n] = (f32x4){0.f, 0.f, 0.f, 0.f};
    bf16x8 At[4][2], B0[2][2], B1[2][2];
    const char* cA = (const char*)g.A + (size_t)cur.pm * tstepA; const char* cB = (const char*)g.Bt + (size_t)cur.pn * tstepB;
    S.a_ready(cur);
    if constexpr (SP2) {
        PG8_STAGE(PG8_SB(0, 0), cB, voffB); PG8_STAGE(PG8_SB(0, 1), cB + hstepB, voffB); PG8_STAGE(PG8_SA(0, 0), cA, voffA); PG8_STAGE(PG8_SA(0, 1), cA + hstepA, voffA);
        if (wr == 1) PG8_BAR;
        PG8_WAIT_V(2); PG8_BAR;
        PG8_STAGE(PG8_SB(1, 0), cB + kstep, voffB); PG8_STAGE(PG8_SA(1, 0), cA + kstep, voffA); PG8_STAGE(PG8_SB(1, 1), cB + hstepB + kstep, voffB);
        PG8_WAIT_V(6); PG8_BAR;
    } else {
        PG8_STAGE(PG8_SB(0, 0), cB, voffB); PG8_STAGE(PG8_SA(0, 0), cA, voffA); PG8_STAGE(PG8_SB(0, 1), cB + hstepB, voffB); PG8_STAGE(PG8_SA(0, 1), cA + hstepA, voffA);
        if (wr == 1) PG8_BAR;
        PG8_WAIT_V(4); PG8_BAR;
        PG8_STAGE(PG8_SB(1, 0), cB + kstep, voffB); PG8_STAGE(PG8_SA(1, 0), cA + kstep, voffA); PG8_STAGE(PG8_SB(1, 1), cB + hstepB + kstep, voffB);
        PG8_WAIT_V(6); PG8_BAR;
    }
    for (;;) {
        const bool has_next = S.next(ui + 1, nxt);
        const char* nA = has_next ? (const char*)g.A + (size_t)nxt.pm * tstepA : cA; const char* nB = has_next ? (const char*)g.Bt + (size_t)nxt.pn * tstepB : cB;
        for (int t = 0; t < nt; t += 2) {
            const bool last = (t == nt - 2);
            const char* a1 = cA + (size_t)(t + 1) * kstep;
            const char* a2 = last ? nA : cA + (size_t)(t + 2) * kstep; const char* b2 = last ? nB : cB + (size_t)(t + 2) * kstep;
            const char* a3 = a2 + kstep; const char* b3 = b2 + kstep;
            if (last && has_next) S.a_ready(nxt);
            if constexpr (SP2) {
            PG8_LDB(B0, 0, 0); PG8_LDB(B1, 0, 1); PG8_SCHED; PG8_LDA(At, 0, 0); PG8_STAGE(PG8_SA(1, 1), a1 + hstepA, voffA);
            PG8_WAIT_V(8); PG8_WAIT_L(0); PG8_BAR; PG8_MMA(0, 0, At, B0); PG8_MMA(0, 1, At, B1); PG8_BAR; PG8_SCHED;
            PG8_LDA(At, 0, 1); PG8_STAGE(PG8_SB(0, 0), b2, voffB); PG8_STAGE(PG8_SB(0, 1), b2 + hstepB, voffB); PG8_STAGE(PG8_SA(0, 0), a2, voffA);
            PG8_WAIT_V(8); PG8_WAIT_L(0); PG8_BAR; PG8_MMA(1, 0, At, B0); PG8_MMA(1, 1, At, B1); PG8_BAR; PG8_SCHED;
            PG8_LDB(B0, 1, 0); PG8_LDB(B1, 1, 1); PG8_SCHED; PG8_LDA(At, 1, 0); PG8_STAGE(PG8_SA(0, 1), a2 + hstepA, voffA);
            PG8_WAIT_V(8); PG8_WAIT_L(0); PG8_BAR; PG8_MMA(0, 0, At, B0); PG8_MMA(0, 1, At, B1); PG8_BAR; PG8_SCHED;
            PG8_LDA(At, 1, 1); PG8_STAGE(PG8_SB(1, 0), b3, voffB); PG8_STAGE(PG8_SB(1, 1), b3 + hstepB, voffB); PG8_STAGE(PG8_SA(1, 0), a3, voffA);
            PG8_WAIT_V(8); PG8_WAIT_L(0); PG8_BAR; PG8_MMA(1, 0, At, B0); PG8_MMA(1, 1, At, B1); PG8_BAR; PG8_SCHED;
            } else {
            PG8_LDB(B0, 0, 0); PG8_SCHED; PG8_LDA(At, 0, 0); PG8_STAGE(PG8_SA(1, 1), a1 + hstepA, voffA);
            PG8_WAIT_L(8); PG8_BAR; PG8_WAIT_L(0); PG8_MMA(0, 0, At, B0); PG8_BAR; PG8_SCHED;
            PG8_LDB(B1, 0, 1); PG8_STAGE(PG8_SB(0, 0), b2, voffB);
            PG8_BAR; PG8_WAIT_L(0); PG8_MMA(0, 1, At, B1); PG8_BAR;
            PG8_LDA(At, 0, 1); PG8_STAGE(PG8_SA(0, 0), a2, voffA);
            PG8_BAR; PG8_WAIT_L(0); PG8_MMA(1, 0, At, B0); PG8_BAR; PG8_SCHED;
            PG8_STAGE(PG8_SB(0, 1), b2 + hstepB, voffB);
            PG8_WAIT_V(6); PG8_BAR; PG8_MMA(1, 1, At, B1); PG8_BAR;
            PG8_LDB(B0, 1, 0); PG8_SCHED; PG8_LDA(At, 1, 0); PG8_STAGE(PG8_SA(0, 1), a2 + hstepA, voffA);
            PG8_WAIT_L(8); PG8_BAR; PG8_WAIT_L(0); PG8_MMA(0, 0, At, B0); PG8_BAR; PG8_SCHED;
            PG8_LDB(B1, 1, 1); PG8_STAGE(PG8_SB(1, 0), b3, voffB);
            PG8_BAR; PG8_WAIT_L(0); PG8_MMA(0, 1, At, B1); PG8_BAR;
            PG8_LDA(At, 1, 1); PG8_STAGE(PG8_SA(1, 0), a3, voffA);
            PG8_BAR; PG8_WAIT_L(0); PG8_MMA(1, 0, At, B0); PG8_BAR; PG8_SCHED;
            PG8_STAGE(PG8_SB(1, 1), b3 + hstepB, voffB);
            PG8_WAIT_V(6); PG8_BAR; PG8_MMA(1, 1, At, B1); PG8_BAR;
            }
        }
        if constexpr (ALIGN_EPI) { if (wr == 0) PG8_BAR; }
        if constexpr (!Epi::AFTER_DRAIN) { E(acc, cur, wr, wc, fr, fq); S.done(cur); }
        if (!has_next) break;
#pragma unroll
        for (int a = 0; a < 2; ++a)
#pragma unroll
            for (int b = 0; b < 2; ++b)
#pragma unroll
                for (int m = 0; m < 4; ++m)
#pragma unroll
                    for (int n = 0; n < 2; ++n) acc[a][b][m][n] = (f32x4){0.f, 0.f, 0.f, 0.f};
        cur = nxt; cA = nA; cB = nB; ++ui;
        if constexpr (ALIGN_EPI) { if (wr == 1) PG8_BAR; }
    }
    PG8_WAIT_V(0);
    if constexpr (!ALIGN_EPI) { if (wr == 0) PG8_BAR; }
    PG8_BAR;
    if constexpr (Epi::AFTER_DRAIN) { E.fused(acc, cur, wr, wc, fr, fq, lds, wid, lane); S.done(cur); }
#undef PG8_SA
#undef PG8_SB
#undef PG8_STAGE
#undef PG8_LDA
#undef PG8_LDB
#undef PG8_MMA
#undef PG8_WAIT_V
#undef PG8_WAIT_L
#undef PG8_BAR
#undef PG8_SCHED
}
}

constexpr int NB = 4, SEQ = 4096, T = NB * SEQ, DM = 1024, DEPTH = 4;
constexpr int NPROJ = 10496;
constexpr int IN_COLS = 10260;
constexpr float NORM_EPS = 1e-6f;
constexpr float LOG2E = 1.4426950408889634f;

typedef unsigned short bf16_t;
typedef short bf16x8 __attribute__((ext_vector_type(8)));
typedef float f32x4 __attribute__((ext_vector_type(4)));
typedef float f32x2 __attribute__((ext_vector_type(2)));
typedef unsigned u32x4 __attribute__((ext_vector_type(4)));
typedef unsigned u32x2 __attribute__((ext_vector_type(2)));
typedef __bf16 bf16x2_t __attribute__((ext_vector_type(2)));

constexpr size_t MiB = 1u << 20;
constexpr size_t O_MOD = 0, O_X = 1 * MiB, O_H = 65 * MiB, O_UV = 97 * MiB, O_FQKV = 129 * MiB, O_MQKV = 177 * MiB, O_Z = 225 * MiB,
                 O_XBC = 249 * MiB, O_GATE = 289 * MiB, O_SMALL = 417 * MiB, O_VTF = 419 * MiB, O_VTM = 435 * MiB, O_XT = 451 * MiB,
                 O_BC = 475 * MiB, O_BT = 491 * MiB, O_ST = 499 * MiB, O_CUMF = 547 * MiB, O_ACUM = 548 * MiB, O_KMEAN = 549 * MiB,
                 O_WIN = 550 * MiB, O_WA = 571 * MiB, O_WB = 572 * MiB, O_WC = 573 * MiB, O_WD = 574 * MiB, O_WO = 576 * MiB,
                 O_W1 = 578 * MiB, O_W2 = 586 * MiB, O_GWS = 594 * MiB, WS_END = 595 * MiB;
constexpr size_t O_ROT = O_GWS + 512 * 1024;
constexpr size_t O_DT = O_KMEAN + 256 * 1024;
constexpr size_t O_CTL = 512 * 1024;
constexpr size_t O_PREV = O_XBC;
constexpr size_t O_HID = O_GATE;
constexpr size_t O_MF32 = O_VTF;
constexpr int LDS_BYTES = 147456;

struct Params { const float* in[26]; float* out; unsigned char* ws; int ph_lo, ph_hi; };

__device__ __forceinline__ int opq(int i) { asm volatile("" : "+s"(i)); return i; }
#define PIN(i) (p.in[opq(i)])
__device__ __forceinline__ unsigned cvtpk(float lo, float hi) { f32x2 v = {lo, hi}; bf16x2_t b = __builtin_convertvector(v, bf16x2_t); return __builtin_bit_cast(unsigned, b); }
__device__ __forceinline__ float bf2f(short h) { return __uint_as_float(((unsigned)(unsigned short)h) << 16); }
__device__ __forceinline__ float bflo(unsigned w) { return __uint_as_float(w << 16); }
__device__ __forceinline__ float bfhi(unsigned w) { return __uint_as_float(w & 0xffff0000u); }
__device__ __forceinline__ bf16x8 pack8(float a0, float a1, float a2, float a3, float a4, float a5, float a6, float a7) {
    u32x4 w = {cvtpk(a0, a1), cvtpk(a2, a3), cvtpk(a4, a5), cvtpk(a6, a7)}; return __builtin_bit_cast(bf16x8, w); }
__device__ __forceinline__ bf16x8 ld2x8(const bf16_t* p0, const bf16_t* p1) { const u32x2 a = *(const u32x2*)p0, b = *(const u32x2*)p1; u32x4 w = {a.x, a.y, b.x, b.y}; return __builtin_bit_cast(bf16x8, w); }
typedef short s16x4_t __attribute__((ext_vector_type(4)));
__device__ __forceinline__ s16x4_t lds_tr(const bf16_t* p) { return __builtin_bit_cast(s16x4_t, __builtin_amdgcn_ds_read_tr16_b64_v4i16((__attribute__((address_space(3))) s16x4_t*)p)); }
__device__ __forceinline__ bf16x8 cat4(s16x4_t a, s16x4_t b) { return (bf16x8){a[0], a[1], a[2], a[3], b[0], b[1], b[2], b[3]}; }
__device__ __forceinline__ f32x4 mfma16(bf16x8 a, bf16x8 b, f32x4 c) { return __builtin_amdgcn_mfma_f32_16x16x32_bf16(a, b, c, 0, 0, 0); }
__device__ __forceinline__ float dpp_add(float v, const int ctrl_sel) {
    const int iv = __builtin_bit_cast(int, v); int m;
    if (ctrl_sel == 0) m = __builtin_amdgcn_update_dpp(0, iv, 0xB1, 0xF, 0xF, true);
    else if (ctrl_sel == 1) m = __builtin_amdgcn_update_dpp(0, iv, 0x4E, 0xF, 0xF, true);
    else if (ctrl_sel == 2) m = __builtin_amdgcn_update_dpp(0, iv, 0x141, 0xF, 0xF, true);
    else m = __builtin_amdgcn_update_dpp(0, iv, 0x140, 0xF, 0xF, true);
    return v + __builtin_bit_cast(float, m); }
__device__ __forceinline__ float row16_sum(float v) { v = dpp_add(v, 0); v = dpp_add(v, 1); v = dpp_add(v, 2); v = dpp_add(v, 3); return v; }
__device__ __forceinline__ float wave_sum(float v) { v = row16_sum(v); v += __shfl_xor(v, 16); v += __shfl_xor(v, 32); return v; }
__device__ __forceinline__ float ex2(float x) { return __builtin_amdgcn_exp2f(x); }
__device__ __forceinline__ float sigmoidf_(float x) { return 1.f / (1.f + __expf(-x)); }
__device__ __forceinline__ float softplusf_(float x) { return fmaxf(x, 0.f) + log1pf(expf(-fabsf(x))); }
#define LDS_WAIT() asm volatile("s_waitcnt lgkmcnt(0)" ::: "memory")
#define VM_WAIT() asm volatile("s_waitcnt vmcnt(0)" ::: "memory")

#define EPI_LANE_SETUP() int t_ = threadIdx.x; asm volatile("" : "+v"(t_)); const int fr = t_ & 15, fq = (t_ >> 4) & 3; const int wv_ = __builtin_amdgcn_readfirstlane(t_ >> 6); const int wr = wv_ >> 2, wc = wv_ & 3
__device__ __forceinline__ unsigned pk4u8(float a, float b, float c, float d) {
    const unsigned ua = (unsigned)(a * 255.f + 0.5f), ub = (unsigned)(b * 255.f + 0.5f), uc = (unsigned)(c * 255.f + 0.5f), ud = (unsigned)(d * 255.f + 0.5f);
    return ua | (ub << 8) | (uc << 16) | (ud << 24); }
__device__ __forceinline__ float u8f(unsigned w, int i) { return (float)((w >> (8 * i)) & 255u); }
__device__ __forceinline__ float act_unified(float x, int act) {
    const float uu = 1.5957691216057308f * (x + 0.044715f * x * x * x);
    const float arg = (act == 1) ? uu : (act == 0) ? INFINITY : x;
    const float num = (act == 3) ? 1.f : x;
    return num * __builtin_amdgcn_rcpf(1.f + ex2(-LOG2E * arg));
}
struct EpiInproj {
    static constexpr bool PERM = true, AFTER_DRAIN = false;
    unsigned char* ws;
    __device__ __forceinline__ void operator()(const f32x4 (&acc)[2][2][4][2], const pg8::Unit& u, int, int, int, int) const {
        EPI_LANE_SETUP();
        const int pn = u.pn; const int row0 = u.pm * 256 + wr * 64 + fr;
        if (pn == 40) {
            if (wc == 0) {
                float* sm = (float*)(ws + O_SMALL);
#pragma unroll
                for (int ai = 0; ai < 2; ++ai)
#pragma unroll
                    for (int m = 0; m < 4; ++m) { float* rp = sm + (size_t)(row0 + ai * 128 + m * 16) * 32 + 8 * fq;
                        *(f32x4*)rp = acc[ai][0][m][0]; *(f32x4*)(rp + 4) = acc[ai][0][m][1]; }
            }
            return;
        }
        bf16_t* base; int pitch, ct, act;
        if (pn < 4) { base = (bf16_t*)(ws + O_UV); pitch = 1024; ct = pn; act = 1; }
        else if (pn < 10) { base = (bf16_t*)(ws + O_FQKV); pitch = 1536; ct = pn - 4; act = 0; }
        else if (pn < 16) { base = (bf16_t*)(ws + O_MQKV); pitch = 1536; ct = pn - 10; act = 0; }
        else if (pn < 19) { base = (bf16_t*)(ws + O_Z); pitch = 768; ct = pn - 16; act = 2; }
        else if (pn < 24) { base = (bf16_t*)(ws + O_XBC); pitch = 1280; ct = pn - 19; act = 0; }
        else { base = (bf16_t*)(ws + O_GATE); pitch = 4096; ct = pn - 24; act = 3; }
        const int col0 = ct * 256 + wc * 32 + 8 * fq;
#pragma unroll
        for (int ai = 0; ai < 2; ++ai)
#pragma unroll
            for (int m = 0; m < 4; ++m) { bf16_t* rowp = base + (size_t)(row0 + ai * 128 + m * 16) * pitch + col0;
#pragma unroll
                for (int bj = 0; bj < 2; ++bj) { f32x4 v0 = acc[ai][bj][m][0], v1 = acc[ai][bj][m][1];
#pragma unroll
                    for (int j = 0; j < 4; ++j) if (act != 0) { v0[j] = act_unified(v0[j], act); v1[j] = act_unified(v1[j], act); }
                    if (act == 3) {
                        unsigned char* gp = (unsigned char*)(ws + O_GATE) + (size_t)(row0 + ai * 128 + m * 16) * 4096 + col0 + bj * 128;
                        u32x2 q; q.x = pk4u8(v0[0], v0[1], v0[2], v0[3]); q.y = pk4u8(v1[0], v1[1], v1[2], v1[3]);
                        __builtin_nontemporal_store(q, (u32x2*)gp);
                    } else {
                        u32x4 w; w.x = cvtpk(v0[0], v0[1]); w.y = cvtpk(v0[2], v0[3]); w.z = cvtpk(v1[0], v1[1]); w.w = cvtpk(v1[2], v1[3]);
                        __builtin_nontemporal_store(w, (u32x4*)(rowp + bj * 128)); } }
                asm volatile("" ::: "memory"); }
    }
};
struct EpiMerge {
    static constexpr bool PERM = true, AFTER_DRAIN = false;
    const unsigned char* gate; float* mf; bf16_t* outb; int mode;
    __device__ __forceinline__ void operator()(const f32x4 (&acc)[2][2][4][2], const pg8::Unit& u, int, int, int, int) const {
        EPI_LANE_SETUP();
        const int row0 = u.pm * 256 + wr * 64 + fr, col0 = u.pn * 256 + wc * 32 + 8 * fq;
#pragma unroll
        for (int ai = 0; ai < 2; ++ai) {
#pragma unroll
            for (int m = 0; m < 4; ++m) { const size_t row = (size_t)(row0 + ai * 128 + m * 16);
#pragma unroll
                for (int bj = 0; bj < 2; ++bj) { const int col = col0 + bj * 128;
                    const u32x2 gw = *(const u32x2*)(gate + row * 4096 + col);
                    f32x4 v0 = acc[ai][bj][m][0] * (1.f / 255.f), v1 = acc[ai][bj][m][1] * (1.f / 255.f);
                    v0[0] *= u8f(gw.x, 0); v0[1] *= u8f(gw.x, 1); v0[2] *= u8f(gw.x, 2); v0[3] *= u8f(gw.x, 3); v1[0] *= u8f(gw.y, 0); v1[1] *= u8f(gw.y, 1); v1[2] *= u8f(gw.y, 2); v1[3] *= u8f(gw.y, 3);
                    bf16_t* op = outb + row * 1024 + col;
                    if (mode != 0) { const u32x4 pw = *(const u32x4*)op;
                        v0[0] += bflo(pw.x); v0[1] += bfhi(pw.x); v0[2] += bflo(pw.y); v0[3] += bfhi(pw.y); v1[0] += bflo(pw.z); v1[1] += bfhi(pw.z); v1[2] += bflo(pw.w); v1[3] += bfhi(pw.w); }
                    u32x4 w; w.x = cvtpk(v0[0], v0[1]); w.y = cvtpk(v0[2], v0[3]); w.z = cvtpk(v1[0], v1[1]); w.w = cvtpk(v1[2], v1[3]);
                    *(u32x4*)op = w; } }
            asm volatile("" ::: "memory"); }
    }
};
struct EpiResid {
    static constexpr bool PERM = true, AFTER_DRAIN = false;
    const float* xin; float* xout; const float* gmod;
    __device__ __forceinline__ void operator()(const f32x4 (&acc)[2][2][4][2], const pg8::Unit& u, int, int, int, int) const {
        EPI_LANE_SETUP();
        const int row0 = u.pm * 256 + wr * 64 + fr, col0 = u.pn * 256 + wc * 32 + 8 * fq; const int b = u.pm >> 4;
        const float* gp = gmod + (size_t)b * 6144 + col0;
        const f32x4 g00 = *(const f32x4*)gp, g01 = *(const f32x4*)(gp + 4), g10 = *(const f32x4*)(gp + 128), g11 = *(const f32x4*)(gp + 132);
#pragma unroll
        for (int ai = 0; ai < 2; ++ai) {
#pragma unroll
            for (int m = 0; m < 4; ++m) { const size_t off = (size_t)(row0 + ai * 128 + m * 16) * 1024 + col0;
                *(f32x4*)(xout + off) = *(const f32x4*)(xin + off) + g00 * acc[ai][0][m][0];
                *(f32x4*)(xout + off + 4) = *(const f32x4*)(xin + off + 4) + g01 * acc[ai][0][m][1];
                *(f32x4*)(xout + off + 128) = *(const f32x4*)(xin + off + 128) + g10 * acc[ai][1][m][0];
                *(f32x4*)(xout + off + 132) = *(const f32x4*)(xin + off + 132) + g11 * acc[ai][1][m][1]; }
            asm volatile("" ::: "memory"); }
    }
};
struct EpiRelu2 {
    static constexpr bool PERM = true, AFTER_DRAIN = false;
    bf16_t* out;
    __device__ __forceinline__ void operator()(const f32x4 (&acc)[2][2][4][2], const pg8::Unit& u, int, int, int, int) const {
        EPI_LANE_SETUP();
        const int row0 = u.pm * 256 + wr * 64 + fr, col0 = u.pn * 256 + wc * 32 + 8 * fq;
#pragma unroll
        for (int ai = 0; ai < 2; ++ai)
#pragma unroll
            for (int m = 0; m < 4; ++m) { bf16_t* rowp = out + (size_t)(row0 + ai * 128 + m * 16) * 4096 + col0;
#pragma unroll
                for (int bj = 0; bj < 2; ++bj) { f32x4 v0 = acc[ai][bj][m][0], v1 = acc[ai][bj][m][1];
#pragma unroll
                    for (int j = 0; j < 4; ++j) { const float r0 = fmaxf(v0[j], 0.f), r1 = fmaxf(v1[j], 0.f); v0[j] = r0 * r0; v1[j] = r1 * r1; }
                    u32x4 w; w.x = cvtpk(v0[0], v0[1]); w.y = cvtpk(v0[2], v0[3]); w.z = cvtpk(v1[0], v1[1]); w.w = cvtpk(v1[2], v1[3]);
                    __builtin_nontemporal_store(w, (u32x4*)(rowp + bj * 128)); }
                asm volatile("" ::: "memory"); }
    }
};
struct EpiU {
    static constexpr bool PERM = true, AFTER_DRAIN = false;
    int kind, mode; const void* p0; void* p1; void* p2; int dry;
    __device__ __forceinline__ void operator()(const f32x4 (&acc)[2][2][4][2], const pg8::Unit& u, int a, int b, int c, int d) const {
        if (dry) return;
        if (kind == 0) { EpiInproj e{(unsigned char*)p1}; e(acc, u, a, b, c, d); }
        else if (kind == 1) { EpiMerge e{(const unsigned char*)p0, (float*)p1, (bf16_t*)p2, mode}; e(acc, u, a, b, c, d); }
        else if (kind == 2) { EpiResid e{(const float*)p0, (float*)p1, (const float*)p2}; e(acc, u, a, b, c, d); }
        else { EpiRelu2 e{(bf16_t*)p1}; e(acc, u, a, b, c, d); }
    }
};
template <class Epi>
__device__ __forceinline__ void run_gemm(unsigned char* lds, const bf16_t* A, int lda, const bf16_t* Bt, int N, int K, const Epi& E) {
    pg8::Gemm g{A, Bt, T, N, K, lda}; pg8::StaticOrder S; S.init(T, N, (int)gridDim.x, (int)blockIdx.x);
    pg8::gemm_phase<Epi, pg8::StaticOrder, true, true>((PG8_LAS unsigned char*)lds, g, S, E);
}

__device__ __forceinline__ void phase_pre(const Params& p, unsigned char* lds, const int tid) {
    float* cs = (float*)lds; float* red = cs + 4096;
    const float* c = PIN(1); const float* ada_w = PIN(2); const float* ada_b = PIN(3);
    float* mod = (float*)(p.ws + O_MOD);
    for (int i = tid; i < 4096; i += 512) { const float v = c[i]; cs[i] = v / (1.f + expf(-v)); }
    __syncthreads();
    { float* rot = (float*)(p.ws + O_ROT);
      for (int e = blockIdx.x * 512 + tid; e < 4096 * 8; e += gridDim.x * 512) { const int pos = e >> 3, j = e & 7;
          const float inv_freq = powf(500000.0f, -(float)j * 0.125f); const float ang = (float)pos * inv_freq;
          rot[pos * 16 + j] = cosf(ang); rot[pos * 16 + 8 + j] = sinf(ang); } }
    const int jj = tid & 63, ks = tid >> 6;
    for (int it = blockIdx.x; it < DEPTH * 96; it += gridDim.x) {
        const int l = it / 96, jb = it % 96;
        const float* w = ada_w + (size_t)l * 1024 * 6144 + jb * 64 + jj;
        float a0 = 0.f, a1 = 0.f, a2 = 0.f, a3 = 0.f;
#pragma unroll 8
        for (int k = ks * 128; k < ks * 128 + 128; ++k) { const float wv = w[(size_t)k * 6144]; a0 += cs[k] * wv; a1 += cs[1024 + k] * wv; a2 += cs[2048 + k] * wv; a3 += cs[3072 + k] * wv; }
        red[(ks * 64 + jj) * 4 + 0] = a0; red[(ks * 64 + jj) * 4 + 1] = a1; red[(ks * 64 + jj) * 4 + 2] = a2; red[(ks * 64 + jj) * 4 + 3] = a3;
        __syncthreads();
        if (tid < 256) { const int b = tid >> 6, j2 = tid & 63; float s = 0.f;
#pragma unroll
            for (int q = 0; q < 8; ++q) s += red[(q * 64 + j2) * 4 + b];
            const int cc = jb * 64 + j2; mod[((size_t)l * 4 + b) * 6144 + cc] = s + ada_b[l * 6144 + cc]; }
        __syncthreads();
    }
}

__device__ __forceinline__ int inproj_src_col(int n) {
    if (n < 2560) return n;
    if (n < 6144) return n + 8;
    if (n < 10240) return n + 20;
    if (n < 10248) return 2560 + (n - 10240);
    if (n < 10260) return 6152 + (n - 10248);
    return -1;
}
__device__ __forceinline__ void transpose_item(const float* W, int K, int Nsrc, bf16_t* WT, float* scr, int k0, int n0, int lane, bool remap) {
    const int nd = n0 + (lane & 31); const int sc = remap ? inproj_src_col(nd) : nd;
#pragma unroll
    for (int i = 0; i < 32; ++i) { const int kk = 2 * i + (lane >> 5); scr[kk * 33 + (lane & 31)] = (sc >= 0) ? W[(size_t)(k0 + kk) * Nsrc + sc] : 0.f; }
    LDS_WAIT();
    const int c = lane & 7;
#pragma unroll
    for (int j = 0; j < 4; ++j) { const int n = (lane >> 3) + 8 * j; const float* s = scr + (8 * c) * 33 + n;
        u32x4 o; o.x = cvtpk(s[0 * 33], s[1 * 33]); o.y = cvtpk(s[2 * 33], s[3 * 33]); o.z = cvtpk(s[4 * 33], s[5 * 33]); o.w = cvtpk(s[6 * 33], s[7 * 33]);
        *(u32x4*)(WT + (size_t)(n0 + n) * K + k0 + 8 * c) = o; }
    LDS_WAIT();
}
__device__ __forceinline__ void convert_weights(const Params& p, int l, unsigned char* lds, int gw, int NGW, int wid, int lane) {
    float* scr = (float*)(lds + wid * 16384);
    unsigned char* ws = p.ws;
    constexpr int I_IN = 16 * (NPROJ / 32), I_BR = 8 * 32, I_D = 12 * 32, I_O = 16 * 32, I_1 = 16 * 128, I_2 = 64 * 32;
    constexpr int TOT = I_IN + 3 * I_BR + I_D + I_O + I_1 + I_2;
    for (int it = gw; it < TOT; it += NGW) {
        int r = it; const float* W; bf16_t* WT; int K, Nsrc, Nd; bool remap = false;
        if (r < I_IN) { W = PIN(5) + (size_t)l * 1024 * IN_COLS; WT = (bf16_t*)(ws + O_WIN); K = 1024; Nsrc = IN_COLS; Nd = NPROJ; remap = true; }
        else if ((r -= I_IN) < I_BR) { W = PIN(17) + (size_t)l * 512 * 1024; WT = (bf16_t*)(ws + O_WA); K = 512; Nsrc = 1024; Nd = 1024; }
        else if ((r -= I_BR) < I_BR) { W = PIN(18) + (size_t)l * 512 * 1024; WT = (bf16_t*)(ws + O_WB); K = 512; Nsrc = 1024; Nd = 1024; }
        else if ((r -= I_BR) < I_BR) { W = PIN(19) + (size_t)l * 512 * 1024; WT = (bf16_t*)(ws + O_WC); K = 512; Nsrc = 1024; Nd = 1024; }
        else if ((r -= I_BR) < I_D) { W = PIN(20) + (size_t)l * 768 * 1024; WT = (bf16_t*)(ws + O_WD); K = 768; Nsrc = 1024; Nd = 1024; }
        else if ((r -= I_D) < I_O) { W = PIN(21) + (size_t)l * 1024 * 1024; WT = (bf16_t*)(ws + O_WO); K = 1024; Nsrc = 1024; Nd = 1024; }
        else if ((r -= I_O) < I_1) { W = PIN(23) + (size_t)l * 1024 * 4096; WT = (bf16_t*)(ws + O_W1); K = 1024; Nsrc = 4096; Nd = 4096; }
        else { r -= I_1; W = PIN(24) + (size_t)l * 4096 * 1024; WT = (bf16_t*)(ws + O_W2); K = 4096; Nsrc = 1024; Nd = 1024; }
        const int nblk = Nd / 32, kb = r / nblk, nb = r % nblk;
        transpose_item(W, K, Nsrc, WT, scr, 64 * kb, 32 * nb, lane, remap);
    }
    const float* gws = PIN(8) + (size_t)l * 8 * 128 * 128; bf16_t* gd = (bf16_t*)(ws + O_GWS);
    for (int e = gw * 64 + lane; e < 8 * 128 * 128; e += NGW * 64) { const int s = e & 127, t = (e >> 7) & 127; const float v = (s <= t) ? gws[e] : 0.f; gd[e] = (bf16_t)(cvtpk(v, 0.f) & 0xffffu); }
}
__device__ __forceinline__ void norm_mod_rows(const float* x, const float* w, const float* sh, const float* sc, bf16_t* out, int gw, int NGW, int lane) {
    const int per = T / NGW;
    const int rbeg = gw * per; const int b = rbeg >> 12;
    f32x4 ws[4], hv[4];
#pragma unroll
    for (int j = 0; j < 4; ++j) { const int col = 4 * (64 * j + lane);
        ws[j] = *(const f32x4*)(w + col) * (*(const f32x4*)(sc + (size_t)b * 6144 + col) + 1.f); hv[j] = *(const f32x4*)(sh + (size_t)b * 6144 + col); }
#pragma unroll 2
    for (int r = 0; r < per; ++r) {
        const int row = rbeg + r; const f32x4* xr = (const f32x4*)(x + (size_t)row * 1024) + lane;
        f32x4 v[4]; float ss = 0.f;
#pragma unroll
        for (int j = 0; j < 4; ++j) { v[j] = xr[64 * j]; ss += (v[j][0] * v[j][0] + v[j][1] * v[j][1]) + (v[j][2] * v[j][2] + v[j][3] * v[j][3]); }
        const float rstd = rsqrtf(wave_sum(ss) * (1.f / 1024.f) + NORM_EPS);
#pragma unroll
        for (int j = 0; j < 4; ++j) { const int col = 4 * (64 * j + lane);
            const f32x4 o = (v[j] * rstd) * ws[j] + hv[j];
            u32x2 pk; pk.x = cvtpk(o[0], o[1]); pk.y = cvtpk(o[2], o[3]); *(u32x2*)(out + (size_t)row * 1024 + col) = pk; }
    }
}
__device__ __forceinline__ void final_norm_rows(const float* x, const float* w, float* out, int gw, int NGW, int lane) {
    for (int row = gw; row < T; row += NGW) {
        const f32x4* xr = (const f32x4*)(x + (size_t)row * 1024) + lane;
        f32x4 v[4]; float ss = 0.f;
#pragma unroll
        for (int j = 0; j < 4; ++j) { v[j] = xr[64 * j]; ss += (v[j][0] * v[j][0] + v[j][1] * v[j][1]) + (v[j][2] * v[j][2] + v[j][3] * v[j][3]); }
        const float rstd = rsqrtf(wave_sum(ss) * (1.f / 1024.f) + NORM_EPS);
#pragma unroll
        for (int j = 0; j < 4; ++j) { const int col = 4 * (64 * j + lane); const f32x4 wv = *(const f32x4*)(w + col);
            *(f32x4*)(out + (size_t)row * 1024 + col) = v[j] * rstd * wv; }
    }
}

__device__ __forceinline__ void gmlp_item(const Params& p, int l, unsigned char* lds, int item, int wid, int lane) {
    const int half = item & 1, ch = (item >> 1) & 31, b = item >> 6;
    const int fr = lane & 15, fq = lane >> 4;
    bf16_t* UV = (bf16_t*)(p.ws + O_UV); const bf16_t* GWS = (const bf16_t*)(p.ws + O_GWS);
    const float* lnw = PIN(6) + l * 512; const float* lnb = PIN(7) + l * 512;
    bf16_t* vnT = (bf16_t*)lds;
    const size_t row0 = (size_t)b * SEQ + ch * 128;
#pragma unroll 8
    for (int r = 0; r < 16; ++r) {
        const int s = wid * 16 + r;
        const bf16x8 raw = *(const bf16x8*)(UV + (row0 + s) * 1024 + 512 + 8 * lane);
        float x[8]; float sum = 0.f;
#pragma unroll
        for (int j = 0; j < 8; ++j) { x[j] = bf2f(raw[j]); sum += x[j]; }
        const float mean = wave_sum(sum) * (1.f / 512.f); float sq = 0.f;
#pragma unroll
        for (int j = 0; j < 8; ++j) { x[j] -= mean; sq += x[j] * x[j]; }
        const float rstd = rsqrtf(wave_sum(sq) * (1.f / 512.f) + NORM_EPS);
        if ((lane >> 5) == half) { const int c0 = (lane & 31) * 8;
#pragma unroll
            for (int j = 0; j < 8; ++j) { const int cc = half * 256 + c0 + j; const float o = x[j] * rstd * lnw[cc] + lnb[cc]; vnT[(c0 + j) * 136 + s] = (bf16_t)(cvtpk(o, 0.f) & 0xffffu); } }
    }
    __syncthreads();
    const int t0 = wid * 16; const int nks = (t0 + 15) / 32 + 1;
#pragma unroll 1
    for (int g4 = 0; g4 < 4; ++g4) {
        const int grp = half * 4 + g4;
        f32x4 acc[4];
#pragma unroll
        for (int ct = 0; ct < 4; ++ct) acc[ct] = (f32x4){0.f, 0.f, 0.f, 0.f};
        for (int ks = 0; ks < nks; ++ks) {
            const bf16x8 bw = *(const bf16x8*)(GWS + ((size_t)grp * 128 + t0 + fr) * 128 + ks * 32 + 8 * fq);
#pragma unroll
            for (int ct = 0; ct < 4; ++ct) { const bf16x8 av = *(const bf16x8*)(vnT + (g4 * 64 + ct * 16 + fr) * 136 + ks * 32 + 8 * fq); acc[ct] = mfma16(av, bw, acc[ct]); }
        }
        const float bsv = (PIN(9) + (size_t)l * 8 * 128 + grp * 128)[t0 + fr];
#pragma unroll
        for (int ct = 0; ct < 4; ++ct) { bf16_t* up = UV + (row0 + t0 + fr) * 1024 + grp * 64 + ct * 16 + 4 * fq;
            const u32x2 uw = *(const u32x2*)up; u32x2 o;
            o.x = cvtpk(bflo(uw.x) * (acc[ct][0] + bsv), bfhi(uw.x) * (acc[ct][1] + bsv)); o.y = cvtpk(bflo(uw.y) * (acc[ct][2] + bsv), bfhi(uw.y) * (acc[ct][3] + bsv));
            *(u32x2*)up = o; }
    }
    __syncthreads();
}
__device__ __forceinline__ void rotary_item(const Params& p, unsigned char* lds, int item, int tid, bool dry = false) {
    const int h = item & 7, nb = (item >> 3) & 15, b = item >> 7;
    float* sums = (float*)lds;
    if (tid < 64) sums[tid] = 0.f;
    __syncthreads();
    bf16_t* MQ = (bf16_t*)(p.ws + O_MQKV);
    const int half = (tid >> 5) & 1, tt = (tid >> 6) * 32 + (tid & 31); const int pos = nb * 256 + tt; const size_t row = (size_t)b * SEQ + pos;
    bf16_t* kp = MQ + row * 1536 + 512 + h * 64 + half * 32;
    float kv[32];
#pragma unroll
    for (int q = 0; q < 4; ++q) { const bf16x8 raw = *(const bf16x8*)(kp + 8 * q);
#pragma unroll
        for (int j = 0; j < 8; ++j) kv[8 * q + j] = bf2f(raw[j]); }
    if (half == 0 && !dry) {
        bf16_t* qp = MQ + row * 1536 + h * 64;
        float qv[16];
        { const bf16x8 r0 = *(const bf16x8*)qp, r1 = *(const bf16x8*)(qp + 8);
#pragma unroll
          for (int j = 0; j < 8; ++j) { qv[j] = bf2f(r0[j]); qv[8 + j] = bf2f(r1[j]); } }
        const float* rt = (const float*)(p.ws + O_ROT) + pos * 16;
        const f32x4 c0 = *(const f32x4*)rt, c1 = *(const f32x4*)(rt + 4), s0 = *(const f32x4*)(rt + 8), s1 = *(const f32x4*)(rt + 12);
#pragma unroll
        for (int j = 0; j < 8; ++j) {
            const float cs = (j < 4) ? c0[j & 3] : c1[j & 3], sn = (j < 4) ? s0[j & 3] : s1[j & 3];
            const float k1 = kv[j], k2 = kv[8 + j]; kv[j] = k1 * cs - k2 * sn; kv[8 + j] = k2 * cs + k1 * sn;
            const float q1 = qv[j], q2 = qv[8 + j]; qv[j] = q1 * cs - q2 * sn; qv[8 + j] = q2 * cs + q1 * sn;
        }
        *(bf16x8*)kp = pack8(kv[0], kv[1], kv[2], kv[3], kv[4], kv[5], kv[6], kv[7]);
        *(bf16x8*)(kp + 8) = pack8(kv[8], kv[9], kv[10], kv[11], kv[12], kv[13], kv[14], kv[15]);
        *(bf16x8*)qp = pack8(qv[0], qv[1], qv[2], qv[3], qv[4], qv[5], qv[6], qv[7]);
        *(bf16x8*)(qp + 8) = pack8(qv[8], qv[9], qv[10], qv[11], qv[12], qv[13], qv[14], qv[15]);
    }
#pragma unroll
    for (int d = 0; d < 32; ++d) {
        float v = row16_sum(kv[d]); v += __shfl_xor(v, 16);
        if ((tid & 31) == 0) atomicAdd(&sums[half * 32 + d], v);
    }
    __syncthreads();
    if (tid < 64) ((float*)(p.ws + O_KMEAN))[(((size_t)b * 8 + h) * 16 + nb) * 64 + tid] = sums[tid] * (1.f / 256.f);
    __syncthreads();
}
__device__ __forceinline__ void vt_item(const Params& p, unsigned char* lds, int item, int tid) {
    const int tb = item & 31, h = (item >> 5) & 7, b = (item >> 8) & 3, which = item >> 10;
    const bf16_t* src = (const bf16_t*)(p.ws + (which ? O_MQKV : O_FQKV)) + ((size_t)b * SEQ + tb * 128) * 1536 + 1024 + h * 64;
    bf16_t* dst = (bf16_t*)(p.ws + (which ? O_VTM : O_VTF)) + ((size_t)(b * 8 + h) * 64) * 4096 + tb * 128;
    bf16_t* tl = (bf16_t*)lds;
    { const int tok = tid >> 2, dq = tid & 3;
      const bf16x8 r0 = *(const bf16x8*)(src + (size_t)tok * 1536 + dq * 16), r1 = *(const bf16x8*)(src + (size_t)tok * 1536 + dq * 16 + 8);
#pragma unroll
      for (int j = 0; j < 8; ++j) { tl[(dq * 16 + j) * 136 + tok] = (bf16_t)r0[j]; tl[(dq * 16 + 8 + j) * 136 + tok] = (bf16_t)r1[j]; } }
    __syncthreads();
    { const int d = tid >> 3, c = tid & 7;
      const bf16x8 a = *(const bf16x8*)(tl + d * 136 + c * 16), bq = *(const bf16x8*)(tl + d * 136 + c * 16 + 8);
      *(bf16x8*)(dst + (size_t)d * 4096 + c * 16) = a; *(bf16x8*)(dst + (size_t)d * 4096 + c * 16 + 8) = bq; }
    __syncthreads();
}
__device__ __forceinline__ void conv_item(const Params& p, int l, int item, int tid) {
    const int cb = item % 20, sp = (item / 20) & 15, b = item / 320;
    const int c8 = tid & 7, tq = tid >> 3; const int gc = cb * 64 + 8 * c8;
    const int t0 = sp * 256 + tq * 4;
    const bf16_t* xp = (const bf16_t*)(p.ws + O_XBC) + ((size_t)b * SEQ) * 1280 + gc;
    float v[7][8];
#pragma unroll
    for (int r = 0; r < 7; ++r) { const int t = t0 - 3 + r;
        if (t >= 0) { const bf16x8 raw = *(const bf16x8*)(xp + (size_t)t * 1280);
#pragma unroll
            for (int j = 0; j < 8; ++j) v[r][j] = bf2f(raw[j]); }
        else {
#pragma unroll
            for (int j = 0; j < 8; ++j) v[r][j] = 0.f; } }
    const float* cw = PIN(11) + (size_t)l * 4 * 1280 + gc; const float* cbp = PIN(12) + l * 1280 + gc;
    float w[4][8], bias[8];
#pragma unroll
    for (int kk = 0; kk < 4; ++kk) { const f32x4 a = *(const f32x4*)(cw + kk * 1280), bq = *(const f32x4*)(cw + kk * 1280 + 4);
#pragma unroll
        for (int j = 0; j < 4; ++j) { w[kk][j] = a[j]; w[kk][4 + j] = bq[j]; } }
    { const f32x4 a = *(const f32x4*)cbp, bq = *(const f32x4*)(cbp + 4);
#pragma unroll
      for (int j = 0; j < 4; ++j) { bias[j] = a[j]; bias[4 + j] = bq[j]; } }
    float o[4][8];
#pragma unroll
    for (int tt = 0; tt < 4; ++tt)
#pragma unroll
        for (int j = 0; j < 8; ++j) { const float x = bias[j] + w[0][j] * v[tt][j] + w[1][j] * v[tt + 1][j] + w[2][j] * v[tt + 2][j] + w[3][j] * v[tt + 3][j]; o[tt][j] = x / (1.f + __expf(-x)); }
    const size_t tok0 = (size_t)b * SEQ + t0;
    if (cb < 12) {
        bf16_t* d = (bf16_t*)(p.ws + O_XT) + ((size_t)(b * 12 + cb) * 64 + 8 * c8) * 4096 + t0;
#pragma unroll
        for (int j = 0; j < 8; ++j) { u32x2 q; q.x = cvtpk(o[0][j], o[1][j]); q.y = cvtpk(o[2][j], o[3][j]); *(u32x2*)(d + (size_t)j * 4096) = q; }
    } else {
        bf16_t* BC = (bf16_t*)(p.ws + O_BC); const int bc = gc - 768;
#pragma unroll
        for (int tt = 0; tt < 4; ++tt) *(bf16x8*)(BC + (tok0 + tt) * 512 + bc) = pack8(o[tt][0], o[tt][1], o[tt][2], o[tt][3], o[tt][4], o[tt][5], o[tt][6], o[tt][7]);
        if (cb < 16) { bf16_t* d = (bf16_t*)(p.ws + O_BT) + ((size_t)b * 256 + bc) * 4096 + t0;
#pragma unroll
            for (int j = 0; j < 8; ++j) { u32x2 q; q.x = cvtpk(o[0][j], o[1][j]); q.y = cvtpk(o[2][j], o[3][j]); *(u32x2*)(d + (size_t)j * 4096) = q; } }
    }
}
__device__ __forceinline__ void acum_item(const Params& p, int l, int item, int lane) {
    const int ch = item & 31, h = (item >> 5) % 12, b = item / 384;
    const float* sm = (const float*)(p.ws + O_SMALL); const float a = -expf(PIN(14)[l * 12 + h]);
    const size_t tok = (size_t)b * SEQ + ch * 128 + 2 * lane;
    const float dtb = PIN(13)[l * 12 + h];
    const f32x2 raw = *(const f32x2*)(sm + (size_t)(8 + h) * T + tok); const float d0 = softplusf_(raw[0] + dtb), d1 = softplusf_(raw[1] + dtb);
    { f32x2 dd = {d0, d1}; *(f32x2*)((float*)(p.ws + O_DT) + ((size_t)(b * 12 + h)) * 4096 + ch * 128 + 2 * lane) = dd; }
    const float v0 = d0 * a, v1 = d1 * a;
    float sc = v0 + v1;
#pragma unroll
    for (int o = 1; o < 64; o <<= 1) { const float t = __shfl_up(sc, o); if (lane >= o) sc += t; }
    const float ex = sc - (v0 + v1);
    f32x2 r = {ex + v0, ex + v0 + v1};
    *(f32x2*)((float*)(p.ws + O_ACUM) + ((size_t)(b * 12 + h)) * 4096 + ch * 128 + 2 * lane) = r;
}
__device__ __forceinline__ void foxcum_item(const Params& p, int l, int item, int lane) {
    const int h = item & 7, b = item >> 3; const float fb = PIN(10)[l * 8 + h];
    const float* sm = (const float*)(p.ws + O_SMALL) + (size_t)h * T + (size_t)b * SEQ + lane * 64;
    float* cum = (float*)(p.ws + O_CUMF) + (size_t)(b * 8 + h) * 4096 + lane * 64;
    float v[64];
#pragma unroll
    for (int i = 0; i < 64; i += 4) { const f32x4 q = *(const f32x4*)(sm + i); v[i] = q[0]; v[i + 1] = q[1]; v[i + 2] = q[2]; v[i + 3] = q[3]; }
    float run = 0.f;
#pragma unroll
    for (int i = 0; i < 64; ++i) { const float x = v[i] + fb; run += fminf(x, 0.f) - __logf(1.f + __expf(-fabsf(x))); v[i] = run; }
    float sc = run;
#pragma unroll
    for (int o = 1; o < 64; o <<= 1) { const float t = __shfl_up(sc, o); if (lane >= o) sc += t; }
    const float ex = sc - run;
#pragma unroll
    for (int i = 0; i < 64; i += 4) { f32x4 w = {v[i] + ex, v[i + 1] + ex, v[i + 2] + ex, v[i + 3] + ex}; *(f32x4*)(cum + i) = w; }
}

template <bool MOBA, int VPITCH>
__device__ __forceinline__ void attn_tile64(const bf16_t* KL, const bf16_t* VL, const float* CL, int k0, bool diag, int kb,
                                            const bf16x8 (&qf)[2][2], const float (&cq)[2], const unsigned (&sel)[2], int qpos0, int fr, int fq,
                                            f32x4 (&lacc)[2], f32x4 (&o)[4][2]) {
    bf16x8 kf[4][2], vf[2][4]; f32x4 nck[4];
#pragma unroll
    for (int jk = 0; jk < 4; ++jk) { kf[jk][0] = *(const bf16x8*)(KL + (16 * jk + fr) * 72 + 8 * fq); kf[jk][1] = *(const bf16x8*)(KL + (16 * jk + fr) * 72 + 32 + 8 * fq); }
#pragma unroll
    for (int jk = 0; jk < 4; ++jk) nck[jk] = MOBA ? (f32x4){0.f, 0.f, 0.f, 0.f} : *(const f32x4*)(CL + 16 * jk + 4 * fq);
#pragma unroll
    for (int dt = 0; dt < 4; ++dt) { const bf16_t* vp = VL + (4 * fq + (fr >> 2)) * VPITCH + dt * 16 + 4 * (fr & 3); vf[0][dt] = cat4(lds_tr(vp), lds_tr(vp + 16 * VPITCH)); }
    __builtin_amdgcn_sched_barrier(0);
    f32x4 s[4][2];
    __builtin_amdgcn_s_setprio(1);
#pragma unroll
    for (int jk = 0; jk < 4; ++jk)
#pragma unroll
        for (int jq = 0; jq < 2; ++jq) { f32x4 z = {0.f, 0.f, 0.f, 0.f}; z = mfma16(kf[jk][0], qf[jq][0], z); s[jk][jq] = mfma16(kf[jk][1], qf[jq][1], z); }
    __builtin_amdgcn_s_setprio(0);
    __builtin_amdgcn_sched_barrier(0);
#pragma unroll
    for (int dt = 0; dt < 4; ++dt) { const bf16_t* vp = VL + (32 + 4 * fq + (fr >> 2)) * VPITCH + dt * 16 + 4 * (fr & 3); vf[1][dt] = cat4(lds_tr(vp), lds_tr(vp + 16 * VPITCH)); }
    __builtin_amdgcn_sched_barrier(0);
    constexpr float C2 = 0.125f * LOG2E;
#pragma unroll
    for (int jk = 0; jk < 4; ++jk)
#pragma unroll
        for (int jq = 0; jq < 2; ++jq)
#pragma unroll
            for (int i = 0; i < 4; ++i) s[jk][jq][i] = MOBA ? s[jk][jq][i] * C2 : fmaf(s[jk][jq][i], C2, nck[jk][i] + cq[jq]);
    if (diag) {
#pragma unroll
        for (int jk = 0; jk < 4; ++jk)
#pragma unroll
            for (int jq = 0; jq < 2; ++jq)
#pragma unroll
                for (int i = 0; i < 4; ++i) if (k0 + 16 * jk + 4 * fq + i > qpos0 + 16 * jq + fr) s[jk][jq][i] = -INFINITY;
    }
    if (MOBA && kb >= 0) {
#pragma unroll
        for (int jq = 0; jq < 2; ++jq) if (!((sel[jq] >> kb) & 1u)) {
#pragma unroll
            for (int jk = 0; jk < 4; ++jk) s[jk][jq] = (f32x4){-INFINITY, -INFINITY, -INFINITY, -INFINITY}; }
    }
    bf16x8 pb[2][2];
#pragma unroll
    for (int jq = 0; jq < 2; ++jq) {
#pragma unroll
        for (int jk = 0; jk < 4; ++jk)
#pragma unroll
            for (int i = 0; i < 4; ++i) s[jk][jq][i] = ex2(fminf(s[jk][jq][i], 100.f));
        pb[jq][0] = pack8(s[0][jq][0], s[0][jq][1], s[0][jq][2], s[0][jq][3], s[1][jq][0], s[1][jq][1], s[1][jq][2], s[1][jq][3]);
        pb[jq][1] = pack8(s[2][jq][0], s[2][jq][1], s[2][jq][2], s[2][jq][3], s[3][jq][0], s[3][jq][1], s[3][jq][2], s[3][jq][3]);
    }
    const u32x4 onesw = {0x3f803f80u, 0x3f803f80u, 0x3f803f80u, 0x3f803f80u}; const bf16x8 ones = __builtin_bit_cast(bf16x8, onesw);
    __builtin_amdgcn_s_setprio(1);
#pragma unroll
    for (int hh = 0; hh < 2; ++hh) {
#pragma unroll
        for (int jq = 0; jq < 2; ++jq) lacc[jq] = mfma16(ones, pb[jq][hh], lacc[jq]);
#pragma unroll
        for (int dt = 0; dt < 4; ++dt)
#pragma unroll
            for (int jq = 0; jq < 2; ++jq) o[dt][jq] = mfma16(vf[hh][dt], pb[jq][hh], o[dt][jq]);
    }
    __builtin_amdgcn_s_setprio(0);
}
__device__ __forceinline__ unsigned moba_select(const bf16_t* qp, const float* km, int own) {
    const bf16x8 r0 = *(const bf16x8*)qp, r1 = *(const bf16x8*)(qp + 8);
    float qd[16];
#pragma unroll
    for (int j = 0; j < 8; ++j) { qd[j] = bf2f(r0[j]); qd[8 + j] = bf2f(r1[j]); }
    float gate[15];
#pragma unroll
    for (int n = 0; n < 15; ++n) {
        float a = -INFINITY;
        if (n < own) { a = 0.f;
#pragma unroll
            for (int d = 0; d < 16; d += 4) { const f32x4 kk = *(const f32x4*)(km + n * 64 + d); a += qd[d] * kk[0] + qd[d + 1] * kk[1] + qd[d + 2] * kk[2] + qd[d + 3] * kk[3]; }
            a += __shfl_xor(a, 16); a += __shfl_xor(a, 32); }
        gate[n] = a;
    }
    unsigned msk = 0u;
#pragma unroll
    for (int pass = 0; pass < 3; ++pass) { float best = -INFINITY; int bi = -1;
#pragma unroll
        for (int n = 0; n < 15; ++n) { const float v = ((msk >> n) & 1u) ? -INFINITY : gate[n]; if (v > best) { best = v; bi = n; } }
        if (bi >= 0) msk |= 1u << bi; }
    return msk;
}
template <bool MOBA>
__device__ __forceinline__ void attn_block_item(const Params& p, unsigned char* lds, int b, int h, int qb, int tid_in, int wid, int lane_in) {
    int tid = tid_in, lane = lane_in; asm volatile("" : "+v"(tid), "+v"(lane));
    const int fr = lane & 15, fq = lane >> 4; const int q0 = qb * 256 + wid * 32;
    bf16_t* qkv = (bf16_t*)(p.ws + (MOBA ? O_MQKV : O_FQKV)) + ((size_t)b * SEQ) * 1536 + h * 64;
    const bf16_t* kbase = qkv + 512; const bf16_t* vtbase = (const bf16_t*)(p.ws + (MOBA ? O_VTM : O_VTF)) + ((size_t)(b * 8 + h) * 64) * 4096;
    const float* cum = (const float*)(p.ws + O_CUMF) + (size_t)(b * 8 + h) * 4096;
    bf16x8 qf[2][2];
#pragma unroll
    for (int jq = 0; jq < 2; ++jq)
#pragma unroll
        for (int ks = 0; ks < 2; ++ks) qf[jq][ks] = *(const bf16x8*)(qkv + (size_t)(q0 + 16 * jq + fr) * 1536 + ks * 32 + 8 * fq);
    float cq[2] = {0.f, 0.f}; unsigned sel[2] = {0u, 0u}; unsigned umask = 0u;
    const int own = qb;
    if (!MOBA) { cq[0] = cum[q0 + fr] * LOG2E; cq[1] = cum[q0 + 16 + fr] * LOG2E; }
    if (MOBA && own > 0) {
        const float* km = (const float*)(p.ws + O_KMEAN) + ((size_t)(b * 8 + h) * 16) * 64 + 16 * fq;
        sel[0] = moba_select(qkv + (size_t)(q0 + fr) * 1536 + 16 * fq, km, own);
        __builtin_amdgcn_sched_barrier(0);
        sel[1] = moba_select(qkv + (size_t)(q0 + 16 + fr) * 1536 + 16 * fq, km, own);
        __builtin_amdgcn_sched_barrier(0);
        umask = sel[0] | sel[1];
#pragma unroll
        for (int o2 = 1; o2 < 16; o2 <<= 1) umask |= __shfl_xor(umask, o2);
        umask = __builtin_amdgcn_readfirstlane(umask);
    }
    f32x4 lacc[2] = {(f32x4){0.f, 0.f, 0.f, 0.f}, (f32x4){0.f, 0.f, 0.f, 0.f}}; f32x4 o[4][2];
#pragma unroll
    for (int dt = 0; dt < 4; ++dt) { o[dt][0] = (f32x4){0.f, 0.f, 0.f, 0.f}; o[dt][1] = (f32x4){0.f, 0.f, 0.f, 0.f}; }
    const int NT = 2 * (qb + 1);
    constexpr int VP = 80;
    bf16_t* KLb = (bf16_t*)lds; bf16_t* VLb = KLb + 2 * 128 * 72;
    float* CLb = (float*)(VLb + 2 * 128 * VP);
    const int lr = tid >> 3, lc = (tid & 7) * 8;
    #define STEP_KT(i) (MOBA ? (((i) < 2) ? 2 * qb + (i) : (i) - 2) : (i))
    bf16x8 kreg0, kreg1, vreg0, vreg1; f32x4 creg = {0.f, 0.f, 0.f, 0.f};
    #define LOAD_STEP(kk0) do { kreg0 = *(const bf16x8*)(kbase + (size_t)((kk0) + lr) * 1536 + lc); kreg1 = *(const bf16x8*)(kbase + (size_t)((kk0) + 64 + lr) * 1536 + lc); \
        vreg0 = *(const bf16x8*)(kbase + 512 + (size_t)((kk0) + lr) * 1536 + lc); vreg1 = *(const bf16x8*)(kbase + 512 + (size_t)((kk0) + 64 + lr) * 1536 + lc); \
        if (!MOBA && tid < 32) creg = *(const f32x4*)(cum + (kk0) + 4 * tid) * (-LOG2E); } while (0)
    #define STORE_STEP(bb) do { *(bf16x8*)(KLb + (bb) * 128 * 72 + lr * 72 + lc) = kreg0; *(bf16x8*)(KLb + (bb) * 128 * 72 + (lr + 64) * 72 + lc) = kreg1; \
        *(bf16x8*)(VLb + (bb) * 128 * VP + lr * VP + lc) = vreg0; *(bf16x8*)(VLb + (bb) * 128 * VP + (lr + 64) * VP + lc) = vreg1; \
        if (!MOBA && tid < 32) *(f32x4*)(CLb + (bb) * 128 + 4 * tid) = creg; } while (0)
    int i_start = 0;
    if (!MOBA) {
        const float cq0 = cum[qb * 256];
        const float ce = (lane < NT) ? cum[lane * 128 + 127] : 0.f;
        const bool need = (lane < NT) && ((cq0 - ce) * LOG2E >= -64.f);
        const unsigned long long bal = __ballot(need);
        i_start = __builtin_amdgcn_readfirstlane(bal ? (int)__ffsll((long long)bal) - 1 : NT - 1);
    }
    LOAD_STEP(STEP_KT(i_start) * 128); STORE_STEP(0);
    __syncthreads();
#pragma unroll 1
    for (int i = i_start; i < NT; ++i) {
        const int k0 = STEP_KT(i) * 128; const int buf = (i - i_start) & 1;
        if (i + 1 < NT) LOAD_STEP(STEP_KT(i + 1) * 128);
        const bf16_t* KL = KLb + buf * 128 * 72; const bf16_t* VL = VLb + buf * 128 * VP; const float* CL = CLb + buf * 128;
        const int kb = k0 >> 8;
        const bool live = !MOBA || kb == own || ((umask >> kb) & 1u);
        if (live) {
#pragma unroll
            for (int hh = 0; hh < 2; ++hh) { const int k0h = k0 + 64 * hh;
                if (k0h <= q0 + 31) attn_tile64<MOBA, VP>(KL + hh * 64 * 72, VL + hh * 64 * VP, CL + hh * 64, k0h, k0h + 63 > q0, (MOBA && kb < own) ? kb : -1, qf, cq, sel, q0, fr, fq, lacc, o); }
        }
        if (i + 1 < NT) STORE_STEP(buf ^ 1);
        __syncthreads();
    }
    #undef STEP_KT
    #undef LOAD_STEP
    #undef STORE_STEP
#pragma unroll
    for (int jq = 0; jq < 2; ++jq) {
        const float inv = 1.f / lacc[jq][0];
        bf16_t* op = qkv + (size_t)(q0 + 16 * jq + fr) * 1536 + 4 * fq;
#pragma unroll
        for (int dt = 0; dt < 4; ++dt) { const f32x4 v = o[dt][jq] * inv; u32x2 w; w.x = cvtpk(v[0], v[1]); w.y = cvtpk(v[2], v[3]); *(u32x2*)(op + dt * 16) = w; }
    }
}
__device__ __forceinline__ void ssd_states_item(const Params& p, int item, int lane) {
    const int h = item % 12, c = (item / 12) & 31, b = item / 384; const int grp = h / 6;
    const int fr = lane & 15, fq = lane >> 4;
    const float* ac = (const float*)(p.ws + O_ACUM) + (size_t)(b * 12 + h) * 4096 + c * 128;
    const float* dtp = (const float*)(p.ws + O_DT) + (size_t)(b * 12 + h) * 4096 + c * 128;
    const bf16_t* XT = (const bf16_t*)(p.ws + O_XT) + ((size_t)(b * 12 + h) * 64) * 4096 + c * 128;
    const bf16_t* BT = (const bf16_t*)(p.ws + O_BT) + ((size_t)(b * 2 + grp) * 128) * 4096 + c * 128;
    float* ST = (float*)(p.ws + O_ST) + ((size_t)((b * 32 + c) * 12 + h)) * 8192;
    const float total = ac[127];
    {
        f32x4 acc[4][8];
#pragma unroll
        for (int pt = 0; pt < 4; ++pt)
#pragma unroll
            for (int nt = 0; nt < 8; ++nt) acc[pt][nt] = (f32x4){0.f, 0.f, 0.f, 0.f};
#pragma unroll 1
        for (int ks = 0; ks < 4; ++ks) {
            const int s0 = ks * 32 + 8 * fq;
            const f32x4 a0 = *(const f32x4*)(ac + s0), a1 = *(const f32x4*)(ac + s0 + 4);
            const f32x4 d0 = *(const f32x4*)(dtp + s0), d1 = *(const f32x4*)(dtp + s0 + 4);
            bf16x8 bfr[8], xa[4];
#pragma unroll
            for (int nt = 0; nt < 8; ++nt) bfr[nt] = *(const bf16x8*)(BT + (size_t)(nt * 16 + fr) * 4096 + s0);
#pragma unroll
            for (int pt = 0; pt < 4; ++pt) xa[pt] = *(const bf16x8*)(XT + (size_t)(pt * 16 + fr) * 4096 + s0);
            float w8[8];
#pragma unroll
            for (int j = 0; j < 4; ++j) { w8[j] = __expf(total - a0[j]) * d0[j]; w8[4 + j] = __expf(total - a1[j]) * d1[j]; }
#pragma unroll
            for (int pt = 0; pt < 4; ++pt) {
                const bf16x8 af = pack8(bf2f(xa[pt][0]) * w8[0], bf2f(xa[pt][1]) * w8[1], bf2f(xa[pt][2]) * w8[2], bf2f(xa[pt][3]) * w8[3], bf2f(xa[pt][4]) * w8[4], bf2f(xa[pt][5]) * w8[5], bf2f(xa[pt][6]) * w8[6], bf2f(xa[pt][7]) * w8[7]);
#pragma unroll
                for (int nt = 0; nt < 8; ++nt) acc[pt][nt] = mfma16(bfr[nt], af, acc[pt][nt]); }
        }
#pragma unroll
        for (int pt = 0; pt < 4; ++pt)
#pragma unroll
            for (int nt = 0; nt < 8; ++nt) *(f32x4*)(ST + (size_t)(pt * 16 + fr) * 128 + nt * 16 + 4 * fq) = acc[pt][nt];
    }
}
__device__ __forceinline__ void ssd_scan(const Params& p, int gtid, int gthreads) {
    const float* ST = (const float*)(p.ws + O_ST); bf16_t* PV = (bf16_t*)(p.ws + O_PREV); const float* ACUM = (const float*)(p.ws + O_ACUM);
    for (int e4 = gtid; e4 < NB * 12 * 2048; e4 += gthreads) {
        const int pn = (e4 & 2047) * 4, h = (e4 >> 11) % 12, b = e4 / (12 * 2048);
        const float* ac = ACUM + (size_t)(b * 12 + h) * 4096 + 127;
        const size_t base = ((size_t)(b * 32) * 12 + h) * 8192 + pn;
        f32x4 hs = {0.f, 0.f, 0.f, 0.f};
#pragma unroll 8
        for (int c = 0; c < 32; ++c) { const f32x4 st = *(const f32x4*)(ST + base + (size_t)c * 12 * 8192); const float dc = __expf(ac[c * 128]);
            u32x2 q; q.x = cvtpk(hs[0], hs[1]); q.y = cvtpk(hs[2], hs[3]); *(u32x2*)(PV + base + (size_t)c * 12 * 8192) = q;
            hs = hs * dc + st; }
    }
}
__device__ __forceinline__ void ssd_out_item(const Params& p, int l, int item, int wid, int lane, bool dry = false) {
    const int grp = item & 1, c = (item >> 1) & 31, b = item >> 6;
    const int fr = lane & 15, fq = lane >> 4; const int w = wid; const int tl = 16 * w + fr;
    const size_t row0 = (size_t)b * SEQ + c * 128; const size_t row = row0 + tl;
    const bf16_t* BC = (const bf16_t*)(p.ws + O_BC);
    bf16_t* Z = (bf16_t*)(p.ws + O_Z);
    bf16x8 cf[4];
#pragma unroll
    for (int ks = 0; ks < 4; ++ks) cf[ks] = *(const bf16x8*)(BC + row * 512 + 256 + grp * 128 + ks * 32 + 8 * fq);
    f32x4 cbt[8];
#pragma unroll
    for (int js = 0; js < 8; ++js) { cbt[js] = (f32x4){0.f, 0.f, 0.f, 0.f};
        if (js <= w) {
#pragma unroll
            for (int ks = 0; ks < 4; ++ks) { const bf16x8 a = *(const bf16x8*)(BC + (row0 + js * 16 + fr) * 512 + grp * 128 + ks * 32 + 8 * fq); cbt[js] = mfma16(a, cf[ks], cbt[js]); } } }
    float ssq = 0.f;
#pragma unroll 1
    for (int r = 0; r < 6; ++r) {
        const int h = grp * 6 + r;
        const float* ac = (const float*)(p.ws + O_ACUM) + (size_t)(b * 12 + h) * 4096 + c * 128;
        const float* dtp = (const float*)(p.ws + O_DT) + (size_t)(b * 12 + h) * 4096 + c * 128;
        const float acl = ac[tl]; const float eacl = __expf(acl); const float Dh = PIN(15)[l * 12 + h];
        const bf16_t* PV = (const bf16_t*)(p.ws + O_PREV) + ((size_t)((b * 32 + c) * 12 + h)) * 8192;
        const bf16_t* XT = (const bf16_t*)(p.ws + O_XT) + ((size_t)(b * 12 + h) * 64) * 4096 + c * 128;
        f32x4 yt[4];
#pragma unroll
        for (int pt = 0; pt < 4; ++pt) yt[pt] = (f32x4){0.f, 0.f, 0.f, 0.f};
#pragma unroll
        for (int ks = 0; ks < 4; ++ks)
#pragma unroll
            for (int pt = 0; pt < 4; ++pt) { const bf16x8 a = *(const bf16x8*)(PV + (size_t)(pt * 16 + fr) * 128 + ks * 32 + 8 * fq); yt[pt] = mfma16(a, cf[ks], yt[pt]); }
#pragma unroll
        for (int pt = 0; pt < 4; ++pt) yt[pt] = yt[pt] * eacl;
#pragma unroll
        for (int jp = 0; jp < 4; ++jp) {
            if (2 * jp <= w) {
                const int sA = 32 * jp + 4 * fq, sB = sA + 16;
                const f32x4 a0 = *(const f32x4*)(ac + sA), a1 = *(const f32x4*)(ac + sB), dv0 = *(const f32x4*)(dtp + sA), dv1 = *(const f32x4*)(dtp + sB);
                float mv[8];
#pragma unroll
                for (int j = 0; j < 4; ++j) {
                    const int s = sA + j; const float d0 = dv0[j];
                    float v = (s <= tl) ? cbt[2 * jp][j] * __expf(acl - a0[j]) * d0 : 0.f; if (s == tl) v += Dh; mv[j] = v;
                    const int s2 = sB + j; const float d1 = dv1[j];
                    float v2 = (s2 <= tl) ? cbt[2 * jp + 1][j] * __expf(acl - a1[j]) * d1 : 0.f; if (s2 == tl) v2 += Dh; mv[4 + j] = v2;
                }
                const bf16x8 mb = pack8(mv[0], mv[1], mv[2], mv[3], mv[4], mv[5], mv[6], mv[7]);
#pragma unroll
                for (int pt = 0; pt < 4; ++pt) { const bf16_t* xp = XT + (size_t)(pt * 16 + fr) * 4096 + sA; yt[pt] = mfma16(ld2x8(xp, xp + 16), mb, yt[pt]); }
            }
        }
#pragma unroll
        for (int pt = 0; pt < 4; ++pt) { bf16_t* zp = Z + row * 768 + h * 64 + pt * 16 + 4 * fq; const u32x2 zw = *(const u32x2*)zp;
            const float y0 = yt[pt][0] * bflo(zw.x), y1 = yt[pt][1] * bfhi(zw.x), y2 = yt[pt][2] * bflo(zw.y), y3 = yt[pt][3] * bfhi(zw.y);
            ssq += (y0 * y0 + y1 * y1) + (y2 * y2 + y3 * y3);
            u32x2 o; o.x = cvtpk(y0, y1); o.y = cvtpk(y2, y3); if (!dry) *(u32x2*)zp = o; }
    }
    ssq += __shfl_xor(ssq, 16); ssq += __shfl_xor(ssq, 32);
    if (dry) return;
    const float rstd = rsqrtf(ssq * (1.f / 384.f) + NORM_EPS);
    VM_WAIT();
    const float* nw = PIN(16) + l * 768 + grp * 384;
    bf16_t* zp0 = Z + row * 768 + grp * 384 + 4 * fq;
#pragma unroll 4
    for (int q = 0; q < 24; ++q) { bf16_t* zp = zp0 + q * 16; const u32x2 zw = *(const u32x2*)zp; const f32x4 nv = *(const f32x4*)(nw + q * 16 + 4 * fq);
        u32x2 o; o.x = cvtpk(bflo(zw.x) * rstd * nv[0], bfhi(zw.x) * rstd * nv[1]); o.y = cvtpk(bflo(zw.y) * rstd * nv[2], bfhi(zw.y) * rstd * nv[3]); *(u32x2*)zp = o; }
}

__device__ __forceinline__ void small_cols_item(const bf16_t* Hh, const bf16_t* Wt, float* sm, int item, int lane) {
    const int fr = lane & 15, fq = lane >> 4; const size_t row0 = (size_t)item * 16;
    const bf16_t* ap = Hh + (row0 + fr) * 1024 + 8 * fq; const bf16_t* b0p = Wt + (size_t)fr * 1024 + 8 * fq; const bf16_t* b1p = b0p + 16 * 1024;
    f32x4 acc0[2] = {(f32x4){0.f, 0.f, 0.f, 0.f}, (f32x4){0.f, 0.f, 0.f, 0.f}}, acc1[2] = {(f32x4){0.f, 0.f, 0.f, 0.f}, (f32x4){0.f, 0.f, 0.f, 0.f}};
#pragma unroll 8
    for (int ks = 0; ks < 32; ++ks) {
        const bf16x8 a = *(const bf16x8*)(ap + ks * 32), w0 = *(const bf16x8*)(b0p + ks * 32), w1 = *(const bf16x8*)(b1p + ks * 32);
        acc0[ks & 1] = mfma16(a, w0, acc0[ks & 1]); acc1[ks & 1] = mfma16(a, w1, acc1[ks & 1]);
    }
    const f32x4 r0 = acc0[0] + acc0[1], r1 = acc1[0] + acc1[1];
    *(f32x4*)(sm + (size_t)fr * T + row0 + 4 * fq) = r0; *(f32x4*)(sm + (size_t)(16 + fr) * T + row0 + 4 * fq) = r1;
}
#define LAS __attribute__((address_space(3)))
#define XB_TMO      128
#define XB_XCNT(j)  (256  + 64 * (j))
#define XB_XSUB(j)  (1280 + 64 * (j))
#define XB_XGEN(j)  (2304 + 64 * (j))
#define XB_TOP      3328
#define XB_TOPGEN   3392
#define XCD_BAR_WORDS 3456
#define XB_SPIN_CAP (1u << 18)

__device__ __forceinline__ unsigned xb_ld(unsigned* p)              { return __hip_atomic_load(p, __ATOMIC_RELAXED, __HIP_MEMORY_SCOPE_AGENT); }
__device__ __forceinline__ unsigned xb_add(unsigned* p, unsigned v) { return __hip_atomic_fetch_add(p, v, __ATOMIC_RELAXED, __HIP_MEMORY_SCOPE_AGENT); }
__device__ __forceinline__ unsigned xb_xcc_id() { return (unsigned)__builtin_amdgcn_s_getreg((3 << 11) | 20) & 0xFu; }
#define XB_SPIN(cond, bar) do { unsigned _sp = 0; while (cond) { __builtin_amdgcn_s_sleep(1); \
    if ((++_sp & 255u) == 0u) { if (xb_ld(&(bar)[XB_TMO])) break; if (_sp > XB_SPIN_CAP) { atomicAdd(&(bar)[XB_TMO], 1u); break; } } } } while (0)

struct XcdBarrier {
    unsigned* bar; unsigned x;
    volatile LAS unsigned* st;
};

__device__ __forceinline__ XcdBarrier xcd_barrier_post(unsigned* bar, volatile LAS unsigned* st) {
    XcdBarrier b; b.bar = bar; b.x = xb_xcc_id(); b.st = st;
    if (threadIdx.x == 0) (void)xb_add(&bar[XB_XCNT(b.x)], 1u);
    return b;
}
__device__ __forceinline__ void xcd_barrier_complete(unsigned* bar, unsigned x, unsigned& nloc, unsigned& nx) {
    const unsigned G = gridDim.x * gridDim.y * gridDim.z;
    unsigned sum, cnt, mine, sp = 0u;
    for (;;) {
        sum = 0u; cnt = 0u; mine = 0u;
#pragma unroll
        for (unsigned j = 0; j < 16; ++j) { const unsigned c = xb_ld(&bar[XB_XCNT(j)]); sum += c; cnt += (c > 0u) ? 1u : 0u; mine = (j == x) ? c : mine; }
        if (sum == G) break;
        __builtin_amdgcn_s_sleep(1);
        if ((++sp & 255u) == 0u) { if (xb_ld(&bar[XB_TMO])) break; if (sp > XB_SPIN_CAP) { atomicAdd(&bar[XB_TMO], 1u); break; } }
    }
    nloc = mine > 0u ? mine : 1u; nx = cnt > 0u ? cnt : 1u;
}

__device__ __forceinline__ void xcd_barrier(const XcdBarrier& b) {
    asm volatile("s_waitcnt vmcnt(0)" ::: "memory");
    __syncthreads();
    if (threadIdx.x == 0) {
        unsigned* bar = b.bar;
        __builtin_amdgcn_s_waitcnt(0);
        unsigned nloc = b.st[0], nx = b.st[1];
        if (nloc == 0u) { xcd_barrier_complete(bar, b.x, nloc, nx); b.st[0] = nloc; b.st[1] = nx; }
        const unsigned old = xb_add(&bar[XB_XSUB(b.x)], 1u);
        const unsigned gen = old / nloc;
        if (old + 1u == (gen + 1u) * nloc) {
            __builtin_amdgcn_fence(__ATOMIC_RELEASE, "agent");
            asm volatile("s_waitcnt vmcnt(0)" ::: "memory");
            const unsigned og = xb_add(&bar[XB_TOP], 1u);
            const unsigned tg = og / nx;
            if (og + 1u == (tg + 1u) * nx) xb_add(&bar[XB_TOPGEN], 1u);
            else XB_SPIN(xb_ld(&bar[XB_TOPGEN]) == tg, bar);
            __builtin_amdgcn_fence(__ATOMIC_ACQUIRE, "agent");
            xb_add(&bar[XB_XGEN(b.x)], 1u);
            asm volatile("s_waitcnt vmcnt(0)" ::: "memory");
        } else {
            XB_SPIN(xb_ld(&bar[XB_XGEN(b.x)]) == gen, bar);
            __builtin_amdgcn_fence(__ATOMIC_ACQUIRE, "agent");
            asm volatile("s_waitcnt vmcnt(0)" ::: "memory");
        }
    }
    __syncthreads();
}

constexpr int PH_PER_LAYER = 11, N_PHASES = 1 + DEPTH * PH_PER_LAYER + 1;
template <int EN_MASK, bool EN_GEMM>
__device__ __forceinline__ void fwd_body(const Params& p) {
    extern __shared__ __attribute__((aligned(16))) unsigned char lds[];
    cg::grid_group grid = cg::this_grid();
    const int G = gridDim.x, NGW = G * 8;
    unsigned char* ws = p.ws;
    volatile LAS unsigned* MISC = (volatile LAS unsigned*)((LAS unsigned char*)lds + 132096);
    if (threadIdx.x < 2) MISC[threadIdx.x] = 0u;
    __syncthreads();
    XcdBarrier xbar = xcd_barrier_post((unsigned*)(ws + O_CTL), MISC);
    float* mod = (float*)(ws + O_MOD); float* X = (float*)(ws + O_X); bf16_t* H = (bf16_t*)(ws + O_H);
    for (int ph = p.ph_lo; ph < p.ph_hi; ++ph) {
        int tid = threadIdx.x; asm volatile("" : "+v"(tid));
        const int lane = tid & 63, wid = __builtin_amdgcn_readfirstlane(tid >> 6); const int gw = blockIdx.x * 8 + wid;
        if (ph == 0) { if constexpr (EN_MASK != 0) phase_pre(p, lds, tid); }
        else if (ph == N_PHASES - 1) { if constexpr (EN_MASK != 0) final_norm_rows(X, PIN(25), p.out, gw, NGW, lane); }
        else {
            const int l = (ph - 1) / PH_PER_LAYER, k = (ph - 1) % PH_PER_LAYER;
            const float* modl = mod + (size_t)l * 4 * 6144;
            const float* xin = (l == 0) ? PIN(0) : X;
            if (k == 1 || k == 6 || k == 7 || k == 9 || k == 10) { if constexpr (EN_GEMM) {
                const int nsub = (k == 6) ? 4 : 1;
#pragma unroll 1
                for (int br = 0; br < nsub; ++br) {
                    EpiU E{}; const bf16_t* A; const bf16_t* Bt; int lda, N, K;
                    if (k == 1) { E.kind = 0; E.p1 = ws; A = H; lda = 1024; Bt = (const bf16_t*)(ws + O_WIN); N = NPROJ - 256; K = 1024; }
                    else if (k == 6) {
                        const size_t aoffs = (br == 0) ? O_UV : (br == 1) ? O_FQKV : (br == 2) ? O_MQKV : O_Z;
                        const size_t woffs = (br == 0) ? O_WA : (br == 1) ? O_WB : (br == 2) ? O_WC : O_WD;
                        E.kind = 1; E.p0 = (const unsigned char*)(ws + O_GATE) + br * 1024; E.p1 = (float*)(ws + O_MF32); E.p2 = H; E.mode = (br == 0) ? 0 : (br == 3) ? 2 : 1;
                        A = (const bf16_t*)(ws + aoffs); lda = (br == 0) ? 1024 : (br == 3) ? 768 : 1536; Bt = (const bf16_t*)(ws + woffs); N = 1024; K = (br == 3) ? 768 : 512; }
                    else if (k == 7) { E.kind = 2; E.p0 = xin; E.p1 = X; E.p2 = (void*)(modl + 2048); A = H; lda = 1024; Bt = (const bf16_t*)(ws + O_WO); N = 1024; K = 1024; }
                    else if (k == 9) { E.kind = 3; E.p1 = (bf16_t*)(ws + O_HID); A = H; lda = 1024; Bt = (const bf16_t*)(ws + O_W1); N = 4096; K = 1024; }
                    else { E.kind = 2; E.p0 = X; E.p1 = X; E.p2 = (void*)(modl + 5120); A = (const bf16_t*)(ws + O_HID); lda = 4096; Bt = (const bf16_t*)(ws + O_W2); N = 1024; K = 4096; }
#ifdef PROBE_DUP_GEMM
                    E.dry = (p.ph_lo == 0); run_gemm(lds, A, lda, Bt, N, K, E); E.dry = 0;
#endif
#ifndef STAGGER_TICKS
#define STAGGER_TICKS 0
#endif
                    if (STAGGER_TICKS > 0 && (k == 1 || k == 9)) {
                        const unsigned long long t0 = __builtin_amdgcn_s_memrealtime(); const unsigned long long dl = (unsigned long long)(((blockIdx.x >> 3) & 3) * STAGGER_TICKS);
                        while (__builtin_amdgcn_s_memrealtime() - t0 < dl) __builtin_amdgcn_s_sleep(16);
                    }
                    run_gemm(lds, A, lda, Bt, N, K, E);
                }
                if (k == 1) for (int it = gw; it < 1024; it += NGW) small_cols_item((const bf16_t*)H, (const bf16_t*)(ws + O_WIN) + (size_t)10240 * 1024, (float*)(ws + O_SMALL), it, lane);
            } } else switch (k) {
            case 0: if constexpr ((EN_MASK >> 0) & 1) {
#ifdef PROBE_A
                convert_weights(p, l, lds, gw, NGW, wid, lane); norm_mod_rows(xin, PIN(4) + l * 1024, modl + 0, modl + 1024, H, gw, NGW, lane);
#endif
                convert_weights(p, l, lds, gw, NGW, wid, lane);
                norm_mod_rows(xin, PIN(4) + l * 1024, modl + 0, modl + 1024, H, gw, NGW, lane);
            } break;
            case 2: if constexpr ((EN_MASK >> 2) & 1) {
#ifdef PROBE_C
                { const bool dry = (p.ph_lo == 0);
                for (int it = blockIdx.x; it < 1024; it += G) gmlp_item(p, l, lds, it, wid, lane, dry);
                for (int it = blockIdx.x; it < 512; it += G) rotary_item(p, lds, it, tid, dry);
                for (int it = blockIdx.x; it < 1280; it += G) conv_item(p, l, it, tid);
                for (int it = gw; it < 1536; it += NGW) acum_item(p, l, it, lane);
                for (int it = NGW - 1 - gw; it < 32; it += NGW) foxcum_item(p, l, it, lane); }
#endif
                for (int it = blockIdx.x; it < 256; it += G) gmlp_item(p, l, lds, it, wid, lane);
                for (int it = blockIdx.x; it < 512; it += G) rotary_item(p, lds, it, tid);
                for (int it = blockIdx.x; it < 1280; it += G) conv_item(p, l, it, tid);
                for (int it = gw; it < 1536; it += NGW) acum_item(p, l, it, lane);
                for (int it = NGW - 1 - gw; it < 32; it += NGW) foxcum_item(p, l, it, lane);
            } break;
            case 3: if constexpr ((EN_MASK >> 3) & 1) {
#ifndef EN3
#define EN3 7
#endif
                { unsigned* qctr = (unsigned*)(ws + O_CTL) + 3584 + 64 * l;
                  volatile unsigned* slot = (volatile unsigned*)(lds + 131584);
                  for (;;) {
                      if (tid == 0) *slot = atomicAdd(qctr, 1u);
                      __syncthreads();
                      const unsigned it = (unsigned)__builtin_amdgcn_readfirstlane((int)*slot);
                      __syncthreads();
                      if (it >= 1024u) break;
                      const int qb = 15 - (int)(it >> 6), sub = (int)(it & 63u), bh = sub & 31;
                      if (sub < 32) attn_block_item<false>(p, lds, bh >> 3, bh & 7, qb, tid, wid, lane);
                      else attn_block_item<true>(p, lds, bh >> 3, bh & 7, qb, tid, wid, lane);
                  } }
                if constexpr (EN3 & 4) for (int i = NGW - 1 - gw; i < 1536; i += NGW) ssd_states_item(p, i, lane);
            } break;
            case 4: if constexpr ((EN_MASK >> 4) & 1) {
#ifdef PROBE_EF
                ssd_scan(p, blockIdx.x * 512 + tid, G * 512);
#endif
                ssd_scan(p, blockIdx.x * 512 + tid, G * 512); } break;
            case 5: if constexpr ((EN_MASK >> 5) & 1) {
#ifdef PROBE_EF
                for (int it = blockIdx.x; it < 256; it += G) ssd_out_item(p, l, it, wid, lane, p.ph_lo == 0);
#endif
                for (int it = blockIdx.x; it < 256; it += G) ssd_out_item(p, l, it, wid, lane); } break;
            case 8: if constexpr ((EN_MASK >> 8) & 1) { norm_mod_rows(X, PIN(22) + l * 1024, modl + 3072, modl + 4096, H, gw, NGW, lane); } break;
            }
        }
        if (ph + 1 < p.ph_hi) { if (ph == 0) grid.sync(); else xcd_barrier(xbar); }
#ifdef PROBE_SYNC
        if (ph + 1 < p.ph_hi) { xcd_barrier(xbar); xcd_barrier(xbar); }
#endif
    }
}

#ifndef N_LAUNCH_MODE
#define N_LAUNCH_MODE 1
#endif
#if N_LAUNCH_MODE == 1
__global__ void __launch_bounds__(512, 2) fwd_all(Params p) { fwd_body<0x7ff, true>(p); }
#define KERNEL_FOR_ATTR fwd_all
#else
__global__ void __launch_bounds__(512, 2) fwd_gemm(Params p) { fwd_body<0, true>(p); }
__global__ void __launch_bounds__(512, 2) fwd_misc(Params p) { fwd_body<0x7ff, false>(p); }
#endif
extern "C" void kernel_launch(void* const* d_in, const int* in_sizes, int n_in, void* d_out, int out_size, void* d_ws, size_t ws_size, hipStream_t stream) {
    static int grid = 0;
    if (grid == 0) {
        if (n_in != 26 || out_size != T * DM || ws_size < WS_END) { fprintf(stderr, "kernel_launch: unexpected shapes (n_in %d out %d ws %zu need %zu)\n", n_in, out_size, ws_size, (size_t)WS_END); grid = -1; return; }
        int dev = 0, cus = 0;
        (void)hipGetDevice(&dev); (void)hipDeviceGetAttribute(&cus, hipDeviceAttributeMultiprocessorCount, dev);
#if N_LAUNCH_MODE == 1
        if (hipFuncSetAttribute((const void*)fwd_all, hipFuncAttributeMaxDynamicSharedMemorySize, LDS_BYTES) != hipSuccess) { fprintf(stderr, "kernel_launch: hipFuncSetAttribute failed\n"); grid = -1; return; }
#else
        if (hipFuncSetAttribute((const void*)fwd_gemm, hipFuncAttributeMaxDynamicSharedMemorySize, LDS_BYTES) != hipSuccess || hipFuncSetAttribute((const void*)fwd_misc, hipFuncAttributeMaxDynamicSharedMemorySize, LDS_BYTES) != hipSuccess) { fprintf(stderr, "kernel_launch: hipFuncSetAttribute failed\n"); grid = -1; return; }
#endif
        (void)hipGetLastError();
        grid = cus > 0 ? cus : 256;
    }
    if (grid < 0) return;
    if (hipMemsetAsync((char*)d_ws + O_CTL, 0, 16384, stream) != hipSuccess) { fprintf(stderr, "kernel_launch: memset failed\n"); return; }
    Params p{};
    for (int i = 0; i < 26; ++i) p.in[i] = (const float*)d_in[i];
    p.out = (float*)d_out; p.ws = (unsigned char*)d_ws;
#if N_LAUNCH_MODE == 1
    p.ph_lo = 0; p.ph_hi = N_PHASES;
    void* args[] = {&p};
    hipError_t e = hipLaunchCooperativeKernel((const void*)fwd_all, dim3(grid), dim3(512), args, LDS_BYTES, stream);
    if (e != hipSuccess) fprintf(stderr, "kernel_launch: cooperative launch failed: %s (grid %d)\n", hipGetErrorString(e), grid);
#else
    for (int ph = 0; ph < N_PHASES; ++ph) { p.ph_lo = ph; p.ph_hi = ph + 1;
        const int k = (ph >= 1 && ph < N_PHASES - 1) ? (ph - 1) % PH_PER_LAYER : -1;
        if (k == 1 || k == 6 || k == 7 || k == 9 || k == 10) hipLaunchKernelGGL(fwd_gemm, dim3(grid), dim3(512), LDS_BYTES, stream, p);
        else hipLaunchKernelGGL(fwd_misc, dim3(grid), dim3(512), LDS_BYTES, stream, p); }
#endif
}
```
